# Optimizing an MI355X kernel written in HIP

```python
import jax, jax.numpy as jnp
from jax import lax
import numpy as np

D_MODEL = 2048
BATCH = 2
SEQ = 8192
DEPTH = 1

HEAD_DIM = 128
ATTN_WIDTH = D_MODEL // 2
N_ATTN_HEADS = ATTN_WIDTH // HEAD_DIM
POOL_WIDTH = D_MODEL - ATTN_WIDTH
POOL_SIZES = (2, 4, 8, 16)
N_POOL_GROUPS = len(POOL_SIZES)
POOL_GROUP = POOL_WIDTH // N_POOL_GROUPS
MIX_WIDTH = ATTN_WIDTH + POOL_WIDTH
IN_WIDTH = 3 * ATTN_WIDTH + POOL_WIDTH
DILATED_PATTERNS = ((128, 1), (512, 4), (2048, 16))
ATTN_BLOCK = 128
ROPE_THETA = 500000.0
ROPE_DIM = HEAD_DIM // 4
PEER_HEADS = 8
PEER_NKEYS = 128
PEER_EXPERTS = PEER_NKEYS * PEER_NKEYS
PEER_QDIM = 256
PEER_TOPK = 16
PEER_CHUNK = 128
NORM_EPS = 1e-6
NEG_BIG = -1e30

kernel_name = "hybrid_dilated_pool_peer_adaln"


def _rmsnorm(x, g):
    xf = x.astype(jnp.float32)
    y = xf * lax.rsqrt(jnp.mean(xf * xf, axis=-1, keepdims=True) + NORM_EPS)
    return (y * g.astype(jnp.float32)).astype(x.dtype)


def _modulate(h, shift, scale):
    return h * (1 + scale[:, None, :]) + shift[:, None, :]


def _rotary(x, positions):
    half = ROPE_DIM // 2
    inv = ROPE_THETA ** (-jnp.arange(half, dtype=jnp.float32) * 2.0 / ROPE_DIM)
    ang = positions.astype(jnp.float32)[..., None] * inv
    cos = jnp.cos(ang)[:, :, None, :]
    sin = jnp.sin(ang)[:, :, None, :]
    xf = x.astype(jnp.float32)
    x1 = xf[..., :half]
    x2 = xf[..., half:ROPE_DIM]
    out = jnp.concatenate([x1 * cos - x2 * sin, x2 * cos + x1 * sin, xf[..., ROPE_DIM:]], axis=-1)
    return out.astype(x.dtype)


def _dilated_window_attention(q, k, v, window, dil):
    B, H, S, hd = q.shape
    n_back = window // dil
    L = S // dil
    nb = -(-L // ATTN_BLOCK)
    Lp = nb * ATTN_BLOCK

    def to_blocks(a):
        a = a.reshape(B, H, L, dil, hd).transpose(0, 1, 3, 2, 4)
        a = jnp.pad(a, ((0, 0), (0, 0), (0, 0), (0, Lp - L), (0, 0)))
        return a.reshape(B, H, dil, nb, ATTN_BLOCK, hd)

    def with_prev(a):
        prev = jnp.pad(a, ((0, 0), (0, 0), (0, 0), (1, 0), (0, 0), (0, 0)))[:, :, :, :nb]
        return jnp.concatenate([prev, a], axis=4)

    qb, kb, vb = to_blocks(q), to_blocks(k), to_blocks(v)
    kk, vv = with_prev(kb), with_prev(vb)
    s = jnp.einsum('bhrnqd,bhrnkd->bhrnqk', qb, kk, preferred_element_type=jnp.float32)
    q_idx = jnp.arange(nb)[:, None, None] * ATTN_BLOCK + jnp.arange(ATTN_BLOCK)[None, :, None]
    k_idx = jnp.arange(nb)[:, None, None] * ATTN_BLOCK - ATTN_BLOCK + jnp.arange(2 * ATTN_BLOCK)[None, None, :]
    dist = q_idx - k_idx
    valid = (dist >= 0) & (dist <= n_back) & (k_idx >= 0)
    s = jnp.where(valid, s, NEG_BIG)
    m = jnp.max(s, axis=-1, keepdims=True)
    p = jnp.exp(s - m)
    den = jnp.sum(p, axis=-1, keepdims=True)
    o = jnp.einsum('bhrnqk,bhrnkd->bhrnqd', p, vv.astype(jnp.float32)) / den
    lse = (m + jnp.log(den))[..., 0]

    def from_blocks(a, tail):
        a = a.reshape((B, H, dil, Lp) + tail)[:, :, :, :L]
        a = jnp.moveaxis(a, 2, 3)
        return a.reshape((B, H, S) + tail)

    return from_blocks(o, (hd,)), from_blocks(lse, ())


def _mixed_dilated_attention(q, k, v):
    outs, lses = [], []
    for window, dil in DILATED_PATTERNS:
        o, l = _dilated_window_attention(q, k, v, window, dil)
        outs.append(o)
        lses.append(l)
    w = jax.nn.softmax(jnp.stack(lses, axis=0), axis=0)
    return jnp.einsum('pbhs,pbhsd->bhsd', w, jnp.stack(outs, axis=0))


def _multiscale_pool(u, w_pool, pool_scale):
    B, S, _ = u.shape
    uf = u.astype(jnp.float32).reshape(B, S, N_POOL_GROUPS, POOL_GROUP)
    cs = jnp.cumsum(uf, axis=1)
    t = jnp.arange(S)
    means = []
    for gi, p in enumerate(POOL_SIZES):
        c_g = cs[:, :, gi]
        prev = jnp.pad(c_g, ((0, 0), (p, 0), (0, 0)))[:, :S]
        cnt = jnp.minimum(t + 1, p).astype(jnp.float32)[None, :, None]
        means.append((c_g - prev) / cnt)
    r = jnp.stack(means, axis=2) - uf
    y = jnp.einsum('bsgc,gce->bsge', r, w_pool.astype(jnp.float32))
    return (y.reshape(B, S, POOL_WIDTH) * pool_scale.astype(jnp.float32)).astype(u.dtype)


def _peer(h, w_query, sub_keys, peer_u, peer_v):
    B, S, D = h.shape
    T = B * S
    xt = h.reshape(T, D)
    q = (xt @ w_query).reshape(T, PEER_HEADS, 2, PEER_QDIM // 2).astype(jnp.float32)
    scores = jnp.einsum('thpc,hpnc->thpn', q, sub_keys.astype(jnp.float32))
    s_half, i_half = lax.top_k(scores, PEER_TOPK)
    cand = (s_half[:, :, 0, :, None] + s_half[:, :, 1, None, :]).reshape(T, PEER_HEADS, PEER_TOPK * PEER_TOPK)
    cand_idx = (i_half[:, :, 0, :, None] * PEER_NKEYS + i_half[:, :, 1, None, :]).reshape(T, PEER_HEADS, PEER_TOPK * PEER_TOPK)
    top_s, pos = lax.top_k(cand, PEER_TOPK)
    idx = jnp.take_along_axis(cand_idx, pos, axis=-1)
    gate = jax.nn.softmax(top_s, axis=-1)
    n_chunks = T // PEER_CHUNK

    def chunk(args):
        xc, ic, gc = args
        u = peer_u[ic]
        a = jnp.einsum('cd,chkd->chk', xc, u, preferred_element_type=jnp.float32)
        act = jax.nn.gelu(a, approximate=False) * gc
        vg = peer_v[ic]
        return jnp.einsum('chk,chkd->cd', act, vg.astype(jnp.float32)).astype(h.dtype)

    y = lax.map(chunk, (xt.reshape(n_chunks, PEER_CHUNK, D),
                        idx.reshape(n_chunks, PEER_CHUNK, PEER_HEADS, PEER_TOPK),
                        gate.reshape(n_chunks, PEER_CHUNK, PEER_HEADS, PEER_TOPK)))
    return y.reshape(B, S, D)


def setup_inputs(seed: int = 0) -> dict:
    key = jax.random.key(seed)
    ks = jax.random.split(key, 16)
    f32 = jnp.float32
    x = jax.random.normal(ks[0], (BATCH, SEQ, D_MODEL), f32)
    c = jax.random.normal(ks[1], (BATCH, D_MODEL), f32)
    positions = (jnp.arange(SEQ, dtype=jnp.int32)[None, :]
                 + jax.random.randint(ks[2], (BATCH, 1), 0, 1024, dtype=jnp.int32))
    w_mod = jax.random.normal(ks[3], (DEPTH, D_MODEL, 6 * D_MODEL), f32) * D_MODEL ** -0.5
    b_mod = jax.random.normal(ks[4], (DEPTH, 6 * D_MODEL), f32) * 0.02
    norm1_g = 1.0 + 0.02 * jax.random.normal(ks[5], (DEPTH, D_MODEL), f32)
    w_in = jax.random.normal(ks[6], (DEPTH, D_MODEL, IN_WIDTH), f32) * D_MODEL ** -0.5
    w_pool = jax.random.normal(ks[7], (DEPTH, N_POOL_GROUPS, POOL_GROUP, POOL_GROUP), f32) * POOL_GROUP ** -0.5
    pool_scale = 1.0 + 0.1 * jax.random.normal(ks[8], (DEPTH, POOL_WIDTH), f32)
    w_out = jax.random.normal(ks[9], (DEPTH, MIX_WIDTH, D_MODEL), f32) * MIX_WIDTH ** -0.5
    norm2_g = 1.0 + 0.02 * jax.random.normal(ks[10], (DEPTH, D_MODEL), f32)
    w_query = jax.random.normal(ks[11], (DEPTH, D_MODEL, PEER_HEADS * PEER_QDIM), f32) * D_MODEL ** -0.5
    sub_keys = jax.random.normal(ks[12], (DEPTH, PEER_HEADS, 2, PEER_NKEYS, PEER_QDIM // 2), f32) * (PEER_QDIM // 2) ** -0.5
    peer_u = jax.random.normal(ks[13], (DEPTH, PEER_EXPERTS, D_MODEL), f32) * D_MODEL ** -0.5
    peer_v = jax.random.normal(ks[14], (DEPTH, PEER_EXPERTS, D_MODEL), f32) * PEER_HEADS ** -0.5
    final_g = 1.0 + 0.02 * jax.random.normal(ks[15], (D_MODEL,), f32)
    return {"x": x, "c": c, "positions": positions, "w_mod": w_mod, "b_mod": b_mod,
            "norm1_g": norm1_g, "w_in": w_in, "w_pool": w_pool, "pool_scale": pool_scale,
            "w_out": w_out, "norm2_g": norm2_g, "w_query": w_query, "sub_keys": sub_keys,
            "peer_u": peer_u, "peer_v": peer_v, "final_g": final_g}


def reference(x, c, positions, w_mod, b_mod, norm1_g, w_in, w_pool, pool_scale,
              w_out, norm2_g, w_query, sub_keys, peer_u, peer_v, final_g):
    B, S, D = x.shape
    A = ATTN_WIDTH
    for l in range(DEPTH):
        mod = jax.nn.silu(c) @ w_mod[l] + b_mod[l]
        shift1, scale1, gate1, shift2, scale2, gate2 = jnp.split(mod, 6, axis=-1)

        h = _modulate(_rmsnorm(x, norm1_g[l]), shift1, scale1)
        z = h @ w_in[l]
        q, k, v, u = jnp.split(z, [A, 2 * A, 3 * A], axis=-1)
        q = _rotary(q.reshape(B, S, N_ATTN_HEADS, HEAD_DIM), positions) * (HEAD_DIM ** -0.5)
        k = _rotary(k.reshape(B, S, N_ATTN_HEADS, HEAD_DIM), positions)
        v = v.reshape(B, S, N_ATTN_HEADS, HEAD_DIM)
        q, k, v = (t.transpose(0, 2, 1, 3) for t in (q, k, v))
        attn = _mixed_dilated_attention(q, k, v)
        attn = attn.transpose(0, 2, 1, 3).reshape(B, S, A).astype(x.dtype)
        pool = _multiscale_pool(u, w_pool[l], pool_scale[l])
        mix = jnp.concatenate([attn, pool], axis=-1) @ w_out[l]
        x = x + gate1[:, None, :] * mix

        h = _modulate(_rmsnorm(x, norm2_g[l]), shift2, scale2)
        x = x + gate2[:, None, :] * _peer(h, w_query[l], sub_keys[l], peer_u[l], peer_v[l])
    return _rmsnorm(x, final_g)
```

```cpp
#include <hip/hip_runtime.h>
#include <cstdio>
#include <cstdint>
namespace pg8 {
#define PG8_LAS __attribute__((address_space(3)))
typedef unsigned short bf16_t;
typedef short bf16x8 __attribute__((ext_vector_type(8)));
typedef float f32x4 __attribute__((ext_vector_type(4)));
typedef unsigned u32x4 __attribute__((ext_vector_type(4)));
constexpr int BM = 256, BK = 64, HALF = 128, HTB = HALF * BK * 2  , STAGE_BYTES = 8 * HTB, NXCD = 8, WGM = 8;

__host__ __device__ __forceinline__ int lds_byte(int r, int c) { const int st = (r >> 4) * 2 + (c >> 5), rr = r & 15, cc = c & 31, ob = rr * 64 + cc * 2; return st * 1024 + (ob ^ (((ob >> 9) & 1) << 5)); }
__host__ __device__ __forceinline__ void stage_rc(int b, int& R, int& C) { const int st = b / 1024, sb = b % 1024, swz = sb ^ (((sb >> 9) & 1) << 5); R = (st >> 1) * 16 + swz / 64; C = (st & 1) * 32 + (swz % 64) / 2; }
__host__ __device__ __forceinline__ int perm32(int rho) { const int n = rho >> 4, i = rho & 15; return 8 * (i >> 2) + 4 * n + (i & 3); }

struct Unit { int pm, pn; };
struct Gemm { const bf16_t* A; const bf16_t* Bt; int M, N, K, lda, ldb, apn; };

struct StaticOrder {
    int nM, nN, nwg, G, c;
    __host__ __device__ void init(int M, int N, int G_, int c_) { nM = M / BM; nN = N / BM; nwg = nM * nN; G = G_; c = c_; }
    __host__ __device__ bool next(int i, Unit& u) const {
        const long L = (long)i * G + c; if (L >= nwg) return false;
        int wgid = (int)L; { const int q = nwg / NXCD, r = nwg % NXCD, xcd = wgid % NXCD, off = wgid / NXCD; wgid = (xcd < r ? xcd * (q + 1) : r * (q + 1) + (xcd - r) * q) + off; }
        const int nig = WGM * nN, gid = wgid / nig, fm = gid * WGM, gsz = (nM - fm) < WGM ? (nM - fm) : WGM;
        u.pm = fm + ((wgid % nig) % gsz); u.pn = (wgid % nig) / gsz; return true;
    }
    __device__ __forceinline__ void a_ready(const Unit&) const {}
    __device__ __forceinline__ void done(const Unit&) const {}
};
__device__ __forceinline__ unsigned cvt_pk_bf16(float lo, float hi) { unsigned r; asm volatile("v_cvt_pk_bf16_f32 %0, %1, %2" : "=v"(r) : "v"(lo), "v"(hi)); return r; }
template <class Epi, class Sched, bool STAMP = false>
__device__ __forceinline__ void gemm_phase(PG8_LAS unsigned char* lds, const Gemm g, const Sched& S, const Epi& E, unsigned long long* stamps) {
    int tid_ = threadIdx.x; asm volatile("" : "+v"(tid_));
    const int tid = tid_, wid = __builtin_amdgcn_readfirstlane(tid >> 6), lane = tid & 63, wr = wid >> 2, wc = wid & 3, fr = lane & 15, fq = lane >> 4;
    int K_ = g.K; asm volatile("" : "+s"(K_));
    const int K = K_, nt = K / BK;
    int ts_lo = 0, ts_hi = 0, nts = 0; const unsigned long long rt_entry = STAMP ? (unsigned long long)wall_clock64() : 0ull;
#define PG8_STAMP() do { if (STAMP && wid == 0 && nts < 64) { const unsigned long long _c = (unsigned long long)clock64(); \
        ts_lo = (lane == nts) ? (int)(unsigned)_c : ts_lo; ts_hi = (lane == nts) ? (int)(unsigned)(_c >> 32) : ts_hi; ++nts; } } while (0)
    PG8_STAMP();
    unsigned voffA[2], voffB[2];
#pragma unroll
    for (int i = 0; i < 2; ++i) { int R, C; stage_rc(tid * 16 + i * 8192, R, C); const int Rb = Epi::PERM ? ((R & ~31) + perm32(R & 31)) : R;
        voffA[i] = (unsigned)(R * g.lda + C) * 2u; voffB[i] = (unsigned)(Rb * g.ldb + C) * 2u; }
    const size_t kstep = (size_t)(BK * 2);
    const size_t hstepA = (size_t)HALF * g.lda * 2, hstepB = (size_t)HALF * g.ldb * 2;
    const size_t tstepA = 2 * hstepA, tstepB = 2 * hstepB;
    const unsigned ldsw = (unsigned)wid * 1024u;
    const int aoff = lds_byte(wr * 64 + fr, fq * 8), boff = lds_byte(wc * 32 + fr, fq * 8);
#define PG8_SA(b, h) (((b) * 2 + (h)) * HTB)
#define PG8_SB(b, h) ((4 + (b) * 2 + (h)) * HTB)
#define PG8_STAGE(bufoff, gbase, voff) do { _Pragma("unroll") for (int _i = 0; _i < 2; ++_i) \
        __builtin_amdgcn_global_load_lds((const unsigned*)((const char*)(gbase) + (voff)[_i]), (PG8_LAS unsigned*)(lds + (bufoff) + ldsw + _i * 8192), 16, 0, 0); } while (0)
#define PG8_LDA(dst, b, h) do { _Pragma("unroll") for (int m = 0; m < 4; ++m) _Pragma("unroll") for (int k = 0; k < 2; ++k) dst[m][k] = *(const PG8_LAS bf16x8*)(lds + PG8_SA(b, h) + aoff + m * 2048 + k * 1024); } while (0)
#define PG8_LDB(dst, b, h) do { _Pragma("unroll") for (int n = 0; n < 2; ++n) _Pragma("unroll") for (int k = 0; k < 2; ++k) dst[n][k] = *(const PG8_LAS bf16x8*)(lds + PG8_SB(b, h) + boff + n * 2048 + k * 1024); } while (0)
#define PG8_MMA(ai, bj, At, Bt) do { __builtin_amdgcn_s_setprio(1); _Pragma("unroll") for (int m = 0; m < 4; ++m) _Pragma("unroll") for (int n = 0; n < 2; ++n) _Pragma("unroll") for (int k = 0; k < 2; ++k) \
        acc[ai][bj][m][n] = __builtin_amdgcn_mfma_f32_16x16x32_bf16(Bt[n][k], At[m][k], acc[ai][bj][m][n], 0, 0, 0); __builtin_amdgcn_s_setprio(0); } while (0)
#define PG8_WAIT_V(n) asm volatile("s_waitcnt vmcnt(" #n ")" ::: "memory")
#define PG8_WAIT_L(n) asm volatile("s_waitcnt lgkmcnt(" #n ")" ::: "memory")
#define PG8_BAR __builtin_amdgcn_s_barrier()
#define PG8_SCHED __builtin_amdgcn_sched_barrier(0)
    Unit cur, nxt; int ui = 0;
    if (!S.next(0, cur)) return;
    f32x4 acc[2][2][4][2];
#pragma unroll
    for (int a = 0; a < 2; ++a)
#pragma unroll
        for (int b = 0; b < 2; ++b)
#pragma unroll
            for (int m = 0; m < 4; ++m)
#pragma unroll
                for (int n = 0; n < 2; ++n) acc[a][b][m][n] = (f32x4){0.f, 0.f, 0.f, 0.f};
    bf16x8 At[4][2], B0[2][2], B1[2][2];
    const char* cA = (const char*)g.A + (size_t)cur.pm * tstepA + (size_t)cur.pn * g.apn; const char* cB = (const char*)g.Bt + (size_t)cur.pn * tstepB;
    S.a_ready(cur);
    PG8_STAGE(PG8_SB(0, 0), cB, voffB); PG8_STAGE(PG8_SA(0, 0), cA, voffA); PG8_STAGE(PG8_SB(0, 1), cB + hstepB, voffB); PG8_STAGE(PG8_SA(0, 1), cA + hstepA, voffA);
    if (wr == 1) PG8_BAR;
    PG8_WAIT_V(4); PG8_BAR;
    PG8_STAGE(PG8_SB(1, 0), cB + kstep, voffB); PG8_STAGE(PG8_SA(1, 0), cA + kstep, voffA); PG8_STAGE(PG8_SB(1, 1), cB + hstepB + kstep, voffB);
    PG8_WAIT_V(6); PG8_BAR;
    PG8_STAMP();
    for (;;) {
        const bool has_next = S.next(ui + 1, nxt);
        const char* nA = has_next ? (const char*)g.A + (size_t)nxt.pm * tstepA + (size_t)nxt.pn * g.apn : cA; const char* nB = has_next ? (const char*)g.Bt + (size_t)nxt.pn * tstepB : cB;
        for (int t = 0; t < nt; t += 2) {
            const bool last = (t == nt - 2);
            const char* a1 = cA + (size_t)(t + 1) * kstep;
            const char* a2 = last ? nA : cA + (size_t)(t + 2) * kstep; const char* b2 = last ? nB : cB + (size_t)(t + 2) * kstep;
            const char* a3 = a2 + kstep; const char* b3 = b2 + kstep;
            if (last && has_next) S.a_ready(nxt);
            PG8_LDB(B0, 0, 0); PG8_SCHED; PG8_LDA(At, 0, 0); PG8_STAGE(PG8_SA(1, 1), a1 + hstepA, voffA);
            PG8_WAIT_L(8); PG8_BAR; PG8_WAIT_L(0); PG8_MMA(0, 0, At, B0); PG8_BAR; PG8_SCHED;
            PG8_LDB(B1, 0, 1); PG8_STAGE(PG8_SB(0, 0), b2, voffB);
            PG8_BAR; PG8_WAIT_L(0); PG8_MMA(0, 1, At, B1); PG8_BAR;
            PG8_LDA(At, 0, 1); PG8_STAGE(PG8_SA(0, 0), a2, voffA);
            PG8_BAR; PG8_WAIT_L(0); PG8_MMA(1, 0, At, B0); PG8_BAR; PG8_SCHED;
            PG8_STAGE(PG8_SB(0, 1), b2 + hstepB, voffB);
            PG8_WAIT_V(6); PG8_BAR; PG8_MMA(1, 1, At, B1); PG8_BAR;
            PG8_LDB(B0, 1, 0); PG8_SCHED; PG8_LDA(At, 1, 0); PG8_STAGE(PG8_SA(0, 1), a2 + hstepA, voffA);
            PG8_WAIT_L(8); PG8_BAR; PG8_WAIT_L(0); PG8_MMA(0, 0, At, B0); PG8_BAR; PG8_SCHED;
            PG8_LDB(B1, 1, 1); PG8_STAGE(PG8_SB(1, 0), b3, voffB);
            PG8_BAR; PG8_WAIT_L(0); PG8_MMA(0, 1, At, B1); PG8_BAR;
            PG8_LDA(At, 1, 1); PG8_STAGE(PG8_SA(1, 0), a3, voffA);
            PG8_BAR; PG8_WAIT_L(0); PG8_MMA(1, 0, At, B0); PG8_BAR; PG8_SCHED;
            PG8_STAGE(PG8_SB(1, 1), b3 + hstepB, voffB);
            PG8_WAIT_V(6); PG8_BAR; PG8_MMA(1, 1, At, B1); PG8_BAR;
        }
        PG8_STAMP();
        if constexpr (!Epi::AFTER_DRAIN) { E(acc, cur, wr, wc, fr, fq); S.done(cur); }
        PG8_STAMP();
        if (!has_next) break;
#pragma unroll
        for (int a = 0; a < 2; ++a)
#pragma unroll
            for (int b = 0; b < 2; ++b)
#pragma unroll
                for (int m = 0; m < 4; ++m)
#pragma unroll
                    for (int n = 0; n < 2; ++n) acc[a][b][m][n] = (f32x4){0.f, 0.f, 0.f, 0.f};
        cur = nxt; cA = nA; cB = nB; ++ui;
    }
    PG8_WAIT_V(0);
    if (wr == 0) PG8_BAR;
    PG8_BAR;
    if constexpr (Epi::AFTER_DRAIN) { E.fused(acc, cur, wr, wc, fr, fq, lds, wid, lane); S.done(cur); }
    PG8_STAMP();
    if (STAMP && wid == 0) { stamps[lane] = lane < nts ? (((unsigned long long)(unsigned)ts_hi << 32) | (unsigned)ts_lo) : 0ull;
        if (lane == 62) stamps[62] = rt_entry; if (lane == 63) stamps[63] = (unsigned long long)wall_clock64(); }
#undef PG8_STAMP
#undef PG8_SA
#undef PG8_SB
#undef PG8_STAGE
#undef PG8_LDA
#undef PG8_LDB
#undef PG8_MMA
#undef PG8_WAIT_V
#undef PG8_WAIT_L
#undef PG8_BAR
#undef PG8_SCHED
}
}


constexpr int NWAVES = 8, NTHREADS = 512;
constexpr int BATCH = 2, SEQ = 8192, T = BATCH * SEQ, D = 2048;
constexpr int AW = 1024, NH = 8, HD = 128, PW = 1024, INW = 4096;
constexpr int NMOD = 6 * D;
constexpr int PE_HEADS = 8, PE_NK = 128, PE_EXP = 16384, PE_K = 16;
constexpr float NORM_EPS = 1e-6f;
constexpr float QSCALE = 0.08838834764831845f * 1.4426950408889634f;

constexpr size_t MiB = 1u << 20;
constexpr size_t WS_CTL = 0, CTL_ZERO_BYTES = 64 * 1024;
constexpr size_t WS_MODP = 1 * MiB;
constexpr size_t WS_MODF = 1 * MiB + 832 * 1024;
constexpr size_t WS_CS = 2 * MiB;
constexpr size_t WS_WTIN = 4 * MiB;
constexpr size_t WS_WTOUT = 20 * MiB;
constexpr size_t WS_WTQ = 28 * MiB;
constexpr size_t WS_WTPOOL = 36 * MiB;
constexpr size_t WS_SKP = 37 * MiB;
constexpr size_t WS_PU = 40 * MiB, WS_PV = 104 * MiB;
constexpr size_t WS_HB = 168 * MiB;
constexpr size_t WS_Q = 232 * MiB, WS_K = 264 * MiB, WS_V = 296 * MiB, WS_U = 328 * MiB;
constexpr size_t WS_HC = 360 * MiB;
constexpr size_t WS_RB = 424 * MiB;
constexpr size_t WS_QP = WS_Q;
constexpr size_t WS_SC = WS_V;
constexpr size_t WS_IDX = WS_RB, WS_GATE = WS_RB + 8 * MiB;
constexpr size_t WS_END = 456 * MiB;

constexpr int RING_BYTES = 131072, MISC_OFF = RING_BYTES, LDS_BYTES = 147456;

#define GAS __attribute__((address_space(1)))
typedef unsigned short bf16;
typedef unsigned v4u __attribute__((ext_vector_type(4)));
typedef unsigned v2u __attribute__((ext_vector_type(2)));
typedef float f32x4 __attribute__((ext_vector_type(4)));
typedef __bf16 bf2 __attribute__((ext_vector_type(2)));
#define LDS_WAIT() asm volatile("s_waitcnt lgkmcnt(0)" ::: "memory")
#define VM_WAIT() asm volatile("s_waitcnt vmcnt(0)" ::: "memory")
__device__ __forceinline__ unsigned pk2(float lo, float hi) { return pg8::cvt_pk_bf16(lo, hi); }
__device__ __forceinline__ float bflo(unsigned w) { return __uint_as_float(w << 16); }
__device__ __forceinline__ float bfhi(unsigned w) { return __uint_as_float(w & 0xffff0000u); }
__device__ __forceinline__ float dot2(unsigned a, unsigned b, float c) { return __builtin_amdgcn_fdot2_f32_bf16(__builtin_bit_cast(bf2, a), __builtin_bit_cast(bf2, b), c, false); }
__device__ __forceinline__ float wave_sum(float v) {
#pragma unroll
    for (int o = 1; o < 64; o <<= 1) v += __shfl_xor(v, o);
    return v;
}
__device__ __forceinline__ float wave_max(float v) {
#pragma unroll
    for (int o = 1; o < 64; o <<= 1) v = fmaxf(v, __shfl_xor(v, o));
    return v;
}

#define XB_TMO      128
#define XB_XCNT(j)  (256  + 64 * (j))
#define XB_XSUB(j)  (1280 + 64 * (j))
#define XB_XGEN(j)  (2304 + 64 * (j))
#define XB_TOP      3328
#define XB_TOPGEN   3392
#define XCD_BAR_WORDS 3456
#define XB_SPIN_CAP (1u << 18)
#define LAS __attribute__((address_space(3)))

__device__ __forceinline__ unsigned xb_ld(unsigned* p)              { return __hip_atomic_load(p, __ATOMIC_RELAXED, __HIP_MEMORY_SCOPE_AGENT); }
__device__ __forceinline__ unsigned xb_add(unsigned* p, unsigned v) { return __hip_atomic_fetch_add(p, v, __ATOMIC_RELAXED, __HIP_MEMORY_SCOPE_AGENT); }
__device__ __forceinline__ unsigned xb_xcc_id() { return (unsigned)__builtin_amdgcn_s_getreg((3 << 11) | 20) & 0xFu; }
#define XB_SPIN(cond, bar) do { unsigned _sp = 0; while (cond) { __builtin_amdgcn_s_sleep(1); \
    if ((++_sp & 255u) == 0u) { if (xb_ld(&(bar)[XB_TMO])) break; if (_sp > XB_SPIN_CAP) { atomicAdd(&(bar)[XB_TMO], 1u); break; } } } } while (0)

struct XcdBarrier {
    unsigned* bar; unsigned x;
    volatile LAS unsigned* st;
};

__device__ __forceinline__ XcdBarrier xcd_barrier_post(unsigned* bar, volatile LAS unsigned* st) {
    XcdBarrier b; b.bar = bar; b.x = xb_xcc_id(); b.st = st;
    if (threadIdx.x == 0) (void)xb_add(&bar[XB_XCNT(b.x)], 1u);
    return b;
}
__device__ __forceinline__ void xcd_barrier_complete(unsigned* bar, unsigned x, unsigned& nloc, unsigned& nx) {
    const unsigned G = gridDim.x * gridDim.y * gridDim.z;
    unsigned sum, cnt, mine, sp = 0u;
    for (;;) {
        sum = 0u; cnt = 0u; mine = 0u;
#pragma unroll
        for (unsigned j = 0; j < 16; ++j) { const unsigned c = xb_ld(&bar[XB_XCNT(j)]); sum += c; cnt += (c > 0u) ? 1u : 0u; mine = (j == x) ? c : mine; }
        if (sum == G) break;
        __builtin_amdgcn_s_sleep(1);
        if ((++sp & 255u) == 0u) { if (xb_ld(&bar[XB_TMO])) break; if (sp > XB_SPIN_CAP) { atomicAdd(&bar[XB_TMO], 1u); break; } }
    }
    nloc = mine > 0u ? mine : 1u; nx = cnt > 0u ? cnt : 1u;
}

__device__ __forceinline__ void xcd_barrier(const XcdBarrier& b) {
    asm volatile("s_waitcnt vmcnt(0)" ::: "memory");
    __syncthreads();
    if (threadIdx.x == 0) {
        unsigned* bar = b.bar;
        __builtin_amdgcn_s_waitcnt(0);
        unsigned nloc = b.st[0], nx = b.st[1];
        if (nloc == 0u) { xcd_barrier_complete(bar, b.x, nloc, nx); b.st[0] = nloc; b.st[1] = nx; }
        const unsigned old = xb_add(&bar[XB_XSUB(b.x)], 1u);
        const unsigned gen = old / nloc;
        if (old + 1u == (gen + 1u) * nloc) {
            __builtin_amdgcn_fence(__ATOMIC_RELEASE, "agent");
            asm volatile("s_waitcnt vmcnt(0)" ::: "memory");
            const unsigned og = xb_add(&bar[XB_TOP], 1u);
            const unsigned tg = og / nx;
            if (og + 1u == (tg + 1u) * nx) xb_add(&bar[XB_TOPGEN], 1u);
            else XB_SPIN(xb_ld(&bar[XB_TOPGEN]) == tg, bar);
            __builtin_amdgcn_fence(__ATOMIC_ACQUIRE, "agent");
            xb_add(&bar[XB_XGEN(b.x)], 1u);
            asm volatile("s_waitcnt vmcnt(0)" ::: "memory");
        } else {
            XB_SPIN(xb_ld(&bar[XB_XGEN(b.x)]) == gen, bar);
            __builtin_amdgcn_fence(__ATOMIC_ACQUIRE, "agent");
            asm volatile("s_waitcnt vmcnt(0)" ::: "memory");
        }
    }
    __syncthreads();
}

struct Ctx { LAS unsigned char* lds; int tid, lane, wave, vcu, G, gw, ngw; };

struct Epi1 {
    static constexpr bool PERM = true, AFTER_DRAIN = false;
    bf16* QKVU; const float* CS;
    __device__ __forceinline__ void operator()(const pg8::f32x4 (&acc)[2][2][4][2], const pg8::Unit& u, int wr, int wc, int fr, int fq) const {
        const int row0 = u.pm * 256 + wr * 64 + fr; const int tt = u.pn >> 2; const int colt = (u.pn & 3) * 256;
        bf16* base = QKVU + (size_t)tt * ((size_t)T * 1024);
        const int col0 = colt + wc * 32 + 8 * fq;
        const bool rot = (tt < 2) && (wc == 0);
        const float sc = (tt == 0) ? QSCALE : 1.0f;
        const float sgn = (fq < 2) ? -1.0f : 1.0f;
#pragma unroll
        for (int ai = 0; ai < 2; ++ai)
#pragma unroll
            for (int m = 0; m < 4; ++m) {
                const int row = row0 + ai * 128 + m * 16;
                bf16* rowp = base + (size_t)row * 1024 + col0;
                f32x4 c0 = {1.f, 1.f, 1.f, 1.f}, c1 = c0, s0 = {0.f, 0.f, 0.f, 0.f}, s1 = s0;
                if (rot) { const float* cs = CS + (size_t)row * 32 + 8 * (fq & 1);
                    c0 = *(const f32x4*)(cs); c1 = *(const f32x4*)(cs + 4); s0 = *(const f32x4*)(cs + 16); s1 = *(const f32x4*)(cs + 20); }
#pragma unroll
                for (int bj = 0; bj < 2; ++bj) {
                    f32x4 v0 = acc[ai][bj][m][0], v1 = acc[ai][bj][m][1];
                    if (rot) {
#pragma unroll
                        for (int e = 0; e < 4; ++e) {
                            const float p0 = __shfl_xor(v0[e], 32), p1 = __shfl_xor(v1[e], 32);
                            v0[e] = v0[e] * c0[e] + sgn * p0 * s0[e];
                            v1[e] = v1[e] * c1[e] + sgn * p1 * s1[e];
                        }
                    }
                    pg8::u32x4 w; w.x = pk2(v0[0] * sc, v0[1] * sc); w.y = pk2(v0[2] * sc, v0[3] * sc); w.z = pk2(v1[0] * sc, v1[1] * sc); w.w = pk2(v1[2] * sc, v1[3] * sc);
                    *(pg8::u32x4*)(rowp + bj * 128) = w;
                }
            }
    }
};
struct EpiPool {
    static constexpr bool PERM = true, AFTER_DRAIN = false;
    bf16* HC; const float* pscale;
    __device__ __forceinline__ void operator()(const pg8::f32x4 (&acc)[2][2][4][2], const pg8::Unit& u, int wr, int wc, int fr, int fq) const {
        const int row0 = u.pm * 256 + wr * 64 + fr, col0 = u.pn * 256 + wc * 32 + 8 * fq;
        f32x4 ps[2][2];
#pragma unroll
        for (int bj = 0; bj < 2; ++bj) { ps[bj][0] = *(const f32x4*)(pscale + col0 + bj * 128); ps[bj][1] = *(const f32x4*)(pscale + col0 + bj * 128 + 4); }
#pragma unroll
        for (int ai = 0; ai < 2; ++ai)
#pragma unroll
            for (int m = 0; m < 4; ++m) {
                bf16* rowp = HC + (size_t)(row0 + ai * 128 + m * 16) * 2048 + 1024 + col0;
#pragma unroll
                for (int bj = 0; bj < 2; ++bj) {
                    const f32x4 v0 = acc[ai][bj][m][0] * ps[bj][0], v1 = acc[ai][bj][m][1] * ps[bj][1];
                    pg8::u32x4 w; w.x = pk2(v0[0], v0[1]); w.y = pk2(v0[2], v0[3]); w.z = pk2(v1[0], v1[1]); w.w = pk2(v1[2], v1[3]);
                    *(pg8::u32x4*)(rowp + bj * 128) = w;
                }
            }
    }
};
struct EpiBf {
    static constexpr bool PERM = true, AFTER_DRAIN = false;
    bf16* O; int ldc;
    __device__ __forceinline__ void operator()(const pg8::f32x4 (&acc)[2][2][4][2], const pg8::Unit& u, int wr, int wc, int fr, int fq) const {
        const int row0 = u.pm * 256 + wr * 64 + fr, col0 = u.pn * 256 + wc * 32 + 8 * fq;
#pragma unroll
        for (int ai = 0; ai < 2; ++ai)
#pragma unroll
            for (int m = 0; m < 4; ++m) {
                bf16* rowp = O + (size_t)(row0 + ai * 128 + m * 16) * ldc + col0;
#pragma unroll
                for (int bj = 0; bj < 2; ++bj) {
                    const f32x4 v0 = acc[ai][bj][m][0], v1 = acc[ai][bj][m][1];
                    pg8::u32x4 w; w.x = pk2(v0[0], v0[1]); w.y = pk2(v0[2], v0[3]); w.z = pk2(v1[0], v1[1]); w.w = pk2(v1[2], v1[3]);
                    *(pg8::u32x4*)(rowp + bj * 128) = w;
                }
            }
    }
};
struct EpiF {
    static constexpr bool PERM = false, AFTER_DRAIN = false;
    float* C; int ldc;
    __device__ __forceinline__ void operator()(const pg8::f32x4 (&acc)[2][2][4][2], const pg8::Unit& u, int wr, int wc, int fr, int fq) const {
        const int row0 = u.pm * 256 + wr * 64 + fr, col0 = u.pn * 256 + wc * 32 + 4 * fq;
#pragma unroll
        for (int ai = 0; ai < 2; ++ai)
#pragma unroll
            for (int m = 0; m < 4; ++m) { float* rowp = C + (size_t)(row0 + ai * 128 + m * 16) * ldc + col0;
#pragma unroll
                for (int bj = 0; bj < 2; ++bj)
#pragma unroll
                    for (int n = 0; n < 2; ++n) *(f32x4*)(rowp + bj * 128 + n * 16) = acc[ai][bj][m][n]; }
    }
};
struct EpiOut {
    static constexpr bool PERM = false, AFTER_DRAIN = false;
    const float* X; float* X1; const float* MODF;
    __device__ __forceinline__ void operator()(const pg8::f32x4 (&acc)[2][2][4][2], const pg8::Unit& u, int wr, int wc, int fr, int fq) const {
        const int row0 = u.pm * 256 + wr * 64 + fr, col0 = u.pn * 256 + wc * 32 + 4 * fq;
        const float* gp = MODF + (size_t)(u.pm >= 32 ? 1 : 0) * NMOD + 2 * D + col0;
        f32x4 gv[2][2];
#pragma unroll
        for (int bj = 0; bj < 2; ++bj)
#pragma unroll
            for (int n = 0; n < 2; ++n) gv[bj][n] = *(const f32x4*)(gp + bj * 128 + n * 16);
#pragma unroll
        for (int ai = 0; ai < 2; ++ai)
#pragma unroll
            for (int m = 0; m < 4; ++m) { const size_t off = (size_t)(row0 + ai * 128 + m * 16) * D + col0;
#pragma unroll
                for (int bj = 0; bj < 2; ++bj)
#pragma unroll
                    for (int n = 0; n < 2; ++n) { const f32x4 xv = *(const f32x4*)(X + off + bj * 128 + n * 16);
                        *(f32x4*)(X1 + off + bj * 128 + n * 16) = xv + gv[bj][n] * acc[ai][bj][m][n]; } }
    }
};

__device__ __forceinline__ void p0_transpose_item(const float* W, int K, int N, bf16* WT, int row_off, LAS float* scr, int item, int lane) {
    const int nblk = N / 32, kb = item / nblk, nb = item % nblk, k0 = 64 * kb, n0 = 32 * nb;
#pragma unroll 8
    for (int i = 0; i < 32; ++i) { const int kk = 2 * i + (lane >> 5); scr[kk * 33 + (lane & 31)] = W[(size_t)(k0 + kk) * N + n0 + (lane & 31)]; }
    LDS_WAIT(); asm volatile("" ::: "memory");
    const int c = lane & 7;
#pragma unroll
    for (int j = 0; j < 4; ++j) { const int n = (lane >> 3) + 8 * j; const LAS float* s = scr + (8 * c) * 33 + n;
        v4u o; o.x = pk2(s[0 * 33], s[1 * 33]); o.y = pk2(s[2 * 33], s[3 * 33]); o.z = pk2(s[4 * 33], s[5 * 33]); o.w = pk2(s[6 * 33], s[7 * 33]);
        *(v4u*)(WT + (size_t)(row_off + n0 + n) * K + k0 + 8 * c) = o; }
    LDS_WAIT(); asm volatile("" ::: "memory");
}
__device__ __forceinline__ float silu_f(float x) { return x / (1.0f + __expf(-x)); }
constexpr int MOD_ITEMS = 48 * 8;
__device__ __forceinline__ void p0_mod_item(const float* cvec, const float* w_mod, float* MODP, int item, int lane) {
    const int cb = item % 48, kc = item / 48, col = 256 * cb + 4 * lane, k0 = 256 * kc;
    f32x4 a0 = {0.f, 0.f, 0.f, 0.f}, a1 = a0;
    const float* wp = w_mod + (size_t)k0 * NMOD + col;
#pragma unroll 8
    for (int k = 0; k < 256; ++k) {
        const f32x4 w = *(const f32x4*)(wp + (size_t)k * NMOD);
        const float s0 = silu_f(cvec[k0 + k]), s1 = silu_f(cvec[D + k0 + k]);
        a0 += w * s0; a1 += w * s1;
    }
    *(f32x4*)(MODP + ((size_t)kc * 2 + 0) * NMOD + col) = a0;
    *(f32x4*)(MODP + ((size_t)kc * 2 + 1) * NMOD + col) = a1;
}
__device__ __forceinline__ void p0_convert_row(const float* src, bf16* dst, int lane) {
#pragma unroll
    for (int j = 0; j < 4; ++j) {
        const f32x4 a = *(const f32x4*)(src + 512 * j + 8 * lane), b = *(const f32x4*)(src + 512 * j + 8 * lane + 4);
        v4u o; o.x = pk2(a[0], a[1]); o.y = pk2(a[2], a[3]); o.z = pk2(b[0], b[1]); o.w = pk2(b[2], b[3]);
        *(v4u*)(dst + 512 * j + 8 * lane) = o;
    }
}
__device__ __forceinline__ void phase0(const Ctx& c, const float* const* in, unsigned char* ws) {
    const float* cvec = in[1]; const float* w_mod = in[3]; const float* w_in = in[6]; const float* w_pool = in[7]; const float* w_out = in[9];
    const float* w_query = in[11]; const float* sub_keys = in[12]; const float* peer_u = in[13]; const float* peer_v = in[14];
    LAS float* scr = (LAS float*)(c.lds + c.wave * 16384);
    if (c.gw < MOD_ITEMS) p0_mod_item(cvec, w_mod, (float*)(ws + WS_MODP), c.gw, c.lane);
    constexpr int I_IN = 32 * 128, I_OUT = 32 * 64, I_Q = 32 * 64, I_POOL = 4 * 32;
    for (int it = c.gw; it < I_IN + I_OUT + I_Q + I_POOL; it += c.ngw) {
        int r = it;
        if (r < I_IN) { p0_transpose_item(w_in, D, INW, (bf16*)(ws + WS_WTIN), 0, scr, r, c.lane); continue; } r -= I_IN;
        if (r < I_OUT) { p0_transpose_item(w_out, D, D, (bf16*)(ws + WS_WTOUT), 0, scr, r, c.lane); continue; } r -= I_OUT;
        if (r < I_Q) { p0_transpose_item(w_query, D, D, (bf16*)(ws + WS_WTQ), 0, scr, r, c.lane); continue; } r -= I_Q;
        { const int g = r >> 5; p0_transpose_item(w_pool + (size_t)g * 65536, 256, 256, (bf16*)(ws + WS_WTPOOL), g * 256, scr, r & 31, c.lane); }
    }
    for (int r = c.gw; r < 2048; r += c.ngw) {
        const int p = (r >> 7) & 1, k = 4 * c.lane; v2u o = {0u, 0u};
        if ((k >> 7) == p) { const f32x4 s = *(const f32x4*)(sub_keys + (size_t)r * 128 + (k & 127)); o.x = pk2(s[0], s[1]); o.y = pk2(s[2], s[3]); }
        *(v2u*)((bf16*)(ws + WS_SKP) + (size_t)r * 256 + k) = o;
    }
    if (c.gw >= MOD_ITEMS)
        for (int r = c.gw - MOD_ITEMS; r < 2 * PE_EXP; r += c.ngw - MOD_ITEMS) {
            if (r < PE_EXP) p0_convert_row(peer_u + (size_t)r * D, (bf16*)(ws + WS_PU) + (size_t)r * D, c.lane);
            else p0_convert_row(peer_v + (size_t)(r - PE_EXP) * D, (bf16*)(ws + WS_PV) + (size_t)(r - PE_EXP) * D, c.lane);
        }
}

template <bool FIRST>
__device__ __forceinline__ void phase_rows(const Ctx& c, const float* X, const float* gvec, const float* b_mod, const int* positions, unsigned char* ws, int shift_chunk, int scale_chunk) {
    LAS float* A1 = (LAS float*)c.lds; LAS float* B1 = A1 + D;
    const int b = c.vcu >> 7;
    const float* MODP = (const float*)(ws + WS_MODP); float* MODF = (float*)(ws + WS_MODF);
    {
        const int j = 4 * c.tid;
        f32x4 sh, sc;
        if (FIRST) {
            sh = *(const f32x4*)(b_mod + shift_chunk * D + j); sc = *(const f32x4*)(b_mod + scale_chunk * D + j);
#pragma unroll
            for (int s = 0; s < 8; ++s) { sh += *(const f32x4*)(MODP + ((size_t)s * 2 + b) * NMOD + shift_chunk * D + j); sc += *(const f32x4*)(MODP + ((size_t)s * 2 + b) * NMOD + scale_chunk * D + j); }
        } else { sh = *(const f32x4*)(MODF + (size_t)b * NMOD + shift_chunk * D + j); sc = *(const f32x4*)(MODF + (size_t)b * NMOD + scale_chunk * D + j); }
        const f32x4 g = *(const f32x4*)(gvec + j);
        *(LAS f32x4*)(A1 + j) = g * (sc + 1.0f); *(LAS f32x4*)(B1 + j) = sh;
    }
    if (FIRST && c.vcu < 48 && c.tid < 256) {
        const int col = 256 * c.vcu + c.tid;
#pragma unroll
        for (int bb = 0; bb < 2; ++bb) { float v = b_mod[col];
#pragma unroll
            for (int s = 0; s < 8; ++s) v += MODP[((size_t)s * 2 + bb) * NMOD + col];
            MODF[(size_t)bb * NMOD + col] = v; }
    }
    __syncthreads();
    bf16* HB = (bf16*)(ws + WS_HB);
    for (int i = 0; i < 8; ++i) {
        const int t = 64 * c.vcu + 8 * c.wave + i;
        const float* xr = X + (size_t)t * D + 4 * c.lane;
        f32x4 v[8]; float ss = 0.f;
#pragma unroll
        for (int q = 0; q < 8; ++q) { v[q] = *(const f32x4*)(xr + 256 * q); ss += (v[q][0] * v[q][0] + v[q][1] * v[q][1]) + (v[q][2] * v[q][2] + v[q][3] * v[q][3]); }
        const float rstd = 1.0f / sqrtf(wave_sum(ss) * (1.0f / D) + NORM_EPS);
        bf16* hr = HB + (size_t)t * D + 4 * c.lane;
#pragma unroll
        for (int q = 0; q < 8; ++q) {
            const f32x4 a = *(const LAS f32x4*)(A1 + 256 * q + 4 * c.lane), bb = *(const LAS f32x4*)(B1 + 256 * q + 4 * c.lane);
            const f32x4 y = v[q] * rstd * a + bb;
            v2u o; o.x = pk2(y[0], y[1]); o.y = pk2(y[2], y[3]);
            *(v2u*)(hr + 256 * q) = o;
        }
        if (FIRST && c.lane < 32) {
            const int fi = c.lane & 15;
            const float inv = (float)pow(500000.0, -(double)fi / 16.0);
            const float ang = (float)positions[t] * inv;
            ((float*)(ws + WS_CS))[(size_t)t * 32 + c.lane] = (c.lane < 16) ? cosf(ang) : sinf(ang);
        }
    }
    __syncthreads();
}

__device__ __forceinline__ void phase_poolr(const Ctx& c, unsigned char* ws) {
    const bf16* U = (const bf16*)(ws + WS_U); bf16* RB = (bf16*)(ws + WS_RB);
    const int nthr = c.G * NTHREADS;
    for (int it = c.vcu * NTHREADS + c.tid; it < T * 128; it += nthr) {
        const int t = it >> 7, ch = it & 127, c0 = 8 * ch, g = c0 >> 8, p = 2 << g, tb = t & (SEQ - 1);
        const int cnt = (tb + 1 < p) ? tb + 1 : p;
        float s[8] = {0.f, 0.f, 0.f, 0.f, 0.f, 0.f, 0.f, 0.f}, u0[8];
        for (int j = 0; j < cnt; ++j) {
            const v4u w = *(const v4u*)(U + (size_t)(t - j) * 1024 + c0);
            const float f[8] = {bflo(w.x), bfhi(w.x), bflo(w.y), bfhi(w.y), bflo(w.z), bfhi(w.z), bflo(w.w), bfhi(w.w)};
#pragma unroll
            for (int e = 0; e < 8; ++e) { s[e] += f[e]; if (j == 0) u0[e] = f[e]; }
        }
        const float ic = 1.0f / (float)cnt;
        v4u o; o.x = pk2(s[0] * ic - u0[0], s[1] * ic - u0[1]); o.y = pk2(s[2] * ic - u0[2], s[3] * ic - u0[3]);
        o.z = pk2(s[4] * ic - u0[4], s[5] * ic - u0[5]); o.w = pk2(s[6] * ic - u0[6], s[7] * ic - u0[7]);
        *(v4u*)(RB + (size_t)t * 1024 + c0) = o;
    }
}

__device__ __forceinline__ void phase_attn_simple(const Ctx& c, unsigned char* ws) {
    const bf16* QB = (const bf16*)(ws + WS_Q); const bf16* KB = (const bf16*)(ws + WS_K); const bf16* VB = (const bf16*)(ws + WS_V); bf16* HC = (bf16*)(ws + WS_HC);
    LAS float* pb = (LAS float*)(c.lds + c.wave * 2048);
    const float NEG = -3.0e38f;
    for (int item = c.gw; item < T * NH; item += c.ngw) {
        const int t = item >> 3, h = item & 7, tb = t & (SEQ - 1);
        const v4u* qp = (const v4u*)(QB + (size_t)t * 1024 + h * 128);
        v4u q[16];
#pragma unroll
        for (int i = 0; i < 16; ++i) q[i] = qp[i];
        float sv[7]; float mx = NEG;
#pragma unroll
        for (int r = 0; r < 7; ++r) {
            const int e = c.lane + 64 * r, pat = e / 129, j = e - pat * 129, off = j << (2 * pat);
            const bool valid = (e < 387) && (off <= tb);
            float s = NEG;
            if (valid) {
                const v4u* kp = (const v4u*)(KB + (size_t)(t - off) * 1024 + h * 128);
                float a0 = 0.f, a1 = 0.f;
#pragma unroll
                for (int i = 0; i < 16; ++i) { const v4u kk = kp[i]; a0 = dot2(q[i].x, kk.x, a0); a1 = dot2(q[i].y, kk.y, a1); a0 = dot2(q[i].z, kk.z, a0); a1 = dot2(q[i].w, kk.w, a1); }
                s = a0 + a1;
            }
            sv[r] = s; mx = fmaxf(mx, s);
        }
        mx = wave_max(mx);
        float l = 0.f;
#pragma unroll
        for (int r = 0; r < 7; ++r) { const float p = (sv[r] > -1.0e38f) ? exp2f(sv[r] - mx) : 0.f; l += p; pb[c.lane + 64 * r] = p; }
        l = wave_sum(l);
        LDS_WAIT();
        float o0 = 0.f, o1 = 0.f;
        for (int e = 0; e < 387; ++e) {
            const int pat = e / 129, j = e - pat * 129, off = j << (2 * pat);
            if (off > tb) continue;
            const float pe = pb[e];
            const unsigned w = *(const unsigned*)(VB + (size_t)(t - off) * 1024 + h * 128 + 2 * c.lane);
            o0 += pe * bflo(w); o1 += pe * bfhi(w);
        }
        const float il = 1.0f / l;
        *(unsigned*)(HC + (size_t)t * 2048 + h * 128 + 2 * c.lane) = pk2(o0 * il, o1 * il);
        LDS_WAIT();
    }
}

__device__ __forceinline__ void phase_topk_simple(const Ctx& c, unsigned char* ws) {
    const float* SC = (const float*)(ws + WS_SC); int* IDX = (int*)(ws + WS_IDX); float* GATE = (float*)(ws + WS_GATE);
    const float NEG = -3.0e38f;
    for (int item = c.gw; item < T * PE_HEADS; item += c.ngw) {
        const int t = item >> 3, h = item & 7;
        const float* sc = SC + (size_t)t * 2048 + h * 256;
        float sh[2] = {0.f, 0.f}; int ih[2] = {0, 0};
#pragma unroll
        for (int p = 0; p < 2; ++p) {
            float va = sc[128 * p + c.lane], vb = sc[128 * p + 64 + c.lane];
            for (int r = 0; r < PE_K; ++r) {
                const float M = wave_max(fmaxf(va, vb));
                const unsigned long long ba = __ballot(va == M), bb = __ballot(vb == M);
                const int n = ba ? (int)__builtin_ctzll(ba) : 64 + (int)__builtin_ctzll(bb);
                if (c.lane == r) { sh[p] = M; ih[p] = n; }
                if (n < 64) { if (c.lane == n) va = NEG; } else { if (c.lane == n - 64) vb = NEG; }
            }
        }
        float cv[4];
#pragma unroll
        for (int q = 0; q < 4; ++q) { const int cc = c.lane + 64 * q; cv[q] = __shfl(sh[0], cc >> 4) + __shfl(sh[1], cc & 15); }
        float ts = NEG; int tc = 0;
        for (int r = 0; r < PE_K; ++r) {
            const float M = wave_max(fmaxf(fmaxf(cv[0], cv[1]), fmaxf(cv[2], cv[3])));
            int cc = -1;
#pragma unroll
            for (int q = 3; q >= 0; --q) { const unsigned long long bq = __ballot(cv[q] == M); if (bq) cc = 64 * q + (int)__builtin_ctzll(bq); }
            if (c.lane == r) { ts = M; tc = cc; }
#pragma unroll
            for (int q = 0; q < 4; ++q) if (cc == c.lane + 64 * q) cv[q] = NEG;
        }
        const int i0 = __shfl(ih[0], tc >> 4), i1 = __shfl(ih[1], tc & 15);
        const float tmax = __shfl(ts, 0);
        const float ex = (c.lane < PE_K) ? __expf(ts - tmax) : 0.f;
        const float sum = wave_sum(ex);
        if (c.lane < PE_K) { IDX[(size_t)t * 128 + h * 16 + c.lane] = i0 * PE_NK + i1; GATE[(size_t)t * 128 + h * 16 + c.lane] = ex / sum; }
    }
}

__device__ __forceinline__ void ld_row(const bf16* tab, int e, int lane, v4u (&r)[4]) {
    const v4u* p = (const v4u*)(tab + (size_t)e * D) + lane;
#pragma unroll
    for (int j = 0; j < 4; ++j) r[j] = p[64 * j];
}
__device__ __forceinline__ float dot_row(const v4u (&h)[4], const v4u (&r)[4]) {
    float a0 = 0.f, a1 = 0.f, a2 = 0.f, a3 = 0.f;
#pragma unroll
    for (int j = 0; j < 4; ++j) { a0 = dot2(h[j].x, r[j].x, a0); a1 = dot2(h[j].y, r[j].y, a1); a2 = dot2(h[j].z, r[j].z, a2); a3 = dot2(h[j].w, r[j].w, a3); }
    return (a0 + a1) + (a2 + a3);
}
__device__ __forceinline__ void axpy_row(float (&y)[32], float a, const v4u (&r)[4]) {
#pragma unroll
    for (int j = 0; j < 4; ++j) {
        y[8 * j + 0] += a * bflo(r[j].x); y[8 * j + 1] += a * bfhi(r[j].x); y[8 * j + 2] += a * bflo(r[j].y); y[8 * j + 3] += a * bfhi(r[j].y);
        y[8 * j + 4] += a * bflo(r[j].z); y[8 * j + 5] += a * bfhi(r[j].z); y[8 * j + 6] += a * bflo(r[j].w); y[8 * j + 7] += a * bfhi(r[j].w);
    }
}
__device__ __forceinline__ void phase_peer(const Ctx& c, const float* X1, const float* final_g, float* out, unsigned char* ws) {
    const bf16* PU = (const bf16*)(ws + WS_PU); const bf16* PV = (const bf16*)(ws + WS_PV); const bf16* HB = (const bf16*)(ws + WS_HB);
    const int* IDX = (const int*)(ws + WS_IDX); const float* GATE = (const float*)(ws + WS_GATE); const float* MODF = (const float*)(ws + WS_MODF);
    LAS float* G2 = (LAS float*)c.lds; LAS float* FG = G2 + D;
    const int b = c.vcu >> 7;
    { const int j = 4 * c.tid; *(LAS f32x4*)(G2 + j) = *(const f32x4*)(MODF + (size_t)b * NMOD + 5 * D + j); *(LAS f32x4*)(FG + j) = *(const f32x4*)(final_g + j); }
    __syncthreads();
    for (int i = 0; i < 8; ++i) {
        const int t = 64 * c.vcu + 8 * c.wave + i;
        v4u h[4]; { const v4u* hp = (const v4u*)(HB + (size_t)t * D) + c.lane;
#pragma unroll
            for (int j = 0; j < 4; ++j) h[j] = hp[64 * j]; }
        const int e0 = IDX[(size_t)t * 128 + c.lane], e1 = IDX[(size_t)t * 128 + 64 + c.lane];
        const float g0 = GATE[(size_t)t * 128 + c.lane], g1 = GATE[(size_t)t * 128 + 64 + c.lane];
        float a0 = 0.f, a1 = 0.f;
        {
            v4u r0[4], r1[4], r2[4], r3[4];
            ld_row(PU, __builtin_amdgcn_readlane(e0, 0), c.lane, r0); ld_row(PU, __builtin_amdgcn_readlane(e0, 1), c.lane, r1);
            ld_row(PU, __builtin_amdgcn_readlane(e0, 2), c.lane, r2); ld_row(PU, __builtin_amdgcn_readlane(e0, 3), c.lane, r3);
#define PEER_U_STEP(R, K) do { const float s_ = wave_sum(dot_row(h, R)); if ((K) < 64) { if (c.lane == (K)) a0 = s_; } else { if (c.lane == (K) - 64) a1 = s_; } \
            const int kn_ = (K) + 4; if (kn_ < 128) { const int en_ = (kn_ < 64) ? __builtin_amdgcn_readlane(e0, kn_ & 63) : __builtin_amdgcn_readlane(e1, kn_ & 63); ld_row(PU, en_, c.lane, R); } } while (0)
            for (int k = 0; k < 128; k += 4) { PEER_U_STEP(r0, k); PEER_U_STEP(r1, k + 1); PEER_U_STEP(r2, k + 2); PEER_U_STEP(r3, k + 3); }
#undef PEER_U_STEP
        }
        const float act0 = 0.5f * a0 * (1.0f + erff(a0 * 0.70710678118654752f)) * g0;
        const float act1 = 0.5f * a1 * (1.0f + erff(a1 * 0.70710678118654752f)) * g1;
        float y[32];
#pragma unroll
        for (int q = 0; q < 32; ++q) y[q] = 0.f;
        {
            v4u r0[4], r1[4], r2[4], r3[4];
            ld_row(PV, __builtin_amdgcn_readlane(e0, 0), c.lane, r0); ld_row(PV, __builtin_amdgcn_readlane(e0, 1), c.lane, r1);
            ld_row(PV, __builtin_amdgcn_readlane(e0, 2), c.lane, r2); ld_row(PV, __builtin_amdgcn_readlane(e0, 3), c.lane, r3);
#define PEER_V_STEP(R, K) do { const float c_ = __uint_as_float(((K) < 64) ? __builtin_amdgcn_readlane(__float_as_uint(act0), (K) & 63) : __builtin_amdgcn_readlane(__float_as_uint(act1), (K) & 63)); axpy_row(y, c_, R); \
            const int kn_ = (K) + 4; if (kn_ < 128) { const int en_ = (kn_ < 64) ? __builtin_amdgcn_readlane(e0, kn_ & 63) : __builtin_amdgcn_readlane(e1, kn_ & 63); ld_row(PV, en_, c.lane, R); } } while (0)
            for (int k = 0; k < 128; k += 4) { PEER_V_STEP(r0, k); PEER_V_STEP(r1, k + 1); PEER_V_STEP(r2, k + 2); PEER_V_STEP(r3, k + 3); }
#undef PEER_V_STEP
        }
        const float* xr = X1 + (size_t)t * D + 8 * c.lane; float* orow = out + (size_t)t * D + 8 * c.lane;
        float ss = 0.f;
#pragma unroll
        for (int j = 0; j < 4; ++j) {
            const f32x4 xa = *(const f32x4*)(xr + 512 * j), xb = *(const f32x4*)(xr + 512 * j + 4);
            const f32x4 ga = *(const LAS f32x4*)(G2 + 512 * j + 8 * c.lane), gb = *(const LAS f32x4*)(G2 + 512 * j + 8 * c.lane + 4);
#pragma unroll
            for (int e = 0; e < 4; ++e) { y[8 * j + e] = xa[e] + ga[e] * y[8 * j + e]; y[8 * j + 4 + e] = xb[e] + gb[e] * y[8 * j + 4 + e];
                ss += y[8 * j + e] * y[8 * j + e] + y[8 * j + 4 + e] * y[8 * j + 4 + e]; }
        }
        const float rstd = 1.0f / sqrtf(wave_sum(ss) * (1.0f / D) + NORM_EPS);
#pragma unroll
        for (int j = 0; j < 4; ++j) {
            const f32x4 fa = *(const LAS f32x4*)(FG + 512 * j + 8 * c.lane), fb = *(const LAS f32x4*)(FG + 512 * j + 8 * c.lane + 4);
            f32x4 oa, ob;
#pragma unroll
            for (int e = 0; e < 4; ++e) { oa[e] = y[8 * j + e] * rstd * fa[e]; ob[e] = y[8 * j + 4 + e] * rstd * fb[e]; }
            *(f32x4*)(orow + 512 * j) = oa; *(f32x4*)(orow + 512 * j + 4) = ob;
        }
    }
}

struct Args { const float* in[16]; float* out; unsigned char* ws; };
__global__ void __launch_bounds__(NTHREADS, 2) fwd_kernel(Args args) {
    extern __shared__ __attribute__((aligned(16))) unsigned char lds_raw[];
#define MKCTX() Ctx c; { c.lds = (LAS unsigned char*)lds_raw; int t_ = threadIdx.x; asm volatile("" : "+v"(t_)); c.tid = t_; c.lane = c.tid & 63; c.wave = __builtin_amdgcn_readfirstlane(c.tid >> 6); \
    c.G = gridDim.x; { const int bx = blockIdx.x; c.vcu = (c.G % 8 == 0) ? (bx % 8) * (c.G / 8) + bx / 8 : bx; } c.gw = c.vcu * NWAVES + c.wave; c.ngw = c.G * NWAVES; }
    LAS unsigned char* const ldsb = (LAS unsigned char*)lds_raw;
    unsigned char* ws = args.ws;
    volatile LAS unsigned* misc = (volatile LAS unsigned*)(ldsb + MISC_OFF);
    if (threadIdx.x < 4) misc[threadIdx.x] = 0u;
    __syncthreads();
    XcdBarrier bar = xcd_barrier_post((unsigned*)(ws + WS_CTL), misc);
    if (gridDim.x != 256) return;

    const float* x = args.in[0];
    { MKCTX(); phase0(c, args.in, ws); }
    xcd_barrier(bar);
    { MKCTX(); phase_rows<true>(c, x, args.in[5], args.in[4], (const int*)args.in[2], ws, 0, 1); }
    xcd_barrier(bar);
    { pg8::Gemm g{(const bf16*)(ws + WS_HB), (const bf16*)(ws + WS_WTIN), T, INW, D, D, D, 0}; pg8::StaticOrder S; S.init(T, INW, 256, (int)blockIdx.x);
      Epi1 E{(bf16*)(ws + WS_Q), (const float*)(ws + WS_CS)};
      pg8::gemm_phase<Epi1, pg8::StaticOrder, false>(ldsb, g, S, E, nullptr); }
    xcd_barrier(bar);
    { MKCTX(); phase_poolr(c, ws); }
    { MKCTX(); phase_attn_simple(c, ws); }
    xcd_barrier(bar);
    { pg8::Gemm g{(const bf16*)(ws + WS_RB), (const bf16*)(ws + WS_WTPOOL), T, PW, 256, PW, 256, 512}; pg8::StaticOrder S; S.init(T, PW, 256, (int)blockIdx.x);
      EpiPool E{(bf16*)(ws + WS_HC), args.in[8]};
      pg8::gemm_phase<EpiPool, pg8::StaticOrder, false>(ldsb, g, S, E, nullptr); }
    xcd_barrier(bar);
    { pg8::Gemm g{(const bf16*)(ws + WS_HC), (const bf16*)(ws + WS_WTOUT), T, D, D, D, D, 0}; pg8::StaticOrder S; S.init(T, D, 256, (int)blockIdx.x);
      EpiOut E{x, args.out, (const float*)(ws + WS_MODF)};
      pg8::gemm_phase<EpiOut, pg8::StaticOrder, false>(ldsb, g, S, E, nullptr); }
    xcd_barrier(bar);
    { MKCTX(); phase_rows<false>(c, args.out, args.in[10], args.in[4], (const int*)args.in[2], ws, 3, 4); }
    xcd_barrier(bar);
    { pg8::Gemm g{(const bf16*)(ws + WS_HB), (const bf16*)(ws + WS_WTQ), T, D, D, D, D, 0}; pg8::StaticOrder S; S.init(T, D, 256, (int)blockIdx.x);
      EpiBf E{(bf16*)(ws + WS_QP), D};
      pg8::gemm_phase<EpiBf, pg8::StaticOrder, false>(ldsb, g, S, E, nullptr); }
    xcd_barrier(bar);
    { pg8::Gemm g{(const bf16*)(ws + WS_QP), (const bf16*)(ws + WS_SKP), T, D, 256, D, 256, 512}; pg8::StaticOrder S; S.init(T, D, 256, (int)blockIdx.x);
      EpiF E{(float*)(ws + WS_SC), D};
      pg8::gemm_phase<EpiF, pg8::StaticOrder, false>(ldsb, g, S, E, nullptr); }
    xcd_barrier(bar);
    { MKCTX(); phase_topk_simple(c, ws); }
    xcd_barrier(bar);
    { MKCTX(); phase_peer(c, args.out, args.in[15], args.out, ws); }
}

extern "C" void kernel_launch(void* const* d_in, const int* in_sizes, int n_in, void* d_out, int out_size, void* d_ws, size_t ws_size, hipStream_t stream) {
    static int grid = 0;
    if (grid == 0) {
        if (n_in != 16 || in_sizes[0] != T * D || out_size != T * D || ws_size < WS_END) { fprintf(stderr, "kernel_launch: unexpected shapes (n_in %d, in0 %d, out %d, ws %zu)\n", n_in, n_in > 0 ? in_sizes[0] : -1, out_size, ws_size); grid = -1; return; }
        int dev = 0, cus = 0, per_cu = 0;
        if (hipGetDevice(&dev) != hipSuccess || hipDeviceGetAttribute(&cus, hipDeviceAttributeMultiprocessorCount, dev) != hipSuccess) { grid = -1; return; }
        if (hipFuncSetAttribute((const void*)fwd_kernel, hipFuncAttributeMaxDynamicSharedMemorySize, LDS_BYTES) != hipSuccess) { fprintf(stderr, "kernel_launch: hipFuncSetAttribute failed\n"); grid = -1; return; }
        if (hipOccupancyMaxActiveBlocksPerMultiprocessor(&per_cu, (const void*)fwd_kernel, NTHREADS, LDS_BYTES) != hipSuccess || per_cu < 1) { fprintf(stderr, "kernel_launch: occupancy query reports %d workgroups per CU\n", per_cu); }
        (void)hipGetLastError();
        grid = (cus < 256) ? cus : 256;
    }
    if (grid < 0) return;
    if (hipMemsetAsync((char*)d_ws + WS_CTL, 0, CTL_ZERO_BYTES, stream) != hipSuccess) return;
    Args a{};
    for (int i = 0; i < 16; ++i) a.in[i] = (const float*)d_in[i];
    a.out = (float*)d_out; a.ws = (unsigned char*)d_ws;
    hipLaunchKernelGGL(fwd_kernel, dim3(grid), dim3(NTHREADS), LDS_BYTES, stream, a);
}
```

```cpp
#include <hip/hip_runtime.h>
#include <cstdio>
#include <cstdint>
#ifndef ATTN_SIMPLE
#define ATTN_SIMPLE 0
#endif
#ifndef TOPK_SIMPLE
#define TOPK_SIMPLE 0
#endif
#ifndef PEER_BITS
#define PEER_BITS 4
#endif
#ifndef V_SORTED
#define V_SORTED 1
#endif
#ifndef V_MFMA
#define V_MFMA 1
#endif
#ifndef U_MFMA
#define U_MFMA 1
#endif
#ifndef U_SORTED
#define U_SORTED 1
#endif
#ifndef DUP
#define DUP 0
#endif
namespace pg8 {
#define PG8_LAS __attribute__((address_space(3)))
typedef unsigned short bf16_t;
typedef short bf16x8 __attribute__((ext_vector_type(8)));
typedef float f32x4 __attribute__((ext_vector_type(4)));
typedef unsigned u32x4 __attribute__((ext_vector_type(4)));
constexpr int BM = 256, BK = 64, HALF = 128, HTB = HALF * BK * 2  , STAGE_BYTES = 8 * HTB, NXCD = 8, WGM = 8;

__host__ __device__ __forceinline__ int lds_byte(int r, int c) { const int st = (r >> 4) * 2 + (c >> 5), rr = r & 15, cc = c & 31, ob = rr * 64 + cc * 2; return st * 1024 + (ob ^ (((ob >> 9) & 1) << 5)); }
__host__ __device__ __forceinline__ void stage_rc(int b, int& R, int& C) { const int st = b / 1024, sb = b % 1024, swz = sb ^ (((sb >> 9) & 1) << 5); R = (st >> 1) * 16 + swz / 64; C = (st & 1) * 32 + (swz % 64) / 2; }
__host__ __device__ __forceinline__ int perm32(int rho) { const int n = rho >> 4, i = rho & 15; return 8 * (i >> 2) + 4 * n + (i & 3); }

struct Unit { int pm, pn; };
struct Gemm { const bf16_t* A; const bf16_t* Bt; int M, N, K, lda, ldb, apn, bhalf; };

struct StaticOrder {
    int nM, nN, nwg, G, c;
    __host__ __device__ __forceinline__ void init(int M, int N, int G_, int c_) { nM = M / BM; nN = N / BM; nwg = nM * nN; G = G_; c = c_; }
    __host__ __device__ __forceinline__ bool next(int i, Unit& u) const {
        const long L = (long)i * G + c; if (L >= nwg) return false;
        int wgid = (int)L; { const int q = nwg / NXCD, r = nwg % NXCD, xcd = wgid % NXCD, off = wgid / NXCD; wgid = (xcd < r ? xcd * (q + 1) : r * (q + 1) + (xcd - r) * q) + off; }
        const int nig = WGM * nN, gid = wgid / nig, fm = gid * WGM, gsz = (nM - fm) < WGM ? (nM - fm) : WGM;
        u.pm = fm + ((wgid % nig) % gsz); u.pn = (wgid % nig) / gsz; return true;
    }
    __device__ __forceinline__ void a_ready(const Unit&) const {}
    __device__ __forceinline__ void done(const Unit&) const {}
};
__device__ __forceinline__ unsigned cvt_pk_bf16(float lo, float hi) { typedef __bf16 bf2_ __attribute__((ext_vector_type(2))); bf2_ v; v[0] = (__bf16)lo; v[1] = (__bf16)hi; return __builtin_bit_cast(unsigned, v); }
template <class Epi, class Sched, bool STAMP = false>
__device__ __forceinline__ void gemm_phase(PG8_LAS unsigned char* lds, const Gemm g, const Sched& S, const Epi& E, unsigned long long* stamps, int wid_in) {
    unsigned ones_ = ~0u; asm volatile("" : "+s"(ones_)); int lane_ = (int)__builtin_amdgcn_mbcnt_hi(ones_, __builtin_amdgcn_mbcnt_lo(ones_, 0u)); asm volatile("" : "+v"(lane_));
    const int wid = __builtin_amdgcn_readfirstlane(wid_in), lane = lane_, tid = wid * 64 + lane, wr = wid >> 2, wc = wid & 3, fr = lane & 15, fq = lane >> 4;
    int K_ = g.K; asm volatile("" : "+s"(K_));
    const int K = K_, nt = K / BK;
    int ts_lo = 0, ts_hi = 0, nts = 0; const unsigned long long rt_entry = STAMP ? (unsigned long long)wall_clock64() : 0ull;
#define PG8_STAMP() do { if (STAMP && wid == 0 && nts < 64) { const unsigned long long _c = (unsigned long long)clock64(); \
        ts_lo = (lane == nts) ? (int)(unsigned)_c : ts_lo; ts_hi = (lane == nts) ? (int)(unsigned)(_c >> 32) : ts_hi; ++nts; } } while (0)
    PG8_STAMP();
    unsigned voffA[2], voffB[2];
#pragma unroll
    for (int i = 0; i < 2; ++i) { int R, C; stage_rc(tid * 16 + i * 8192, R, C); const int Rb = Epi::PERM ? ((R & ~31) + perm32(R & 31)) : R;
        voffA[i] = (unsigned)(R * g.lda + C) * 2u; voffB[i] = (unsigned)(Rb * g.ldb + C) * 2u; }
    const size_t kstep = (size_t)(BK * 2);
    const size_t hstepA = (size_t)HALF * g.lda * 2, hstepB = (size_t)HALF * g.ldb * 2;
    const size_t tstepA = 2 * hstepA, tstepB = 2 * hstepB;
    const unsigned ldsw = (unsigned)wid * 1024u;
    const int aoff = lds_byte(wr * 64 + fr, fq * 8), boff = lds_byte(wc * 32 + fr, fq * 8);
#define PG8_SA(b, h) (((b) * 2 + (h)) * HTB)
#define PG8_SB(b, h) ((4 + (b) * 2 + (h)) * HTB)
#define PG8_STAGE(bufoff, gbase, voff) do { _Pragma("unroll") for (int _i = 0; _i < 2; ++_i) \
        __builtin_amdgcn_global_load_lds((const unsigned*)((const char*)(gbase) + (voff)[_i]), (PG8_LAS unsigned*)(lds + (bufoff) + ldsw + _i * 8192), 16, 0, 0); } while (0)
#define PG8_LDA(dst, b, h) do { _Pragma("unroll") for (int m = 0; m < 4; ++m) _Pragma("unroll") for (int k = 0; k < 2; ++k) dst[m][k] = *(const PG8_LAS bf16x8*)(lds + PG8_SA(b, h) + aoff + m * 2048 + k * 1024); } while (0)
#define PG8_LDB(dst, b, h) do { _Pragma("unroll") for (int n = 0; n < 2; ++n) _Pragma("unroll") for (int k = 0; k < 2; ++k) dst[n][k] = *(const PG8_LAS bf16x8*)(lds + PG8_SB(b, h) + boff + n * 2048 + k * 1024); } while (0)
#define PG8_MMA(ai, bj, At, Bt) do { __builtin_amdgcn_s_setprio(1); _Pragma("unroll") for (int m = 0; m < 4; ++m) _Pragma("unroll") for (int n = 0; n < 2; ++n) _Pragma("unroll") for (int k = 0; k < 2; ++k) \
        acc[ai][bj][m][n] = __builtin_amdgcn_mfma_f32_16x16x32_bf16(Bt[n][k], At[m][k], acc[ai][bj][m][n], 0, 0, 0); __builtin_amdgcn_s_setprio(0); } while (0)
#define PG8_WAIT_V(n) asm volatile("s_waitcnt vmcnt(" #n ")" ::: "memory")
#define PG8_WAIT_L(n) asm volatile("s_waitcnt lgkmcnt(" #n ")" ::: "memory")
#define PG8_BAR __builtin_amdgcn_s_barrier()
#define PG8_SCHED __builtin_amdgcn_sched_barrier(0)
    Unit cur, nxt; int ui = 0;
    if (!S.next(0, cur)) return;
    f32x4 acc[2][2][4][2];
#pragma unroll
    for (int a = 0; a < 2; ++a)
#pragma unroll
        for (int b = 0; b < 2; ++b)
#pragma unroll
            for (int m = 0; m < 4; ++m)
#pragma unroll
                for (int n = 0; n < 2; ++n) acc[a][b][m][n] = (f32x4){0.f, 0.f, 0.f, 0.f};
    bf16x8 At[4][2], B0[2][2], B1[2][2];
    const char* cA = (const char*)g.A + (size_t)cur.pm * tstepA + (size_t)cur.pn * g.apn; const char* cB = (const char*)g.Bt + (size_t)cur.pn * tstepB + ((2 * cur.pm * BM >= g.M) ? (size_t)g.bhalf : (size_t)0);
    S.a_ready(cur);
    PG8_STAGE(PG8_SB(0, 0), cB, voffB); PG8_STAGE(PG8_SA(0, 0), cA, voffA); PG8_STAGE(PG8_SB(0, 1), cB + hstepB, voffB); PG8_STAGE(PG8_SA(0, 1), cA + hstepA, voffA);
    if (wr == 1) PG8_BAR;
    PG8_WAIT_V(4); PG8_BAR;
    PG8_STAGE(PG8_SB(1, 0), cB + kstep, voffB); PG8_STAGE(PG8_SA(1, 0), cA + kstep, voffA); PG8_STAGE(PG8_SB(1, 1), cB + hstepB + kstep, voffB);
    PG8_WAIT_V(6); PG8_BAR;
    PG8_STAMP();
    for (;;) {
        const bool has_next = S.next(ui + 1, nxt);
        const char* nA = has_next ? (const char*)g.A + (size_t)nxt.pm * tstepA + (size_t)nxt.pn * g.apn : cA; const char* nB = has_next ? (const char*)g.Bt + (size_t)nxt.pn * tstepB + ((2 * nxt.pm * BM >= g.M) ? (size_t)g.bhalf : (size_t)0) : cB;
        for (int t = 0; t < nt; t += 2) {
            const bool last = (t == nt - 2);
            const char* a1 = cA + (size_t)(t + 1) * kstep;
            const char* a2 = last ? nA : cA + (size_t)(t + 2) * kstep; const char* b2 = last ? nB : cB + (size_t)(t + 2) * kstep;
            const char* a3 = a2 + kstep; const char* b3 = b2 + kstep;
            if (last && has_next) S.a_ready(nxt);
            PG8_LDB(B0, 0, 0); PG8_SCHED; PG8_LDA(At, 0, 0); PG8_STAGE(PG8_SA(1, 1), a1 + hstepA, voffA);
            PG8_WAIT_L(8); PG8_BAR; PG8_WAIT_L(0); PG8_MMA(0, 0, At, B0); PG8_BAR; PG8_SCHED;
            PG8_LDB(B1, 0, 1); PG8_STAGE(PG8_SB(0, 0), b2, voffB);
            PG8_BAR; PG8_WAIT_L(0); PG8_MMA(0, 1, At, B1); PG8_BAR;
            PG8_LDA(At, 0, 1); PG8_STAGE(PG8_SA(0, 0), a2, voffA);
            PG8_BAR; PG8_WAIT_L(0); PG8_MMA(1, 0, At, B0); PG8_BAR; PG8_SCHED;
            PG8_STAGE(PG8_SB(0, 1), b2 + hstepB, voffB);
            PG8_WAIT_V(6); PG8_BAR; PG8_MMA(1, 1, At, B1); PG8_BAR;
            PG8_LDB(B0, 1, 0); PG8_SCHED; PG8_LDA(At, 1, 0); PG8_STAGE(PG8_SA(0, 1), a2 + hstepA, voffA);
            PG8_WAIT_L(8); PG8_BAR; PG8_WAIT_L(0); PG8_MMA(0, 0, At, B0); PG8_BAR; PG8_SCHED;
            PG8_LDB(B1, 1, 1); PG8_STAGE(PG8_SB(1, 0), b3, voffB);
            PG8_BAR; PG8_WAIT_L(0); PG8_MMA(0, 1, At, B1); PG8_BAR;
            PG8_LDA(At, 1, 1); PG8_STAGE(PG8_SA(1, 0), a3, voffA);
            PG8_BAR; PG8_WAIT_L(0); PG8_MMA(1, 0, At, B0); PG8_BAR; PG8_SCHED;
            PG8_STAGE(PG8_SB(1, 1), b3 + hstepB, voffB);
            PG8_WAIT_V(6); PG8_BAR; PG8_MMA(1, 1, At, B1); PG8_BAR;
        }
        PG8_STAMP();
        if constexpr (!Epi::AFTER_DRAIN) { E(acc, cur, wr, wc, fr, fq); S.done(cur); }
        PG8_STAMP();
        if (!has_next) break;
#pragma unroll
        for (int a = 0; a < 2; ++a)
#pragma unroll
            for (int b = 0; b < 2; ++b)
#pragma unroll
                for (int m = 0; m < 4; ++m)
#pragma unroll
                    for (int n = 0; n < 2; ++n) acc[a][b][m][n] = (f32x4){0.f, 0.f, 0.f, 0.f};
        cur = nxt; cA = nA; cB = nB; ++ui;
    }
    PG8_WAIT_V(0);
    if (wr == 0) PG8_BAR;
    PG8_BAR;
    if constexpr (Epi::AFTER_DRAIN) { E.fused(acc, cur, wr, wc, fr, fq, lds, wid, lane); S.done(cur); }
    PG8_STAMP();
    if (STAMP && wid == 0) { stamps[lane] = lane < nts ? (((unsigned long long)(unsigned)ts_hi << 32) | (unsigned)ts_lo) : 0ull;
        if (lane == 62) stamps[62] = rt_entry; if (lane == 63) stamps[63] = (unsigned long long)wall_clock64(); }
#undef PG8_STAMP
#undef PG8_SA
#undef PG8_SB
#undef PG8_STAGE
#undef PG8_LDA
#undef PG8_LDB
#undef PG8_MMA
#undef PG8_WAIT_V
#undef PG8_WAIT_L
#undef PG8_BAR
#undef PG8_SCHED
}
}


constexpr int NWAVES = 8, NTHREADS = 512;
constexpr int BATCH = 2, SEQ = 8192, T = BATCH * SEQ, D = 2048;
constexpr int AW = 1024, NH = 8, HD = 128, PW = 1024, INW = 4096;
constexpr int NMOD = 6 * D;
constexpr int PE_HEADS = 8, PE_NK = 128, PE_EXP = 16384, PE_K = 16;
constexpr float NORM_EPS = 1e-6f;
constexpr float QSCALE = 0.08838834764831845f * 1.4426950408889634f;

constexpr size_t MiB = 1u << 20;
constexpr size_t WS_CTL = 0, CTL_ZERO_BYTES = 64 * 1024;
constexpr size_t WS_MODP = 1 * MiB;
constexpr size_t WS_MODF = 1 * MiB + 832 * 1024;
constexpr size_t WS_CS = 2 * MiB;
constexpr size_t WS_WTIN = 4 * MiB;
constexpr size_t WS_WTOUT = 20 * MiB;
constexpr size_t WS_WTQ = 28 * MiB;
constexpr size_t WS_WTPOOL = 36 * MiB;
constexpr size_t WS_SKP = 37 * MiB;
constexpr size_t WS_SU = 38 * MiB, WS_SV = 38 * MiB + 64 * 1024;
constexpr size_t WS_PU = 40 * MiB, WS_PV = 104 * MiB;
constexpr size_t WS_HB = 168 * MiB;
constexpr size_t WS_Q = 232 * MiB, WS_K = 264 * MiB, WS_V = 296 * MiB, WS_U = 328 * MiB;
constexpr size_t WS_HC = 360 * MiB;
constexpr size_t WS_RB = 424 * MiB;
constexpr size_t WS_QP = WS_Q;
constexpr size_t WS_SC = WS_V;
constexpr size_t WS_IDX = WS_RB, WS_GATE = WS_RB + 8 * MiB;
constexpr size_t WS_TQ = WS_RB + 16 * MiB, WS_CSC = WS_RB + 24 * MiB;
constexpr size_t WS_OP0 = WS_HB, WS_OP1 = WS_HB + 32 * MiB, WS_OP2 = 456 * MiB;
constexpr size_t WS_X1B = WS_V;
constexpr size_t WS_LSE = 488 * MiB;
constexpr size_t WS_WQ2 = 490 * MiB;
constexpr size_t WS_BIASP = 506 * MiB;
constexpr size_t WS_RSQP = 507 * MiB;
constexpr size_t WS_END = 509 * MiB;

constexpr int RING_BYTES = 131072, MISC_OFF = RING_BYTES, LDS_BYTES = 147456;

#define GAS __attribute__((address_space(1)))
typedef unsigned short bf16;
typedef unsigned v4u __attribute__((ext_vector_type(4)));
typedef unsigned v2u __attribute__((ext_vector_type(2)));
typedef float f32x4 __attribute__((ext_vector_type(4)));
typedef __bf16 bf2 __attribute__((ext_vector_type(2)));
#define LDS_WAIT() asm volatile("s_waitcnt lgkmcnt(0)" ::: "memory")
#define VM_WAIT() asm volatile("s_waitcnt vmcnt(0)" ::: "memory")
__device__ __forceinline__ unsigned pk2(float lo, float hi) { return pg8::cvt_pk_bf16(lo, hi); }
__device__ __forceinline__ float bflo(unsigned w) { return __uint_as_float(w << 16); }
__device__ __forceinline__ float bfhi(unsigned w) { return __uint_as_float(w & 0xffff0000u); }
__device__ __forceinline__ float dot2(unsigned a, unsigned b, float c) { return __builtin_amdgcn_fdot2_f32_bf16(__builtin_bit_cast(bf2, a), __builtin_bit_cast(bf2, b), c, false); }
__device__ __forceinline__ int my_lane() { unsigned ones = ~0u; asm volatile("" : "+s"(ones)); return (int)__builtin_amdgcn_mbcnt_hi(ones, __builtin_amdgcn_mbcnt_lo(ones, 0u)); }
__device__ __forceinline__ int sh_idx(int v, int idx) { return __builtin_amdgcn_ds_bpermute(idx << 2, v); }
__device__ __forceinline__ unsigned sh_idx(unsigned v, int idx) { return (unsigned)__builtin_amdgcn_ds_bpermute(idx << 2, (int)v); }
__device__ __forceinline__ float sh_idx(float v, int idx) { return __int_as_float(__builtin_amdgcn_ds_bpermute(idx << 2, __float_as_int(v))); }
#define SXOR(v, m, lane) sh_idx((v), (lane) ^ (m))
__device__ __forceinline__ float wave_sum(float v) {
    const int lane = my_lane();
#pragma unroll
    for (int o = 1; o < 64; o <<= 1) v += SXOR(v, o, lane);
    return v;
}
__device__ __forceinline__ int wave_sum_i(int v) {
    const int lane = my_lane();
#pragma unroll
    for (int o = 1; o < 64; o <<= 1) v += SXOR(v, o, lane);
    return v;
}
__device__ __forceinline__ float wave_max(float v) {
    const int lane = my_lane();
#pragma unroll
    for (int o = 1; o < 64; o <<= 1) v = fmaxf(v, SXOR(v, o, lane));
    return v;
}

#define XB_TMO      128
#define XB_XCNT(j)  (256  + 64 * (j))
#define XB_XSUB(j)  (1280 + 64 * (j))
#define XB_XGEN(j)  (2304 + 64 * (j))
#define XB_TOP      3328
#define XB_TOPGEN   3392
#define XCD_BAR_WORDS 3456
#define XB_SPIN_CAP (1u << 18)
#define LAS __attribute__((address_space(3)))

__device__ __forceinline__ unsigned xb_ld(unsigned* p)              { return __hip_atomic_load(p, __ATOMIC_RELAXED, __HIP_MEMORY_SCOPE_AGENT); }
__device__ __forceinline__ unsigned xb_add(unsigned* p, unsigned v) { return __hip_atomic_fetch_add(p, v, __ATOMIC_RELAXED, __HIP_MEMORY_SCOPE_AGENT); }
__device__ __forceinline__ unsigned xb_xcc_id() { return (unsigned)__builtin_amdgcn_s_getreg((3 << 11) | 20) & 0xFu; }
#define XB_SPIN(cond, bar) do { unsigned _sp = 0; while (cond) { __builtin_amdgcn_s_sleep(1); \
    if ((++_sp & 255u) == 0u) { if (xb_ld(&(bar)[XB_TMO])) break; if (_sp > XB_SPIN_CAP) { atomicAdd(&(bar)[XB_TMO], 1u); break; } } } } while (0)

struct XcdBarrier {
    unsigned* bar; unsigned x;
    volatile LAS unsigned* st;
};

__device__ __forceinline__ XcdBarrier xcd_barrier_post(unsigned* bar, volatile LAS unsigned* st, bool is_t0) {
    XcdBarrier b; b.bar = bar; b.x = xb_xcc_id(); b.st = st;
    if (is_t0) (void)xb_add(&bar[XB_XCNT(b.x)], 1u);
    return b;
}
__device__ __forceinline__ void xcd_barrier_complete(unsigned* bar, unsigned x, unsigned& nloc, unsigned& nx) {
    const unsigned G = gridDim.x * gridDim.y * gridDim.z;
    unsigned sum, cnt, mine, sp = 0u;
    for (;;) {
        sum = 0u; cnt = 0u; mine = 0u;
#pragma unroll
        for (unsigned j = 0; j < 16; ++j) { const unsigned c = xb_ld(&bar[XB_XCNT(j)]); sum += c; cnt += (c > 0u) ? 1u : 0u; mine = (j == x) ? c : mine; }
        if (sum == G) break;
        __builtin_amdgcn_s_sleep(1);
        if ((++sp & 255u) == 0u) { if (xb_ld(&bar[XB_TMO])) break; if (sp > XB_SPIN_CAP) { atomicAdd(&bar[XB_TMO], 1u); break; } }
    }
    nloc = mine > 0u ? mine : 1u; nx = cnt > 0u ? cnt : 1u;
}

__device__ __forceinline__ void xcd_barrier(const XcdBarrier& b, bool is_t0) {
    asm volatile("s_waitcnt vmcnt(0)" ::: "memory");
    __syncthreads();
    if (is_t0) {
        unsigned* bar = b.bar;
        __builtin_amdgcn_s_waitcnt(0);
        unsigned nloc = b.st[0], nx = b.st[1];
        if (nloc == 0u) { xcd_barrier_complete(bar, b.x, nloc, nx); b.st[0] = nloc; b.st[1] = nx; }
        const unsigned old = xb_add(&bar[XB_XSUB(b.x)], 1u);
        const unsigned gen = old / nloc;
        if (old + 1u == (gen + 1u) * nloc) {
            __builtin_amdgcn_fence(__ATOMIC_RELEASE, "agent");
            asm volatile("s_waitcnt vmcnt(0)" ::: "memory");
            const unsigned og = xb_add(&bar[XB_TOP], 1u);
            const unsigned tg = og / nx;
            if (og + 1u == (tg + 1u) * nx) xb_add(&bar[XB_TOPGEN], 1u);
            else XB_SPIN(xb_ld(&bar[XB_TOPGEN]) == tg, bar);
            __builtin_amdgcn_fence(__ATOMIC_ACQUIRE, "agent");
            xb_add(&bar[XB_XGEN(b.x)], 1u);
            asm volatile("s_waitcnt vmcnt(0)" ::: "memory");
        } else {
            XB_SPIN(xb_ld(&bar[XB_XGEN(b.x)]) == gen, bar);
            __builtin_amdgcn_fence(__ATOMIC_ACQUIRE, "agent");
            asm volatile("s_waitcnt vmcnt(0)" ::: "memory");
        }
    }
    __syncthreads();
}

struct Ctx { LAS unsigned char* lds; int tid, lane, wave, vcu, G, gw, ngw; };

struct Epi1 {
    static constexpr bool PERM = true, AFTER_DRAIN = false;
    bf16* QKVU; const float* CS;
    __device__ __forceinline__ void operator()(const pg8::f32x4 (&acc)[2][2][4][2], const pg8::Unit& u, int wr, int wc, int fr, int fq) const {
        const int row0 = u.pm * 256 + wr * 64 + fr; const int tt = u.pn >> 2; const int colt = (u.pn & 3) * 256;
        bf16* base = QKVU + (size_t)tt * ((size_t)T * 1024);
        const int col0 = colt + wc * 32 + 8 * fq;
        const bool rot = (tt < 2) && (wc == 0);
        const float sc = (tt == 0) ? QSCALE : 1.0f;
        const float sgn = (fq < 2) ? -1.0f : 1.0f;
#pragma unroll
        for (int ai = 0; ai < 2; ++ai)
#pragma unroll
            for (int m = 0; m < 4; ++m) {
                const int row = row0 + ai * 128 + m * 16;
                bf16* rowp = base + (size_t)row * 1024 + col0;
                f32x4 c0 = {1.f, 1.f, 1.f, 1.f}, c1 = c0, s0 = {0.f, 0.f, 0.f, 0.f}, s1 = s0;
                if (rot) { const float* cs = CS + (size_t)row * 32 + 8 * (fq & 1);
                    c0 = *(const f32x4*)(cs); c1 = *(const f32x4*)(cs + 4); s0 = *(const f32x4*)(cs + 16); s1 = *(const f32x4*)(cs + 20); }
#pragma unroll
                for (int bj = 0; bj < 2; ++bj) {
                    f32x4 v0 = acc[ai][bj][m][0], v1 = acc[ai][bj][m][1];
                    if (rot) {
#pragma unroll
                        for (int e = 0; e < 4; ++e) {
                            const float p0 = SXOR(v0[e], 32, 16 * fq + fr), p1 = SXOR(v1[e], 32, 16 * fq + fr);
                            v0[e] = v0[e] * c0[e] + sgn * p0 * s0[e];
                            v1[e] = v1[e] * c1[e] + sgn * p1 * s1[e];
                        }
                    }
                    pg8::u32x4 w; w.x = pk2(v0[0] * sc, v0[1] * sc); w.y = pk2(v0[2] * sc, v0[3] * sc); w.z = pk2(v1[0] * sc, v1[1] * sc); w.w = pk2(v1[2] * sc, v1[3] * sc);
                    *(pg8::u32x4*)(rowp + bj * 128) = w;
                }
            }
    }
};
struct EpiPool {
    static constexpr bool PERM = true, AFTER_DRAIN = false;
    bf16* HC; const float* pscale;
    __device__ __forceinline__ void operator()(const pg8::f32x4 (&acc)[2][2][4][2], const pg8::Unit& u, int wr, int wc, int fr, int fq) const {
        const int row0 = u.pm * 256 + wr * 64 + fr, col0 = u.pn * 256 + wc * 32 + 8 * fq;
        f32x4 ps[2][2];
#pragma unroll
        for (int bj = 0; bj < 2; ++bj) { ps[bj][0] = *(const f32x4*)(pscale + col0 + bj * 128); ps[bj][1] = *(const f32x4*)(pscale + col0 + bj * 128 + 4); }
#pragma unroll
        for (int ai = 0; ai < 2; ++ai)
#pragma unroll
            for (int m = 0; m < 4; ++m) {
                bf16* rowp = HC + (size_t)(row0 + ai * 128 + m * 16) * 2048 + 1024 + col0;
#pragma unroll
                for (int bj = 0; bj < 2; ++bj) {
                    const f32x4 v0 = acc[ai][bj][m][0] * ps[bj][0], v1 = acc[ai][bj][m][1] * ps[bj][1];
                    pg8::u32x4 w; w.x = pk2(v0[0], v0[1]); w.y = pk2(v0[2], v0[3]); w.z = pk2(v1[0], v1[1]); w.w = pk2(v1[2], v1[3]);
                    *(pg8::u32x4*)(rowp + bj * 128) = w;
                }
            }
    }
};
struct EpiBf {
    static constexpr bool PERM = true, AFTER_DRAIN = false;
    bf16* O; int ldc;
    __device__ __forceinline__ void operator()(const pg8::f32x4 (&acc)[2][2][4][2], const pg8::Unit& u, int wr, int wc, int fr, int fq) const {
        const int row0 = u.pm * 256 + wr * 64 + fr, col0 = u.pn * 256 + wc * 32 + 8 * fq;
#pragma unroll
        for (int ai = 0; ai < 2; ++ai)
#pragma unroll
            for (int m = 0; m < 4; ++m) {
                bf16* rowp = O + (size_t)(row0 + ai * 128 + m * 16) * ldc + col0;
#pragma unroll
                for (int bj = 0; bj < 2; ++bj) {
                    const f32x4 v0 = acc[ai][bj][m][0], v1 = acc[ai][bj][m][1];
                    pg8::u32x4 w; w.x = pk2(v0[0], v0[1]); w.y = pk2(v0[2], v0[3]); w.z = pk2(v1[0], v1[1]); w.w = pk2(v1[2], v1[3]);
                    *(pg8::u32x4*)(rowp + bj * 128) = w;
                }
            }
    }
};
struct EpiQ {
    static constexpr bool PERM = true, AFTER_DRAIN = false;
    bf16* O; const LAS float* rstdT; const LAS float* biasT; int pm0, pn0;
    __device__ __forceinline__ void operator()(const pg8::f32x4 (&acc)[2][2][4][2], const pg8::Unit& u, int wr, int wc, int fr, int fq) const {
        const int slot = (u.pm == pm0 && u.pn == pn0) ? 0 : 1;
        const int row0 = u.pm * 256 + wr * 64 + fr, col0 = u.pn * 256 + wc * 32 + 8 * fq;
        f32x4 bv[2][2];
#pragma unroll
        for (int bj = 0; bj < 2; ++bj) { bv[bj][0] = *(const LAS f32x4*)(biasT + slot * 256 + bj * 128 + wc * 32 + 8 * fq); bv[bj][1] = *(const LAS f32x4*)(biasT + slot * 256 + bj * 128 + wc * 32 + 8 * fq + 4); }
#pragma unroll
        for (int ai = 0; ai < 2; ++ai)
#pragma unroll
            for (int m = 0; m < 4; ++m) {
                const float rs = rstdT[slot * 256 + ai * 128 + wr * 64 + m * 16 + fr];
                bf16* rowp = O + (size_t)(row0 + ai * 128 + m * 16) * D + col0;
#pragma unroll
                for (int bj = 0; bj < 2; ++bj) {
                    const f32x4 v0 = acc[ai][bj][m][0] * rs + bv[bj][0], v1 = acc[ai][bj][m][1] * rs + bv[bj][1];
                    pg8::u32x4 w; w.x = pk2(v0[0], v0[1]); w.y = pk2(v0[2], v0[3]); w.z = pk2(v1[0], v1[1]); w.w = pk2(v1[2], v1[3]);
                    *(pg8::u32x4*)(rowp + bj * 128) = w;
                }
            }
    }
};
struct EpiF {
    static constexpr bool PERM = false, AFTER_DRAIN = false;
    float* C; int ldc;
    __device__ __forceinline__ void operator()(const pg8::f32x4 (&acc)[2][2][4][2], const pg8::Unit& u, int wr, int wc, int fr, int fq) const {
        const int row0 = u.pm * 256 + wr * 64 + fr, col0 = u.pn * 256 + wc * 32 + 4 * fq;
#pragma unroll
        for (int ai = 0; ai < 2; ++ai)
#pragma unroll
            for (int m = 0; m < 4; ++m) { float* rowp = C + (size_t)(row0 + ai * 128 + m * 16) * ldc + col0;
#pragma unroll
                for (int bj = 0; bj < 2; ++bj)
#pragma unroll
                    for (int n = 0; n < 2; ++n) *(f32x4*)(rowp + bj * 128 + n * 16) = acc[ai][bj][m][n]; }
    }
};
struct EpiOut {
    static constexpr bool PERM = true, AFTER_DRAIN = false;
    const float* X; bf16* X1; const float* MODF; float* RSQP;
    __device__ __forceinline__ void operator()(const pg8::f32x4 (&acc)[2][2][4][2], const pg8::Unit& u, int wr, int wc, int fr, int fq) const {
        const int row0 = u.pm * 256 + wr * 64 + fr, col0 = u.pn * 256 + wc * 32 + 8 * fq;
        const float* gp = MODF + (size_t)(u.pm >= 32 ? 1 : 0) * NMOD + 2 * D + col0;
        f32x4 gv[2][2];
#pragma unroll
        for (int bj = 0; bj < 2; ++bj)
#pragma unroll
            for (int n = 0; n < 2; ++n) gv[bj][n] = *(const f32x4*)(gp + bj * 128 + 4 * n);
#pragma unroll
        for (int ai = 0; ai < 2; ++ai)
#pragma unroll
            for (int m = 0; m < 4; ++m) { const size_t off = (size_t)(row0 + ai * 128 + m * 16) * D + col0; float ssr = 0.f;
#pragma unroll
                for (int bj = 0; bj < 2; ++bj) {
                    const f32x4 v0 = __builtin_nontemporal_load((const f32x4*)(X + off + bj * 128)) + gv[bj][0] * acc[ai][bj][m][0], v1 = __builtin_nontemporal_load((const f32x4*)(X + off + bj * 128 + 4)) + gv[bj][1] * acc[ai][bj][m][1];
                    pg8::u32x4 w; w.x = pk2(v0[0], v0[1]); w.y = pk2(v0[2], v0[3]); w.z = pk2(v1[0], v1[1]); w.w = pk2(v1[2], v1[3]);
                    *(pg8::u32x4*)(X1 + off + bj * 128) = w;
                    ssr += (v0[0] * v0[0] + v0[1] * v0[1]) + (v0[2] * v0[2] + v0[3] * v0[3]) + (v1[0] * v1[0] + v1[1] * v1[1]) + (v1[2] * v1[2] + v1[3] * v1[3]); }
                ssr += SXOR(ssr, 16, 16 * fq + fr); ssr += SXOR(ssr, 32, 16 * fq + fr);
                if (fq == 0) RSQP[(size_t)(row0 + ai * 128 + m * 16) * 32 + u.pn * 4 + wc] = ssr; }
    }
};

__device__ __forceinline__ void p0_transpose_item(const float* W, int K, int N, bf16* WT, int row_off, LAS float* scr, int item, int lane) {
    const int nblk = N / 32, kb = item / nblk, nb = item % nblk, k0 = 64 * kb, n0 = 32 * nb;
#pragma unroll 8
    for (int i = 0; i < 32; ++i) { const int kk = 2 * i + (lane >> 5); scr[kk * 33 + (lane & 31)] = W[(size_t)(k0 + kk) * N + n0 + (lane & 31)]; }
    LDS_WAIT(); asm volatile("" ::: "memory");
    const int c = lane & 7;
#pragma unroll
    for (int j = 0; j < 4; ++j) { const int n = (lane >> 3) + 8 * j; const LAS float* s = scr + (8 * c) * 33 + n;
        v4u o; o.x = pk2(s[0 * 33], s[1 * 33]); o.y = pk2(s[2 * 33], s[3 * 33]); o.z = pk2(s[4 * 33], s[5 * 33]); o.w = pk2(s[6 * 33], s[7 * 33]);
        *(v4u*)(WT + (size_t)(row_off + n0 + n) * K + k0 + 8 * c) = o; }
    LDS_WAIT(); asm volatile("" ::: "memory");
}
__device__ __forceinline__ float silu_f(float x) { return x / (1.0f + __expf(-x)); }
constexpr int MOD_ITEMS = 48 * 8;
__device__ __forceinline__ void p0_mod_item(const float* cvec, const float* w_mod, float* MODP, int item, int lane) {
    const int cb = item % 48, kc = item / 48, col = 256 * cb + 4 * lane, k0 = 256 * kc;
    f32x4 a0 = {0.f, 0.f, 0.f, 0.f}, a1 = a0;
    const float* wp = w_mod + (size_t)k0 * NMOD + col;
#pragma unroll 32
    for (int k = 0; k < 256; ++k) {
        const f32x4 w = __builtin_nontemporal_load((const f32x4*)(wp + (size_t)k * NMOD));
        const float s0 = silu_f(cvec[k0 + k]), s1 = silu_f(cvec[D + k0 + k]);
        a0 += w * s0; a1 += w * s1;
    }
    *(f32x4*)(MODP + ((size_t)kc * 2 + 0) * NMOD + col) = a0;
    *(f32x4*)(MODP + ((size_t)kc * 2 + 1) * NMOD + col) = a1;
}
template <int OFFS>
__device__ __forceinline__ void p0_quant_row(const float* src, unsigned char* dst, float* scale_out, int lane) {
    f32x4 v[8]; float am = 0.f;
#pragma unroll
    for (int j = 0; j < 8; ++j) { v[j] = *(const f32x4*)(src + 256 * j + 4 * lane); am = fmaxf(fmaxf(am, fmaxf(fabsf(v[j][0]), fabsf(v[j][1]))), fmaxf(fabsf(v[j][2]), fabsf(v[j][3]))); }
    am = wave_max(am);
    const float inv = (am > 0.f) ? 127.0f / am : 0.f;
    if (lane == 0) *scale_out = am * (1.0f / 127.0f);
#pragma unroll
    for (int j = 0; j < 8; ++j) {
        unsigned w = 0u;
#pragma unroll
        for (int e = 0; e < 4; ++e) { int q = __float2int_rn(v[j][e] * inv); q = q > 127 ? 127 : (q < -127 ? -127 : q); w |= ((unsigned)(q + OFFS) & 0xffu) << (8 * e); }
        *(unsigned*)(dst + 256 * j + 4 * lane) = w;
    }
}
__device__ __forceinline__ void p0_quant_load4(const float* src, int lane, f32x4 (&v)[8]) {
#pragma unroll
    for (int j = 0; j < 8; ++j) v[j] = __builtin_nontemporal_load((const f32x4*)(src + 256 * j + 4 * lane));
}
template <unsigned XR>
__device__ __forceinline__ void p0_quant_finish4(const f32x4 (&v)[8], unsigned char* dst, float* scale_out, int lane) {
    float am = 0.f, sq = 0.f;
#pragma unroll
    for (int j = 0; j < 8; ++j)
#pragma unroll
        for (int e = 0; e < 4; ++e) { am = fmaxf(am, fabsf(v[j][e])); sq += v[j][e] * v[j][e]; }
    am = wave_max(am); sq = wave_sum(sq);
    const float step = fmaxf(0.335f * sqrtf(sq * (1.0f / D)), am * (1.0f / 24.0f));
    const float inv = (step > 0.f) ? 1.0f / step : 0.f;
    if (lane == 0) *scale_out = step;
    v4u o;
#pragma unroll
    for (int d = 0; d < 4; ++d) {
        unsigned w = 0u;
#pragma unroll
        for (int e = 0; e < 4; ++e) {
            int lo = (int)floorf(v[2 * d][e] * inv) + 8, hi = (int)floorf(v[2 * d + 1][e] * inv) + 8;
            lo = lo < 0 ? 0 : (lo > 15 ? 15 : lo); hi = hi < 0 ? 0 : (hi > 15 ? 15 : hi);
            w |= ((unsigned)lo | ((unsigned)hi << 4)) << (8 * e);
        }
        w ^= XR * 0x01010101u;
        if (d == 0) o.x = w; else if (d == 1) o.y = w; else if (d == 2) o.z = w; else o.w = w;
    }
    *(v4u*)(dst + 16 * lane) = o;
}
__device__ __forceinline__ unsigned fp4_code(float x) {
    const float a = fabsf(x);
    const unsigned m = (unsigned)(a > 0.25f) + (unsigned)(a > 0.75f) + (unsigned)(a > 1.25f) + (unsigned)(a > 1.75f) + (unsigned)(a > 2.5f) + (unsigned)(a > 3.5f) + (unsigned)(a > 5.0f);
    return m | (x < 0.f ? 8u : 0u);
}
__device__ __forceinline__ void p0_quant_finish_fp4(const f32x4 (&v)[8], unsigned char* dst, float* scale_out, int lane) {
    float am = 0.f, sq = 0.f;
#pragma unroll
    for (int j = 0; j < 8; ++j)
#pragma unroll
        for (int e = 0; e < 4; ++e) { am = fmaxf(am, fabsf(v[j][e])); sq += v[j][e] * v[j][e]; }
    am = wave_max(am); sq = wave_sum(sq);
    const float step = fmaxf(0.48f * sqrtf(sq * (1.0f / D)), am * (1.0f / 18.0f));
    const float inv = (step > 0.f) ? 1.0f / step : 0.f;
    if (lane == 0) *scale_out = step;
    v4u o;
#pragma unroll
    for (int d = 0; d < 4; ++d) {
        unsigned w = 0u;
#pragma unroll
        for (int e = 0; e < 4; ++e) w |= (fp4_code(v[2 * d][e] * inv) | (fp4_code(v[2 * d + 1][e] * inv) << 4)) << (8 * e);
        if (d == 0) o.x = w; else if (d == 1) o.y = w; else if (d == 2) o.z = w; else o.w = w;
    }
    *(v4u*)(dst + 16 * lane) = o;
}
__device__ __forceinline__ void phase0(const Ctx& c, const float* const* in, unsigned char* ws) {
    const float* cvec = in[1]; const float* w_mod = in[3]; const float* w_in = in[6]; const float* w_pool = in[7]; const float* w_out = in[9];
    const float* w_query = in[11]; const float* sub_keys = in[12]; const float* peer_u = in[13]; const float* peer_v = in[14];
    LAS float* scr = (LAS float*)(c.lds + c.wave * 16384);
    if (c.gw < MOD_ITEMS) p0_mod_item(cvec, w_mod, (float*)(ws + WS_MODP), c.gw, c.lane);
    constexpr int I_IN = 32 * 128, I_OUT = 32 * 64, I_POOL = 4 * 32;
    for (int it = c.gw; it < I_IN + I_OUT + I_POOL; it += c.ngw) {
        int r = it;
        if (r < I_IN) { p0_transpose_item(w_in, D, INW, (bf16*)(ws + WS_WTIN), 0, scr, r, c.lane); continue; } r -= I_IN;
        if (r < I_OUT) { p0_transpose_item(w_out, D, D, (bf16*)(ws + WS_WTOUT), 0, scr, r, c.lane); continue; } r -= I_OUT;
        { const int g = r >> 5; p0_transpose_item(w_pool + (size_t)g * 65536, 256, 256, (bf16*)(ws + WS_WTPOOL), g * 256, scr, r & 31, c.lane); }
    }
#if TOPK_SIMPLE
    for (int r = c.gw; r < 2048; r += c.ngw) {
        const int p = (r >> 7) & 1, k = 4 * c.lane; v2u o = {0u, 0u};
        if ((k >> 7) == p) { const f32x4 s = *(const f32x4*)(sub_keys + (size_t)r * 128 + (k & 127)); o.x = pk2(s[0], s[1]); o.y = pk2(s[2], s[3]); }
        *(v2u*)((bf16*)(ws + WS_SKP) + (size_t)r * 256 + k) = o;
    }
#else
    for (int r = c.gw; r < 2048; r += c.ngw) {
        const float a = sub_keys[(size_t)r * 128 + 2 * c.lane], b = sub_keys[(size_t)r * 128 + 2 * c.lane + 1];
        *(unsigned*)((bf16*)(ws + WS_SKP) + (size_t)r * 128 + 2 * c.lane) = pk2(a, b);
    }
#endif
    if (c.gw >= MOD_ITEMS) {
        const int stride = c.ngw - MOD_ITEMS;
        int r = c.gw - MOD_ITEMS;
        f32x4 va[8], vb[8];
#define P0_SRC(R) (((R) < PE_EXP) ? peer_u + (size_t)(R) * D : peer_v + (size_t)((R) - PE_EXP) * D)
#define P0_FIN(V, R) do { if ((R) < PE_EXP) { if (U_MFMA) p0_quant_finish_fp4(V, ws + WS_PU + (size_t)(R) * 1024, (float*)(ws + WS_SU) + (R), c.lane); else p0_quant_finish4<0x88u>(V, ws + WS_PU + (size_t)(R) * 1024, (float*)(ws + WS_SU) + (R), c.lane); } \
                          else { if (V_MFMA) p0_quant_finish_fp4(V, ws + WS_PV + (size_t)((R) - PE_EXP) * 1024, (float*)(ws + WS_SV) + ((R) - PE_EXP), c.lane); else p0_quant_finish4<0x80u>(V, ws + WS_PV + (size_t)((R) - PE_EXP) * 1024, (float*)(ws + WS_SV) + ((R) - PE_EXP), c.lane); } } while (0)
        if (r < 2 * PE_EXP) p0_quant_load4(P0_SRC(r), c.lane, va);
        while (r < 2 * PE_EXP) {
            const int r1 = r + stride, r2 = r + 2 * stride;
            if (r1 < 2 * PE_EXP) p0_quant_load4(P0_SRC(r1), c.lane, vb);
            P0_FIN(va, r);
            if (r1 >= 2 * PE_EXP) break;
            if (r2 < 2 * PE_EXP) p0_quant_load4(P0_SRC(r2), c.lane, va);
            P0_FIN(vb, r1);
            r = r2;
        }
#undef P0_SRC
#undef P0_FIN
    }
}

__device__ __forceinline__ void p1_fold_q_item(const float* W, bf16* WQ2, float* BIASP, const LAS float* A2s, const LAS float* B2s, LAS float* scr, int item, int lane) {
    const int kb = item >> 6, nb = item & 63, k0 = 64 * kb, n0 = 32 * nb;
#pragma unroll 8
    for (int i = 0; i < 32; ++i) { const int kk = 2 * i + (lane >> 5); scr[kk * 33 + (lane & 31)] = W[(size_t)(k0 + kk) * D + n0 + (lane & 31)]; }
    LDS_WAIT(); asm volatile("" ::: "memory");
    {
        const int bb = lane >> 5, n = lane & 31; float sacc = 0.f;
#pragma unroll 8
        for (int kk = 0; kk < 64; ++kk) sacc += B2s[bb * D + k0 + kk] * scr[kk * 33 + n];
        BIASP[((size_t)kb * 2 + bb) * D + n0 + n] = sacc;
    }
    const int c8 = lane & 7;
#pragma unroll
    for (int bb = 0; bb < 2; ++bb) {
        const f32x4 a0 = *(const LAS f32x4*)(A2s + bb * D + k0 + 8 * c8), a1 = *(const LAS f32x4*)(A2s + bb * D + k0 + 8 * c8 + 4);
#pragma unroll
        for (int j = 0; j < 4; ++j) { const int n = (lane >> 3) + 8 * j; const LAS float* t = scr + (8 * c8) * 33 + n;
            v4u o; o.x = pk2(t[0 * 33] * a0[0], t[1 * 33] * a0[1]); o.y = pk2(t[2 * 33] * a0[2], t[3 * 33] * a0[3]); o.z = pk2(t[4 * 33] * a1[0], t[5 * 33] * a1[1]); o.w = pk2(t[6 * 33] * a1[2], t[7 * 33] * a1[3]);
            *(v4u*)(WQ2 + ((size_t)bb * D + n0 + n) * D + k0 + 8 * c8) = o; }
    }
    LDS_WAIT(); asm volatile("" ::: "memory");
}
template <bool FIRST>
__device__ __forceinline__ void phase_rows(const Ctx& c, const float* X, const bf16* XB, const float* gvec, const float* b_mod, const int* positions, unsigned char* ws, int shift_chunk, int scale_chunk, const float* gvec2 = nullptr, const float* w_query = nullptr) {
    LAS float* A1 = (LAS float*)c.lds; LAS float* B1 = A1 + D;
    const int b = c.vcu >> 7;
    const float* MODP = (const float*)(ws + WS_MODP); float* MODF = (float*)(ws + WS_MODF);
    {
        const int j = 4 * c.tid;
        f32x4 sh, sc;
        if (FIRST) {
            sh = *(const f32x4*)(b_mod + shift_chunk * D + j); sc = *(const f32x4*)(b_mod + scale_chunk * D + j);
#pragma unroll
            for (int s = 0; s < 8; ++s) { sh += *(const f32x4*)(MODP + ((size_t)s * 2 + b) * NMOD + shift_chunk * D + j); sc += *(const f32x4*)(MODP + ((size_t)s * 2 + b) * NMOD + scale_chunk * D + j); }
        } else { sh = *(const f32x4*)(MODF + (size_t)b * NMOD + shift_chunk * D + j); sc = *(const f32x4*)(MODF + (size_t)b * NMOD + scale_chunk * D + j); }
        const f32x4 g = *(const f32x4*)(gvec + j);
        *(LAS f32x4*)(A1 + j) = g * (sc + 1.0f); *(LAS f32x4*)(B1 + j) = sh;
    }
    LAS float* A2s = (LAS float*)(c.lds + 16384); LAS float* B2s = A2s + 2 * D;
    if (FIRST) {
        const int j = 4 * c.tid; const f32x4 g2v = *(const f32x4*)(gvec2 + j);
#pragma unroll
        for (int bb = 0; bb < 2; ++bb) {
            f32x4 sh = *(const f32x4*)(b_mod + 3 * D + j), sc = *(const f32x4*)(b_mod + 4 * D + j);
#pragma unroll
            for (int sx = 0; sx < 8; ++sx) { sh += *(const f32x4*)(MODP + ((size_t)sx * 2 + bb) * NMOD + 3 * D + j); sc += *(const f32x4*)(MODP + ((size_t)sx * 2 + bb) * NMOD + 4 * D + j); }
            *(LAS f32x4*)(A2s + bb * D + j) = g2v * (sc + 1.0f); *(LAS f32x4*)(B2s + bb * D + j) = sh;
        }
    }
    if (FIRST && c.vcu < 48 && c.tid < 256) {
        const int col = 256 * c.vcu + c.tid;
#pragma unroll
        for (int bb = 0; bb < 2; ++bb) { float v = b_mod[col];
#pragma unroll
            for (int s = 0; s < 8; ++s) v += MODP[((size_t)s * 2 + bb) * NMOD + col];
            MODF[(size_t)bb * NMOD + col] = v; }
    }
    __syncthreads();
    if (FIRST) {
        LAS float* scr = (LAS float*)(c.lds + 49152 + c.wave * 8448);
        p1_fold_q_item(w_query, (bf16*)(ws + WS_WQ2), (float*)(ws + WS_BIASP), A2s, B2s, scr, c.gw, c.lane);
    }
    bf16* HB = (bf16*)(ws + WS_HB);
    for (int i = 0; i < 8; ++i) {
        const int t = 64 * c.vcu + 8 * c.wave + i;
        f32x4 v[8]; float ss = 0.f;
#pragma unroll
        for (int q = 0; q < 8; ++q) {
            if (FIRST) v[q] = __builtin_nontemporal_load((const f32x4*)(X + (size_t)t * D + 4 * c.lane + 256 * q));
            else { const v2u w = *(const v2u*)(XB + (size_t)t * D + 4 * c.lane + 256 * q); v[q] = (f32x4){bflo(w.x), bfhi(w.x), bflo(w.y), bfhi(w.y)}; }
            ss += (v[q][0] * v[q][0] + v[q][1] * v[q][1]) + (v[q][2] * v[q][2] + v[q][3] * v[q][3]); }
        const float rstd = 1.0f / sqrtf(wave_sum(ss) * (1.0f / D) + NORM_EPS);
        bf16* hr = HB + (size_t)t * D + 4 * c.lane;
#pragma unroll
        for (int q = 0; q < 8; ++q) {
            const f32x4 a = *(const LAS f32x4*)(A1 + 256 * q + 4 * c.lane), bb = *(const LAS f32x4*)(B1 + 256 * q + 4 * c.lane);
            const f32x4 y = v[q] * rstd * a + bb;
            v2u o; o.x = pk2(y[0], y[1]); o.y = pk2(y[2], y[3]);
            *(v2u*)(hr + 256 * q) = o;
        }
        if (FIRST && c.lane < 32) {
            const int fi = c.lane & 15;
            const float inv = (float)pow(500000.0, -(double)fi / 16.0);
            const float ang = (float)positions[t] * inv;
            ((float*)(ws + WS_CS))[(size_t)t * 32 + c.lane] = (c.lane < 16) ? cosf(ang) : sinf(ang);
        }
    }
    __syncthreads();
}

template <int P>
__device__ __forceinline__ void poolr_item(const bf16* U, bf16* RB, int t, int c0) {
    const int tb = t & (SEQ - 1);
    float s[8] = {0.f, 0.f, 0.f, 0.f, 0.f, 0.f, 0.f, 0.f}, u0[8];
    v4u w[P];
#pragma unroll
    for (int j = 0; j < P; ++j) w[j] = *(const v4u*)(U + (size_t)(t - (j <= tb ? j : tb)) * 1024 + c0);
#pragma unroll
    for (int j = 0; j < P; ++j) {
        const float m = (j <= tb) ? 1.0f : 0.0f;
        const float f[8] = {bflo(w[j].x), bfhi(w[j].x), bflo(w[j].y), bfhi(w[j].y), bflo(w[j].z), bfhi(w[j].z), bflo(w[j].w), bfhi(w[j].w)};
#pragma unroll
        for (int e = 0; e < 8; ++e) { s[e] += m * f[e]; if (j == 0) u0[e] = f[e]; }
    }
    const int cnt = (tb + 1 < P) ? tb + 1 : P;
    const float ic = 1.0f / (float)cnt;
    v4u o; o.x = pk2(s[0] * ic - u0[0], s[1] * ic - u0[1]); o.y = pk2(s[2] * ic - u0[2], s[3] * ic - u0[3]);
    o.z = pk2(s[4] * ic - u0[4], s[5] * ic - u0[5]); o.w = pk2(s[6] * ic - u0[6], s[7] * ic - u0[7]);
    *(v4u*)(RB + (size_t)t * 1024 + c0) = o;
}
__device__ __forceinline__ void phase_poolr(const Ctx& c, unsigned char* ws) {
    const bf16* U = (const bf16*)(ws + WS_U); bf16* RB = (bf16*)(ws + WS_RB);
    LAS unsigned char* tile = c.lds;
    const int ch = c.tid & 31, rg = c.tid >> 5;
    for (int it = c.vcu; it < 1024; it += c.G) {
        const int g = it & 3, t0 = 64 * (it >> 2), P = 2 << g, tb0 = t0 & (SEQ - 1), nrows = 63 + P;
        __syncthreads();
        for (int id = c.tid; id < nrows * 32; id += NTHREADS) {
            const int lr = id >> 5, cc = id & 31, dt = lr - (P - 1);
            v4u w = {0u, 0u, 0u, 0u};
            if (tb0 + dt >= 0) w = *(const v4u*)(U + (size_t)(t0 + dt) * 1024 + 256 * g + 8 * cc);
            *(LAS v4u*)(tile + lr * 512 + cc * 16) = w;
        }
        __syncthreads();
        float sacc[8];
#pragma unroll
        for (int e = 0; e < 8; ++e) sacc[e] = 0.f;
        const int r0 = 4 * rg;
        for (int j = 0; j < P; ++j) {
            const v4u w = *(const LAS v4u*)(tile + (r0 + P - 1 - j) * 512 + ch * 16);
            sacc[0] += bflo(w.x); sacc[1] += bfhi(w.x); sacc[2] += bflo(w.y); sacc[3] += bfhi(w.y); sacc[4] += bflo(w.z); sacc[5] += bfhi(w.z); sacc[6] += bflo(w.w); sacc[7] += bfhi(w.w);
        }
#pragma unroll
        for (int i = 0; i < 4; ++i) {
            const int r = r0 + i, tb = tb0 + r;
            const v4u wu = *(const LAS v4u*)(tile + (r + P - 1) * 512 + ch * 16);
            const float u0[8] = {bflo(wu.x), bfhi(wu.x), bflo(wu.y), bfhi(wu.y), bflo(wu.z), bfhi(wu.z), bflo(wu.w), bfhi(wu.w)};
            if (i > 0) {
                const v4u wo = *(const LAS v4u*)(tile + (r - 1) * 512 + ch * 16);
                const float uo[8] = {bflo(wo.x), bfhi(wo.x), bflo(wo.y), bfhi(wo.y), bflo(wo.z), bfhi(wo.z), bflo(wo.w), bfhi(wo.w)};
#pragma unroll
                for (int e = 0; e < 8; ++e) sacc[e] += u0[e] - uo[e];
            }
            const int cnt = (tb + 1 < P) ? tb + 1 : P;
            const float ic = 1.0f / (float)cnt;
            v4u o; o.x = pk2(sacc[0] * ic - u0[0], sacc[1] * ic - u0[1]); o.y = pk2(sacc[2] * ic - u0[2], sacc[3] * ic - u0[3]);
            o.z = pk2(sacc[4] * ic - u0[4], sacc[5] * ic - u0[5]); o.w = pk2(sacc[6] * ic - u0[6], sacc[7] * ic - u0[7]);
            *(v4u*)(RB + (size_t)(t0 + r) * 1024 + 256 * g + 8 * ch) = o;
        }
    }
    __syncthreads();
}

__device__ __forceinline__ void phase_attn_simple(const Ctx& c, unsigned char* ws) {
    const bf16* QB = (const bf16*)(ws + WS_Q); const bf16* KB = (const bf16*)(ws + WS_K); const bf16* VB = (const bf16*)(ws + WS_V); bf16* HC = (bf16*)(ws + WS_HC);
    LAS float* pb = (LAS float*)(c.lds + c.wave * 2048);
    const float NEG = -3.0e38f;
    for (int item = c.gw; item < T * NH; item += c.ngw) {
        const int t = item >> 3, h = item & 7, tb = t & (SEQ - 1);
        const v4u* qp = (const v4u*)(QB + (size_t)t * 1024 + h * 128);
        v4u q[16];
#pragma unroll
        for (int i = 0; i < 16; ++i) q[i] = qp[i];
        float sv[7]; float mx = NEG;
#pragma unroll
        for (int r = 0; r < 7; ++r) {
            const int e = c.lane + 64 * r, pat = e / 129, j = e - pat * 129, off = j << (2 * pat);
            const bool valid = (e < 387) && (off <= tb);
            float s = NEG;
            if (valid) {
                const v4u* kp = (const v4u*)(KB + (size_t)(t - off) * 1024 + h * 128);
                float a0 = 0.f, a1 = 0.f;
#pragma unroll
                for (int i = 0; i < 16; ++i) { const v4u kk = kp[i]; a0 = dot2(q[i].x, kk.x, a0); a1 = dot2(q[i].y, kk.y, a1); a0 = dot2(q[i].z, kk.z, a0); a1 = dot2(q[i].w, kk.w, a1); }
                s = a0 + a1;
            }
            sv[r] = s; mx = fmaxf(mx, s);
        }
        mx = wave_max(mx);
        float l = 0.f;
#pragma unroll
        for (int r = 0; r < 7; ++r) { const float p = (sv[r] > -1.0e38f) ? exp2f(sv[r] - mx) : 0.f; l += p; pb[c.lane + 64 * r] = p; }
        l = wave_sum(l);
        LDS_WAIT();
        float o0 = 0.f, o1 = 0.f;
        for (int e = 0; e < 387; ++e) {
            const int pat = e / 129, j = e - pat * 129, off = j << (2 * pat);
            if (off > tb) continue;
            const float pe = pb[e];
            const unsigned w = *(const unsigned*)(VB + (size_t)(t - off) * 1024 + h * 128 + 2 * c.lane);
            o0 += pe * bflo(w); o1 += pe * bfhi(w);
        }
        const float il = 1.0f / l;
        *(unsigned*)(HC + (size_t)t * 2048 + h * 128 + 2 * c.lane) = pk2(o0 * il, o1 * il);
        LDS_WAIT();
    }
}

__device__ __forceinline__ unsigned off_k(unsigned row, unsigned ch) { return 256u * row + 16u * (ch ^ ((row & 3u) | (((row >> 3) & 3u) << 2))); }
__device__ __forceinline__ unsigned off_b(unsigned row, unsigned ch) { return 256u * row + 16u * (ch ^ (((row & 3u) << 2) | ((row >> 2) & 3u))); }
typedef short s4v __attribute__((ext_vector_type(4)));
__device__ __forceinline__ void phase_attn_mfma(const Ctx& c, unsigned char* ws) {
    const bf16* QB = (const bf16*)(ws + WS_Q); const bf16* KB = (const bf16*)(ws + WS_K); const bf16* VB = (const bf16*)(ws + WS_V);
    float* LSE = (float*)(ws + WS_LSE);
    const int g = c.lane >> 4, lq = c.lane & 15;
    const float NEG = -3.0e38f;
    const int i0 = 16 * c.wave, jb = 32 * (c.wave >> 1), iq = i0 + lq;
    unsigned kaddr[2][4], vbase[2], vxor[2];
    {
        const unsigned rowa = (unsigned)(jb + 8 * (lq >> 2) + (lq & 3));
        const unsigned q4 = (unsigned)(lq >> 2), p4 = (unsigned)(c.lane & 3);
#pragma unroll
        for (int s4 = 0; s4 < 4; ++s4) { kaddr[0][s4] = off_k(rowa, (unsigned)(4 * s4 + g)); kaddr[1][s4] = off_k(rowa + 4u, (unsigned)(4 * s4 + g)); }
#pragma unroll
        for (int t = 0; t < 2; ++t) {
            const unsigned row = (unsigned)(jb + 8 * g + 4 * t) + q4, f = ((row & 3u) << 2) | ((row >> 2) & 3u);
            vxor[t] = 16u * (f & 14u);
            vbase[t] = 65536u + 256u * row + 16u * ((p4 >> 1) ^ (f & 1u)) + 8u * (p4 & 1u);
        }
    }
    v4u kreg[8], vreg[8]; pg8::bf16x8 qnext[4];
#define ATTN_DECODE(U) const int p_ = (U) >> 10, rem_ = (U) & 1023, bh_ = rem_ >> 6, rn_ = rem_ & 63, b_ = bh_ >> 3, h_ = bh_ & 7; \
        const int dsh_ = 2 * p_, nbl_ = 64 >> dsh_, r_ = rn_ / nbl_, n_ = rn_ - r_ * nbl_; \
        const int tok0q_ = b_ * SEQ + r_ + ((n_ * 128) << dsh_), tok0k_ = tok0q_ - (128 << dsh_);
#define ATTN_ISSUE(U) do { ATTN_DECODE(U) \
        const unsigned rstr_ = 2048u << dsh_;                         \
        const unsigned off0_ = (unsigned)(tok0k_ + ((c.tid >> 4) << dsh_)) * 2048u + (unsigned)(h_ * 256 + (c.tid & 15) * 16); \
        _Pragma("unroll") for (int i_ = 0; i_ < 8; ++i_) {           \
            v4u kv_ = {0u, 0u, 0u, 0u}, vv_ = kv_; \
            if (i_ >= 4 || n_ > 0) { const unsigned o_ = off0_ + (unsigned)(32 * i_) * rstr_; kv_ = *(const v4u*)((const unsigned char*)KB + o_); vv_ = *(const v4u*)((const unsigned char*)VB + o_); } \
            kreg[i_] = kv_; vreg[i_] = vv_; } \
        const int tokq_ = tok0q_ + (iq << dsh_); \
        _Pragma("unroll") for (int s_ = 0; s_ < 4; ++s_) qnext[s_] = *(const pg8::bf16x8*)(QB + (size_t)tokq_ * 1024 + h_ * 128 + 32 * s_ + 8 * g); } while (0)
    ATTN_ISSUE(c.vcu);
    for (int unit = c.vcu; unit < 3072; unit += c.G) {
        ATTN_DECODE(unit)
        const int p = p_, h = h_, n = n_, dsh = dsh_, tok0q = tok0q_;
        bf16* OP = (bf16*)(ws + (p == 0 ? WS_OP0 : (p == 1 ? WS_OP1 : WS_OP2)));
        __syncthreads();
#pragma unroll
        for (int i = 0; i < 8; ++i) {
            const int id = c.tid + 512 * i, row = id >> 4, ch = id & 15;
            *(LAS v4u*)(c.lds + off_k((unsigned)row, (unsigned)ch)) = kreg[i]; *(LAS v4u*)(c.lds + 65536u + off_b((unsigned)row, (unsigned)ch)) = vreg[i];
        }
        const int tokq = tok0q + (iq << dsh);
        pg8::bf16x8 qf[4];
#pragma unroll
        for (int s4 = 0; s4 < 4; ++s4) qf[s4] = qnext[s4];
        __syncthreads();
        if (unit + c.G < 3072) ATTN_ISSUE(unit + c.G);
        f32x4 sa[5], sb[5];
#pragma unroll
        for (int kt = 0; kt < 5; ++kt) {
            f32x4 aa = {0.f, 0.f, 0.f, 0.f}, ab = aa;
#pragma unroll
            for (int s4 = 0; s4 < 4; ++s4) {
                const pg8::bf16x8 ka = *(const LAS pg8::bf16x8*)(c.lds + kaddr[0][s4] + 8192u * kt);
                const pg8::bf16x8 kb = *(const LAS pg8::bf16x8*)(c.lds + kaddr[1][s4] + 8192u * kt);
                aa = __builtin_amdgcn_mfma_f32_16x16x32_bf16(ka, qf[s4], aa, 0, 0, 0);
                ab = __builtin_amdgcn_mfma_f32_16x16x32_bf16(kb, qf[s4], ab, 0, 0, 0);
            }
            sa[kt] = aa; sb[kt] = ab;
        }
        const int jlo = (n > 0) ? iq : (iq > 128 ? iq : 128);
#pragma unroll
        for (int i = 0; i < 4; ++i) {
            const int ja = jb + 8 * g + i;
            sa[0][i] = (ja >= jlo) ? sa[0][i] : NEG; sb[0][i] = (ja + 4 >= jlo) ? sb[0][i] : NEG;
            sa[4][i] = (ja + 128 <= iq + 128) ? sa[4][i] : NEG; sb[4][i] = (ja + 132 <= iq + 128) ? sb[4][i] : NEG;
        }
        if (n == 0) {
#pragma unroll
            for (int kt = 1; kt < 5; ++kt)
#pragma unroll
                for (int i = 0; i < 4; ++i) { const int ja = jb + 32 * kt + 8 * g + i; sa[kt][i] = (ja >= jlo) ? sa[kt][i] : NEG; sb[kt][i] = (ja + 4 >= jlo) ? sb[kt][i] : NEG; }
        }
        float mx = NEG;
#pragma unroll
        for (int kt = 0; kt < 5; ++kt)
#pragma unroll
            for (int i = 0; i < 4; ++i) mx = fmaxf(mx, fmaxf(sa[kt][i], sb[kt][i]));
        mx = fmaxf(mx, SXOR(mx, 16, c.lane)); mx = fmaxf(mx, SXOR(mx, 32, c.lane));
        float l = 0.f;
#pragma unroll
        for (int kt = 0; kt < 5; ++kt)
#pragma unroll
            for (int i = 0; i < 4; ++i) { sa[kt][i] = __builtin_amdgcn_exp2f(sa[kt][i] - mx); sb[kt][i] = __builtin_amdgcn_exp2f(sb[kt][i] - mx); l += sa[kt][i] + sb[kt][i]; }
        l += SXOR(l, 16, c.lane); l += SXOR(l, 32, c.lane);
        f32x4 o[8];
#pragma unroll
        for (int c8 = 0; c8 < 8; ++c8) o[c8] = (f32x4){0.f, 0.f, 0.f, 0.f};
#pragma unroll
        for (int kt = 0; kt < 5; ++kt) {
            pg8::u32x4 pw; pw.x = pk2(sa[kt][0], sa[kt][1]); pw.y = pk2(sa[kt][2], sa[kt][3]); pw.z = pk2(sb[kt][0], sb[kt][1]); pw.w = pk2(sb[kt][2], sb[kt][3]);
            const pg8::bf16x8 pf = __builtin_bit_cast(pg8::bf16x8, pw);
#pragma unroll
            for (int c8 = 0; c8 < 8; ++c8) {
                const s4v t0 = __builtin_amdgcn_ds_read_tr16_b64_v4i16((LAS s4v*)(c.lds + (vbase[0] + ((32u * c8) ^ vxor[0])) + 8192u * kt));
                const s4v t1 = __builtin_amdgcn_ds_read_tr16_b64_v4i16((LAS s4v*)(c.lds + (vbase[1] + ((32u * c8) ^ vxor[1])) + 8192u * kt));
                const pg8::bf16x8 vf = __builtin_shufflevector(t0, t1, 0, 1, 2, 3, 4, 5, 6, 7);
                o[c8] = __builtin_amdgcn_mfma_f32_16x16x32_bf16(vf, pf, o[c8], 0, 0, 0);
            }
        }
        const float il = 1.0f / l;
        bf16* orow = OP + (size_t)tokq * 1024 + h * 128 + 4 * g;
#pragma unroll
        for (int c8 = 0; c8 < 8; ++c8) { v2u w; w.x = pk2(o[c8][0] * il, o[c8][1] * il); w.y = pk2(o[c8][2] * il, o[c8][3] * il); *(v2u*)(orow + 16 * c8) = w; }
        if (g == 0) LSE[((size_t)p * T + tokq) * 8 + h] = mx + __builtin_amdgcn_logf(l);
    }
    __syncthreads();
}
__device__ __forceinline__ void phase_combine(const Ctx& c, unsigned char* ws) {
    const float* LSE = (const float*)(ws + WS_LSE); bf16* HC = (bf16*)(ws + WS_HC);
    const bf16* OP0 = (const bf16*)(ws + WS_OP0); const bf16* OP1 = (const bf16*)(ws + WS_OP1); const bf16* OP2 = (const bf16*)(ws + WS_OP2);
    for (int t = c.gw; t < T; t += c.ngw) {
        const int h = c.lane >> 3;
        const float l0 = LSE[((size_t)0 * T + t) * 8 + h], l1 = LSE[((size_t)1 * T + t) * 8 + h], l2 = LSE[((size_t)2 * T + t) * 8 + h];
        const float m = fmaxf(l0, fmaxf(l1, l2));
        float w0 = exp2f(l0 - m), w1 = exp2f(l1 - m), w2 = exp2f(l2 - m);
        const float inv = 1.0f / (w0 + w1 + w2); w0 *= inv; w1 *= inv; w2 *= inv;
        const size_t off = (size_t)t * 1024 + 16 * c.lane;
#pragma unroll
        for (int hh = 0; hh < 2; ++hh) {
            const v4u a = *(const v4u*)(OP0 + off + 8 * hh), bq = *(const v4u*)(OP1 + off + 8 * hh), cq = *(const v4u*)(OP2 + off + 8 * hh);
            v4u o;
            o.x = pk2(w0 * bflo(a.x) + w1 * bflo(bq.x) + w2 * bflo(cq.x), w0 * bfhi(a.x) + w1 * bfhi(bq.x) + w2 * bfhi(cq.x));
            o.y = pk2(w0 * bflo(a.y) + w1 * bflo(bq.y) + w2 * bflo(cq.y), w0 * bfhi(a.y) + w1 * bfhi(bq.y) + w2 * bfhi(cq.y));
            o.z = pk2(w0 * bflo(a.z) + w1 * bflo(bq.z) + w2 * bflo(cq.z), w0 * bfhi(a.z) + w1 * bfhi(bq.z) + w2 * bfhi(cq.z));
            o.w = pk2(w0 * bflo(a.w) + w1 * bflo(bq.w) + w2 * bflo(cq.w), w0 * bfhi(a.w) + w1 * bfhi(bq.w) + w2 * bfhi(cq.w));
            *(v4u*)(HC + (size_t)t * 2048 + 16 * c.lane + 8 * hh) = o;
        }
    }
}

__device__ __forceinline__ int f2sort(float f) { const int b = __float_as_int(f); return b ^ ((b >> 31) & 0x7fffffff); }
__device__ __forceinline__ float sort2f(int k) { return __int_as_float(k ^ ((k >> 31) & 0x7fffffff)); }
#define CE_DESC(a, b) do { const int hi_ = max((a), (b)), lo_ = min((a), (b)); (a) = hi_; (b) = lo_; } while (0)
__device__ __forceinline__ void bitonic_merge16(int (&v)[16]) {
#pragma unroll
    for (int j = 8; j > 0; j >>= 1)
#pragma unroll
        for (int i = 0; i < 16; ++i) { const int l = i ^ j; if (l > i) CE_DESC(v[i], v[l]); }
}
__device__ __forceinline__ void sort16(int (&v)[16]) {
#pragma unroll
    for (int k = 2; k <= 16; k <<= 1)
#pragma unroll
        for (int j = k >> 1; j > 0; j >>= 1)
#pragma unroll
            for (int i = 0; i < 16; ++i) { const int l = i ^ j; if (l > i) { if ((i & k) == 0) CE_DESC(v[i], v[l]); else CE_DESC(v[l], v[i]); } }
}
__device__ __forceinline__ void merge_top16(int (&a)[16], const int (&b)[16]) {
#pragma unroll
    for (int k = 0; k < 16; ++k) a[k] = max(a[k], b[15 - k]);
    bitonic_merge16(a);
}
__device__ __forceinline__ void xlane_merge(int (&a)[16], int xr, int lane) {
    int b[16];
#pragma unroll
    for (int k = 0; k < 16; ++k) b[k] = SXOR(a[k], xr, lane);
    merge_top16(a, b);
}
__device__ __forceinline__ void phase_scores_topk(const Ctx& c, unsigned char* ws) {
    const bf16* QP = (const bf16*)(ws + WS_QP); const bf16* SKB = (const bf16*)(ws + WS_SKP);
    int* IDX = (int*)(ws + WS_IDX); float* GATE = (float*)(ws + WS_GATE);
    const int g = c.lane >> 4, lq = c.lane & 15;
    const int h = c.vcu & 7, tb = c.vcu >> 3;
    LAS unsigned char* lut = c.lds + 65536 + c.wave * 2560 + c.lane * 36;
#pragma unroll
    for (int i = 0; i < 8; ++i) {
        const int id = c.tid + 512 * i, row = id >> 4, ch = id & 15;
        *(LAS v4u*)(c.lds + off_b((unsigned)row, (unsigned)ch)) = *(const v4u*)(SKB + ((size_t)h * 256 + row) * 128 + ch * 8);
    }
    unsigned ka[4];
#pragma unroll
    for (int s4 = 0; s4 < 4; ++s4) ka[s4] = off_b((unsigned)lq, (unsigned)(4 * s4 + g));
    __syncthreads();
    for (int it = 0; it < 4; ++it) {
        const int t = 512 * tb + 128 * it + 16 * c.wave + lq;
        int top[2][16];
#pragma unroll
        for (int p = 0; p < 2; ++p) {
            pg8::bf16x8 qf[4];
#pragma unroll
            for (int s4 = 0; s4 < 4; ++s4) qf[s4] = *(const pg8::bf16x8*)(QP + (size_t)t * 2048 + h * 256 + p * 128 + 32 * s4 + 8 * g);
            int lo[16], hi[16];
#pragma unroll
            for (int c8 = 0; c8 < 8; ++c8) {
                f32x4 acc = {0.f, 0.f, 0.f, 0.f};
#pragma unroll
                for (int s4 = 0; s4 < 4; ++s4) {
                    const pg8::bf16x8 kf = *(const LAS pg8::bf16x8*)(c.lds + ka[s4] + (unsigned)(32768 * p + 4096 * c8));
                    acc = __builtin_amdgcn_mfma_f32_16x16x32_bf16(kf, qf[s4], acc, 0, 0, 0);
                }
#pragma unroll
                for (int i = 0; i < 4; ++i) { const int key = (f2sort(acc[i]) & ~127) | (16 * c8 + 4 * g + i); if (c8 < 4) lo[4 * c8 + i] = key; else hi[4 * (c8 - 4) + i] = key; }
            }
            sort16(lo); sort16(hi); merge_top16(lo, hi);
            xlane_merge(lo, 16, c.lane); xlane_merge(lo, 32, c.lane);
#pragma unroll
            for (int k = 0; k < 16; ++k) top[p][k] = lo[k];
        }
#pragma unroll
        for (int p = 0; p < 2; ++p)
#pragma unroll
            for (int q = 0; q < 4; ++q)
                *(LAS unsigned*)(lut + 16 * p + 4 * q) = (unsigned)(top[p][4 * q] & 127) | ((unsigned)(top[p][4 * q + 1] & 127) << 8) | ((unsigned)(top[p][4 * q + 2] & 127) << 16) | ((unsigned)(top[p][4 * q + 3] & 127) << 24);
        float f0[16], f1[16];
#pragma unroll
        for (int k = 0; k < 16; ++k) { f0[k] = sort2f(top[0][k] & ~127); f1[k] = sort2f(top[1][k] & ~127); }
#define CAND(a, b) ((f2sort(f0[a] + f1[b]) & ~255) | ((a) << 4) | (b))
        int X[16], Y[16], Z[16];
#pragma unroll
        for (int b2 = 0; b2 < 16; ++b2) X[b2] = CAND(0, b2);
#pragma unroll
        for (int b2 = 0; b2 < 8; ++b2) Y[b2] = CAND(1, b2);
#pragma unroll
        for (int a2 = 8; a2 < 16; ++a2) Y[23 - a2] = CAND(a2, 0);
        Z[0] = CAND(2, 0); Z[1] = CAND(2, 1); Z[2] = CAND(2, 2); Z[3] = CAND(2, 3); Z[4] = CAND(2, 4);
        Z[5] = CAND(3, 0); Z[6] = CAND(3, 1); Z[7] = CAND(3, 2); Z[8] = CAND(3, 3);
        Z[9] = CAND(4, 0); Z[10] = CAND(4, 1); Z[11] = CAND(4, 2);
        Z[12] = CAND(5, 0); Z[13] = CAND(5, 1); Z[14] = CAND(6, 0); Z[15] = CAND(6, 1);
        const int w0 = CAND(7, 0), w1 = CAND(7, 1);
#undef CAND
        bitonic_merge16(Y); sort16(Z);
        merge_top16(X, Y); merge_top16(X, Z);
        X[14] = max(X[14], w1); X[15] = max(X[15], w0); bitonic_merge16(X);
        LDS_WAIT();
        float e[16], sum = 0.f; const float fmx = sort2f(X[0] & ~255);
#pragma unroll
        for (int k = 0; k < 16; ++k) { e[k] = __expf(sort2f(X[k] & ~255) - fmx); sum += e[k]; }
        const float inv = 1.0f / sum;
        int ex[16];
#pragma unroll
        for (int k = 0; k < 16; ++k) { const int a2 = (X[k] >> 4) & 15, b2 = X[k] & 15; ex[k] = (int)(*(const LAS unsigned char*)(lut + a2)) * PE_NK + (int)(*(const LAS unsigned char*)(lut + 16 + b2)); }
        if (g == 0) {
            int* ip = IDX + (size_t)t * 128 + h * 16; float* gp = GATE + (size_t)t * 128 + h * 16;
#pragma unroll
            for (int q = 0; q < 4; ++q) {
                *(int4*)(ip + 4 * q) = make_int4(ex[4 * q], ex[4 * q + 1], ex[4 * q + 2], ex[4 * q + 3]);
                *(f32x4*)(gp + 4 * q) = (f32x4){e[4 * q] * inv, e[4 * q + 1] * inv, e[4 * q + 2] * inv, e[4 * q + 3] * inv};
            }
        }
        LDS_WAIT();
    }
    __syncthreads();
}

__device__ __forceinline__ void phase_topk_simple(const Ctx& c, unsigned char* ws) {
    const float* SC = (const float*)(ws + WS_SC); int* IDX = (int*)(ws + WS_IDX); float* GATE = (float*)(ws + WS_GATE);
    const float NEG = -3.0e38f;
    for (int item = c.gw; item < T * PE_HEADS; item += c.ngw) {
        const int t = item >> 3, h = item & 7;
        const float* sc = SC + (size_t)t * 2048 + h * 256;
        float sh[2] = {0.f, 0.f}; int ih[2] = {0, 0};
#pragma unroll
        for (int p = 0; p < 2; ++p) {
            float va = sc[128 * p + c.lane], vb = sc[128 * p + 64 + c.lane];
            for (int r = 0; r < PE_K; ++r) {
                const float M = wave_max(fmaxf(va, vb));
                const unsigned long long ba = __ballot(va == M), bb = __ballot(vb == M);
                const int n = ba ? (int)__builtin_ctzll(ba) : 64 + (int)__builtin_ctzll(bb);
                if (c.lane == r) { sh[p] = M; ih[p] = n; }
                if (n < 64) { if (c.lane == n) va = NEG; } else { if (c.lane == n - 64) vb = NEG; }
            }
        }
        float cv[4];
#pragma unroll
        for (int q = 0; q < 4; ++q) { const int cc = c.lane + 64 * q; cv[q] = sh_idx(sh[0], cc >> 4) + sh_idx(sh[1], cc & 15); }
        float ts = NEG; int tc = 0;
        for (int r = 0; r < PE_K; ++r) {
            const float M = wave_max(fmaxf(fmaxf(cv[0], cv[1]), fmaxf(cv[2], cv[3])));
            int cc = -1;
#pragma unroll
            for (int q = 3; q >= 0; --q) { const unsigned long long bq = __ballot(cv[q] == M); if (bq) cc = 64 * q + (int)__builtin_ctzll(bq); }
            if (c.lane == r) { ts = M; tc = cc; }
#pragma unroll
            for (int q = 0; q < 4; ++q) if (cc == c.lane + 64 * q) cv[q] = NEG;
        }
        const int i0 = sh_idx(ih[0], tc >> 4), i1 = sh_idx(ih[1], tc & 15);
        const float tmax = sh_idx(ts, 0);
        const float ex = (c.lane < PE_K) ? __expf(ts - tmax) : 0.f;
        const float sum = wave_sum(ex);
        if (c.lane < PE_K) { IDX[(size_t)t * 128 + h * 16 + c.lane] = i0 * PE_NK + i1; GATE[(size_t)t * 128 + h * 16 + c.lane] = ex / sum; }
    }
}

__device__ __forceinline__ void ld_row8(const unsigned char* tab, int e, int lane, v4u (&r)[2]) {
    const v4u* p = (const v4u*)(tab + (size_t)e * D) + lane;
    r[0] = p[0]; r[1] = p[64];
}
__device__ __forceinline__ int idot_row(const int (&h)[8], const v4u (&r)[2]) {
    int a = 0, b = 0;
    a = __builtin_amdgcn_sdot4(h[0], (int)r[0].x, a, false); b = __builtin_amdgcn_sdot4(h[1], (int)r[0].y, b, false);
    a = __builtin_amdgcn_sdot4(h[2], (int)r[0].z, a, false); b = __builtin_amdgcn_sdot4(h[3], (int)r[0].w, b, false);
    a = __builtin_amdgcn_sdot4(h[4], (int)r[1].x, a, false); b = __builtin_amdgcn_sdot4(h[5], (int)r[1].y, b, false);
    a = __builtin_amdgcn_sdot4(h[6], (int)r[1].z, a, false); b = __builtin_amdgcn_sdot4(h[7], (int)r[1].w, b, false);
    return a + b;
}
__device__ __forceinline__ int reduce8(const int (&p)[8], int lane) {
    const bool b0 = lane & 1, b1 = lane & 2, b2 = lane & 4;
    int q[4], r2[2];
#pragma unroll
    for (int i = 0; i < 4; ++i) { const int keep = b0 ? p[2 * i + 1] : p[2 * i], send = b0 ? p[2 * i] : p[2 * i + 1]; q[i] = keep + SXOR(send, 1, lane); }
#pragma unroll
    for (int i = 0; i < 2; ++i) { const int keep = b1 ? q[2 * i + 1] : q[2 * i], send = b1 ? q[2 * i] : q[2 * i + 1]; r2[i] = keep + SXOR(send, 2, lane); }
    int v = (b2 ? r2[1] : r2[0]) + SXOR(b2 ? r2[0] : r2[1], 4, lane);
    v += SXOR(v, 8, lane); v += SXOR(v, 16, lane); v += SXOR(v, 32, lane);
    return v;
}
__device__ __forceinline__ void axpy_row8(float (&y)[32], float a, const v4u (&r)[2]) {
#pragma unroll
    for (int q = 0; q < 2; ++q) {
        const unsigned w[4] = {r[q].x, r[q].y, r[q].z, r[q].w};
#pragma unroll
        for (int d = 0; d < 4; ++d) {
            y[16 * q + 4 * d + 0] += a * (float)(w[d] & 0xffu); y[16 * q + 4 * d + 1] += a * (float)((w[d] >> 8) & 0xffu);
            y[16 * q + 4 * d + 2] += a * (float)((w[d] >> 16) & 0xffu); y[16 * q + 4 * d + 3] += a * (float)(w[d] >> 24);
        }
    }
}
__device__ __forceinline__ void phase_peer(const Ctx& c, const float* X1, const float* final_g, float* out, unsigned char* ws) {
    const unsigned char* PU = ws + WS_PU; const unsigned char* PV = ws + WS_PV; const bf16* HB = (const bf16*)(ws + WS_HB);
    const float* SU = (const float*)(ws + WS_SU); const float* SV = (const float*)(ws + WS_SV);
    const int* IDX = (const int*)(ws + WS_IDX); const float* GATE = (const float*)(ws + WS_GATE); const float* MODF = (const float*)(ws + WS_MODF);
    LAS float* G2 = (LAS float*)c.lds; LAS float* FG = G2 + D;
    const int b = c.vcu >> 7;
    { const int j = 4 * c.tid; *(LAS f32x4*)(G2 + j) = *(const f32x4*)(MODF + (size_t)b * NMOD + 5 * D + j); *(LAS f32x4*)(FG + j) = *(const f32x4*)(final_g + j); }
    __syncthreads();
#pragma unroll 1
    for (int i = (DUP & 1024) ? -8 : 0; i < 8; ++i) {
        const int t = 64 * c.vcu + 8 * c.wave + (i & 7);
        const int e0 = IDX[(size_t)t * 128 + c.lane], e1 = IDX[(size_t)t * 128 + 64 + c.lane];
        const float g0 = GATE[(size_t)t * 128 + c.lane], g1 = GATE[(size_t)t * 128 + 64 + c.lane];
        v4u r[8][2];
#pragma unroll
        for (int q = 0; q < 8; ++q) ld_row8(PU, __builtin_amdgcn_readlane(e0, q), c.lane, r[q]);
        const float su0 = SU[e0], su1 = SU[e1], sv0 = SV[e0], sv1 = SV[e1];
        int hq[8]; float sh;
        {
            float hf[32]; float am = 0.f;
#pragma unroll
            for (int q = 0; q < 2; ++q)
#pragma unroll
                for (int rr = 0; rr < 2; ++rr) {
                    const v4u w = *(const v4u*)(HB + (size_t)t * D + 1024 * q + 16 * c.lane + 8 * rr);
                    float* f = hf + 16 * q + 8 * rr;
                    f[0] = bflo(w.x); f[1] = bfhi(w.x); f[2] = bflo(w.y); f[3] = bfhi(w.y); f[4] = bflo(w.z); f[5] = bfhi(w.z); f[6] = bflo(w.w); f[7] = bfhi(w.w);
                }
#pragma unroll
            for (int k = 0; k < 32; ++k) am = fmaxf(am, fabsf(hf[k]));
            am = wave_max(am);
            const float inv = (am > 0.f) ? 127.0f / am : 0.f; sh = am * (1.0f / 127.0f);
#pragma unroll
            for (int d = 0; d < 8; ++d) { unsigned w = 0u;
#pragma unroll
                for (int e = 0; e < 4; ++e) { const int qv = __float2int_rn(hf[4 * d + e] * inv); w |= ((unsigned)qv & 0xffu) << (8 * e); }
                hq[d] = (int)w; }
        }
        int ia0 = 0, ia1 = 0;
#pragma unroll 1
        for (int m = 0; m < 16; ++m) {
            int part[8];
#pragma unroll
            for (int q = 0; q < 8; ++q) {
                part[q] = idot_row(hq, r[q]);
                const int kn = 8 * (m + 1) + q;
                if (m < 15) { const int en = (kn < 64) ? __builtin_amdgcn_readlane(e0, kn & 63) : __builtin_amdgcn_readlane(e1, kn & 63); ld_row8(PU, en, c.lane, r[q]); }
            }
            const int v = reduce8(part, c.lane);
            if (m < 8) { if ((c.lane >> 3) == m) ia0 = v; } else { if ((c.lane >> 3) == m - 8) ia1 = v; }
        }
#pragma unroll
        for (int q = 0; q < 8; ++q) ld_row8(PV, __builtin_amdgcn_readlane(e0, q), c.lane, r[q]);
        const float a0 = (float)ia0 * su0 * sh, a1 = (float)ia1 * su1 * sh;
        const float c0 = 0.5f * a0 * (1.0f + erff(a0 * 0.70710678118654752f)) * g0 * sv0;
        const float c1 = 0.5f * a1 * (1.0f + erff(a1 * 0.70710678118654752f)) * g1 * sv1;
        const float csum = wave_sum(c0 + c1);
        float y[32];
#pragma unroll
        for (int q = 0; q < 32; ++q) y[q] = 0.f;
#pragma unroll 1
        for (int m = 0; m < 16; ++m) {
#pragma unroll
            for (int q = 0; q < 8; ++q) {
                const int k = 8 * m + q;
                const float ck = __uint_as_float((k < 64) ? __builtin_amdgcn_readlane(__float_as_uint(c0), k & 63) : __builtin_amdgcn_readlane(__float_as_uint(c1), k & 63));
                axpy_row8(y, ck, r[q]);
                const int kn = k + 8;
                if (m < 15) { const int en = (kn < 64) ? __builtin_amdgcn_readlane(e0, kn & 63) : __builtin_amdgcn_readlane(e1, kn & 63); ld_row8(PV, en, c.lane, r[q]); }
            }
        }
        const float* xr = X1 + (size_t)t * D + 16 * c.lane; float* orow = ((DUP & 1024) && i < 0 ? (float*)(ws + WS_HC) : out) + (size_t)t * D + 16 * c.lane;
        const float yoff = 128.0f * csum;
        float ss = 0.f;
#pragma unroll
        for (int q = 0; q < 2; ++q)
#pragma unroll
            for (int d = 0; d < 4; ++d) {
                const f32x4 xa = *(const f32x4*)(xr + 1024 * q + 4 * d);
                const f32x4 ga = *(const LAS f32x4*)(G2 + 1024 * q + 16 * c.lane + 4 * d);
#pragma unroll
                for (int e = 0; e < 4; ++e) { const float v = xa[e] + ga[e] * (y[16 * q + 4 * d + e] - yoff); y[16 * q + 4 * d + e] = v; ss += v * v; }
            }
        const float rstd = 1.0f / sqrtf(wave_sum(ss) * (1.0f / D) + NORM_EPS);
#pragma unroll
        for (int q = 0; q < 2; ++q)
#pragma unroll
            for (int d = 0; d < 4; ++d) {
                const f32x4 fa = *(const LAS f32x4*)(FG + 1024 * q + 16 * c.lane + 4 * d);
                f32x4 o;
#pragma unroll
                for (int e = 0; e < 4; ++e) o[e] = y[16 * q + 4 * d + e] * rstd * fa[e];
                *(f32x4*)(orow + 1024 * q + 4 * d) = o;
            }
    }
}

__device__ __forceinline__ v4u ld_row4(const unsigned char* tab, int e, int lane) { return *((const v4u*)(tab + (size_t)e * 1024) + lane); }
__device__ __forceinline__ int idot_row4(const int (&h)[8], const v4u& r) {
    const int w[4] = {(int)r.x, (int)r.y, (int)r.z, (int)r.w}; int ah = 0, al = 0;
#pragma unroll
    for (int d = 0; d < 4; ++d) { ah = __builtin_amdgcn_sdot8(h[d], w[d], ah, false); al = __builtin_amdgcn_sdot8(h[4 + d], w[d], al, false); }
    return 16 * ah + al;
}
__device__ __forceinline__ void vacc4(int (&y)[32], const v4u& ra, const v4u& rb, const v4u& rc, const v4u& rd, int cq4) {
    const unsigned A[4] = {ra.x, ra.y, ra.z, ra.w}, B[4] = {rb.x, rb.y, rb.z, rb.w}, C[4] = {rc.x, rc.y, rc.z, rc.w}, Dd[4] = {rd.x, rd.y, rd.z, rd.w};
#pragma unroll
    for (int d = 0; d < 4; ++d) {
        const unsigned t0 = __builtin_amdgcn_perm(A[d], B[d], 0x01050004u), t1 = __builtin_amdgcn_perm(A[d], B[d], 0x03070206u);
        const unsigned t2 = __builtin_amdgcn_perm(C[d], Dd[d], 0x01050004u), t3 = __builtin_amdgcn_perm(C[d], Dd[d], 0x03070206u);
        const unsigned T[4] = {__builtin_amdgcn_perm(t0, t2, 0x01000504u), __builtin_amdgcn_perm(t0, t2, 0x03020706u),
                               __builtin_amdgcn_perm(t1, t3, 0x01000504u), __builtin_amdgcn_perm(t1, t3, 0x03020706u)};
#pragma unroll
        for (int e = 0; e < 4; ++e) {
            y[8 * d + e] = __builtin_amdgcn_sdot4((int)(T[e] & 0x0f0f0f0fu), cq4, y[8 * d + e], false);
            y[8 * d + 4 + e] = __builtin_amdgcn_sdot4((int)T[e], cq4, y[8 * d + 4 + e], false);
        }
    }
}
#define SCHED_FENCE() __builtin_amdgcn_sched_barrier(0)
template <bool REMAP>
__device__ __forceinline__ void phase_peer4_u(const Ctx& c, const float* g2vec, unsigned char* ws) {
    const unsigned char* PU = ws + WS_PU; const bf16* HB = (const bf16*)(ws + WS_X1B);
    LAS float* A2 = (LAS float*)(c.lds + 16384); LAS float* B2 = A2 + D;
    { const float* MODF_ = (const float*)(ws + WS_MODF) + (size_t)(c.vcu >> 7) * NMOD; const int j = 4 * c.tid;
      *(LAS f32x4*)(A2 + j) = *(const f32x4*)(g2vec + j) * (*(const f32x4*)(MODF_ + 4 * D + j) + 1.0f); *(LAS f32x4*)(B2 + j) = *(const f32x4*)(MODF_ + 3 * D + j); }
    __syncthreads();
    const float* SU = (const float*)(ws + WS_SU); const float* SV = (const float*)(ws + WS_SV);
    const int* IDX = (const int*)(ws + WS_IDX); const float* GATE = (const float*)(ws + WS_GATE);
    int* TQ = (int*)(ws + (REMAP ? WS_HC : WS_TQ)); float* CSC = (float*)(ws + (REMAP ? WS_HC + 16 * MiB : WS_CSC));
    const int rm_or = (int)(blockIdx.x & 7) << 11;
#define RM(e) (REMAP ? (((e) & 2047) | rm_or) : (e))
    const int tbase = 64 * c.vcu + 8 * c.wave;
    int e0n = RM(IDX[(size_t)tbase * 128 + c.lane]), e1n = RM(IDX[(size_t)tbase * 128 + 64 + c.lane]);
    float g0n = GATE[(size_t)tbase * 128 + c.lane], g1n = GATE[(size_t)tbase * 128 + 64 + c.lane];
    v2u hraw[8];
#pragma unroll
    for (int j = 0; j < 8; ++j) hraw[j] = __builtin_nontemporal_load((const v2u*)(HB + (size_t)tbase * D + 256 * j + 4 * c.lane));
    v4u r[16];
#pragma unroll
    for (int q = 0; q < 16; ++q) r[q] = ld_row4(PU, __builtin_amdgcn_readlane(e0n, q), c.lane);
#pragma unroll 1
    for (int i = (DUP & 1024) ? -8 : 0; i < 8; ++i) {
        const int t = tbase + (i & 7), tn = tbase + ((i + 1) & 7);
        const int e0 = e0n, e1 = e1n; const float g0 = g0n, g1 = g1n;
        const float su0 = SU[e0], su1 = SU[e1], sv0 = SV[e0], sv1 = SV[e1];
        int hq[8]; float sh; int hsum;
        {
            float hf[32]; float am = 0.f, ssx = 0.f;
#pragma unroll
            for (int j = 0; j < 8; ++j) { hf[4 * j] = bflo(hraw[j].x); hf[4 * j + 1] = bfhi(hraw[j].x); hf[4 * j + 2] = bflo(hraw[j].y); hf[4 * j + 3] = bfhi(hraw[j].y); }
#pragma unroll
            for (int k = 0; k < 32; ++k) ssx += hf[k] * hf[k];
            const float rstd2 = 1.0f / sqrtf(wave_sum(ssx) * (1.0f / D) + NORM_EPS);
#pragma unroll
            for (int j = 0; j < 8; ++j) { const f32x4 av = *(const LAS f32x4*)(A2 + 256 * j + 4 * c.lane), bv = *(const LAS f32x4*)(B2 + 256 * j + 4 * c.lane);
#pragma unroll
                for (int e = 0; e < 4; ++e) hf[4 * j + e] = hf[4 * j + e] * rstd2 * av[e] + bv[e]; }
#pragma unroll
            for (int k = 0; k < 32; ++k) am = fmaxf(am, fabsf(hf[k]));
            am = wave_max(am);
            const float inv = (am > 0.f) ? 119.0f / am : 0.f; sh = am * (1.0f / 119.0f);
            int hs = 0;
#pragma unroll
            for (int d = 0; d < 4; ++d) { unsigned wh = 0u, wl = 0u;
#pragma unroll
                for (int e = 0; e < 4; ++e)
#pragma unroll
                    for (int odd = 0; odd < 2; ++odd) {
                        const int qv = __float2int_rn(hf[4 * (2 * d + odd) + e] * inv), hh = (qv + 8) >> 4, hl = qv - 16 * hh;
                        hs += qv; wh |= ((unsigned)hh & 15u) << (8 * e + 4 * odd); wl |= ((unsigned)hl & 15u) << (8 * e + 4 * odd);
                    }
                hq[d] = (int)wh; hq[4 + d] = (int)wl; }
            hsum = wave_sum_i(hs);
        }
        e0n = RM(IDX[(size_t)tn * 128 + c.lane]); e1n = RM(IDX[(size_t)tn * 128 + 64 + c.lane]);
        g0n = GATE[(size_t)tn * 128 + c.lane]; g1n = GATE[(size_t)tn * 128 + 64 + c.lane];
#pragma unroll
        for (int j = 0; j < 8; ++j) hraw[j] = __builtin_nontemporal_load((const v2u*)(HB + (size_t)tn * D + 256 * j + 4 * c.lane));
        int ia0 = 0, ia1 = 0;
#pragma unroll 1
        for (int m = 0; m < 8; ++m) {
            const int esrc = (m + 1 < 4) ? e0 : ((m + 1 < 8) ? e1 : e0n);
            int part[16];
#pragma unroll
            for (int q = 0; q < 16; ++q) {
                part[q] = idot_row4(hq, r[q]);
                SCHED_FENCE();
                r[q] = ld_row4(PU, __builtin_amdgcn_readlane(esrc, (16 * (m + 1) + q) & 63), c.lane);
                SCHED_FENCE();
            }
            int pa[8], pb[8];
#pragma unroll
            for (int q = 0; q < 8; ++q) { pa[q] = part[q]; pb[q] = part[8 + q]; }
            const int va = reduce8(pa, c.lane), vb = reduce8(pb, c.lane);
            const int grp = c.lane >> 3;
            if (m < 4) { if (grp == 2 * m) ia0 = va; if (grp == 2 * m + 1) ia0 = vb; } else { if (grp == 2 * (m - 4)) ia1 = va; if (grp == 2 * (m - 4) + 1) ia1 = vb; }
        }
        const float hoff = 0.5f * (float)hsum;
        const float a0 = ((float)ia0 + hoff) * su0 * sh, a1 = ((float)ia1 + hoff) * su1 * sh;
        const float c0 = 0.5f * a0 * (1.0f + erff(a0 * 0.70710678118654752f)) * g0 * sv0;
        const float c1 = 0.5f * a1 * (1.0f + erff(a1 * 0.70710678118654752f)) * g1 * sv1;
        const float cmx = wave_max(fmaxf(fabsf(c0), fabsf(c1)));
        const float cinv = (cmx > 0.f) ? 127.0f / cmx : 0.f, csc = cmx * (1.0f / 127.0f);
        const int q0 = __float2int_rn(c0 * cinv), q1 = __float2int_rn(c1 * cinv);
        const int cqs = wave_sum_i(q0 + q1);
        const unsigned b0 = (unsigned)q0 & 0xffu, b1 = (unsigned)q1 & 0xffu;
        const int t0 = (int)(b0 | (sh_idx(b0, c.lane + 1) << 8) | (sh_idx(b0, c.lane + 2) << 16) | (sh_idx(b0, c.lane + 3) << 24));
        const int t1 = (int)(b1 | (sh_idx(b1, c.lane + 1) << 8) | (sh_idx(b1, c.lane + 2) << 16) | (sh_idx(b1, c.lane + 3) << 24));
        TQ[(size_t)t * 128 + c.lane] = t0; TQ[(size_t)t * 128 + 64 + c.lane] = t1;
        if (c.lane == 0) { CSC[(size_t)t * 2] = csc; CSC[(size_t)t * 2 + 1] = (float)cqs; }
    }
#undef RM
}
__device__ __forceinline__ void phase_peer4_u_sorted(const Ctx& c, const float* g2vec, unsigned char* ws) {
    const unsigned char* PU = ws + WS_PU; const bf16* X1 = (const bf16*)(ws + WS_X1B);
    LAS float* A2 = (LAS float*)(c.lds + 16384); LAS float* B2 = A2 + D;
    { const float* MODF_ = (const float*)(ws + WS_MODF) + (size_t)(c.vcu >> 7) * NMOD; const int j = 4 * c.tid;
      *(LAS f32x4*)(A2 + j) = *(const f32x4*)(g2vec + j) * (*(const f32x4*)(MODF_ + 4 * D + j) + 1.0f); *(LAS f32x4*)(B2 + j) = *(const f32x4*)(MODF_ + 3 * D + j); }
    __syncthreads();
    const float* SU = (const float*)(ws + WS_SU); const float* SV = (const float*)(ws + WS_SV);
    const int* IDX = (const int*)(ws + WS_IDX); const float* GATE = (const float*)(ws + WS_GATE);
    int* TQ = (int*)(ws + WS_TQ); float* CSC = (float*)(ws + WS_CSC);
    LAS unsigned char* wb = c.lds + 32768 + c.wave * 12288;
    LAS v4u* hqv = (LAS v4u*)wb; LAS unsigned* lst = (LAS unsigned*)(wb + 8192); LAS int* acc = (LAS int*)(wb + 10240);
    v2u hraw[4][8];
#pragma unroll
    for (int jj = 0; jj < 4; ++jj) { const int t = 64 * c.vcu + 8 * c.wave + jj;
#pragma unroll
        for (int j = 0; j < 8; ++j) hraw[jj][j] = __builtin_nontemporal_load((const v2u*)(X1 + (size_t)t * D + 256 * j + 4 * c.lane)); }
#pragma unroll 1
    for (int hf = 0; hf < 2; ++hf) {
        const int tb4 = 64 * c.vcu + 8 * c.wave + 4 * hf;
        int e0[4], e1[4]; float shs[4], hoffs[4];
#pragma unroll
        for (int jj = 0; jj < 4; ++jj) { e0[jj] = IDX[(size_t)(tb4 + jj) * 128 + c.lane]; e1[jj] = IDX[(size_t)(tb4 + jj) * 128 + 64 + c.lane]; }
        {
#pragma unroll
            for (int jj = 0; jj < 4; ++jj) {
                float hf32[32]; float am = 0.f, ssx = 0.f;
#pragma unroll
                for (int j = 0; j < 8; ++j) { hf32[4 * j] = bflo(hraw[jj][j].x); hf32[4 * j + 1] = bfhi(hraw[jj][j].x); hf32[4 * j + 2] = bflo(hraw[jj][j].y); hf32[4 * j + 3] = bfhi(hraw[jj][j].y); }
#pragma unroll
                for (int k = 0; k < 32; ++k) ssx += hf32[k] * hf32[k];
                const float rstd2 = 1.0f / sqrtf(wave_sum(ssx) * (1.0f / D) + NORM_EPS);
#pragma unroll
                for (int j = 0; j < 8; ++j) { const f32x4 av = *(const LAS f32x4*)(A2 + 256 * j + 4 * c.lane), bv = *(const LAS f32x4*)(B2 + 256 * j + 4 * c.lane);
#pragma unroll
                    for (int e = 0; e < 4; ++e) hf32[4 * j + e] = hf32[4 * j + e] * rstd2 * av[e] + bv[e]; }
#pragma unroll
                for (int k = 0; k < 32; ++k) am = fmaxf(am, fabsf(hf32[k]));
                am = wave_max(am);
                const float inv = (am > 0.f) ? 119.0f / am : 0.f;
                unsigned W[8]; unsigned hsu = 0u;
#pragma unroll
                for (int j = 0; j < 8; ++j) { W[j] = 0u;
#pragma unroll
                    for (int e = 0; e < 4; ++e) W[j] = __builtin_amdgcn_cvt_pk_u8_f32(__builtin_rintf(fmaf(hf32[4 * j + e], inv, 136.0f)), e, W[j]);
                    hsu = __builtin_amdgcn_sad_u8(W[j], 0u, hsu); }
                const int hs = (int)hsu - 136 * 32;
                unsigned wh[4], wl[4];
#pragma unroll
                for (int d = 0; d < 4; ++d) {
                    wh[d] = (((W[2 * d] >> 4) & 0x0f0f0f0fu) | (W[2 * d + 1] & 0xf0f0f0f0u)) ^ 0x88888888u;
                    wl[d] = ((W[2 * d] & 0x0f0f0f0fu) | ((W[2 * d + 1] << 4) & 0xf0f0f0f0u)) ^ 0x88888888u; }
                hqv[(jj * 2 + 0) * 64 + c.lane] = (v4u){wh[0], wh[1], wh[2], wh[3]}; hqv[(jj * 2 + 1) * 64 + c.lane] = (v4u){wl[0], wl[1], wl[2], wl[3]};
                shs[jj] = am * (1.0f / 119.0f); hoffs[jj] = 0.5f * (float)wave_sum_i(hs);
            }
        }
        acc[c.lane] = 0;
        LDS_WAIT();
        int pos[8];
#pragma unroll
        for (int jj = 0; jj < 4; ++jj) { pos[2 * jj] = __hip_atomic_fetch_add(acc + (e0[jj] >> 8), 1, __ATOMIC_RELAXED, __HIP_MEMORY_SCOPE_WORKGROUP);
                                         pos[2 * jj + 1] = __hip_atomic_fetch_add(acc + (e1[jj] >> 8), 1, __ATOMIC_RELAXED, __HIP_MEMORY_SCOPE_WORKGROUP); }
        LDS_WAIT();
        { int cnt = acc[c.lane], inc = cnt;
#pragma unroll
          for (int o = 1; o < 64; o <<= 1) { const int up = sh_idx(inc, c.lane - o); inc += (c.lane >= o) ? up : 0; }
          LDS_WAIT(); acc[64 + c.lane] = inc - cnt; }
        LDS_WAIT();
#pragma unroll
        for (int jj = 0; jj < 4; ++jj) {
            lst[acc[64 + (e0[jj] >> 8)] + pos[2 * jj]] = ((unsigned)e0[jj] << 10) | ((unsigned)jj << 7) | (unsigned)c.lane;
            lst[acc[64 + (e1[jj] >> 8)] + pos[2 * jj + 1]] = ((unsigned)e1[jj] << 10) | ((unsigned)jj << 7) | (unsigned)(64 + c.lane);
        }
        LDS_WAIT();
        { const int tbn = 64 * c.vcu + 8 * c.wave + 4;
#pragma unroll
          for (int jj = 0; jj < 4; ++jj) { const int t = tbn + jj;
#pragma unroll
              for (int j = 0; j < 8; ++j) hraw[jj][j] = __builtin_nontemporal_load((const v2u*)(X1 + (size_t)t * D + 256 * j + 4 * c.lane)); } }
        SCHED_FENCE();
        unsigned ent = lst[c.lane & 15];
        v4u r[16];
#pragma unroll
        for (int q = 0; q < 16; ++q) r[q] = ld_row4(PU, (int)(__builtin_amdgcn_readlane(ent, q) >> 10), c.lane);
        v4u hh, hl;
        { const int jj = (int)((__builtin_amdgcn_readlane(ent, 0) >> 7) & 3u); hh = hqv[(jj * 2 + 0) * 64 + c.lane]; hl = hqv[(jj * 2 + 1) * 64 + c.lane]; }
#pragma unroll 1
        for (int m = 0; m < 32; ++m) {
            const unsigned entn = lst[((16 * (m + 1)) & 511) + (c.lane & 15)];
#pragma unroll
            for (int hb = 0; hb < 2; ++hb) {
                int pa[8];
#pragma unroll
                for (int q = 0; q < 8; ++q) {
                    const int s16 = 8 * hb + q;
                    const int jn = (int)(((s16 < 15 ? __builtin_amdgcn_readlane(ent, (s16 + 1) & 15) : __builtin_amdgcn_readlane(entn, 0)) >> 7) & 3u);
                    const v4u hhn = hqv[(jn * 2 + 0) * 64 + c.lane], hln = hqv[(jn * 2 + 1) * 64 + c.lane];
                    const int h8[8] = {(int)hh.x, (int)hh.y, (int)hh.z, (int)hh.w, (int)hl.x, (int)hl.y, (int)hl.z, (int)hl.w};
                    pa[q] = idot_row4(h8, r[s16]);
                    SCHED_FENCE();
                    r[s16] = ld_row4(PU, (int)(__builtin_amdgcn_readlane(entn, s16) >> 10), c.lane);
                    SCHED_FENCE();
                    hh = hhn; hl = hln;
                }
                const int v = reduce8(pa, c.lane);
                if ((c.lane >> 3) == hb) acc[((ent >> 7) & 3u) * 128 + (ent & 127u)] = v;
            }
            ent = entn;
        }
        LDS_WAIT();
        float gg0[4], gg1[4], su0[4], su1[4], sv0[4], sv1[4];
#pragma unroll
        for (int jj = 0; jj < 4; ++jj) { const int t = tb4 + jj;
            gg0[jj] = GATE[(size_t)t * 128 + c.lane]; gg1[jj] = GATE[(size_t)t * 128 + 64 + c.lane];
            su0[jj] = SU[e0[jj]]; su1[jj] = SU[e1[jj]]; sv0[jj] = SV[e0[jj]]; sv1[jj] = SV[e1[jj]]; }
#pragma unroll
        for (int jj = 0; jj < 4; ++jj) { const int t = tb4 + jj;
            const int ia0 = acc[jj * 128 + c.lane], ia1 = acc[jj * 128 + 64 + c.lane];
            const float a0 = ((float)ia0 + hoffs[jj]) * su0[jj] * shs[jj], a1 = ((float)ia1 + hoffs[jj]) * su1[jj] * shs[jj];
            const float c0 = 0.5f * a0 * (1.0f + erff(a0 * 0.70710678118654752f)) * gg0[jj] * sv0[jj];
            const float c1 = 0.5f * a1 * (1.0f + erff(a1 * 0.70710678118654752f)) * gg1[jj] * sv1[jj];
            const float cmx = wave_max(fmaxf(fabsf(c0), fabsf(c1)));
            const float cinv = (cmx > 0.f) ? 127.0f / cmx : 0.f, csc = cmx * (1.0f / 127.0f);
            const int q0 = __float2int_rn(c0 * cinv), q1 = __float2int_rn(c1 * cinv);
            const int cqs = wave_sum_i(q0 + q1);
            const unsigned b0 = (unsigned)q0 & 0xffu, b1 = (unsigned)q1 & 0xffu;
            const int t0 = (int)(b0 | (sh_idx(b0, c.lane + 1) << 8) | (sh_idx(b0, c.lane + 2) << 16) | (sh_idx(b0, c.lane + 3) << 24));
            const int t1 = (int)(b1 | (sh_idx(b1, c.lane + 1) << 8) | (sh_idx(b1, c.lane + 2) << 16) | (sh_idx(b1, c.lane + 3) << 24));
            TQ[(size_t)t * 128 + c.lane] = t0; TQ[(size_t)t * 128 + 64 + c.lane] = t1;
            if (c.lane == 0) { CSC[(size_t)t * 2] = csc; CSC[(size_t)t * 2 + 1] = (float)cqs; }
        }
        LDS_WAIT();
    }
}
typedef int v8i __attribute__((ext_vector_type(8)));
typedef float f32x2 __attribute__((ext_vector_type(2)));
__device__ __forceinline__ void phase_peer4_u_mfma(const Ctx& c, const float* g2vec, unsigned char* ws) {
    const unsigned char* PU = ws + WS_PU; const bf16* X1 = (const bf16*)(ws + WS_X1B);
    LAS float* A2 = (LAS float*)(c.lds + 16384); LAS float* B2 = A2 + D;
    { const float* MODF_ = (const float*)(ws + WS_MODF) + (size_t)(c.vcu >> 7) * NMOD; const int j = 4 * c.tid;
      *(LAS f32x4*)(A2 + j) = *(const f32x4*)(g2vec + j) * (*(const f32x4*)(MODF_ + 4 * D + j) + 1.0f); *(LAS f32x4*)(B2 + j) = *(const f32x4*)(MODF_ + 3 * D + j); }
    __syncthreads();
    const float* SU = (const float*)(ws + WS_SU); const float* SV = (const float*)(ws + WS_SV);
    const int* IDX = (const int*)(ws + WS_IDX); const float* GATE = (const float*)(ws + WS_GATE);
    int* TQ = (int*)(ws + WS_TQ); float* CSC = (float*)(ws + WS_CSC);
    LAS unsigned char* wb = c.lds + 32768 + c.wave * 12288;
    LAS unsigned char* hq = wb; LAS unsigned* lst = (LAS unsigned*)(wb + 8192); LAS int* acc = (LAS int*)(wb + 10240); LAS float* accf = (LAS float*)(wb + 10240);
    const int kg = c.lane >> 4, ncol = c.lane & 15, rho = ncol >> 2, kap = ncol & 3;
#pragma unroll 1
    for (int hf = 0; hf < 2; ++hf) {
        const int tb4 = 64 * c.vcu + 8 * c.wave + 4 * hf;
        int e0[4], e1[4]; float shs[4];
#pragma unroll
        for (int jj = 0; jj < 4; ++jj) { e0[jj] = IDX[(size_t)(tb4 + jj) * 128 + c.lane]; e1[jj] = IDX[(size_t)(tb4 + jj) * 128 + 64 + c.lane]; }
        {
            v2u hraw[4][8];
#pragma unroll
            for (int jj = 0; jj < 4; ++jj) {
#pragma unroll
                for (int j = 0; j < 8; ++j) hraw[jj][j] = __builtin_nontemporal_load((const v2u*)(X1 + (size_t)(tb4 + jj) * D + 256 * j + 4 * c.lane)); }
#pragma unroll
            for (int jj = 0; jj < 4; ++jj) {
                float hf32[32]; float am = 0.f, ssx = 0.f;
#pragma unroll
                for (int j = 0; j < 8; ++j) { hf32[4 * j] = bflo(hraw[jj][j].x); hf32[4 * j + 1] = bfhi(hraw[jj][j].x); hf32[4 * j + 2] = bflo(hraw[jj][j].y); hf32[4 * j + 3] = bfhi(hraw[jj][j].y); }
#pragma unroll
                for (int k = 0; k < 32; ++k) ssx += hf32[k] * hf32[k];
                const float rstd2 = 1.0f / sqrtf(wave_sum(ssx) * (1.0f / D) + NORM_EPS);
#pragma unroll
                for (int j = 0; j < 8; ++j) { const f32x4 av = *(const LAS f32x4*)(A2 + 256 * j + 4 * c.lane), bv = *(const LAS f32x4*)(B2 + 256 * j + 4 * c.lane);
#pragma unroll
                    for (int e = 0; e < 4; ++e) hf32[4 * j + e] = hf32[4 * j + e] * rstd2 * av[e] + bv[e]; }
#pragma unroll
                for (int k = 0; k < 32; ++k) am = fmaxf(am, fabsf(hf32[k]));
                am = wave_max(am);
                const float inv = (am > 0.f) ? 224.0f / am : 0.f;
                unsigned W[8];
#pragma unroll
                for (int w = 0; w < 8; ++w) { const int j0 = 2 * (w >> 1), e0_ = 2 * (w & 1);
                    int pk = __builtin_amdgcn_cvt_pk_fp8_f32(hf32[4 * j0 + e0_] * inv, hf32[4 * (j0 + 1) + e0_] * inv, 0, false);
                    pk = __builtin_amdgcn_cvt_pk_fp8_f32(hf32[4 * j0 + e0_ + 1] * inv, hf32[4 * (j0 + 1) + e0_ + 1] * inv, pk, true);
                    W[w] = (unsigned)pk; }
                { LAS unsigned char* hp = hq + jj * 2048 + c.lane * 32;
                  *(LAS v4u*)hp = (v4u){W[0], W[1], W[2], W[3]}; *(LAS v4u*)(hp + 16) = (v4u){W[4], W[5], W[6], W[7]}; }
                shs[jj] = am * (1.0f / 224.0f);
            }
        }
        acc[c.lane] = 0;
        LDS_WAIT();
        int pos[8];
#pragma unroll
        for (int jj = 0; jj < 4; ++jj) { pos[2 * jj] = __hip_atomic_fetch_add(acc + (e0[jj] >> 8), 1, __ATOMIC_RELAXED, __HIP_MEMORY_SCOPE_WORKGROUP);
                                         pos[2 * jj + 1] = __hip_atomic_fetch_add(acc + (e1[jj] >> 8), 1, __ATOMIC_RELAXED, __HIP_MEMORY_SCOPE_WORKGROUP); }
        LDS_WAIT();
        { int cnt = acc[c.lane], inc = cnt;
#pragma unroll
          for (int o = 1; o < 64; o <<= 1) { const int up = sh_idx(inc, c.lane - o); inc += (c.lane >= o) ? up : 0; }
          LDS_WAIT(); acc[64 + c.lane] = inc - cnt; }
        LDS_WAIT();
#pragma unroll
        for (int jj = 0; jj < 4; ++jj) {
            lst[acc[64 + (e0[jj] >> 8)] + pos[2 * jj]] = ((unsigned)e0[jj] << 10) | ((unsigned)jj << 7) | (unsigned)c.lane;
            lst[acc[64 + (e1[jj] >> 8)] + pos[2 * jj + 1]] = ((unsigned)e1[jj] << 10) | ((unsigned)jj << 7) | (unsigned)(64 + c.lane);
        }
        LDS_WAIT();
        v8i Bp[4];
#pragma unroll
        for (int s4 = 0; s4 < 4; ++s4) { const LAS unsigned char* bp = hq + rho * 2048 + (16 * s4 + 4 * (kg >> 1) + kap) * 32 + (kg & 1) * 16;
            const v4u lo = *(const LAS v4u*)bp, hi = *(const LAS v4u*)(bp + 8 * 32);
            Bp[s4] = (v8i){(int)lo.x, (int)lo.y, (int)lo.z, (int)lo.w, (int)hi.x, (int)hi.y, (int)hi.z, (int)hi.w}; }
        const unsigned lane_off = 64u * (unsigned)kg + 16u * (unsigned)kap;
        v4u r[16];
#pragma unroll
        for (int G = 0; G < 4; ++G) { const unsigned vo = (lst[4 * G + rho] & ~1023u) + lane_off;
#pragma unroll
            for (int s4 = 0; s4 < 4; ++s4) r[4 * G + s4] = *(const v4u*)(PU + vo + 256 * s4); }
#pragma unroll 1
        for (int m = 0; m < 32; ++m) {
#pragma unroll
            for (int G = 0; G < 4; ++G) {
                const unsigned von = (lst[((16 * (m + 1)) & 511) + 4 * G + rho] & ~1023u) + lane_off;
                const unsigned erow = lst[16 * m + 4 * G + kg];
                f32x4 cacc = {0.f, 0.f, 0.f, 0.f};
#pragma unroll
                for (int s4 = 0; s4 < 4; ++s4) {
                    v8i av; av[0] = (int)r[4 * G + s4].x; av[1] = (int)r[4 * G + s4].y; av[2] = (int)r[4 * G + s4].z; av[3] = (int)r[4 * G + s4].w; av[4] = 0; av[5] = 0; av[6] = 0; av[7] = 0;
                    cacc = __builtin_amdgcn_mfma_scale_f32_16x16x128_f8f6f4(av, Bp[s4], cacc, 4, 0, 0, 0x7f7f7f7f, 0, 0x7f7f7f7f);
                }
                SCHED_FENCE();
#pragma unroll
                for (int s4 = 0; s4 < 4; ++s4) r[4 * G + s4] = *(const v4u*)(PU + von + 256 * s4);
                SCHED_FENCE();
                float v = (kap == 0) ? cacc[0] : (kap == 1) ? cacc[1] : (kap == 2) ? cacc[2] : cacc[3];
                v += SXOR(v, 1, c.lane); v += SXOR(v, 2, c.lane);
                const unsigned tk = (erow >> 7) & 3u;
                if (kap == 0 && (unsigned)rho == tk) accf[tk * 128 + (erow & 127u)] = v;
            }
        }
        LDS_WAIT();
        float gg0[4], gg1[4], su0[4], su1[4], sv0[4], sv1[4];
#pragma unroll
        for (int jj = 0; jj < 4; ++jj) { const int t = tb4 + jj;
            gg0[jj] = GATE[(size_t)t * 128 + c.lane]; gg1[jj] = GATE[(size_t)t * 128 + 64 + c.lane];
            su0[jj] = SU[e0[jj]]; su1[jj] = SU[e1[jj]]; sv0[jj] = SV[e0[jj]]; sv1[jj] = SV[e1[jj]]; }
#pragma unroll
        for (int jj = 0; jj < 4; ++jj) { const int t = tb4 + jj;
            const float a0 = accf[jj * 128 + c.lane] * su0[jj] * shs[jj], a1 = accf[jj * 128 + 64 + c.lane] * su1[jj] * shs[jj];
            const float c0 = 0.5f * a0 * (1.0f + erff(a0 * 0.70710678118654752f)) * gg0[jj] * sv0[jj];
            const float c1 = 0.5f * a1 * (1.0f + erff(a1 * 0.70710678118654752f)) * gg1[jj] * sv1[jj];
            const float cmx = wave_max(fmaxf(fabsf(c0), fabsf(c1)));
#if V_MFMA
            const float cinv = (cmx > 0.f) ? 224.0f / cmx : 0.f;
            ((float*)TQ)[(size_t)t * 128 + c.lane] = c0 * cinv; ((float*)TQ)[(size_t)t * 128 + 64 + c.lane] = c1 * cinv;
            if (c.lane == 0) { CSC[(size_t)t * 2] = cmx * (1.0f / 224.0f); CSC[(size_t)t * 2 + 1] = 0.f; }
#else
            const float cinv = (cmx > 0.f) ? 127.0f / cmx : 0.f, csc = cmx * (1.0f / 127.0f);
            const int q0 = __float2int_rn(c0 * cinv), q1 = __float2int_rn(c1 * cinv);
            const int cqs = wave_sum_i(q0 + q1);
            const unsigned b0_ = (unsigned)q0 & 0xffu, b1_ = (unsigned)q1 & 0xffu;
            const int t0 = (int)(b0_ | (sh_idx(b0_, c.lane + 1) << 8) | (sh_idx(b0_, c.lane + 2) << 16) | (sh_idx(b0_, c.lane + 3) << 24));
            const int t1 = (int)(b1_ | (sh_idx(b1_, c.lane + 1) << 8) | (sh_idx(b1_, c.lane + 2) << 16) | (sh_idx(b1_, c.lane + 3) << 24));
            TQ[(size_t)t * 128 + c.lane] = t0; TQ[(size_t)t * 128 + 64 + c.lane] = t1;
            if (c.lane == 0) { CSC[(size_t)t * 2] = csc; CSC[(size_t)t * 2 + 1] = (float)cqs; }
#endif
        }
        LDS_WAIT();
    }
}
__device__ __forceinline__ void phase_peer4_v_mfma(const Ctx& c, const float* final_g, float* out, unsigned char* ws) {
    const bf16* X1 = (const bf16*)(ws + WS_X1B);
    const unsigned char* PV = ws + WS_PV;
    const int* IDX = (const int*)(ws + WS_IDX); const float* CF = (const float*)(ws + WS_TQ); const float* CSC = (const float*)(ws + WS_CSC); const float* MODF = (const float*)(ws + WS_MODF);
    LAS float* G2 = (LAS float*)c.lds; LAS float* FG = G2 + D;
    const int b = c.vcu >> 7;
    { const int j = 4 * c.tid; *(LAS f32x4*)(G2 + j) = *(const f32x4*)(MODF + (size_t)b * NMOD + 5 * D + j); *(LAS f32x4*)(FG + j) = *(const f32x4*)(final_g + j); }
    __syncthreads();
    const int n = c.lane & 15, g = c.lane >> 4;
    const int tbase = 64 * c.vcu + 8 * c.wave;
    const unsigned nb8 = 8u * (unsigned)n;
    const int F0 = 256 * (4 * (n & 1) + 2 * (g >> 1)) + 4 * (n >> 1) + 2 * (g & 1);
    int e0n = IDX[(size_t)tbase * 128 + c.lane], e1n = IDX[(size_t)tbase * 128 + 64 + c.lane];
    float cf0n = CF[(size_t)tbase * 128 + c.lane], cf1n = CF[(size_t)tbase * 128 + 64 + c.lane];
    v2u br[2][8][2];
#pragma unroll
    for (int bf = 0; bf < 2; ++bf) {
        const unsigned o0 = ((unsigned)sh_idx(e0n, 8 * bf + 2 * g) << 10) + nb8, o1 = ((unsigned)sh_idx(e0n, 8 * bf + 2 * g + 1) << 10) + nb8;
#pragma unroll
        for (int s8 = 0; s8 < 8; ++s8) { br[bf][s8][0] = *(const v2u*)(PV + o0 + 128 * s8); br[bf][s8][1] = *(const v2u*)(PV + o1 + 128 * s8); }
    }
#pragma unroll 1
    for (int i = 0; i < 8; ++i) {
        const int t = tbase + i, tn = tbase + ((i + 1) & 7);
        const int e0 = e0n, e1 = e1n; const float cf0 = cf0n, cf1 = cf1n;
        const float csc = CSC[(size_t)t * 2];
        e0n = IDX[(size_t)tn * 128 + c.lane]; e1n = IDX[(size_t)tn * 128 + 64 + c.lane];
        cf0n = CF[(size_t)tn * 128 + c.lane]; cf1n = CF[(size_t)tn * 128 + 64 + c.lane];
        f32x4 C[8];
#pragma unroll
        for (int s8 = 0; s8 < 8; ++s8) C[s8] = (f32x4){0.f, 0.f, 0.f, 0.f};
#pragma unroll 1
        for (int gp = 0; gp < 8; ++gp) {
#pragma unroll
            for (int bf = 0; bf < 2; ++bf) {
                const int grp = 2 * gp + bf;
                const float cfs = (gp < 4) ? cf0 : cf1;
                const float ca = sh_idx(cfs, (8 * grp + g) & 63), cb = sh_idx(cfs, (8 * grp + 4 + g) & 63);
                const unsigned pk = (unsigned)__builtin_amdgcn_cvt_pk_fp8_f32(ca, cb, 0, false);
                const unsigned wlo = (pk & 0xffu) << (8 * (n & 3)), whi = ((pk >> 8) & 0xffu) << (8 * (n & 3));
                const int q = n >> 2;
                const v8i av = {(int)(q == 0 ? wlo : 0u), (int)(q == 1 ? wlo : 0u), (int)(q == 2 ? wlo : 0u), (int)(q == 3 ? wlo : 0u),
                                (int)(q == 0 ? whi : 0u), (int)(q == 1 ? whi : 0u), (int)(q == 2 ? whi : 0u), (int)(q == 3 ? whi : 0u)};
#pragma unroll
                for (int s8 = 0; s8 < 8; ++s8) {
                    v8i bv; bv[0] = (int)br[bf][s8][0].x; bv[1] = (int)br[bf][s8][0].y; bv[2] = (int)br[bf][s8][1].x; bv[3] = (int)br[bf][s8][1].y; bv[4] = 0; bv[5] = 0; bv[6] = 0; bv[7] = 0;
                    C[s8] = __builtin_amdgcn_mfma_scale_f32_16x16x128_f8f6f4(av, bv, C[s8], 0, 4, 0, 0x7f7f7f7f, 0, 0x7f7f7f7f);
                }
                SCHED_FENCE();
                {
                    const int gn = grp + 2;
                    const int es = (gn < 8) ? e0 : ((gn < 16) ? e1 : e0n);
                    const unsigned o0 = ((unsigned)sh_idx(es, (8 * gn + 2 * g) & 63) << 10) + nb8, o1 = ((unsigned)sh_idx(es, (8 * gn + 2 * g + 1) & 63) << 10) + nb8;
#pragma unroll
                    for (int s8 = 0; s8 < 8; ++s8) { br[bf][s8][0] = *(const v2u*)(PV + o0 + 128 * s8); br[bf][s8][1] = *(const v2u*)(PV + o1 + 128 * s8); }
                }
                SCHED_FENCE();
            }
        }
        const bf16* xr = X1 + (size_t)t * D + F0; float* orow = out + (size_t)t * D + F0;
        float ss = 0.f;
#pragma unroll
        for (int s8 = 0; s8 < 8; ++s8) {
            const unsigned xa = __builtin_nontemporal_load((const unsigned*)(xr + 32 * s8)), xb = __builtin_nontemporal_load((const unsigned*)(xr + 256 + 32 * s8));
            const f32x2 ga = *(const LAS f32x2*)(G2 + F0 + 32 * s8), gb = *(const LAS f32x2*)(G2 + F0 + 256 + 32 * s8);
            const float v0 = bflo(xa) + ga[0] * (csc * C[s8][0]), v2 = bfhi(xa) + ga[1] * (csc * C[s8][2]);
            const float v1 = bflo(xb) + gb[0] * (csc * C[s8][1]), v3 = bfhi(xb) + gb[1] * (csc * C[s8][3]);
            C[s8] = (f32x4){v0, v1, v2, v3}; ss += (v0 * v0 + v1 * v1) + (v2 * v2 + v3 * v3);
        }
        const float rstd = 1.0f / sqrtf(wave_sum(ss) * (1.0f / D) + NORM_EPS);
#pragma unroll
        for (int s8 = 0; s8 < 8; ++s8) {
            const f32x2 fa = *(const LAS f32x2*)(FG + F0 + 32 * s8), fb = *(const LAS f32x2*)(FG + F0 + 256 + 32 * s8);
            const f32x2 oa = {C[s8][0] * rstd * fa[0], C[s8][2] * rstd * fa[1]}, ob = {C[s8][1] * rstd * fb[0], C[s8][3] * rstd * fb[1]};
            __builtin_nontemporal_store(oa, (f32x2*)(orow + 32 * s8)); __builtin_nontemporal_store(ob, (f32x2*)(orow + 256 + 32 * s8));
        }
    }
}
__device__ __forceinline__ void phase_peer4_v_sorted(const Ctx& c, const float* final_g, float* out, unsigned char* ws) {
    const bf16* X1 = (const bf16*)(ws + WS_X1B);
    const unsigned char* PV = ws + WS_PV;
    const int* IDX = (const int*)(ws + WS_IDX); const float* CF = (const float*)(ws + WS_TQ); const float* CSC = (const float*)(ws + WS_CSC); const float* MODF = (const float*)(ws + WS_MODF);
    LAS float* G2 = (LAS float*)c.lds; LAS float* FG = G2 + D;
    const int b = c.vcu >> 7;
    { const int j = 4 * c.tid; *(LAS f32x4*)(G2 + j) = *(const f32x4*)(MODF + (size_t)b * NMOD + 5 * D + j); *(LAS f32x4*)(FG + j) = *(const f32x4*)(final_g + j); }
    __syncthreads();
    LAS unsigned char* wb = c.lds + 32768 + c.wave * 12288;
    LAS v2u* lst2 = (LAS v2u*)wb; LAS int* hist = (LAS int*)(wb + 4096);
    const int n = c.lane & 15, g = c.lane >> 4;
    const unsigned nb8 = 8u * (unsigned)n;
    const int F0 = 256 * (4 * (n & 1) + 2 * (g >> 1)) + 4 * (n >> 1) + 2 * (g & 1);
    const int q4 = n >> 2, sh8 = 8 * (n & 3);
#pragma unroll 1
    for (int hf = 0; hf < 2; ++hf) {
        const int tb4 = 64 * c.vcu + 8 * c.wave + 4 * hf;
        {
            int e0[4], e1[4]; float w0[4], w1[4];
#pragma unroll
            for (int jj = 0; jj < 4; ++jj) { const size_t o = (size_t)(tb4 + jj) * 128 + c.lane; e0[jj] = IDX[o]; e1[jj] = IDX[o + 64]; w0[jj] = CF[o]; w1[jj] = CF[o + 64]; }
            hist[c.lane] = 0;
            LDS_WAIT();
            int pos[8];
#pragma unroll
            for (int jj = 0; jj < 4; ++jj) { pos[2 * jj] = __hip_atomic_fetch_add(hist + ((e0[jj] >> 10) * 4 + jj), 1, __ATOMIC_RELAXED, __HIP_MEMORY_SCOPE_WORKGROUP);
                                             pos[2 * jj + 1] = __hip_atomic_fetch_add(hist + ((e1[jj] >> 10) * 4 + jj), 1, __ATOMIC_RELAXED, __HIP_MEMORY_SCOPE_WORKGROUP); }
            LDS_WAIT();
            { int cnt = hist[c.lane], inc = cnt;
#pragma unroll
              for (int o = 1; o < 64; o <<= 1) { const int up = sh_idx(inc, c.lane - o); inc += (c.lane >= o) ? up : 0; }
              LDS_WAIT(); hist[64 + c.lane] = inc - cnt; }
            LDS_WAIT();
#pragma unroll
            for (int jj = 0; jj < 4; ++jj) {
                lst2[hist[64 + (e0[jj] >> 10) * 4 + jj] + pos[2 * jj]] = (v2u){((unsigned)e0[jj] << 2) | (unsigned)jj, __float_as_uint(w0[jj])};
                lst2[hist[64 + (e1[jj] >> 10) * 4 + jj] + pos[2 * jj + 1]] = (v2u){((unsigned)e1[jj] << 2) | (unsigned)jj, __float_as_uint(w1[jj])};
            }
            LDS_WAIT();
        }
        f32x4 C[4][8];
#pragma unroll
        for (int jj = 0; jj < 4; ++jj)
#pragma unroll
            for (int s8 = 0; s8 < 8; ++s8) C[jj][s8] = (f32x4){0.f, 0.f, 0.f, 0.f};
        v2u br[2][8][2];
#pragma unroll
        for (int bf = 0; bf < 2; ++bf) {
            const v4u qe = *(const LAS v4u*)(lst2 + 8 * bf + 2 * g);
            const unsigned o0 = ((qe.x >> 2) << 10) + nb8, o1 = ((qe.z >> 2) << 10) + nb8;
#pragma unroll
            for (int s8 = 0; s8 < 8; ++s8) { br[bf][s8][0] = *(const v2u*)(PV + o0 + 128 * s8); br[bf][s8][1] = *(const v2u*)(PV + o1 + 128 * s8); }
        }
#pragma unroll 1
        for (int gp = 0; gp < 32; ++gp) {
#pragma unroll
            for (int bf = 0; bf < 2; ++bf) {
                const int G = 2 * gp + bf;
                const v2u ea = lst2[8 * G + g], eb = lst2[8 * G + 4 + g];
                const unsigned tokA = ea.x & 3u, tokB = eb.x & 3u; const float cA = __uint_as_float(ea.y), cB = __uint_as_float(eb.y);
                const v4u qn = *(const LAS v4u*)(lst2 + ((8 * (G + 2)) & 511) + 2 * g);
#pragma unroll
                for (int jj = 0; jj < 4; ++jj) {
                    const bool hasA = (tokA == (unsigned)jj), hasB = (tokB == (unsigned)jj);
                    if (__builtin_amdgcn_ballot_w64(hasA || hasB) != 0ull) {
                        const unsigned pk = (unsigned)__builtin_amdgcn_cvt_pk_fp8_f32(hasA ? cA : 0.f, hasB ? cB : 0.f, 0, false);
                        const unsigned wlo = (pk & 0xffu) << sh8, whi = ((pk >> 8) & 0xffu) << sh8;
                        const v8i av = {(int)(q4 == 0 ? wlo : 0u), (int)(q4 == 1 ? wlo : 0u), (int)(q4 == 2 ? wlo : 0u), (int)(q4 == 3 ? wlo : 0u),
                                        (int)(q4 == 0 ? whi : 0u), (int)(q4 == 1 ? whi : 0u), (int)(q4 == 2 ? whi : 0u), (int)(q4 == 3 ? whi : 0u)};
#pragma unroll
                        for (int s8 = 0; s8 < 8; ++s8) {
                            v8i bv; bv[0] = (int)br[bf][s8][0].x; bv[1] = (int)br[bf][s8][0].y; bv[2] = (int)br[bf][s8][1].x; bv[3] = (int)br[bf][s8][1].y; bv[4] = 0; bv[5] = 0; bv[6] = 0; bv[7] = 0;
                            C[jj][s8] = __builtin_amdgcn_mfma_scale_f32_16x16x128_f8f6f4(av, bv, C[jj][s8], 0, 4, 0, 0x7f7f7f7f, 0, 0x7f7f7f7f);
                        }
                    }
                }
                SCHED_FENCE();
                { const unsigned o0 = ((qn.x >> 2) << 10) + nb8, o1 = ((qn.z >> 2) << 10) + nb8;
#pragma unroll
                  for (int s8 = 0; s8 < 8; ++s8) { br[bf][s8][0] = *(const v2u*)(PV + o0 + 128 * s8); br[bf][s8][1] = *(const v2u*)(PV + o1 + 128 * s8); } }
                SCHED_FENCE();
            }
        }
#pragma unroll
        for (int jj = 0; jj < 4; ++jj) {
            const int t = tb4 + jj;
            const float csc = CSC[(size_t)t * 2];
            const bf16* xr = X1 + (size_t)t * D + F0; float* orow = out + (size_t)t * D + F0;
            float ss = 0.f;
#pragma unroll
            for (int s8 = 0; s8 < 8; ++s8) {
                const unsigned xa = __builtin_nontemporal_load((const unsigned*)(xr + 32 * s8)), xb = __builtin_nontemporal_load((const unsigned*)(xr + 256 + 32 * s8));
                const f32x2 ga = *(const LAS f32x2*)(G2 + F0 + 32 * s8), gb = *(const LAS f32x2*)(G2 + F0 + 256 + 32 * s8);
                const float v0 = bflo(xa) + ga[0] * (csc * C[jj][s8][0]), v2 = bfhi(xa) + ga[1] * (csc * C[jj][s8][2]);
                const float v1 = bflo(xb) + gb[0] * (csc * C[jj][s8][1]), v3 = bfhi(xb) + gb[1] * (csc * C[jj][s8][3]);
                C[jj][s8] = (f32x4){v0, v1, v2, v3}; ss += (v0 * v0 + v1 * v1) + (v2 * v2 + v3 * v3);
            }
            const float rstd = 1.0f / sqrtf(wave_sum(ss) * (1.0f / D) + NORM_EPS);
#pragma unroll
            for (int s8 = 0; s8 < 8; ++s8) {
                const f32x2 fa = *(const LAS f32x2*)(FG + F0 + 32 * s8), fb = *(const LAS f32x2*)(FG + F0 + 256 + 32 * s8);
                const f32x2 oa = {C[jj][s8][0] * rstd * fa[0], C[jj][s8][2] * rstd * fa[1]}, ob = {C[jj][s8][1] * rstd * fb[0], C[jj][s8][3] * rstd * fb[1]};
                __builtin_nontemporal_store(oa, (f32x2*)(orow + 32 * s8)); __builtin_nontemporal_store(ob, (f32x2*)(orow + 256 + 32 * s8));
            }
        }
        LDS_WAIT();
    }
}
__device__ __forceinline__ void phase_peer4_v(const Ctx& c, const float* final_g, float* out, unsigned char* ws) {
    const bf16* X1 = (const bf16*)(ws + WS_X1B);
    const unsigned char* PV = ws + WS_PV;
    const int* IDX = (const int*)(ws + WS_IDX); const int* TQ = (const int*)(ws + WS_TQ); const float* CSC = (const float*)(ws + WS_CSC); const float* MODF = (const float*)(ws + WS_MODF);
    LAS float* G2 = (LAS float*)c.lds; LAS float* FG = G2 + D;
    const int b = c.vcu >> 7;
    { const int j = 4 * c.tid; *(LAS f32x4*)(G2 + j) = *(const f32x4*)(MODF + (size_t)b * NMOD + 5 * D + j); *(LAS f32x4*)(FG + j) = *(const f32x4*)(final_g + j); }
    __syncthreads();
    const int tbase = 64 * c.vcu + 8 * c.wave;
    int e0n = IDX[(size_t)tbase * 128 + c.lane], e1n = IDX[(size_t)tbase * 128 + 64 + c.lane];
    int t0n = TQ[(size_t)tbase * 128 + c.lane], t1n = TQ[(size_t)tbase * 128 + 64 + c.lane];
    v4u r[16];
#pragma unroll
    for (int q = 0; q < 16; ++q) r[q] = ld_row4(PV, __builtin_amdgcn_readlane(e0n, q), c.lane);
#pragma unroll 1
    for (int i = (DUP & 2048) ? -8 : 0; i < 8; ++i) {
        const int t = tbase + (i & 7), tn = tbase + ((i + 1) & 7);
        const int e0 = e0n, e1 = e1n, t0 = t0n, t1 = t1n;
        const float csc = CSC[(size_t)t * 2], cqsf = CSC[(size_t)t * 2 + 1];
        e0n = IDX[(size_t)tn * 128 + c.lane]; e1n = IDX[(size_t)tn * 128 + 64 + c.lane];
        t0n = TQ[(size_t)tn * 128 + c.lane]; t1n = TQ[(size_t)tn * 128 + 64 + c.lane];
        int y[32];
#pragma unroll
        for (int q = 0; q < 32; ++q) y[q] = 0;
#pragma unroll 1
        for (int m = 0; m < 8; ++m) {
            const int esrc = (m + 1 < 4) ? e0 : ((m + 1 < 8) ? e1 : e0n);
            const int tsrc = (m < 4) ? t0 : t1;
#pragma unroll
            for (int gq = 0; gq < 4; ++gq) {
                const int cq4 = __builtin_amdgcn_readlane(tsrc, (16 * m + 4 * gq) & 63);
                vacc4(y, r[4 * gq], r[4 * gq + 1], r[4 * gq + 2], r[4 * gq + 3], cq4);
                SCHED_FENCE();
#pragma unroll
                for (int q = 0; q < 4; ++q) r[4 * gq + q] = ld_row4(PV, __builtin_amdgcn_readlane(esrc, (16 * (m + 1) + 4 * gq + q) & 63), c.lane);
                SCHED_FENCE();
            }
        }
        const bf16* xr = X1 + (size_t)t * D + 4 * c.lane; float* orow = ((DUP & 2048) && i < 0 ? (float*)(ws + WS_HC) : out) + (size_t)t * D + 4 * c.lane;
        float yf[32]; float ss = 0.f;
#pragma unroll
        for (int j = 0; j < 8; ++j) {
            const v2u xw = __builtin_nontemporal_load((const v2u*)(xr + 256 * j)); const f32x4 xa = {bflo(xw.x), bfhi(xw.x), bflo(xw.y), bfhi(xw.y)};
            const f32x4 ga = *(const LAS f32x4*)(G2 + 256 * j + 4 * c.lane);
#pragma unroll
            for (int e = 0; e < 4; ++e) {
                const int d = j >> 1;
                const float yv = (j & 1) ? (float)((y[8 * d + 4 + e] - y[8 * d + e]) >> 4) + 0.5f * cqsf : (float)y[8 * d + e] - 7.5f * cqsf;
                const float v = xa[e] + ga[e] * (csc * yv); yf[4 * j + e] = v; ss += v * v; }
        }
        const float rstd = 1.0f / sqrtf(wave_sum(ss) * (1.0f / D) + NORM_EPS);
#pragma unroll
        for (int j = 0; j < 8; ++j) {
            const f32x4 fa = *(const LAS f32x4*)(FG + 256 * j + 4 * c.lane);
            f32x4 o;
#pragma unroll
            for (int e = 0; e < 4; ++e) o[e] = yf[4 * j + e] * rstd * fa[e];
            __builtin_nontemporal_store(o, (f32x4*)(orow + 256 * j));
        }
    }
}

struct Args { const float* in[16]; float* out; unsigned char* ws; };
__device__ __forceinline__ int lane_id() { unsigned ones = ~0u; asm volatile("" : "+s"(ones)); return (int)__builtin_amdgcn_mbcnt_hi(ones, __builtin_amdgcn_mbcnt_lo(ones, 0u)); }
__global__ void __launch_bounds__(NTHREADS, 2) fwd_kernel(Args args_unused) {
    extern __shared__ __attribute__((aligned(16))) unsigned char lds_raw[];
    const int wave_s = __builtin_amdgcn_readfirstlane((int)(threadIdx.x >> 6));
#define CAS __attribute__((address_space(4)))
#define KARGS() const CAS unsigned char* ka_ = (const CAS unsigned char*)__builtin_amdgcn_kernarg_segment_ptr(); asm volatile("" : "+s"(ka_));
#define ARG_IN(i) (*(const float* const CAS*)(ka_ + 8 * (i)))
#define ARG_OUT() (*(float* const CAS*)(ka_ + 128))
#define ARG_WS() (*(unsigned char* const CAS*)(ka_ + 136))
#define MKCTX() KARGS(); unsigned char* ws = ARG_WS(); Ctx c; { c.lds = (LAS unsigned char*)lds_raw; int l_ = lane_id(); asm volatile("" : "+v"(l_)); c.lane = l_; c.wave = wave_s; c.tid = wave_s * 64 + l_; \
    c.G = 256; { const int bx = blockIdx.x; c.vcu = (bx % 8) * 32 + bx / 8; } c.gw = c.vcu * NWAVES + c.wave; c.ngw = 256 * NWAVES; }
#define IS_T0() (wave_s == 0 && lane_id() == 0)
#define GRID_BAR() xcd_barrier(bar, IS_T0())
    LAS unsigned char* const ldsb = (LAS unsigned char*)lds_raw;
    volatile LAS unsigned* misc = (volatile LAS unsigned*)(ldsb + MISC_OFF);
    if (threadIdx.x < 4) misc[threadIdx.x] = 0u;
    __syncthreads();
    XcdBarrier bar;
    { KARGS(); bar = xcd_barrier_post((unsigned*)(ARG_WS() + WS_CTL), misc, IS_T0()); }
    if (gridDim.x != 256) return;

    { MKCTX(); const float* inp[16];
#pragma unroll
      for (int i = 0; i < 16; ++i) inp[i] = ARG_IN(i);
      phase0(c, inp, ws); if (DUP & 1) phase0(c, inp, ws); }
    GRID_BAR();
    { MKCTX(); phase_rows<true>(c, ARG_IN(0), nullptr, ARG_IN(5), ARG_IN(4), (const int*)ARG_IN(2), ws, 0, 1, ARG_IN(10), ARG_IN(11)); if (DUP & 2) phase_rows<true>(c, ARG_IN(0), nullptr, ARG_IN(5), ARG_IN(4), (const int*)ARG_IN(2), ws, 0, 1, ARG_IN(10), ARG_IN(11)); }
    GRID_BAR();
    { KARGS(); unsigned char* ws = ARG_WS();
      pg8::Gemm g{(const bf16*)(ws + WS_HB), (const bf16*)(ws + WS_WTIN), T, INW, D, D, D, 0}; pg8::StaticOrder S; S.init(T, INW, 256, (int)blockIdx.x);
      Epi1 E{(bf16*)(ws + WS_Q), (const float*)(ws + WS_CS)};
      int nrep_ = (DUP & 4) ? 2 : 1; asm volatile("" : "+s"(nrep_));
#pragma unroll 1
      for (int rep_ = 0; rep_ < nrep_; ++rep_) { pg8::gemm_phase<Epi1, pg8::StaticOrder, false>(ldsb, g, S, E, nullptr, wave_s); } }
    GRID_BAR();
    { MKCTX(); phase_poolr(c, ws); if (DUP & 256) phase_poolr(c, ws); }
#if ATTN_SIMPLE
    { MKCTX(); phase_attn_simple(c, ws); }
#else
    { MKCTX(); phase_attn_mfma(c, ws); if (DUP & 8) phase_attn_mfma(c, ws); }
#endif
    GRID_BAR();
#if !ATTN_SIMPLE
    { MKCTX(); phase_combine(c, ws); if (DUP & 16384) phase_combine(c, ws); }
#endif
    { KARGS(); unsigned char* ws = ARG_WS();
      pg8::Gemm g{(const bf16*)(ws + WS_RB), (const bf16*)(ws + WS_WTPOOL), T, PW, 256, PW, 256, 512}; pg8::StaticOrder S; S.init(T, PW, 256, (int)blockIdx.x);
      EpiPool E{(bf16*)(ws + WS_HC), ARG_IN(8)};
      int nrep_ = (DUP & 16) ? 2 : 1; asm volatile("" : "+s"(nrep_));
#pragma unroll 1
      for (int rep_ = 0; rep_ < nrep_; ++rep_) { pg8::gemm_phase<EpiPool, pg8::StaticOrder, false>(ldsb, g, S, E, nullptr, wave_s); } }
    GRID_BAR();
    { KARGS(); unsigned char* ws = ARG_WS();
      pg8::Gemm g{(const bf16*)(ws + WS_HC), (const bf16*)(ws + WS_WTOUT), T, D, D, D, D, 0}; pg8::StaticOrder S; S.init(T, D, 256, (int)blockIdx.x);
      EpiOut E{ARG_IN(0), (bf16*)(ws + WS_X1B), (const float*)(ws + WS_MODF), (float*)(ws + WS_RSQP)};
      int nrep_ = (DUP & 32) ? 2 : 1; asm volatile("" : "+s"(nrep_));
#pragma unroll 1
      for (int rep_ = 0; rep_ < nrep_; ++rep_) { pg8::gemm_phase<EpiOut, pg8::StaticOrder, false>(ldsb, g, S, E, nullptr, wave_s); } }
    GRID_BAR();
    { KARGS(); unsigned char* ws = ARG_WS();
      pg8::StaticOrder S; S.init(T, D, 256, (int)blockIdx.x);
      pg8::Unit u0, u1; S.next(0, u0); S.next(1, u1);
      LAS float* rstdT = (LAS float*)(ldsb + 131072 + 256); LAS float* biasT = rstdT + 512;
      { const int l_ = lane_id(), tid_ = wave_s * 64 + l_, slot = tid_ >> 8, i_ = tid_ & 255; const pg8::Unit uu = slot ? u1 : u0;
        const float* rp = (const float*)(ws + WS_RSQP) + (size_t)(uu.pm * 256 + i_) * 32; float ssum = 0.f;
#pragma unroll
        for (int q = 0; q < 8; ++q) { const f32x4 v = *(const f32x4*)(rp + 4 * q); ssum += (v[0] + v[1]) + (v[2] + v[3]); }
        rstdT[slot * 256 + i_] = 1.0f / sqrtf(ssum * (1.0f / D) + NORM_EPS);
        const float* bp = (const float*)(ws + WS_BIASP) + (size_t)(uu.pm >= 32 ? 1 : 0) * D + uu.pn * 256 + i_; float bsum = 0.f;
#pragma unroll 8
        for (int kb = 0; kb < 32; ++kb) bsum += bp[(size_t)kb * 2 * D];
        biasT[slot * 256 + i_] = bsum; }
      __syncthreads();
      pg8::Gemm g{(const bf16*)(ws + WS_X1B), (const bf16*)(ws + WS_WQ2), T, D, D, D, D, 0, D * D * 2};
      EpiQ E{(bf16*)(ws + WS_QP), rstdT, biasT, u0.pm, u0.pn};
      int nrep_ = (DUP & 128) ? 2 : 1; asm volatile("" : "+s"(nrep_));
#pragma unroll 1
      for (int rep_ = 0; rep_ < nrep_; ++rep_) { pg8::gemm_phase<EpiQ, pg8::StaticOrder, false>(ldsb, g, S, E, nullptr, wave_s); } }
    GRID_BAR();
#if TOPK_SIMPLE
    { KARGS(); unsigned char* ws = ARG_WS();
      pg8::Gemm g{(const bf16*)(ws + WS_QP), (const bf16*)(ws + WS_SKP), T, D, 256, D, 256, 512}; pg8::StaticOrder S; S.init(T, D, 256, (int)blockIdx.x);
      EpiF E{(float*)(ws + WS_SC), D};
      pg8::gemm_phase<EpiF, pg8::StaticOrder, false>(ldsb, g, S, E, nullptr, wave_s); }
    GRID_BAR();
    { MKCTX(); phase_topk_simple(c, ws); if (DUP & 512) phase_topk_simple(c, ws); }
    GRID_BAR();
#else
    { MKCTX(); phase_scores_topk(c, ws); if (DUP & 512) phase_scores_topk(c, ws); }
    GRID_BAR();
#endif
#if PEER_BITS == 8
    { MKCTX(); phase_peer(c, ARG_OUT(), ARG_IN(15), ARG_OUT(), ws); }
#else
#if U_MFMA
    { MKCTX(); int nrep_ = (DUP & 8192) ? 2 : 1; asm volatile("" : "+s"(nrep_));
#pragma unroll 1
      for (int rep_ = 0; rep_ < nrep_; ++rep_) phase_peer4_u_mfma(c, ARG_IN(10), ws); }
#elif U_SORTED
    { MKCTX(); int nrep_ = (DUP & 8192) ? 2 : 1; asm volatile("" : "+s"(nrep_));
#pragma unroll 1
      for (int rep_ = 0; rep_ < nrep_; ++rep_) phase_peer4_u_sorted(c, ARG_IN(10), ws); }
#else
    { MKCTX(); phase_peer4_u<false>(c, ARG_IN(10), ws); }
#endif
    if (DUP & 4096) { MKCTX(); phase_peer4_u<true>(c, ARG_IN(10), ws); }
    asm volatile("s_waitcnt vmcnt(0)" ::: "memory");
#if V_MFMA && V_SORTED
    { MKCTX(); phase_peer4_v_sorted(c, ARG_IN(15), ARG_OUT(), ws); }
#elif V_MFMA
    { MKCTX(); phase_peer4_v_mfma(c, ARG_IN(15), ARG_OUT(), ws); }
#else
    { MKCTX(); phase_peer4_v(c, ARG_IN(15), ARG_OUT(), ws); }
#endif
#endif
}

extern "C" void kernel_launch(void* const* d_in, const int* in_sizes, int n_in, void* d_out, int out_size, void* d_ws, size_t ws_size, hipStream_t stream) {
    static int grid = 0;
    if (grid == 0) {
        if (n_in != 16 || in_sizes[0] != T * D || out_size != T * D || ws_size < WS_END) { fprintf(stderr, "kernel_launch: unexpected shapes (n_in %d, in0 %d, out %d, ws %zu)\n", n_in, n_in > 0 ? in_sizes[0] : -1, out_size, ws_size); grid = -1; return; }
        int dev = 0, cus = 0, per_cu = 0;
        if (hipGetDevice(&dev) != hipSuccess || hipDeviceGetAttribute(&cus, hipDeviceAttributeMultiprocessorCount, dev) != hipSuccess) { grid = -1; return; }
        if (hipFuncSetAttribute((const void*)fwd_kernel, hipFuncAttributeMaxDynamicSharedMemorySize, LDS_BYTES) != hipSuccess) { fprintf(stderr, "kernel_launch: hipFuncSetAttribute failed\n"); grid = -1; return; }
        if (hipOccupancyMaxActiveBlocksPerMultiprocessor(&per_cu, (const void*)fwd_kernel, NTHREADS, LDS_BYTES) != hipSuccess || per_cu < 1) { fprintf(stderr, "kernel_launch: occupancy query reports %d workgroups per CU\n", per_cu); }
        (void)hipGetLastError();
        grid = (cus < 256) ? cus : 256;
    }
    if (grid < 0) return;
    if (hipMemsetAsync((char*)d_ws + WS_CTL, 0, CTL_ZERO_BYTES, stream) != hipSuccess) return;
    Args a{};
    for (int i = 0; i < 16; ++i) a.in[i] = (const float*)d_in[i];
    a.out = (float*)d_out; a.ws = (unsigned char*)d_ws;
    hipLaunchKernelGGL(fwd_kernel, dim3(grid), dim3(NTHREADS), LDS_BYTES, stream, a);
}
```

```cpp
#include <hip/hip_runtime.h>
#include <cstdio>
#include <cstdint>
#ifndef ATTN_SIMPLE
#define ATTN_SIMPLE 0
#endif
#ifndef TOPK_SIMPLE
#define TOPK_SIMPLE 0
#endif
#ifndef PEER_BITS
#define PEER_BITS 4
#endif
#ifndef V_SORTED
#define V_SORTED 1
#endif
#ifndef V_MFMA
#define V_MFMA 1
#endif
#ifndef U_MFMA
#define U_MFMA 1
#endif
#ifndef U_SORTED
#define U_SORTED 1
#endif
#ifndef DUP
#define DUP 0
#endif
namespace pg8 {
#define PG8_LAS __attribute__((address_space(3)))
typedef unsigned short bf16_t;
typedef short bf16x8 __attribute__((ext_vector_type(8)));
typedef float f32x4 __attribute__((ext_vector_type(4)));
typedef unsigned u32x4 __attribute__((ext_vector_type(4)));
constexpr int BM = 256, BK = 64, HALF = 128, HTB = HALF * BK * 2  , STAGE_BYTES = 8 * HTB, NXCD = 8, WGM = 8;

__host__ __device__ __forceinline__ int lds_byte(int r, int c) { const int st = (r >> 4) * 2 + (c >> 5), rr = r & 15, cc = c & 31, ob = rr * 64 + cc * 2; return st * 1024 + (ob ^ (((ob >> 9) & 1) << 5)); }
__host__ __device__ __forceinline__ void stage_rc(int b, int& R, int& C) { const int st = b / 1024, sb = b % 1024, swz = sb ^ (((sb >> 9) & 1) << 5); R = (st >> 1) * 16 + swz / 64; C = (st & 1) * 32 + (swz % 64) / 2; }
__host__ __device__ __forceinline__ int perm32(int rho) { const int n = rho >> 4, i = rho & 15; return 8 * (i >> 2) + 4 * n + (i & 3); }

struct Unit { int pm, pn; };
struct Gemm { const bf16_t* A; const bf16_t* Bt; int M, N, K, lda, ldb, apn, bhalf; };

struct StaticOrder {
    int nM, nN, nwg, G, c;
    __host__ __device__ __forceinline__ void init(int M, int N, int G_, int c_) { nM = M / BM; nN = N / BM; nwg = nM * nN; G = G_; c = c_; }
    __host__ __device__ __forceinline__ bool next(int i, Unit& u) const {
        const long L = (long)i * G + c; if (L >= nwg) return false;
        int wgid = (int)L; { const int q = nwg / NXCD, r = nwg % NXCD, xcd = wgid % NXCD, off = wgid / NXCD; wgid = (xcd < r ? xcd * (q + 1) : r * (q + 1) + (xcd - r) * q) + off; }
        const int nig = WGM * nN, gid = wgid / nig, fm = gid * WGM, gsz = (nM - fm) < WGM ? (nM - fm) : WGM;
        u.pm = fm + ((wgid % nig) % gsz); u.pn = (wgid % nig) / gsz; return true;
    }
    __device__ __forceinline__ void a_ready(const Unit&) const {}
    __device__ __forceinline__ void done(const Unit&) const {}
};
__device__ __forceinline__ unsigned cvt_pk_bf16(float lo, float hi) { typedef __bf16 bf2_ __attribute__((ext_vector_type(2))); bf2_ v; v[0] = (__bf16)lo; v[1] = (__bf16)hi; return __builtin_bit_cast(unsigned, v); }
template <class Epi, class Sched, bool STAMP = false>
__device__ __forceinline__ void gemm_phase(PG8_LAS unsigned char* lds, const Gemm g, const Sched& S, const Epi& E, unsigned long long* stamps, int wid_in) {
    unsigned ones_ = ~0u; asm volatile("" : "+s"(ones_)); int lane_ = (int)__builtin_amdgcn_mbcnt_hi(ones_, __builtin_amdgcn_mbcnt_lo(ones_, 0u)); asm volatile("" : "+v"(lane_));
    const int wid = __builtin_amdgcn_readfirstlane(wid_in), lane = lane_, tid = wid * 64 + lane, wr = wid >> 2, wc = wid & 3, fr = lane & 15, fq = lane >> 4;
    int K_ = g.K; asm volatile("" : "+s"(K_));
    const int K = K_, nt = K / BK;
    int ts_lo = 0, ts_hi = 0, nts = 0; const unsigned long long rt_entry = STAMP ? (unsigned long long)wall_clock64() : 0ull;
#define PG8_STAMP() do { if (STAMP && wid == 0 && nts < 64) { const unsigned long long _c = (unsigned long long)clock64(); \
        ts_lo = (lane == nts) ? (int)(unsigned)_c : ts_lo; ts_hi = (lane == nts) ? (int)(unsigned)(_c >> 32) : ts_hi; ++nts; } } while (0)
    PG8_STAMP();
    unsigned voffA[2], voffB[2];
#pragma unroll
    for (int i = 0; i < 2; ++i) { int R, C; stage_rc(tid * 16 + i * 8192, R, C); const int Rb = Epi::PERM ? ((R & ~31) + perm32(R & 31)) : R;
        voffA[i] = (unsigned)(R * g.lda + C) * 2u; voffB[i] = (unsigned)(Rb * g.ldb + C) * 2u; }
    const size_t kstep = (size_t)(BK * 2);
    const size_t hstepA = (size_t)HALF * g.lda * 2, hstepB = (size_t)HALF * g.ldb * 2;
    const size_t tstepA = 2 * hstepA, tstepB = 2 * hstepB;
    const unsigned ldsw = (unsigned)wid * 1024u;
    const int aoff = lds_byte(wr * 64 + fr, fq * 8), boff = lds_byte(wc * 32 + fr, fq * 8);
#define PG8_SA(b, h) (((b) * 2 + (h)) * HTB)
#define PG8_SB(b, h) ((4 + (b) * 2 + (h)) * HTB)
#define PG8_STAGE(bufoff, gbase, voff) do { _Pragma("unroll") for (int _i = 0; _i < 2; ++_i) \
        __builtin_amdgcn_global_load_lds((const unsigned*)((const char*)(gbase) + (voff)[_i]), (PG8_LAS unsigned*)(lds + (bufoff) + ldsw + _i * 8192), 16, 0, 0); } while (0)
#define PG8_LDA(dst, b, h) do { _Pragma("unroll") for (int m = 0; m < 4; ++m) _Pragma("unroll") for (int k = 0; k < 2; ++k) dst[m][k] = *(const PG8_LAS bf16x8*)(lds + PG8_SA(b, h) + aoff + m * 2048 + k * 1024); } while (0)
#define PG8_LDB(dst, b, h) do { _Pragma("unroll") for (int n = 0; n < 2; ++n) _Pragma("unroll") for (int k = 0; k < 2; ++k) dst[n][k] = *(const PG8_LAS bf16x8*)(lds + PG8_SB(b, h) + boff + n * 2048 + k * 1024); } while (0)
#define PG8_MMA(ai, bj, At, Bt) do { __builtin_amdgcn_s_setprio(1); _Pragma("unroll") for (int m = 0; m < 4; ++m) _Pragma("unroll") for (int n = 0; n < 2; ++n) _Pragma("unroll") for (int k = 0; k < 2; ++k) \
        acc[ai][bj][m][n] = __builtin_amdgcn_mfma_f32_16x16x32_bf16(Bt[n][k], At[m][k], acc[ai][bj][m][n], 0, 0, 0); __builtin_amdgcn_s_setprio(0); } while (0)
#define PG8_WAIT_V(n) asm volatile("s_waitcnt vmcnt(" #n ")" ::: "memory")
#define PG8_WAIT_L(n) asm volatile("s_waitcnt lgkmcnt(" #n ")" ::: "memory")
#define PG8_BAR __builtin_amdgcn_s_barrier()
#define PG8_SCHED __builtin_amdgcn_sched_barrier(0)
    Unit cur, nxt; int ui = 0;
    if (!S.next(0, cur)) return;
    f32x4 acc[2][2][4][2];
#pragma unroll
    for (int a = 0; a < 2; ++a)
#pragma unroll
        for (int b = 0; b < 2; ++b)
#pragma unroll
            for (int m = 0; m < 4; ++m)
#pragma unroll
                for (int n = 0; n < 2; ++n) acc[a][b][m][n] = (f32x4){0.f, 0.f, 0.f, 0.f};
    bf16x8 At[4][2], B0[2][2], B1[2][2];
    const char* cA = (const char*)g.A + (size_t)cur.pm * tstepA + (size_t)cur.pn * g.apn; const char* cB = (const char*)g.Bt + (size_t)cur.pn * tstepB + ((2 * cur.pm * BM >= g.M) ? (size_t)g.bhalf : (size_t)0);
    S.a_ready(cur);
    PG8_STAGE(PG8_SB(0, 0), cB, voffB); PG8_STAGE(PG8_SA(0, 0), cA, voffA); PG8_STAGE(PG8_SB(0, 1), cB + hstepB, voffB); PG8_STAGE(PG8_SA(0, 1), cA + hstepA, voffA);
    if (wr == 1) PG8_BAR;
    PG8_WAIT_V(4); PG8_BAR;
    PG8_STAGE(PG8_SB(1, 0), cB + kstep, voffB); PG8_STAGE(PG8_SA(1, 0), cA + kstep, voffA); PG8_STAGE(PG8_SB(1, 1), cB + hstepB + kstep, voffB);
    PG8_WAIT_V(6); PG8_BAR;
    PG8_STAMP();
    for (;;) {
        const bool has_next = S.next(ui + 1, nxt);
        const char* nA = has_next ? (const char*)g.A + (size_t)nxt.pm * tstepA + (size_t)nxt.pn * g.apn : cA; const char* nB = has_next ? (const char*)g.Bt + (size_t)nxt.pn * tstepB + ((2 * nxt.pm * BM >= g.M) ? (size_t)g.bhalf : (size_t)0) : cB;
        for (int t = 0; t < nt; t += 2) {
            const bool last = (t == nt - 2);
            const char* a1 = cA + (size_t)(t + 1) * kstep;
            const char* a2 = last ? nA : cA + (size_t)(t + 2) * kstep; const char* b2 = last ? nB : cB + (size_t)(t + 2) * kstep;
            const char* a3 = a2 + kstep; const char* b3 = b2 + kstep;
            if (last && has_next) S.a_ready(nxt);
            PG8_LDB(B0, 0, 0); PG8_SCHED; PG8_LDA(At, 0, 0); PG8_STAGE(PG8_SA(1, 1), a1 + hstepA, voffA);
            PG8_WAIT_L(8); PG8_BAR; PG8_WAIT_L(0); PG8_MMA(0, 0, At, B0); PG8_BAR; PG8_SCHED;
            PG8_LDB(B1, 0, 1); PG8_STAGE(PG8_SB(0, 0), b2, voffB);
            PG8_BAR; PG8_WAIT_L(0); PG8_MMA(0, 1, At, B1); PG8_BAR;
            PG8_LDA(At, 0, 1); PG8_STAGE(PG8_SA(0, 0), a2, voffA);
            PG8_BAR; PG8_WAIT_L(0); PG8_MMA(1, 0, At, B0); PG8_BAR; PG8_SCHED;
            PG8_STAGE(PG8_SB(0, 1), b2 + hstepB, voffB);
            PG8_WAIT_V(6); PG8_BAR; PG8_MMA(1, 1, At, B1); PG8_BAR;
            PG8_LDB(B0, 1, 0); PG8_SCHED; PG8_LDA(At, 1, 0); PG8_STAGE(PG8_SA(0, 1), a2 + hstepA, voffA);
            PG8_WAIT_L(8); PG8_BAR; PG8_WAIT_L(0); PG8_MMA(0, 0, At, B0); PG8_BAR; PG8_SCHED;
            PG8_LDB(B1, 1, 1); PG8_STAGE(PG8_SB(1, 0), b3, voffB);
            PG8_BAR; PG8_WAIT_L(0); PG8_MMA(0, 1, At, B1); PG8_BAR;
            PG8_LDA(At, 1, 1); PG8_STAGE(PG8_SA(1, 0), a3, voffA);
            PG8_BAR; PG8_WAIT_L(0); PG8_MMA(1, 0, At, B0); PG8_BAR; PG8_SCHED;
            PG8_STAGE(PG8_SB(1, 1), b3 + hstepB, voffB);
            PG8_WAIT_V(6); PG8_BAR; PG8_MMA(1, 1, At, B1); PG8_BAR;
        }
        PG8_STAMP();
        if constexpr (!Epi::AFTER_DRAIN) { E(acc, cur, wr, wc, fr, fq); S.done(cur); }
        PG8_STAMP();
        if (!has_next) break;
#pragma unroll
        for (int a = 0; a < 2; ++a)
#pragma unroll
            for (int b = 0; b < 2; ++b)
#pragma unroll
                for (int m = 0; m < 4; ++m)
#pragma unroll
                    for (int n = 0; n < 2; ++n) acc[a][b][m][n] = (f32x4){0.f, 0.f, 0.f, 0.f};
        cur = nxt; cA = nA; cB = nB; ++ui;
    }
    PG8_WAIT_V(0);
    if (wr == 0) PG8_BAR;
    PG8_BAR;
    if constexpr (Epi::AFTER_DRAIN) { E.fused(acc, cur, wr, wc, fr, fq, lds, wid, lane); S.done(cur); }
    PG8_STAMP();
    if (STAMP && wid == 0) { stamps[lane] = lane < nts ? (((unsigned long long)(unsigned)ts_hi << 32) | (unsigned)ts_lo) : 0ull;
        if (lane == 62) stamps[62] = rt_entry; if (lane == 63) stamps[63] = (unsigned long long)wall_clock64(); }
#undef PG8_STAMP
#undef PG8_SA
#undef PG8_SB
#undef PG8_STAGE
#undef PG8_LDA
#undef PG8_LDB
#undef PG8_MMA
#undef PG8_WAIT_V
#undef PG8_WAIT_L
#undef PG8_BAR
#undef PG8_SCHED
}
}


constexpr int NWAVES = 8, NTHREADS = 512;
constexpr int BATCH = 2, SEQ = 8192, T = BATCH * SEQ, D = 2048;
constexpr int AW = 1024, NH = 8, HD = 128, PW = 1024, INW = 4096;
constexpr int NMOD = 6 * D;
constexpr int PE_HEADS = 8, PE_NK = 128, PE_EXP = 16384, PE_K = 16;
constexpr float NORM_EPS = 1e-6f;
constexpr float QSCALE = 0.08838834764831845f * 1.4426950408889634f;

constexpr size_t MiB = 1u << 20;
constexpr size_t WS_CTL = 0, CTL_ZERO_BYTES = 64 * 1024;
constexpr size_t WS_MODP = 1 * MiB;
constexpr size_t WS_MODF = 1 * MiB + 832 * 1024;
constexpr size_t WS_CS = 2 * MiB;
constexpr size_t WS_WTIN = 4 * MiB;
constexpr size_t WS_WTOUT = 20 * MiB;
constexpr size_t WS_WTQ = 28 * MiB;
constexpr size_t WS_WTPOOL = 36 * MiB;
constexpr size_t WS_SKP = 37 * MiB;
constexpr size_t WS_SU = 38 * MiB, WS_SV = 38 * MiB + 64 * 1024;
constexpr size_t WS_PU = 40 * MiB, WS_PV = 104 * MiB;
constexpr size_t WS_HB = 168 * MiB;
constexpr size_t WS_Q = 232 * MiB, WS_K = 264 * MiB, WS_V = 296 * MiB, WS_U = 328 * MiB;
constexpr size_t WS_HC = 360 * MiB;
constexpr size_t WS_RB = 424 * MiB;
constexpr size_t WS_QP = WS_Q;
constexpr size_t WS_SC = WS_V;
constexpr size_t WS_IDX = WS_RB, WS_GATE = WS_RB + 8 * MiB;
constexpr size_t WS_TQ = WS_RB + 16 * MiB, WS_CSC = WS_RB + 24 * MiB;
constexpr size_t WS_OP0 = WS_HB, WS_OP1 = WS_HB + 32 * MiB, WS_OP2 = 456 * MiB;
constexpr size_t WS_X1B = WS_V;
constexpr size_t WS_LSE = 488 * MiB;
constexpr size_t WS_WQ2 = 490 * MiB;
constexpr size_t WS_BIASP = 506 * MiB;
constexpr size_t WS_RSQP = 507 * MiB;
constexpr size_t WS_END = 509 * MiB;

constexpr int RING_BYTES = 131072, MISC_OFF = RING_BYTES, LDS_BYTES = 147456;

#define GAS __attribute__((address_space(1)))
typedef unsigned short bf16;
typedef unsigned v4u __attribute__((ext_vector_type(4)));
typedef unsigned v2u __attribute__((ext_vector_type(2)));
typedef float f32x4 __attribute__((ext_vector_type(4)));
typedef __bf16 bf2 __attribute__((ext_vector_type(2)));
#define LDS_WAIT() asm volatile("s_waitcnt lgkmcnt(0)" ::: "memory")
#define VM_WAIT() asm volatile("s_waitcnt vmcnt(0)" ::: "memory")
__device__ __forceinline__ unsigned pk2(float lo, float hi) { return pg8::cvt_pk_bf16(lo, hi); }
__device__ __forceinline__ float bflo(unsigned w) { return __uint_as_float(w << 16); }
__device__ __forceinline__ float bfhi(unsigned w) { return __uint_as_float(w & 0xffff0000u); }
__device__ __forceinline__ float dot2(unsigned a, unsigned b, float c) { return __builtin_amdgcn_fdot2_f32_bf16(__builtin_bit_cast(bf2, a), __builtin_bit_cast(bf2, b), c, false); }
__device__ __forceinline__ int my_lane() { unsigned ones = ~0u; asm volatile("" : "+s"(ones)); return (int)__builtin_amdgcn_mbcnt_hi(ones, __builtin_amdgcn_mbcnt_lo(ones, 0u)); }
__device__ __forceinline__ int sh_idx(int v, int idx) { return __builtin_amdgcn_ds_bpermute(idx << 2, v); }
__device__ __forceinline__ unsigned sh_idx(unsigned v, int idx) { return (unsigned)__builtin_amdgcn_ds_bpermute(idx << 2, (int)v); }
__device__ __forceinline__ float sh_idx(float v, int idx) { return __int_as_float(__builtin_amdgcn_ds_bpermute(idx << 2, __float_as_int(v))); }
#define SXOR(v, m, lane) sh_idx((v), (lane) ^ (m))
__device__ __forceinline__ float wave_sum(float v) {
    const int lane = my_lane();
#pragma unroll
    for (int o = 1; o < 64; o <<= 1) v += SXOR(v, o, lane);
    return v;
}
__device__ __forceinline__ int wave_sum_i(int v) {
    const int lane = my_lane();
#pragma unroll
    for (int o = 1; o < 64; o <<= 1) v += SXOR(v, o, lane);
    return v;
}
__device__ __forceinline__ float wave_max(float v) {
    const int lane = my_lane();
#pragma unroll
    for (int o = 1; o < 64; o <<= 1) v = fmaxf(v, SXOR(v, o, lane));
    return v;
}

#define XB_TMO      128
#define XB_XCNT(j)  (256  + 64 * (j))
#define XB_XSUB(j)  (1280 + 64 * (j))
#define XB_XGEN(j)  (2304 + 64 * (j))
#define XB_TOP      3328
#define XB_TOPGEN   3392
#define XCD_BAR_WORDS 3456
#define XB_SPIN_CAP (1u << 18)
#define LAS __attribute__((address_space(3)))

__device__ __forceinline__ unsigned xb_ld(unsigned* p)              { return __hip_atomic_load(p, __ATOMIC_RELAXED, __HIP_MEMORY_SCOPE_AGENT); }
__device__ __forceinline__ unsigned xb_add(unsigned* p, unsigned v) { return __hip_atomic_fetch_add(p, v, __ATOMIC_RELAXED, __HIP_MEMORY_SCOPE_AGENT); }
__device__ __forceinline__ unsigned xb_xcc_id() { return (unsigned)__builtin_amdgcn_s_getreg((3 << 11) | 20) & 0xFu; }
#define XB_SPIN(cond, bar) do { unsigned _sp = 0; while (cond) { __builtin_amdgcn_s_sleep(1); \
    if ((++_sp & 255u) == 0u) { if (xb_ld(&(bar)[XB_TMO])) break; if (_sp > XB_SPIN_CAP) { atomicAdd(&(bar)[XB_TMO], 1u); break; } } } } while (0)

struct XcdBarrier {
    unsigned* bar; unsigned x;
    volatile LAS unsigned* st;
};

__device__ __forceinline__ XcdBarrier xcd_barrier_post(unsigned* bar, volatile LAS unsigned* st, bool is_t0) {
    XcdBarrier b; b.bar = bar; b.x = xb_xcc_id(); b.st = st;
    if (is_t0) (void)xb_add(&bar[XB_XCNT(b.x)], 1u);
    return b;
}
__device__ __forceinline__ void xcd_barrier_complete(unsigned* bar, unsigned x, unsigned& nloc, unsigned& nx) {
    const unsigned G = gridDim.x * gridDim.y * gridDim.z;
    unsigned sum, cnt, mine, sp = 0u;
    for (;;) {
        sum = 0u; cnt = 0u; mine = 0u;
#pragma unroll
        for (unsigned j = 0; j < 16; ++j) { const unsigned c = xb_ld(&bar[XB_XCNT(j)]); sum += c; cnt += (c > 0u) ? 1u : 0u; mine = (j == x) ? c : mine; }
        if (sum == G) break;
        __builtin_amdgcn_s_sleep(1);
        if ((++sp & 255u) == 0u) { if (xb_ld(&bar[XB_TMO])) break; if (sp > XB_SPIN_CAP) { atomicAdd(&bar[XB_TMO], 1u); break; } }
    }
    nloc = mine > 0u ? mine : 1u; nx = cnt > 0u ? cnt : 1u;
}

__device__ __forceinline__ void xcd_barrier(const XcdBarrier& b, bool is_t0) {
    asm volatile("s_waitcnt vmcnt(0)" ::: "memory");
    __syncthreads();
    if (is_t0) {
        unsigned* bar = b.bar;
        __builtin_amdgcn_s_waitcnt(0);
        unsigned nloc = b.st[0], nx = b.st[1];
        if (nloc == 0u) { xcd_barrier_complete(bar, b.x, nloc, nx); b.st[0] = nloc; b.st[1] = nx; }
        const unsigned old = xb_add(&bar[XB_XSUB(b.x)], 1u);
        const unsigned gen = old / nloc;
        if (old + 1u == (gen + 1u) * nloc) {
            __builtin_amdgcn_fence(__ATOMIC_RELEASE, "agent");
            asm volatile("s_waitcnt vmcnt(0)" ::: "memory");
            const unsigned og = xb_add(&bar[XB_TOP], 1u);
            const unsigned tg = og / nx;
            if (og + 1u == (tg + 1u) * nx) xb_add(&bar[XB_TOPGEN], 1u);
            else XB_SPIN(xb_ld(&bar[XB_TOPGEN]) == tg, bar);
            __builtin_amdgcn_fence(__ATOMIC_ACQUIRE, "agent");
            xb_add(&bar[XB_XGEN(b.x)], 1u);
            asm volatile("s_waitcnt vmcnt(0)" ::: "memory");
        } else {
            XB_SPIN(xb_ld(&bar[XB_XGEN(b.x)]) == gen, bar);
            __builtin_amdgcn_fence(__ATOMIC_ACQUIRE, "agent");
            asm volatile("s_waitcnt vmcnt(0)" ::: "memory");
        }
    }
    __syncthreads();
}

struct Ctx { LAS unsigned char* lds; int tid, lane, wave, vcu, G, gw, ngw; };

struct Epi1 {
    static constexpr bool PERM = true, AFTER_DRAIN = false;
    bf16* QKVU; const float* CS;
    __device__ __forceinline__ void operator()(const pg8::f32x4 (&acc)[2][2][4][2], const pg8::Unit& u, int wr, int wc, int fr, int fq) const {
        const int row0 = u.pm * 256 + wr * 64 + fr; const int tt = u.pn >> 2; const int colt = (u.pn & 3) * 256;
        bf16* base = QKVU + (size_t)tt * ((size_t)T * 1024);
        const int col0 = colt + wc * 32 + 8 * fq;
        const bool rot = (tt < 2) && (wc == 0);
        const float sc = (tt == 0) ? QSCALE : 1.0f;
        const float sgn = (fq < 2) ? -1.0f : 1.0f;
#pragma unroll
        for (int ai = 0; ai < 2; ++ai)
#pragma unroll
            for (int m = 0; m < 4; ++m) {
                const int row = row0 + ai * 128 + m * 16;
                bf16* rowp = base + (size_t)row * 1024 + col0;
                f32x4 c0 = {1.f, 1.f, 1.f, 1.f}, c1 = c0, s0 = {0.f, 0.f, 0.f, 0.f}, s1 = s0;
                if (rot) { const float* cs = CS + (size_t)row * 32 + 8 * (fq & 1);
                    c0 = *(const f32x4*)(cs); c1 = *(const f32x4*)(cs + 4); s0 = *(const f32x4*)(cs + 16); s1 = *(const f32x4*)(cs + 20); }
#pragma unroll
                for (int bj = 0; bj < 2; ++bj) {
                    f32x4 v0 = acc[ai][bj][m][0], v1 = acc[ai][bj][m][1];
                    if (rot) {
#pragma unroll
                        for (int e = 0; e < 4; ++e) {
                            const float p0 = SXOR(v0[e], 32, 16 * fq + fr), p1 = SXOR(v1[e], 32, 16 * fq + fr);
                            v0[e] = v0[e] * c0[e] + sgn * p0 * s0[e];
                            v1[e] = v1[e] * c1[e] + sgn * p1 * s1[e];
                        }
                    }
                    pg8::u32x4 w; w.x = pk2(v0[0] * sc, v0[1] * sc); w.y = pk2(v0[2] * sc, v0[3] * sc); w.z = pk2(v1[0] * sc, v1[1] * sc); w.w = pk2(v1[2] * sc, v1[3] * sc);
                    *(pg8::u32x4*)(rowp + bj * 128) = w;
                }
            }
    }
};
struct EpiPool {
    static constexpr bool PERM = true, AFTER_DRAIN = false;
    bf16* HC; const float* pscale;
    __device__ __forceinline__ void operator()(const pg8::f32x4 (&acc)[2][2][4][2], const pg8::Unit& u, int wr, int wc, int fr, int fq) const {
        const int row0 = u.pm * 256 + wr * 64 + fr, col0 = u.pn * 256 + wc * 32 + 8 * fq;
        f32x4 ps[2][2];
#pragma unroll
        for (int bj = 0; bj < 2; ++bj) { ps[bj][0] = *(const f32x4*)(pscale + col0 + bj * 128); ps[bj][1] = *(const f32x4*)(pscale + col0 + bj * 128 + 4); }
#pragma unroll
        for (int ai = 0; ai < 2; ++ai)
#pragma unroll
            for (int m = 0; m < 4; ++m) {
                bf16* rowp = HC + (size_t)(row0 + ai * 128 + m * 16) * 2048 + 1024 + col0;
#pragma unroll
                for (int bj = 0; bj < 2; ++bj) {
                    const f32x4 v0 = acc[ai][bj][m][0] * ps[bj][0], v1 = acc[ai][bj][m][1] * ps[bj][1];
                    pg8::u32x4 w; w.x = pk2(v0[0], v0[1]); w.y = pk2(v0[2], v0[3]); w.z = pk2(v1[0], v1[1]); w.w = pk2(v1[2], v1[3]);
                    *(pg8::u32x4*)(rowp + bj * 128) = w;
                }
            }
    }
};
struct EpiBf {
    static constexpr bool PERM = true, AFTER_DRAIN = false;
    bf16* O; int ldc;
    __device__ __forceinline__ void operator()(const pg8::f32x4 (&acc)[2][2][4][2], const pg8::Unit& u, int wr, int wc, int fr, int fq) const {
        const int row0 = u.pm * 256 + wr * 64 + fr, col0 = u.pn * 256 + wc * 32 + 8 * fq;
#pragma unroll
        for (int ai = 0; ai < 2; ++ai)
#pragma unroll
            for (int m = 0; m < 4; ++m) {
                bf16* rowp = O + (size_t)(row0 + ai * 128 + m * 16) * ldc + col0;
#pragma unroll
                for (int bj = 0; bj < 2; ++bj) {
                    const f32x4 v0 = acc[ai][bj][m][0], v1 = acc[ai][bj][m][1];
                    pg8::u32x4 w; w.x = pk2(v0[0], v0[1]); w.y = pk2(v0[2], v0[3]); w.z = pk2(v1[0], v1[1]); w.w = pk2(v1[2], v1[3]);
                    *(pg8::u32x4*)(rowp + bj * 128) = w;
                }
            }
    }
};
struct EpiQ {
    static constexpr bool PERM = true, AFTER_DRAIN = false;
    bf16* O; const LAS float* rstdT; const LAS float* biasT; int pm0, pn0;
    __device__ __forceinline__ void operator()(const pg8::f32x4 (&acc)[2][2][4][2], const pg8::Unit& u, int wr, int wc, int fr, int fq) const {
        const int slot = (u.pm == pm0 && u.pn == pn0) ? 0 : 1;
        const int row0 = u.pm * 256 + wr * 64 + fr, col0 = u.pn * 256 + wc * 32 + 8 * fq;
        f32x4 bv[2][2];
#pragma unroll
        for (int bj = 0; bj < 2; ++bj) { bv[bj][0] = *(const LAS f32x4*)(biasT + slot * 256 + bj * 128 + wc * 32 + 8 * fq); bv[bj][1] = *(const LAS f32x4*)(biasT + slot * 256 + bj * 128 + wc * 32 + 8 * fq + 4); }
#pragma unroll
        for (int ai = 0; ai < 2; ++ai)
#pragma unroll
            for (int m = 0; m < 4; ++m) {
                const float rs = rstdT[slot * 256 + ai * 128 + wr * 64 + m * 16 + fr];
                bf16* rowp = O + (size_t)(row0 + ai * 128 + m * 16) * D + col0;
#pragma unroll
                for (int bj = 0; bj < 2; ++bj) {
                    const f32x4 v0 = acc[ai][bj][m][0] * rs + bv[bj][0], v1 = acc[ai][bj][m][1] * rs + bv[bj][1];
                    pg8::u32x4 w; w.x = pk2(v0[0], v0[1]); w.y = pk2(v0[2], v0[3]); w.z = pk2(v1[0], v1[1]); w.w = pk2(v1[2], v1[3]);
                    *(pg8::u32x4*)(rowp + bj * 128) = w;
                }
            }
    }
};
struct EpiF {
    static constexpr bool PERM = false, AFTER_DRAIN = false;
    float* C; int ldc;
    __device__ __forceinline__ void operator()(const pg8::f32x4 (&acc)[2][2][4][2], const pg8::Unit& u, int wr, int wc, int fr, int fq) const {
        const int row0 = u.pm * 256 + wr * 64 + fr, col0 = u.pn * 256 + wc * 32 + 4 * fq;
#pragma unroll
        for (int ai = 0; ai < 2; ++ai)
#pragma unroll
            for (int m = 0; m < 4; ++m) { float* rowp = C + (size_t)(row0 + ai * 128 + m * 16) * ldc + col0;
#pragma unroll
                for (int bj = 0; bj < 2; ++bj)
#pragma unroll
                    for (int n = 0; n < 2; ++n) *(f32x4*)(rowp + bj * 128 + n * 16) = acc[ai][bj][m][n]; }
    }
};
struct EpiOut {
    static constexpr bool PERM = true, AFTER_DRAIN = false;
    const float* X; bf16* X1; const float* MODF; float* RSQP;
    __device__ __forceinline__ void operator()(const pg8::f32x4 (&acc)[2][2][4][2], const pg8::Unit& u, int wr, int wc, int fr, int fq) const {
        const int row0 = u.pm * 256 + wr * 64 + fr, col0 = u.pn * 256 + wc * 32 + 8 * fq;
        const float* gp = MODF + (size_t)(u.pm >= 32 ? 1 : 0) * NMOD + 2 * D + col0;
        f32x4 gv[2][2];
#pragma unroll
        for (int bj = 0; bj < 2; ++bj)
#pragma unroll
            for (int n = 0; n < 2; ++n) gv[bj][n] = *(const f32x4*)(gp + bj * 128 + 4 * n);
#pragma unroll
        for (int ai = 0; ai < 2; ++ai)
#pragma unroll
            for (int m = 0; m < 4; ++m) { const size_t off = (size_t)(row0 + ai * 128 + m * 16) * D + col0; float ssr = 0.f;
#pragma unroll
                for (int bj = 0; bj < 2; ++bj) {
                    const f32x4 v0 = __builtin_nontemporal_load((const f32x4*)(X + off + bj * 128)) + gv[bj][0] * acc[ai][bj][m][0], v1 = __builtin_nontemporal_load((const f32x4*)(X + off + bj * 128 + 4)) + gv[bj][1] * acc[ai][bj][m][1];
                    pg8::u32x4 w; w.x = pk2(v0[0], v0[1]); w.y = pk2(v0[2], v0[3]); w.z = pk2(v1[0], v1[1]); w.w = pk2(v1[2], v1[3]);
                    *(pg8::u32x4*)(X1 + off + bj * 128) = w;
                    ssr += (v0[0] * v0[0] + v0[1] * v0[1]) + (v0[2] * v0[2] + v0[3] * v0[3]) + (v1[0] * v1[0] + v1[1] * v1[1]) + (v1[2] * v1[2] + v1[3] * v1[3]); }
                ssr += SXOR(ssr, 16, 16 * fq + fr); ssr += SXOR(ssr, 32, 16 * fq + fr);
                if (fq == 0) RSQP[(size_t)(row0 + ai * 128 + m * 16) * 32 + u.pn * 4 + wc] = ssr; }
    }
};

__device__ __forceinline__ void p0_transpose_item(const float* W, int K, int N, bf16* WT, int row_off, LAS float* scr, int item, int lane) {
    const int nblk = N / 32, kb = item / nblk, nb = item % nblk, k0 = 64 * kb, n0 = 32 * nb;
#pragma unroll 8
    for (int i = 0; i < 32; ++i) { const int kk = 2 * i + (lane >> 5); scr[kk * 33 + (lane & 31)] = W[(size_t)(k0 + kk) * N + n0 + (lane & 31)]; }
    LDS_WAIT(); asm volatile("" ::: "memory");
    const int c = lane & 7;
#pragma unroll
    for (int j = 0; j < 4; ++j) { const int n = (lane >> 3) + 8 * j; const LAS float* s = scr + (8 * c) * 33 + n;
        v4u o; o.x = pk2(s[0 * 33], s[1 * 33]); o.y = pk2(s[2 * 33], s[3 * 33]); o.z = pk2(s[4 * 33], s[5 * 33]); o.w = pk2(s[6 * 33], s[7 * 33]);
        *(v4u*)(WT + (size_t)(row_off + n0 + n) * K + k0 + 8 * c) = o; }
    LDS_WAIT(); asm volatile("" ::: "memory");
}
__device__ __forceinline__ float silu_f(float x) { return x / (1.0f + __expf(-x)); }
constexpr int MOD_ITEMS = 48 * 8;
__device__ __forceinline__ void p0_mod_item(const float* cvec, const float* w_mod, float* MODP, int item, int lane) {
    const int cb = item % 48, kc = item / 48, col = 256 * cb + 4 * lane, k0 = 256 * kc;
    f32x4 a0 = {0.f, 0.f, 0.f, 0.f}, a1 = a0;
    const float* wp = w_mod + (size_t)k0 * NMOD + col;
#pragma unroll 32
    for (int k = 0; k < 256; ++k) {
        const f32x4 w = __builtin_nontemporal_load((const f32x4*)(wp + (size_t)k * NMOD));
        const float s0 = silu_f(cvec[k0 + k]), s1 = silu_f(cvec[D + k0 + k]);
        a0 += w * s0; a1 += w * s1;
    }
    *(f32x4*)(MODP + ((size_t)kc * 2 + 0) * NMOD + col) = a0;
    *(f32x4*)(MODP + ((size_t)kc * 2 + 1) * NMOD + col) = a1;
}
template <int OFFS>
__device__ __forceinline__ void p0_quant_row(const float* src, unsigned char* dst, float* scale_out, int lane) {
    f32x4 v[8]; float am = 0.f;
#pragma unroll
    for (int j = 0; j < 8; ++j) { v[j] = *(const f32x4*)(src + 256 * j + 4 * lane); am = fmaxf(fmaxf(am, fmaxf(fabsf(v[j][0]), fabsf(v[j][1]))), fmaxf(fabsf(v[j][2]), fabsf(v[j][3]))); }
    am = wave_max(am);
    const float inv = (am > 0.f) ? 127.0f / am : 0.f;
    if (lane == 0) *scale_out = am * (1.0f / 127.0f);
#pragma unroll
    for (int j = 0; j < 8; ++j) {
        unsigned w = 0u;
#pragma unroll
        for (int e = 0; e < 4; ++e) { int q = __float2int_rn(v[j][e] * inv); q = q > 127 ? 127 : (q < -127 ? -127 : q); w |= ((unsigned)(q + OFFS) & 0xffu) << (8 * e); }
        *(unsigned*)(dst + 256 * j + 4 * lane) = w;
    }
}
__device__ __forceinline__ void p0_quant_load4(const float* src, int lane, f32x4 (&v)[8]) {
#pragma unroll
    for (int j = 0; j < 8; ++j) v[j] = __builtin_nontemporal_load((const f32x4*)(src + 256 * j + 4 * lane));
}
template <unsigned XR>
__device__ __forceinline__ void p0_quant_finish4(const f32x4 (&v)[8], unsigned char* dst, float* scale_out, int lane) {
    float am = 0.f, sq = 0.f;
#pragma unroll
    for (int j = 0; j < 8; ++j)
#pragma unroll
        for (int e = 0; e < 4; ++e) { am = fmaxf(am, fabsf(v[j][e])); sq += v[j][e] * v[j][e]; }
    am = wave_max(am); sq = wave_sum(sq);
    const float step = fmaxf(0.335f * sqrtf(sq * (1.0f / D)), am * (1.0f / 24.0f));
    const float inv = (step > 0.f) ? 1.0f / step : 0.f;
    if (lane == 0) *scale_out = step;
    v4u o;
#pragma unroll
    for (int d = 0; d < 4; ++d) {
        unsigned w = 0u;
#pragma unroll
        for (int e = 0; e < 4; ++e) {
            int lo = (int)floorf(v[2 * d][e] * inv) + 8, hi = (int)floorf(v[2 * d + 1][e] * inv) + 8;
            lo = lo < 0 ? 0 : (lo > 15 ? 15 : lo); hi = hi < 0 ? 0 : (hi > 15 ? 15 : hi);
            w |= ((unsigned)lo | ((unsigned)hi << 4)) << (8 * e);
        }
        w ^= XR * 0x01010101u;
        if (d == 0) o.x = w; else if (d == 1) o.y = w; else if (d == 2) o.z = w; else o.w = w;
    }
    *(v4u*)(dst + 16 * lane) = o;
}
__device__ __forceinline__ unsigned fp4_code(float x) {
    const float a = fabsf(x);
    const unsigned m = (unsigned)(a > 0.25f) + (unsigned)(a > 0.75f) + (unsigned)(a > 1.25f) + (unsigned)(a > 1.75f) + (unsigned)(a > 2.5f) + (unsigned)(a > 3.5f) + (unsigned)(a > 5.0f);
    return m | (x < 0.f ? 8u : 0u);
}
__device__ __forceinline__ void p0_quant_finish_fp4(const f32x4 (&v)[8], unsigned char* dst, float* scale_out, int lane) {
    float am = 0.f, sq = 0.f;
#pragma unroll
    for (int j = 0; j < 8; ++j)
#pragma unroll
        for (int e = 0; e < 4; ++e) { am = fmaxf(am, fabsf(v[j][e])); sq += v[j][e] * v[j][e]; }
    am = wave_max(am); sq = wave_sum(sq);
    const float step = fmaxf(0.48f * sqrtf(sq * (1.0f / D)), am * (1.0f / 18.0f));
    const float inv = (step > 0.f) ? 1.0f / step : 0.f;
    if (lane == 0) *scale_out = step;
    v4u o;
#pragma unroll
    for (int d = 0; d < 4; ++d) {
        unsigned w = 0u;
#pragma unroll
        for (int e = 0; e < 4; ++e) w |= (fp4_code(v[2 * d][e] * inv) | (fp4_code(v[2 * d + 1][e] * inv) << 4)) << (8 * e);
        if (d == 0) o.x = w; else if (d == 1) o.y = w; else if (d == 2) o.z = w; else o.w = w;
    }
    *(v4u*)(dst + 16 * lane) = o;
}
__device__ __forceinline__ void phase0(const Ctx& c, const float* const* in, unsigned char* ws) {
    const float* cvec = in[1]; const float* w_mod = in[3]; const float* w_in = in[6]; const float* w_pool = in[7]; const float* w_out = in[9];
    const float* w_query = in[11]; const float* sub_keys = in[12]; const float* peer_u = in[13]; const float* peer_v = in[14];
    LAS float* scr = (LAS float*)(c.lds + c.wave * 16384);
    if (c.gw < MOD_ITEMS) p0_mod_item(cvec, w_mod, (float*)(ws + WS_MODP), c.gw, c.lane);
    constexpr int I_IN = 32 * 128, I_OUT = 32 * 64, I_POOL = 4 * 32;
    for (int it = c.gw; it < I_IN + I_OUT + I_POOL; it += c.ngw) {
        int r = it;
        if (r < I_IN) { p0_transpose_item(w_in, D, INW, (bf16*)(ws + WS_WTIN), 0, scr, r, c.lane); continue; } r -= I_IN;
        if (r < I_OUT) { p0_transpose_item(w_out, D, D, (bf16*)(ws + WS_WTOUT), 0, scr, r, c.lane); continue; } r -= I_OUT;
        { const int g = r >> 5; p0_transpose_item(w_pool + (size_t)g * 65536, 256, 256, (bf16*)(ws + WS_WTPOOL), g * 256, scr, r & 31, c.lane); }
    }
#if TOPK_SIMPLE
    for (int r = c.gw; r < 2048; r += c.ngw) {
        const int p = (r >> 7) & 1, k = 4 * c.lane; v2u o = {0u, 0u};
        if ((k >> 7) == p) { const f32x4 s = *(const f32x4*)(sub_keys + (size_t)r * 128 + (k & 127)); o.x = pk2(s[0], s[1]); o.y = pk2(s[2], s[3]); }
        *(v2u*)((bf16*)(ws + WS_SKP) + (size_t)r * 256 + k) = o;
    }
#else
    for (int r = c.gw; r < 2048; r += c.ngw) {
        const float a = sub_keys[(size_t)r * 128 + 2 * c.lane], b = sub_keys[(size_t)r * 128 + 2 * c.lane + 1];
        *(unsigned*)((bf16*)(ws + WS_SKP) + (size_t)r * 128 + 2 * c.lane) = pk2(a, b);
    }
#endif
    if (c.gw >= MOD_ITEMS) {
        const int stride = c.ngw - MOD_ITEMS;
        int r = c.gw - MOD_ITEMS;
        f32x4 va[8], vb[8];
#define P0_SRC(R) (((R) < PE_EXP) ? peer_u + (size_t)(R) * D : peer_v + (size_t)((R) - PE_EXP) * D)
#define P0_FIN(V, R) do { if ((R) < PE_EXP) { if (U_MFMA) p0_quant_finish_fp4(V, ws + WS_PU + (size_t)(R) * 1024, (float*)(ws + WS_SU) + (R), c.lane); else p0_quant_finish4<0x88u>(V, ws + WS_PU + (size_t)(R) * 1024, (float*)(ws + WS_SU) + (R), c.lane); } \
                          else { if (V_MFMA) p0_quant_finish_fp4(V, ws + WS_PV + (size_t)((R) - PE_EXP) * 1024, (float*)(ws + WS_SV) + ((R) - PE_EXP), c.lane); else p0_quant_finish4<0x80u>(V, ws + WS_PV + (size_t)((R) - PE_EXP) * 1024, (float*)(ws + WS_SV) + ((R) - PE_EXP), c.lane); } } while (0)
        if (r < 2 * PE_EXP) p0_quant_load4(P0_SRC(r), c.lane, va);
        while (r < 2 * PE_EXP) {
            const int r1 = r + stride, r2 = r + 2 * stride;
            if (r1 < 2 * PE_EXP) p0_quant_load4(P0_SRC(r1), c.lane, vb);
            P0_FIN(va, r);
            if (r1 >= 2 * PE_EXP) break;
            if (r2 < 2 * PE_EXP) p0_quant_load4(P0_SRC(r2), c.lane, va);
            P0_FIN(vb, r1);
            r = r2;
        }
#undef P0_SRC
#undef P0_FIN
    }
}

__device__ __forceinline__ void p1_fold_q_item(const float* W, bf16* WQ2, float* BIASP, const LAS float* A2s, const LAS float* B2s, LAS float* scr, int item, int lane) {
    const int kb = item >> 6, nb = item & 63, k0 = 64 * kb, n0 = 32 * nb;
#pragma unroll 8
    for (int i = 0; i < 32; ++i) { const int kk = 2 * i + (lane >> 5); scr[kk * 33 + (lane & 31)] = W[(size_t)(k0 + kk) * D + n0 + (lane & 31)]; }
    LDS_WAIT(); asm volatile("" ::: "memory");
    {
        const int bb = lane >> 5, n = lane & 31; float sacc = 0.f;
#pragma unroll 8
        for (int kk = 0; kk < 64; ++kk) sacc += B2s[bb * D + k0 + kk] * scr[kk * 33 + n];
        BIASP[((size_t)kb * 2 + bb) * D + n0 + n] = sacc;
    }
    const int c8 = lane & 7;
#pragma unroll
    for (int bb = 0; bb < 2; ++bb) {
        const f32x4 a0 = *(const LAS f32x4*)(A2s + bb * D + k0 + 8 * c8), a1 = *(const LAS f32x4*)(A2s + bb * D + k0 + 8 * c8 + 4);
#pragma unroll
        for (int j = 0; j < 4; ++j) { const int n = (lane >> 3) + 8 * j; const LAS float* t = scr + (8 * c8) * 33 + n;
            v4u o; o.x = pk2(t[0 * 33] * a0[0], t[1 * 33] * a0[1]); o.y = pk2(t[2 * 33] * a0[2], t[3 * 33] * a0[3]); o.z = pk2(t[4 * 33] * a1[0], t[5 * 33] * a1[1]); o.w = pk2(t[6 * 33] * a1[2], t[7 * 33] * a1[3]);
            *(v4u*)(WQ2 + ((size_t)bb * D + n0 + n) * D + k0 + 8 * c8) = o; }
    }
    LDS_WAIT(); asm volatile("" ::: "memory");
}
template <bool FIRST>
__device__ __forceinline__ void phase_rows(const Ctx& c, const float* X, const bf16* XB, const float* gvec, const float* b_mod, const int* positions, unsigned char* ws, int shift_chunk, int scale_chunk, const float* gvec2 = nullptr, const float* w_query = nullptr) {
    LAS float* A1 = (LAS float*)c.lds; LAS float* B1 = A1 + D;
    const int b = c.vcu >> 7;
    const float* MODP = (const float*)(ws + WS_MODP); float* MODF = (float*)(ws + WS_MODF);
    {
        const int j = 4 * c.tid;
        f32x4 sh, sc;
        if (FIRST) {
            sh = *(const f32x4*)(b_mod + shift_chunk * D + j); sc = *(const f32x4*)(b_mod + scale_chunk * D + j);
#pragma unroll
            for (int s = 0; s < 8; ++s) { sh += *(const f32x4*)(MODP + ((size_t)s * 2 + b) * NMOD + shift_chunk * D + j); sc += *(const f32x4*)(MODP + ((size_t)s * 2 + b) * NMOD + scale_chunk * D + j); }
        } else { sh = *(const f32x4*)(MODF + (size_t)b * NMOD + shift_chunk * D + j); sc = *(const f32x4*)(MODF + (size_t)b * NMOD + scale_chunk * D + j); }
        const f32x4 g = *(const f32x4*)(gvec + j);
        *(LAS f32x4*)(A1 + j) = g * (sc + 1.0f); *(LAS f32x4*)(B1 + j) = sh;
    }
    LAS float* A2s = (LAS float*)(c.lds + 16384); LAS float* B2s = A2s + 2 * D;
    if (FIRST) {
        const int j = 4 * c.tid; const f32x4 g2v = *(const f32x4*)(gvec2 + j);
#pragma unroll
        for (int bb = 0; bb < 2; ++bb) {
            f32x4 sh = *(const f32x4*)(b_mod + 3 * D + j), sc = *(const f32x4*)(b_mod + 4 * D + j);
#pragma unroll
            for (int sx = 0; sx < 8; ++sx) { sh += *(const f32x4*)(MODP + ((size_t)sx * 2 + bb) * NMOD + 3 * D + j); sc += *(const f32x4*)(MODP + ((size_t)sx * 2 + bb) * NMOD + 4 * D + j); }
            *(LAS f32x4*)(A2s + bb * D + j) = g2v * (sc + 1.0f); *(LAS f32x4*)(B2s + bb * D + j) = sh;
        }
    }
    if (FIRST && c.vcu < 48 && c.tid < 256) {
        const int col = 256 * c.vcu + c.tid;
#pragma unroll
        for (int bb = 0; bb < 2; ++bb) { float v = b_mod[col];
#pragma unroll
            for (int s = 0; s < 8; ++s) v += MODP[((size_t)s * 2 + bb) * NMOD + col];
            MODF[(size_t)bb * NMOD + col] = v; }
    }
    __syncthreads();
    if (FIRST) {
        LAS float* scr = (LAS float*)(c.lds + 49152 + c.wave * 8448);
        p1_fold_q_item(w_query, (bf16*)(ws + WS_WQ2), (float*)(ws + WS_BIASP), A2s, B2s, scr, c.gw, c.lane);
    }
    bf16* HB = (bf16*)(ws + WS_HB);
    for (int i = 0; i < 8; ++i) {
        const int t = 64 * c.vcu + 8 * c.wave + i;
        f32x4 v[8]; float ss = 0.f;
#pragma unroll
        for (int q = 0; q < 8; ++q) {
            if (FIRST) v[q] = __builtin_nontemporal_load((const f32x4*)(X + (size_t)t * D + 4 * c.lane + 256 * q));
            else { const v2u w = *(const v2u*)(XB + (size_t)t * D + 4 * c.lane + 256 * q); v[q] = (f32x4){bflo(w.x), bfhi(w.x), bflo(w.y), bfhi(w.y)}; }
            ss += (v[q][0] * v[q][0] + v[q][1] * v[q][1]) + (v[q][2] * v[q][2] + v[q][3] * v[q][3]); }
        const float rstd = 1.0f / sqrtf(wave_sum(ss) * (1.0f / D) + NORM_EPS);
        bf16* hr = HB + (size_t)t * D + 4 * c.lane;
#pragma unroll
        for (int q = 0; q < 8; ++q) {
            const f32x4 a = *(const LAS f32x4*)(A1 + 256 * q + 4 * c.lane), bb = *(const LAS f32x4*)(B1 + 256 * q + 4 * c.lane);
            const f32x4 y = v[q] * rstd * a + bb;
            v2u o; o.x = pk2(y[0], y[1]); o.y = pk2(y[2], y[3]);
            *(v2u*)(hr + 256 * q) = o;
        }
        if (FIRST && c.lane < 32) {
            const int fi = c.lane & 15;
            const float inv = (float)pow(500000.0, -(double)fi / 16.0);
            const float ang = (float)positions[t] * inv;
            ((float*)(ws + WS_CS))[(size_t)t * 32 + c.lane] = (c.lane < 16) ? cosf(ang) : sinf(ang);
        }
    }
    __syncthreads();
}

template <int P>
__device__ __forceinline__ void poolr_item(const bf16* U, bf16* RB, int t, int c0) {
    const int tb = t & (SEQ - 1);
    float s[8] = {0.f, 0.f, 0.f, 0.f, 0.f, 0.f, 0.f, 0.f}, u0[8];
    v4u w[P];
#pragma unroll
    for (int j = 0; j < P; ++j) w[j] = *(const v4u*)(U + (size_t)(t - (j <= tb ? j : tb)) * 1024 + c0);
#pragma unroll
    for (int j = 0; j < P; ++j) {
        const float m = (j <= tb) ? 1.0f : 0.0f;
        const float f[8] = {bflo(w[j].x), bfhi(w[j].x), bflo(w[j].y), bfhi(w[j].y), bflo(w[j].z), bfhi(w[j].z), bflo(w[j].w), bfhi(w[j].w)};
#pragma unroll
        for (int e = 0; e < 8; ++e) { s[e] += m * f[e]; if (j == 0) u0[e] = f[e]; }
    }
    const int cnt = (tb + 1 < P) ? tb + 1 : P;
    const float ic = 1.0f / (float)cnt;
    v4u o; o.x = pk2(s[0] * ic - u0[0], s[1] * ic - u0[1]); o.y = pk2(s[2] * ic - u0[2], s[3] * ic - u0[3]);
    o.z = pk2(s[4] * ic - u0[4], s[5] * ic - u0[5]); o.w = pk2(s[6] * ic - u0[6], s[7] * ic - u0[7]);
    *(v4u*)(RB + (size_t)t * 1024 + c0) = o;
}
__device__ __forceinline__ void phase_poolr(const Ctx& c, unsigned char* ws) {
    const bf16* U = (const bf16*)(ws + WS_U); bf16* RB = (bf16*)(ws + WS_RB);
    LAS unsigned char* tile = c.lds;
    const int ch = c.tid & 31, rg = c.tid >> 5;
    for (int it = c.vcu; it < 1024; it += c.G) {
        const int g = it & 3, t0 = 64 * (it >> 2), P = 2 << g, tb0 = t0 & (SEQ - 1), nrows = 63 + P;
        __syncthreads();
        for (int id = c.tid; id < nrows * 32; id += NTHREADS) {
            const int lr = id >> 5, cc = id & 31, dt = lr - (P - 1);
            v4u w = {0u, 0u, 0u, 0u};
            if (tb0 + dt >= 0) w = *(const v4u*)(U + (size_t)(t0 + dt) * 1024 + 256 * g + 8 * cc);
            *(LAS v4u*)(tile + lr * 512 + cc * 16) = w;
        }
        __syncthreads();
        float sacc[8];
#pragma unroll
        for (int e = 0; e < 8; ++e) sacc[e] = 0.f;
        const int r0 = 4 * rg;
        for (int j = 0; j < P; ++j) {
            const v4u w = *(const LAS v4u*)(tile + (r0 + P - 1 - j) * 512 + ch * 16);
            sacc[0] += bflo(w.x); sacc[1] += bfhi(w.x); sacc[2] += bflo(w.y); sacc[3] += bfhi(w.y); sacc[4] += bflo(w.z); sacc[5] += bfhi(w.z); sacc[6] += bflo(w.w); sacc[7] += bfhi(w.w);
        }
#pragma unroll
        for (int i = 0; i < 4; ++i) {
            const int r = r0 + i, tb = tb0 + r;
            const v4u wu = *(const LAS v4u*)(tile + (r + P - 1) * 512 + ch * 16);
            const float u0[8] = {bflo(wu.x), bfhi(wu.x), bflo(wu.y), bfhi(wu.y), bflo(wu.z), bfhi(wu.z), bflo(wu.w), bfhi(wu.w)};
            if (i > 0) {
                const v4u wo = *(const LAS v4u*)(tile + (r - 1) * 512 + ch * 16);
                const float uo[8] = {bflo(wo.x), bfhi(wo.x), bflo(wo.y), bfhi(wo.y), bflo(wo.z), bfhi(wo.z), bflo(wo.w), bfhi(wo.w)};
#pragma unroll
                for (int e = 0; e < 8; ++e) sacc[e] += u0[e] - uo[e];
            }
            const int cnt = (tb + 1 < P) ? tb + 1 : P;
            const float ic = 1.0f / (float)cnt;
            v4u o; o.x = pk2(sacc[0] * ic - u0[0], sacc[1] * ic - u0[1]); o.y = pk2(sacc[2] * ic - u0[2], sacc[3] * ic - u0[3]);
            o.z = pk2(sacc[4] * ic - u0[4], sacc[5] * ic - u0[5]); o.w = pk2(sacc[6] * ic - u0[6], sacc[7] * ic - u0[7]);
            *(v4u*)(RB + (size_t)(t0 + r) * 1024 + 256 * g + 8 * ch) = o;
        }
    }
    __syncthreads();
}

__device__ __forceinline__ void phase_attn_simple(const Ctx& c, unsigned char* ws) {
    const bf16* QB = (const bf16*)(ws + WS_Q); const bf16* KB = (const bf16*)(ws + WS_K); const bf16* VB = (const bf16*)(ws + WS_V); bf16* HC = (bf16*)(ws + WS_HC);
    LAS float* pb = (LAS float*)(c.lds + c.wave * 2048);
    const float NEG = -3.0e38f;
    for (int item = c.gw; item < T * NH; item += c.ngw) {
        const int t = item >> 3, h = item & 7, tb = t & (SEQ - 1);
        const v4u* qp = (const v4u*)(QB + (size_t)t * 1024 + h * 128);
        v4u q[16];
#pragma unroll
        for (int i = 0; i < 16; ++i) q[i] = qp[i];
        float sv[7]; float mx = NEG;
#pragma unroll
        for (int r = 0; r < 7; ++r) {
            const int e = c.lane + 64 * r, pat = e / 129, j = e - pat * 129, off = j << (2 * pat);
            const bool valid = (e < 387) && (off <= tb);
            float s = NEG;
            if (valid) {
                const v4u* kp = (const v4u*)(KB + (size_t)(t - off) * 1024 + h * 128);
                float a0 = 0.f, a1 = 0.f;
#pragma unroll
                for (int i = 0; i < 16; ++i) { const v4u kk = kp[i]; a0 = dot2(q[i].x, kk.x, a0); a1 = dot2(q[i].y, kk.y, a1); a0 = dot2(q[i].z, kk.z, a0); a1 = dot2(q[i].w, kk.w, a1); }
                s = a0 + a1;
            }
            sv[r] = s; mx = fmaxf(mx, s);
        }
        mx = wave_max(mx);
        float l = 0.f;
#pragma unroll
        for (int r = 0; r < 7; ++r) { const float p = (sv[r] > -1.0e38f) ? exp2f(sv[r] - mx) : 0.f; l += p; pb[c.lane + 64 * r] = p; }
        l = wave_sum(l);
        LDS_WAIT();
        float o0 = 0.f, o1 = 0.f;
        for (int e = 0; e < 387; ++e) {
            const int pat = e / 129, j = e - pat * 129, off = j << (2 * pat);
            if (off > tb) continue;
            const float pe = pb[e];
            const unsigned w = *(const unsigned*)(VB + (size_t)(t - off) * 1024 + h * 128 + 2 * c.lane);
            o0 += pe * bflo(w); o1 += pe * bfhi(w);
        }
        const float il = 1.0f / l;
        *(unsigned*)(HC + (size_t)t * 2048 + h * 128 + 2 * c.lane) = pk2(o0 * il, o1 * il);
        LDS_WAIT();
    }
}

__device__ __forceinline__ unsigned off_k(unsigned row, unsigned ch) { return 256u * row + 16u * (ch ^ ((row & 3u) | (((row >> 3) & 3u) << 2))); }
__device__ __forceinline__ unsigned off_b(unsigned row, unsigned ch) { return 256u * row + 16u * (ch ^ (((row & 3u) << 2) | ((row >> 2) & 3u))); }
typedef short s4v __attribute__((ext_vector_type(4)));
__device__ __forceinline__ void phase_attn_mfma(const Ctx& c, unsigned char* ws) {
    const bf16* QB = (const bf16*)(ws + WS_Q); const bf16* KB = (const bf16*)(ws + WS_K); const bf16* VB = (const bf16*)(ws + WS_V);
    float* LSE = (float*)(ws + WS_LSE);
    const int g = c.lane >> 4, lq = c.lane & 15;
    const float NEG = -3.0e38f;
    const int i0 = 16 * c.wave, jb = 32 * (c.wave >> 1), iq = i0 + lq;
    unsigned kaddr[2][4], vbase[2], vxor[2];
    {
        const unsigned rowa = (unsigned)(jb + 8 * (lq >> 2) + (lq & 3));
        const unsigned q4 = (unsigned)(lq >> 2), p4 = (unsigned)(c.lane & 3);
#pragma unroll
        for (int s4 = 0; s4 < 4; ++s4) { kaddr[0][s4] = off_k(rowa, (unsigned)(4 * s4 + g)); kaddr[1][s4] = off_k(rowa + 4u, (unsigned)(4 * s4 + g)); }
#pragma unroll
        for (int t = 0; t < 2; ++t) {
            const unsigned row = (unsigned)(jb + 8 * g + 4 * t) + q4, f = ((row & 3u) << 2) | ((row >> 2) & 3u);
            vxor[t] = 16u * (f & 14u);
            vbase[t] = 65536u + 256u * row + 16u * ((p4 >> 1) ^ (f & 1u)) + 8u * (p4 & 1u);
        }
    }
    v4u kreg[8], vreg[8]; pg8::bf16x8 qnext[4];
#define ATTN_DECODE(U) const int p_ = (U) >> 10, rem_ = (U) & 1023, bh_ = rem_ >> 6, rn_ = rem_ & 63, b_ = bh_ >> 3, h_ = bh_ & 7; \
        const int dsh_ = 2 * p_, nbl_ = 64 >> dsh_, r_ = rn_ / nbl_, n_ = rn_ - r_ * nbl_; \
        const int tok0q_ = b_ * SEQ + r_ + ((n_ * 128) << dsh_), tok0k_ = tok0q_ - (128 << dsh_);
#define ATTN_ISSUE(U) do { ATTN_DECODE(U) \
        const unsigned rstr_ = 2048u << dsh_;                         \
        const unsigned off0_ = (unsigned)(tok0k_ + ((c.tid >> 4) << dsh_)) * 2048u + (unsigned)(h_ * 256 + (c.tid & 15) * 16); \
        _Pragma("unroll") for (int i_ = 0; i_ < 8; ++i_) {           \
            v4u kv_ = {0u, 0u, 0u, 0u}, vv_ = kv_; \
            if (i_ >= 4 || n_ > 0) { const unsigned o_ = off0_ + (unsigned)(32 * i_) * rstr_; kv_ = *(const v4u*)((const unsigned char*)KB + o_); vv_ = *(const v4u*)((const unsigned char*)VB + o_); } \
            kreg[i_] = kv_; vreg[i_] = vv_; } \
        const int tokq_ = tok0q_ + (iq << dsh_); \
        _Pragma("unroll") for (int s_ = 0; s_ < 4; ++s_) qnext[s_] = *(const pg8::bf16x8*)(QB + (size_t)tokq_ * 1024 + h_ * 128 + 32 * s_ + 8 * g); } while (0)
    ATTN_ISSUE(c.vcu);
    for (int unit = c.vcu; unit < 3072; unit += c.G) {
        ATTN_DECODE(unit)
        const int p = p_, h = h_, n = n_, dsh = dsh_, tok0q = tok0q_;
        bf16* OP = (bf16*)(ws + (p == 0 ? WS_OP0 : (p == 1 ? WS_OP1 : WS_OP2)));
        __syncthreads();
#pragma unroll
        for (int i = 0; i < 8; ++i) {
            const int id = c.tid + 512 * i, row = id >> 4, ch = id & 15;
            *(LAS v4u*)(c.lds + off_k((unsigned)row, (unsigned)ch)) = kreg[i]; *(LAS v4u*)(c.lds + 65536u + off_b((unsigned)row, (unsigned)ch)) = vreg[i];
        }
        const int tokq = tok0q + (iq << dsh);
        pg8::bf16x8 qf[4];
#pragma unroll
        for (int s4 = 0; s4 < 4; ++s4) qf[s4] = qnext[s4];
        __syncthreads();
        if (unit + c.G < 3072) ATTN_ISSUE(unit + c.G);
        f32x4 sa[5], sb[5];
#pragma unroll
        for (int kt = 0; kt < 5; ++kt) {
            f32x4 aa = {0.f, 0.f, 0.f, 0.f}, ab = aa;
#pragma unroll
            for (int s4 = 0; s4 < 4; ++s4) {
                const pg8::bf16x8 ka = *(const LAS pg8::bf16x8*)(c.lds + kaddr[0][s4] + 8192u * kt);
                const pg8::bf16x8 kb = *(const LAS pg8::bf16x8*)(c.lds + kaddr[1][s4] + 8192u * kt);
                aa = __builtin_amdgcn_mfma_f32_16x16x32_bf16(ka, qf[s4], aa, 0, 0, 0);
                ab = __builtin_amdgcn_mfma_f32_16x16x32_bf16(kb, qf[s4], ab, 0, 0, 0);
            }
            sa[kt] = aa; sb[kt] = ab;
        }
        const int jlo = (n > 0) ? iq : (iq > 128 ? iq : 128);
#pragma unroll
        for (int i = 0; i < 4; ++i) {
            const int ja = jb + 8 * g + i;
            sa[0][i] = (ja >= jlo) ? sa[0][i] : NEG; sb[0][i] = (ja + 4 >= jlo) ? sb[0][i] : NEG;
            sa[4][i] = (ja + 128 <= iq + 128) ? sa[4][i] : NEG; sb[4][i] = (ja + 132 <= iq + 128) ? sb[4][i] : NEG;
        }
        if (n == 0) {
#pragma unroll
            for (int kt = 1; kt < 5; ++kt)
#pragma unroll
                for (int i = 0; i < 4; ++i) { const int ja = jb + 32 * kt + 8 * g + i; sa[kt][i] = (ja >= jlo) ? sa[kt][i] : NEG; sb[kt][i] = (ja + 4 >= jlo) ? sb[kt][i] : NEG; }
        }
        float mx = NEG;
#pragma unroll
        for (int kt = 0; kt < 5; ++kt)
#pragma unroll
            for (int i = 0; i < 4; ++i) mx = fmaxf(mx, fmaxf(sa[kt][i], sb[kt][i]));
        mx = fmaxf(mx, SXOR(mx, 16, c.lane)); mx = fmaxf(mx, SXOR(mx, 32, c.lane));
        float l = 0.f;
#pragma unroll
        for (int kt = 0; kt < 5; ++kt)
#pragma unroll
            for (int i = 0; i < 4; ++i) { sa[kt][i] = __builtin_amdgcn_exp2f(sa[kt][i] - mx); sb[kt][i] = __builtin_amdgcn_exp2f(sb[kt][i] - mx); l += sa[kt][i] + sb[kt][i]; }
        l += SXOR(l, 16, c.lane); l += SXOR(l, 32, c.lane);
        f32x4 o[8];
#pragma unroll
        for (int c8 = 0; c8 < 8; ++c8) o[c8] = (f32x4){0.f, 0.f, 0.f, 0.f};
#pragma unroll
        for (int kt = 0; kt < 5; ++kt) {
            pg8::u32x4 pw; pw.x = pk2(sa[kt][0], sa[kt][1]); pw.y = pk2(sa[kt][2], sa[kt][3]); pw.z = pk2(sb[kt][0], sb[kt][1]); pw.w = pk2(sb[kt][2], sb[kt][3]);
            const pg8::bf16x8 pf = __builtin_bit_cast(pg8::bf16x8, pw);
#pragma unroll
            for (int c8 = 0; c8 < 8; ++c8) {
                const s4v t0 = __builtin_amdgcn_ds_read_tr16_b64_v4i16((LAS s4v*)(c.lds + (vbase[0] + ((32u * c8) ^ vxor[0])) + 8192u * kt));
                const s4v t1 = __builtin_amdgcn_ds_read_tr16_b64_v4i16((LAS s4v*)(c.lds + (vbase[1] + ((32u * c8) ^ vxor[1])) + 8192u * kt));
                const pg8::bf16x8 vf = __builtin_shufflevector(t0, t1, 0, 1, 2, 3, 4, 5, 6, 7);
                o[c8] = __builtin_amdgcn_mfma_f32_16x16x32_bf16(vf, pf, o[c8], 0, 0, 0);
            }
        }
        const float il = 1.0f / l;
        bf16* orow = OP + (size_t)tokq * 1024 + h * 128 + 4 * g;
#pragma unroll
        for (int c8 = 0; c8 < 8; ++c8) { v2u w; w.x = pk2(o[c8][0] * il, o[c8][1] * il); w.y = pk2(o[c8][2] * il, o[c8][3] * il); *(v2u*)(orow + 16 * c8) = w; }
        if (g == 0) LSE[((size_t)p * T + tokq) * 8 + h] = mx + __builtin_amdgcn_logf(l);
    }
    __syncthreads();
}
__device__ __forceinline__ void phase_combine(const Ctx& c, unsigned char* ws) {
    const float* LSE = (const float*)(ws + WS_LSE); bf16* HC = (bf16*)(ws + WS_HC);
    const bf16* OP0 = (const bf16*)(ws + WS_OP0); const bf16* OP1 = (const bf16*)(ws + WS_OP1); const bf16* OP2 = (const bf16*)(ws + WS_OP2);
    for (int t = c.gw; t < T; t += c.ngw) {
        const int h = c.lane >> 3;
        const float l0 = LSE[((size_t)0 * T + t) * 8 + h], l1 = LSE[((size_t)1 * T + t) * 8 + h], l2 = LSE[((size_t)2 * T + t) * 8 + h];
        const float m = fmaxf(l0, fmaxf(l1, l2));
        float w0 = exp2f(l0 - m), w1 = exp2f(l1 - m), w2 = exp2f(l2 - m);
        const float inv = 1.0f / (w0 + w1 + w2); w0 *= inv; w1 *= inv; w2 *= inv;
        const size_t off = (size_t)t * 1024 + 16 * c.lane;
#pragma unroll
        for (int hh = 0; hh < 2; ++hh) {
            const v4u a = *(const v4u*)(OP0 + off + 8 * hh), bq = *(const v4u*)(OP1 + off + 8 * hh), cq = *(const v4u*)(OP2 + off + 8 * hh);
            v4u o;
            o.x = pk2(w0 * bflo(a.x) + w1 * bflo(bq.x) + w2 * bflo(cq.x), w0 * bfhi(a.x) + w1 * bfhi(bq.x) + w2 * bfhi(cq.x));
            o.y = pk2(w0 * bflo(a.y) + w1 * bflo(bq.y) + w2 * bflo(cq.y), w0 * bfhi(a.y) + w1 * bfhi(bq.y) + w2 * bfhi(cq.y));
            o.z = pk2(w0 * bflo(a.z) + w1 * bflo(bq.z) + w2 * bflo(cq.z), w0 * bfhi(a.z) + w1 * bfhi(bq.z) + w2 * bfhi(cq.z));
            o.w = pk2(w0 * bflo(a.w) + w1 * bflo(bq.w) + w2 * bflo(cq.w), w0 * bfhi(a.w) + w1 * bfhi(bq.w) + w2 * bfhi(cq.w));
            *(v4u*)(HC + (size_t)t * 2048 + 16 * c.lane + 8 * hh) = o;
        }
    }
}

__device__ __forceinline__ int f2sort(float f) { const int b = __float_as_int(f); return b ^ ((b >> 31) & 0x7fffffff); }
__device__ __forceinline__ float sort2f(int k) { return __int_as_float(k ^ ((k >> 31) & 0x7fffffff)); }
#define CE_DESC(a, b) do { const int hi_ = max((a), (b)), lo_ = min((a), (b)); (a) = hi_; (b) = lo_; } while (0)
__device__ __forceinline__ void bitonic_merge16(int (&v)[16]) {
#pragma unroll
    for (int j = 8; j > 0; j >>= 1)
#pragma unroll
        for (int i = 0; i < 16; ++i) { const int l = i ^ j; if (l > i) CE_DESC(v[i], v[l]); }
}
__device__ __forceinline__ void sort16(int (&v)[16]) {
#pragma unroll
    for (int k = 2; k <= 16; k <<= 1)
#pragma unroll
        for (int j = k >> 1; j > 0; j >>= 1)
#pragma unroll
            for (int i = 0; i < 16; ++i) { const int l = i ^ j; if (l > i) { if ((i & k) == 0) CE_DESC(v[i], v[l]); else CE_DESC(v[l], v[i]); } }
}
__device__ __forceinline__ void merge_top16(int (&a)[16], const int (&b)[16]) {
#pragma unroll
    for (int k = 0; k < 16; ++k) a[k] = max(a[k], b[15 - k]);
    bitonic_merge16(a);
}
__device__ __forceinline__ void xlane_merge(int (&a)[16], int xr, int lane) {
    int b[16];
#pragma unroll
    for (int k = 0; k < 16; ++k) b[k] = SXOR(a[k], xr, lane);
    merge_top16(a, b);
}
__device__ __forceinline__ void phase_scores_topk(const Ctx& c, unsigned char* ws) {
    const bf16* QP = (const bf16*)(ws + WS_QP); const bf16* SKB = (const bf16*)(ws + WS_SKP);
    int* IDX = (int*)(ws + WS_IDX); float* GATE = (float*)(ws + WS_GATE);
    const int g = c.lane >> 4, lq = c.lane & 15;
    const int h = c.vcu & 7, tb = c.vcu >> 3;
    LAS unsigned char* lut = c.lds + 65536 + c.wave * 2560 + c.lane * 36;
#pragma unroll
    for (int i = 0; i < 8; ++i) {
        const int id = c.tid + 512 * i, row = id >> 4, ch = id & 15;
        *(LAS v4u*)(c.lds + off_b((unsigned)row, (unsigned)ch)) = *(const v4u*)(SKB + ((size_t)h * 256 + row) * 128 + ch * 8);
    }
    unsigned ka[4];
#pragma unroll
    for (int s4 = 0; s4 < 4; ++s4) ka[s4] = off_b((unsigned)lq, (unsigned)(4 * s4 + g));
    __syncthreads();
    for (int it = 0; it < 4; ++it) {
        const int t = 512 * tb + 128 * it + 16 * c.wave + lq;
        int top[2][16];
#pragma unroll
        for (int p = 0; p < 2; ++p) {
            pg8::bf16x8 qf[4];
#pragma unroll
            for (int s4 = 0; s4 < 4; ++s4) qf[s4] = *(const pg8::bf16x8*)(QP + (size_t)t * 2048 + h * 256 + p * 128 + 32 * s4 + 8 * g);
            int lo[16], hi[16];
#pragma unroll
            for (int c8 = 0; c8 < 8; ++c8) {
                f32x4 acc = {0.f, 0.f, 0.f, 0.f};
#pragma unroll
                for (int s4 = 0; s4 < 4; ++s4) {
                    const pg8::bf16x8 kf = *(const LAS pg8::bf16x8*)(c.lds + ka[s4] + (unsigned)(32768 * p + 4096 * c8));
                    acc = __builtin_amdgcn_mfma_f32_16x16x32_bf16(kf, qf[s4], acc, 0, 0, 0);
                }
#pragma unroll
                for (int i = 0; i < 4; ++i) { const int key = (f2sort(acc[i]) & ~127) | (16 * c8 + 4 * g + i); if (c8 < 4) lo[4 * c8 + i] = key; else hi[4 * (c8 - 4) + i] = key; }
            }
            sort16(lo); sort16(hi); merge_top16(lo, hi);
            xlane_merge(lo, 16, c.lane); xlane_merge(lo, 32, c.lane);
#pragma unroll
            for (int k = 0; k < 16; ++k) top[p][k] = lo[k];
        }
#pragma unroll
        for (int p = 0; p < 2; ++p)
#pragma unroll
            for (int q = 0; q < 4; ++q)
                *(LAS unsigned*)(lut + 16 * p + 4 * q) = (unsigned)(top[p][4 * q] & 127) | ((unsigned)(top[p][4 * q + 1] & 127) << 8) | ((unsigned)(top[p][4 * q + 2] & 127) << 16) | ((unsigned)(top[p][4 * q + 3] & 127) << 24);
        float f0[16], f1[16];
#pragma unroll
        for (int k = 0; k < 16; ++k) { f0[k] = sort2f(top[0][k] & ~127); f1[k] = sort2f(top[1][k] & ~127); }
#define CAND(a, b) ((f2sort(f0[a] + f1[b]) & ~255) | ((a) << 4) | (b))
        int X[16], Y[16], Z[16];
#pragma unroll
        for (int b2 = 0; b2 < 16; ++b2) X[b2] = CAND(0, b2);
#pragma unroll
        for (int b2 = 0; b2 < 8; ++b2) Y[b2] = CAND(1, b2);
#pragma unroll
        for (int a2 = 8; a2 < 16; ++a2) Y[23 - a2] = CAND(a2, 0);
        Z[0] = CAND(2, 0); Z[1] = CAND(2, 1); Z[2] = CAND(2, 2); Z[3] = CAND(2, 3); Z[4] = CAND(2, 4);
        Z[5] = CAND(3, 0); Z[6] = CAND(3, 1); Z[7] = CAND(3, 2); Z[8] = CAND(3, 3);
        Z[9] = CAND(4, 0); Z[10] = CAND(4, 1); Z[11] = CAND(4, 2);
        Z[12] = CAND(5, 0); Z[13] = CAND(5, 1); Z[14] = CAND(6, 0); Z[15] = CAND(6, 1);
        const int w0 = CAND(7, 0), w1 = CAND(7, 1);
#undef CAND
        bitonic_merge16(Y); sort16(Z);
        merge_top16(X, Y); merge_top16(X, Z);
        X[14] = max(X[14], w1); X[15] = max(X[15], w0); bitonic_merge16(X);
        LDS_WAIT();
        float e[16], sum = 0.f; const float fmx = sort2f(X[0] & ~255);
#pragma unroll
        for (int k = 0; k < 16; ++k) { e[k] = __expf(sort2f(X[k] & ~255) - fmx); sum += e[k]; }
        const float inv = 1.0f / sum;
        int ex[16];
#pragma unroll
        for (int k = 0; k < 16; ++k) { const int a2 = (X[k] >> 4) & 15, b2 = X[k] & 15; ex[k] = (int)(*(const LAS unsigned char*)(lut + a2)) * PE_NK + (int)(*(const LAS unsigned char*)(lut + 16 + b2)); }
        if (g == 0) {
            int* ip = IDX + (size_t)t * 128 + h * 16; float* gp = GATE + (size_t)t * 128 + h * 16;
#pragma unroll
            for (int q = 0; q < 4; ++q) {
                *(int4*)(ip + 4 * q) = make_int4(ex[4 * q], ex[4 * q + 1], ex[4 * q + 2], ex[4 * q + 3]);
                *(f32x4*)(gp + 4 * q) = (f32x4){e[4 * q] * inv, e[4 * q + 1] * inv, e[4 * q + 2] * inv, e[4 * q + 3] * inv};
            }
        }
        LDS_WAIT();
    }
    __syncthreads();
}

__device__ __forceinline__ void phase_topk_simple(const Ctx& c, unsigned char* ws) {
    const float* SC = (const float*)(ws + WS_SC); int* IDX = (int*)(ws + WS_IDX); float* GATE = (float*)(ws + WS_GATE);
    const float NEG = -3.0e38f;
    for (int item = c.gw; item < T * PE_HEADS; item += c.ngw) {
        const int t = item >> 3, h = item & 7;
        const float* sc = SC + (size_t)t * 2048 + h * 256;
        float sh[2] = {0.f, 0.f}; int ih[2] = {0, 0};
#pragma unroll
        for (int p = 0; p < 2; ++p) {
            float va = sc[128 * p + c.lane], vb = sc[128 * p + 64 + c.lane];
            for (int r = 0; r < PE_K; ++r) {
                const float M = wave_max(fmaxf(va, vb));
                const unsigned long long ba = __ballot(va == M), bb = __ballot(vb == M);
                const int n = ba ? (int)__builtin_ctzll(ba) : 64 + (int)__builtin_ctzll(bb);
                if (c.lane == r) { sh[p] = M; ih[p] = n; }
                if (n < 64) { if (c.lane == n) va = NEG; } else { if (c.lane == n - 64) vb = NEG; }
            }
        }
        float cv[4];
#pragma unroll
        for (int q = 0; q < 4; ++q) { const int cc = c.lane + 64 * q; cv[q] = sh_idx(sh[0], cc >> 4) + sh_idx(sh[1], cc & 15); }
        float ts = NEG; int tc = 0;
        for (int r = 0; r < PE_K; ++r) {
            const float M = wave_max(fmaxf(fmaxf(cv[0], cv[1]), fmaxf(cv[2], cv[3])));
            int cc = -1;
#pragma unroll
            for (int q = 3; q >= 0; --q) { const unsigned long long bq = __ballot(cv[q] == M); if (bq) cc = 64 * q + (int)__builtin_ctzll(bq); }
            if (c.lane == r) { ts = M; tc = cc; }
#pragma unroll
            for (int q = 0; q < 4; ++q) if (cc == c.lane + 64 * q) cv[q] = NEG;
        }
        const int i0 = sh_idx(ih[0], tc >> 4), i1 = sh_idx(ih[1], tc & 15);
        const float tmax = sh_idx(ts, 0);
        const float ex = (c.lane < PE_K) ? __expf(ts - tmax) : 0.f;
        const float sum = wave_sum(ex);
        if (c.lane < PE_K) { IDX[(size_t)t * 128 + h * 16 + c.lane] = i0 * PE_NK + i1; GATE[(size_t)t * 128 + h * 16 + c.lane] = ex / sum; }
    }
}

__device__ __forceinline__ void ld_row8(const unsigned char* tab, int e, int lane, v4u (&r)[2]) {
    const v4u* p = (const v4u*)(tab + (size_t)e * D) + lane;
    r[0] = p[0]; r[1] = p[64];
}
__device__ __forceinline__ int idot_row(const int (&h)[8], const v4u (&r)[2]) {
    int a = 0, b = 0;
    a = __builtin_amdgcn_sdot4(h[0], (int)r[0].x, a, false); b = __builtin_amdgcn_sdot4(h[1], (int)r[0].y, b, false);
    a = __builtin_amdgcn_sdot4(h[2], (int)r[0].z, a, false); b = __builtin_amdgcn_sdot4(h[3], (int)r[0].w, b, false);
    a = __builtin_amdgcn_sdot4(h[4], (int)r[1].x, a, false); b = __builtin_amdgcn_sdot4(h[5], (int)r[1].y, b, false);
    a = __builtin_amdgcn_sdot4(h[6], (int)r[1].z, a, false); b = __builtin_amdgcn_sdot4(h[7], (int)r[1].w, b, false);
    return a + b;
}
__device__ __forceinline__ int reduce8(const int (&p)[8], int lane) {
    const bool b0 = lane & 1, b1 = lane & 2, b2 = lane & 4;
    int q[4], r2[2];
#pragma unroll
    for (int i = 0; i < 4; ++i) { const int keep = b0 ? p[2 * i + 1] : p[2 * i], send = b0 ? p[2 * i] : p[2 * i + 1]; q[i] = keep + SXOR(send, 1, lane); }
#pragma unroll
    for (int i = 0; i < 2; ++i) { const int keep = b1 ? q[2 * i + 1] : q[2 * i], send = b1 ? q[2 * i] : q[2 * i + 1]; r2[i] = keep + SXOR(send, 2, lane); }
    int v = (b2 ? r2[1] : r2[0]) + SXOR(b2 ? r2[0] : r2[1], 4, lane);
    v += SXOR(v, 8, lane); v += SXOR(v, 16, lane); v += SXOR(v, 32, lane);
    return v;
}
__device__ __forceinline__ void axpy_row8(float (&y)[32], float a, const v4u (&r)[2]) {
#pragma unroll
    for (int q = 0; q < 2; ++q) {
        const unsigned w[4] = {r[q].x, r[q].y, r[q].z, r[q].w};
#pragma unroll
        for (int d = 0; d < 4; ++d) {
            y[16 * q + 4 * d + 0] += a * (float)(w[d] & 0xffu); y[16 * q + 4 * d + 1] += a * (float)((w[d] >> 8) & 0xffu);
            y[16 * q + 4 * d + 2] += a * (float)((w[d] >> 16) & 0xffu); y[16 * q + 4 * d + 3] += a * (float)(w[d] >> 24);
        }
    }
}
__device__ __forceinline__ void phase_peer(const Ctx& c, const float* X1, const float* final_g, float* out, unsigned char* ws) {
    const unsigned char* PU = ws + WS_PU; const unsigned char* PV = ws + WS_PV; const bf16* HB = (const bf16*)(ws + WS_HB);
    const float* SU = (const float*)(ws + WS_SU); const float* SV = (const float*)(ws + WS_SV);
    const int* IDX = (const int*)(ws + WS_IDX); const float* GATE = (const float*)(ws + WS_GATE); const float* MODF = (const float*)(ws + WS_MODF);
    LAS float* G2 = (LAS float*)c.lds; LAS float* FG = G2 + D;
    const int b = c.vcu >> 7;
    { const int j = 4 * c.tid; *(LAS f32x4*)(G2 + j) = *(const f32x4*)(MODF + (size_t)b * NMOD + 5 * D + j); *(LAS f32x4*)(FG + j) = *(const f32x4*)(final_g + j); }
    __syncthreads();
#pragma unroll 1
    for (int i = (DUP & 1024) ? -8 : 0; i < 8; ++i) {
        const int t = 64 * c.vcu + 8 * c.wave + (i & 7);
        const int e0 = IDX[(size_t)t * 128 + c.lane], e1 = IDX[(size_t)t * 128 + 64 + c.lane];
        const float g0 = GATE[(size_t)t * 128 + c.lane], g1 = GATE[(size_t)t * 128 + 64 + c.lane];
        v4u r[8][2];
#pragma unroll
        for (int q = 0; q < 8; ++q) ld_row8(PU, __builtin_amdgcn_readlane(e0, q), c.lane, r[q]);
        const float su0 = SU[e0], su1 = SU[e1], sv0 = SV[e0], sv1 = SV[e1];
        int hq[8]; float sh;
        {
            float hf[32]; float am = 0.f;
#pragma unroll
            for (int q = 0; q < 2; ++q)
#pragma unroll
                for (int rr = 0; rr < 2; ++rr) {
                    const v4u w = *(const v4u*)(HB + (size_t)t * D + 1024 * q + 16 * c.lane + 8 * rr);
                    float* f = hf + 16 * q + 8 * rr;
                    f[0] = bflo(w.x); f[1] = bfhi(w.x); f[2] = bflo(w.y); f[3] = bfhi(w.y); f[4] = bflo(w.z); f[5] = bfhi(w.z); f[6] = bflo(w.w); f[7] = bfhi(w.w);
                }
#pragma unroll
            for (int k = 0; k < 32; ++k) am = fmaxf(am, fabsf(hf[k]));
            am = wave_max(am);
            const float inv = (am > 0.f) ? 127.0f / am : 0.f; sh = am * (1.0f / 127.0f);
#pragma unroll
            for (int d = 0; d < 8; ++d) { unsigned w = 0u;
#pragma unroll
                for (int e = 0; e < 4; ++e) { const int qv = __float2int_rn(hf[4 * d + e] * inv); w |= ((unsigned)qv & 0xffu) << (8 * e); }
                hq[d] = (int)w; }
        }
        int ia0 = 0, ia1 = 0;
#pragma unroll 1
        for (int m = 0; m < 16; ++m) {
            int part[8];
#pragma unroll
            for (int q = 0; q < 8; ++q) {
                part[q] = idot_row(hq, r[q]);
                const int kn = 8 * (m + 1) + q;
                if (m < 15) { const int en = (kn < 64) ? __builtin_amdgcn_readlane(e0, kn & 63) : __builtin_amdgcn_readlane(e1, kn & 63); ld_row8(PU, en, c.lane, r[q]); }
            }
            const int v = reduce8(part, c.lane);
            if (m < 8) { if ((c.lane >> 3) == m) ia0 = v; } else { if ((c.lane >> 3) == m - 8) ia1 = v; }
        }
#pragma unroll
        for (int q = 0; q < 8; ++q) ld_row8(PV, __builtin_amdgcn_readlane(e0, q), c.lane, r[q]);
        const float a0 = (float)ia0 * su0 * sh, a1 = (float)ia1 * su1 * sh;
        const float c0 = 0.5f * a0 * (1.0f + erff(a0 * 0.70710678118654752f)) * g0 * sv0;
        const float c1 = 0.5f * a1 * (1.0f + erff(a1 * 0.70710678118654752f)) * g1 * sv1;
        const float csum = wave_sum(c0 + c1);
        float y[32];
#pragma unroll
        for (int q = 0; q < 32; ++q) y[q] = 0.f;
#pragma unroll 1
        for (int m = 0; m < 16; ++m) {
#pragma unroll
            for (int q = 0; q < 8; ++q) {
                const int k = 8 * m + q;
                const float ck = __uint_as_float((k < 64) ? __builtin_amdgcn_readlane(__float_as_uint(c0), k & 63) : __builtin_amdgcn_readlane(__float_as_uint(c1), k & 63));
                axpy_row8(y, ck, r[q]);
                const int kn = k + 8;
                if (m < 15) { const int en = (kn < 64) ? __builtin_amdgcn_readlane(e0, kn & 63) : __builtin_amdgcn_readlane(e1, kn & 63); ld_row8(PV, en, c.lane, r[q]); }
            }
        }
        const float* xr = X1 + (size_t)t * D + 16 * c.lane; float* orow = ((DUP & 1024) && i < 0 ? (float*)(ws + WS_HC) : out) + (size_t)t * D + 16 * c.lane;
        const float yoff = 128.0f * csum;
        float ss = 0.f;
#pragma unroll
        for (int q = 0; q < 2; ++q)
#pragma unroll
            for (int d = 0; d < 4; ++d) {
                const f32x4 xa = *(const f32x4*)(xr + 1024 * q + 4 * d);
                const f32x4 ga = *(const LAS f32x4*)(G2 + 1024 * q + 16 * c.lane + 4 * d);
#pragma unroll
                for (int e = 0; e < 4; ++e) { const float v = xa[e] + ga[e] * (y[16 * q + 4 * d + e] - yoff); y[16 * q + 4 * d + e] = v; ss += v * v; }
            }
        const float rstd = 1.0f / sqrtf(wave_sum(ss) * (1.0f / D) + NORM_EPS);
#pragma unroll
        for (int q = 0; q < 2; ++q)
#pragma unroll
            for (int d = 0; d < 4; ++d) {
                const f32x4 fa = *(const LAS f32x4*)(FG + 1024 * q + 16 * c.lane + 4 * d);
                f32x4 o;
#pragma unroll
                for (int e = 0; e < 4; ++e) o[e] = y[16 * q + 4 * d + e] * rstd * fa[e];
                *(f32x4*)(orow + 1024 * q + 4 * d) = o;
            }
    }
}

__device__ __forceinline__ v4u ld_row4(const unsigned char* tab, int e, int lane) { return *((const v4u*)(tab + (size_t)e * 1024) + lane); }
__device__ __forceinline__ int idot_row4(const int (&h)[8], const v4u& r) {
    const int w[4] = {(int)r.x, (int)r.y, (int)r.z, (int)r.w}; int ah = 0, al = 0;
#pragma unroll
    for (int d = 0; d < 4; ++d) { ah = __builtin_amdgcn_sdot8(h[d], w[d], ah, false); al = __builtin_amdgcn_sdot8(h[4 + d], w[d], al, false); }
    return 16 * ah + al;
}
__device__ __forceinline__ void vacc4(int (&y)[32], const v4u& ra, const v4u& rb, const v4u& rc, const v4u& rd, int cq4) {
    const unsigned A[4] = {ra.x, ra.y, ra.z, ra.w}, B[4] = {rb.x, rb.y, rb.z, rb.w}, C[4] = {rc.x, rc.y, rc.z, rc.w}, Dd[4] = {rd.x, rd.y, rd.z, rd.w};
#pragma unroll
    for (int d = 0; d < 4; ++d) {
        const unsigned t0 = __builtin_amdgcn_perm(A[d], B[d], 0x01050004u), t1 = __builtin_amdgcn_perm(A[d], B[d], 0x03070206u);
        const unsigned t2 = __builtin_amdgcn_perm(C[d], Dd[d], 0x01050004u), t3 = __builtin_amdgcn_perm(C[d], Dd[d], 0x03070206u);
        const unsigned T[4] = {__builtin_amdgcn_perm(t0, t2, 0x01000504u), __builtin_amdgcn_perm(t0, t2, 0x03020706u),
                               __builtin_amdgcn_perm(t1, t3, 0x01000504u), __builtin_amdgcn_perm(t1, t3, 0x03020706u)};
#pragma unroll
        for (int e = 0; e < 4; ++e) {
            y[8 * d + e] = __builtin_amdgcn_sdot4((int)(T[e] & 0x0f0f0f0fu), cq4, y[8 * d + e], false);
            y[8 * d + 4 + e] = __builtin_amdgcn_sdot4((int)T[e], cq4, y[8 * d + 4 + e], false);
        }
    }
}
#define SCHED_FENCE() __builtin_amdgcn_sched_barrier(0)
template <bool REMAP>
__device__ __forceinline__ void phase_peer4_u(const Ctx& c, const float* g2vec, unsigned char* ws) {
    const unsigned char* PU = ws + WS_PU; const bf16* HB = (const bf16*)(ws + WS_X1B);
    LAS float* A2 = (LAS float*)(c.lds + 16384); LAS float* B2 = A2 + D;
    { const float* MODF_ = (const float*)(ws + WS_MODF) + (size_t)(c.vcu >> 7) * NMOD; const int j = 4 * c.tid;
      *(LAS f32x4*)(A2 + j) = *(const f32x4*)(g2vec + j) * (*(const f32x4*)(MODF_ + 4 * D + j) + 1.0f); *(LAS f32x4*)(B2 + j) = *(const f32x4*)(MODF_ + 3 * D + j); }
    __syncthreads();
    const float* SU = (const float*)(ws + WS_SU); const float* SV = (const float*)(ws + WS_SV);
    const int* IDX = (const int*)(ws + WS_IDX); const float* GATE = (const float*)(ws + WS_GATE);
    int* TQ = (int*)(ws + (REMAP ? WS_HC : WS_TQ)); float* CSC = (float*)(ws + (REMAP ? WS_HC + 16 * MiB : WS_CSC));
    const int rm_or = (int)(blockIdx.x & 7) << 11;
#define RM(e) (REMAP ? (((e) & 2047) | rm_or) : (e))
    const int tbase = 64 * c.vcu + 8 * c.wave;
    int e0n = RM(IDX[(size_t)tbase * 128 + c.lane]), e1n = RM(IDX[(size_t)tbase * 128 + 64 + c.lane]);
    float g0n = GATE[(size_t)tbase * 128 + c.lane], g1n = GATE[(size_t)tbase * 128 + 64 + c.lane];
    v2u hraw[8];
#pragma unroll
    for (int j = 0; j < 8; ++j) hraw[j] = __builtin_nontemporal_load((const v2u*)(HB + (size_t)tbase * D + 256 * j + 4 * c.lane));
    v4u r[16];
#pragma unroll
    for (int q = 0; q < 16; ++q) r[q] = ld_row4(PU, __builtin_amdgcn_readlane(e0n, q), c.lane);
#pragma unroll 1
    for (int i = (DUP & 1024) ? -8 : 0; i < 8; ++i) {
        const int t = tbase + (i & 7), tn = tbase + ((i + 1) & 7);
        const int e0 = e0n, e1 = e1n; const float g0 = g0n, g1 = g1n;
        const float su0 = SU[e0], su1 = SU[e1], sv0 = SV[e0], sv1 = SV[e1];
        int hq[8]; float sh; int hsum;
        {
            float hf[32]; float am = 0.f, ssx = 0.f;
#pragma unroll
            for (int j = 0; j < 8; ++j) { hf[4 * j] = bflo(hraw[j].x); hf[4 * j + 1] = bfhi(hraw[j].x); hf[4 * j + 2] = bflo(hraw[j].y); hf[4 * j + 3] = bfhi(hraw[j].y); }
#pragma unroll
            for (int k = 0; k < 32; ++k) ssx += hf[k] * hf[k];
            const float rstd2 = 1.0f / sqrtf(wave_sum(ssx) * (1.0f / D) + NORM_EPS);
#pragma unroll
            for (int j = 0; j < 8; ++j) { const f32x4 av = *(const LAS f32x4*)(A2 + 256 * j + 4 * c.lane), bv = *(const LAS f32x4*)(B2 + 256 * j + 4 * c.lane);
#pragma unroll
                for (int e = 0; e < 4; ++e) hf[4 * j + e] = hf[4 * j + e] * rstd2 * av[e] + bv[e]; }
#pragma unroll
            for (int k = 0; k < 32; ++k) am = fmaxf(am, fabsf(hf[k]));
            am = wave_max(am);
            const float inv = (am > 0.f) ? 119.0f / am : 0.f; sh = am * (1.0f / 119.0f);
            int hs = 0;
#pragma unroll
            for (int d = 0; d < 4; ++d) { unsigned wh = 0u, wl = 0u;
#pragma unroll
                for (int e = 0; e < 4; ++e)
#pragma unroll
                    for (int odd = 0; odd < 2; ++odd) {
                        const int qv = __float2int_rn(hf[4 * (2 * d + odd) + e] * inv), hh = (qv + 8) >> 4, hl = qv - 16 * hh;
                        hs += qv; wh |= ((unsigned)hh & 15u) << (8 * e + 4 * odd); wl |= ((unsigned)hl & 15u) << (8 * e + 4 * odd);
                    }
                hq[d] = (int)wh; hq[4 + d] = (int)wl; }
            hsum = wave_sum_i(hs);
        }
        e0n = RM(IDX[(size_t)tn * 128 + c.lane]); e1n = RM(IDX[(size_t)tn * 128 + 64 + c.lane]);
        g0n = GATE[(size_t)tn * 128 + c.lane]; g1n = GATE[(size_t)tn * 128 + 64 + c.lane];
#pragma unroll
        for (int j = 0; j < 8; ++j) hraw[j] = __builtin_nontemporal_load((const v2u*)(HB + (size_t)tn * D + 256 * j + 4 * c.lane));
        int ia0 = 0, ia1 = 0;
#pragma unroll 1
        for (int m = 0; m < 8; ++m) {
            const int esrc = (m + 1 < 4) ? e0 : ((m + 1 < 8) ? e1 : e0n);
            int part[16];
#pragma unroll
            for (int q = 0; q < 16; ++q) {
                part[q] = idot_row4(hq, r[q]);
                SCHED_FENCE();
                r[q] = ld_row4(PU, __builtin_amdgcn_readlane(esrc, (16 * (m + 1) + q) & 63), c.lane);
                SCHED_FENCE();
            }
            int pa[8], pb[8];
#pragma unroll
            for (int q = 0; q < 8; ++q) { pa[q] = part[q]; pb[q] = part[8 + q]; }
            const int va = reduce8(pa, c.lane), vb = reduce8(pb, c.lane);
            const int grp = c.lane >> 3;
            if (m < 4) { if (grp == 2 * m) ia0 = va; if (grp == 2 * m + 1) ia0 = vb; } else { if (grp == 2 * (m - 4)) ia1 = va; if (grp == 2 * (m - 4) + 1) ia1 = vb; }
        }
        const float hoff = 0.5f * (float)hsum;
        const float a0 = ((float)ia0 + hoff) * su0 * sh, a1 = ((float)ia1 + hoff) * su1 * sh;
        const float c0 = 0.5f * a0 * (1.0f + erff(a0 * 0.70710678118654752f)) * g0 * sv0;
        const float c1 = 0.5f * a1 * (1.0f + erff(a1 * 0.70710678118654752f)) * g1 * sv1;
        const float cmx = wave_max(fmaxf(fabsf(c0), fabsf(c1)));
        const float cinv = (cmx > 0.f) ? 127.0f / cmx : 0.f, csc = cmx * (1.0f / 127.0f);
        const int q0 = __float2int_rn(c0 * cinv), q1 = __float2int_rn(c1 * cinv);
        const int cqs = wave_sum_i(q0 + q1);
        const unsigned b0 = (unsigned)q0 & 0xffu, b1 = (unsigned)q1 & 0xffu;
        const int t0 = (int)(b0 | (sh_idx(b0, c.lane + 1) << 8) | (sh_idx(b0, c.lane + 2) << 16) | (sh_idx(b0, c.lane + 3) << 24));
        const int t1 = (int)(b1 | (sh_idx(b1, c.lane + 1) << 8) | (sh_idx(b1, c.lane + 2) << 16) | (sh_idx(b1, c.lane + 3) << 24));
        TQ[(size_t)t * 128 + c.lane] = t0; TQ[(size_t)t * 128 + 64 + c.lane] = t1;
        if (c.lane == 0) { CSC[(size_t)t * 2] = csc; CSC[(size_t)t * 2 + 1] = (float)cqs; }
    }
#undef RM
}
__device__ __forceinline__ void phase_peer4_u_sorted(const Ctx& c, const float* g2vec, unsigned char* ws) {
    const unsigned char* PU = ws + WS_PU; const bf16* X1 = (const bf16*)(ws + WS_X1B);
    LAS float* A2 = (LAS float*)(c.lds + 16384); LAS float* B2 = A2 + D;
    { const float* MODF_ = (const float*)(ws + WS_MODF) + (size_t)(c.vcu >> 7) * NMOD; const int j = 4 * c.tid;
      *(LAS f32x4*)(A2 + j) = *(const f32x4*)(g2vec + j) * (*(const f32x4*)(MODF_ + 4 * D + j) + 1.0f); *(LAS f32x4*)(B2 + j) = *(const f32x4*)(MODF_ + 3 * D + j); }
    __syncthreads();
    const float* SU = (const float*)(ws + WS_SU); const float* SV = (const float*)(ws + WS_SV);
    const int* IDX = (const int*)(ws + WS_IDX); const float* GATE = (const float*)(ws + WS_GATE);
    int* TQ = (int*)(ws + WS_TQ); float* CSC = (float*)(ws + WS_CSC);
    LAS unsigned char* wb = c.lds + 32768 + c.wave * 12288;
    LAS v4u* hqv = (LAS v4u*)wb; LAS unsigned* lst = (LAS unsigned*)(wb + 8192); LAS int* acc = (LAS int*)(wb + 10240);
    v2u hraw[4][8];
#pragma unroll
    for (int jj = 0; jj < 4; ++jj) { const int t = 64 * c.vcu + 8 * c.wave + jj;
#pragma unroll
        for (int j = 0; j < 8; ++j) hraw[jj][j] = __builtin_nontemporal_load((const v2u*)(X1 + (size_t)t * D + 256 * j + 4 * c.lane)); }
#pragma unroll 1
    for (int hf = 0; hf < 2; ++hf) {
        const int tb4 = 64 * c.vcu + 8 * c.wave + 4 * hf;
        int e0[4], e1[4]; float shs[4], hoffs[4];
#pragma unroll
        for (int jj = 0; jj < 4; ++jj) { e0[jj] = IDX[(size_t)(tb4 + jj) * 128 + c.lane]; e1[jj] = IDX[(size_t)(tb4 + jj) * 128 + 64 + c.lane]; }
        {
#pragma unroll
            for (int jj = 0; jj < 4; ++jj) {
                float hf32[32]; float am = 0.f, ssx = 0.f;
#pragma unroll
                for (int j = 0; j < 8; ++j) { hf32[4 * j] = bflo(hraw[jj][j].x); hf32[4 * j + 1] = bfhi(hraw[jj][j].x); hf32[4 * j + 2] = bflo(hraw[jj][j].y); hf32[4 * j + 3] = bfhi(hraw[jj][j].y); }
#pragma unroll
                for (int k = 0; k < 32; ++k) ssx += hf32[k] * hf32[k];
                const float rstd2 = 1.0f / sqrtf(wave_sum(ssx) * (1.0f / D) + NORM_EPS);
#pragma unroll
                for (int j = 0; j < 8; ++j) { const f32x4 av = *(const LAS f32x4*)(A2 + 256 * j + 4 * c.lane), bv = *(const LAS f32x4*)(B2 + 256 * j + 4 * c.lane);
#pragma unroll
                    for (int e = 0; e < 4; ++e) hf32[4 * j + e] = hf32[4 * j + e] * rstd2 * av[e] + bv[e]; }
#pragma unroll
                for (int k = 0; k < 32; ++k) am = fmaxf(am, fabsf(hf32[k]));
                am = wave_max(am);
                const float inv = (am > 0.f) ? 119.0f / am : 0.f;
                unsigned W[8]; unsigned hsu = 0u;
#pragma unroll
                for (int j = 0; j < 8; ++j) { W[j] = 0u;
#pragma unroll
                    for (int e = 0; e < 4; ++e) W[j] = __builtin_amdgcn_cvt_pk_u8_f32(__builtin_rintf(fmaf(hf32[4 * j + e], inv, 136.0f)), e, W[j]);
                    hsu = __builtin_amdgcn_sad_u8(W[j], 0u, hsu); }
                const int hs = (int)hsu - 136 * 32;
                unsigned wh[4], wl[4];
#pragma unroll
                for (int d = 0; d < 4; ++d) {
                    wh[d] = (((W[2 * d] >> 4) & 0x0f0f0f0fu) | (W[2 * d + 1] & 0xf0f0f0f0u)) ^ 0x88888888u;
                    wl[d] = ((W[2 * d] & 0x0f0f0f0fu) | ((W[2 * d + 1] << 4) & 0xf0f0f0f0u)) ^ 0x88888888u; }
                hqv[(jj * 2 + 0) * 64 + c.lane] = (v4u){wh[0], wh[1], wh[2], wh[3]}; hqv[(jj * 2 + 1) * 64 + c.lane] = (v4u){wl[0], wl[1], wl[2], wl[3]};
                shs[jj] = am * (1.0f / 119.0f); hoffs[jj] = 0.5f * (float)wave_sum_i(hs);
            }
        }
        acc[c.lane] = 0;
        LDS_WAIT();
        int pos[8];
#pragma unroll
        for (int jj = 0; jj < 4; ++jj) { pos[2 * jj] = __hip_atomic_fetch_add(acc + (e0[jj] >> 8), 1, __ATOMIC_RELAXED, __HIP_MEMORY_SCOPE_WORKGROUP);
                                         pos[2 * jj + 1] = __hip_atomic_fetch_add(acc + (e1[jj] >> 8), 1, __ATOMIC_RELAXED, __HIP_MEMORY_SCOPE_WORKGROUP); }
        LDS_WAIT();
        { int cnt = acc[c.lane], inc = cnt;
#pragma unroll
          for (int o = 1; o < 64; o <<= 1) { const int up = sh_idx(inc, c.lane - o); inc += (c.lane >= o) ? up : 0; }
          LDS_WAIT(); acc[64 + c.lane] = inc - cnt; }
        LDS_WAIT();
#pragma unroll
        for (int jj = 0; jj < 4; ++jj) {
            lst[acc[64 + (e0[jj] >> 8)] + pos[2 * jj]] = ((unsigned)e0[jj] << 10) | ((unsigned)jj << 7) | (unsigned)c.lane;
            lst[acc[64 + (e1[jj] >> 8)] + pos[2 * jj + 1]] = ((unsigned)e1[jj] << 10) | ((unsigned)jj << 7) | (unsigned)(64 + c.lane);
        }
        LDS_WAIT();
        { const int tbn = 64 * c.vcu + 8 * c.wave + 4;
#pragma unroll
          for (int jj = 0; jj < 4; ++jj) { const int t = tbn + jj;
#pragma unroll
              for (int j = 0; j < 8; ++j) hraw[jj][j] = __builtin_nontemporal_load((const v2u*)(X1 + (size_t)t * D + 256 * j + 4 * c.lane)); } }
        SCHED_FENCE();
        unsigned ent = lst[c.lane & 15];
        v4u r[16];
#pragma unroll
        for (int q = 0; q < 16; ++q) r[q] = ld_row4(PU, (int)(__builtin_amdgcn_readlane(ent, q) >> 10), c.lane);
        v4u hh, hl;
        { const int jj = (int)((__builtin_amdgcn_readlane(ent, 0) >> 7) & 3u); hh = hqv[(jj * 2 + 0) * 64 + c.lane]; hl = hqv[(jj * 2 + 1) * 64 + c.lane]; }
#pragma unroll 1
        for (int m = 0; m < 32; ++m) {
            const unsigned entn = lst[((16 * (m + 1)) & 511) + (c.lane & 15)];
#pragma unroll
            for (int hb = 0; hb < 2; ++hb) {
                int pa[8];
#pragma unroll
                for (int q = 0; q < 8; ++q) {
                    const int s16 = 8 * hb + q;
                    const int jn = (int)(((s16 < 15 ? __builtin_amdgcn_readlane(ent, (s16 + 1) & 15) : __builtin_amdgcn_readlane(entn, 0)) >> 7) & 3u);
                    const v4u hhn = hqv[(jn * 2 + 0) * 64 + c.lane], hln = hqv[(jn * 2 + 1) * 64 + c.lane];
                    const int h8[8] = {(int)hh.x, (int)hh.y, (int)hh.z, (int)hh.w, (int)hl.x, (int)hl.y, (int)hl.z, (int)hl.w};
                    pa[q] = idot_row4(h8, r[s16]);
                    SCHED_FENCE();
                    r[s16] = ld_row4(PU, (int)(__builtin_amdgcn_readlane(entn, s16) >> 10), c.lane);
                    SCHED_FENCE();
                    hh = hhn; hl = hln;
                }
                const int v = reduce8(pa, c.lane);
                if ((c.lane >> 3) == hb) acc[((ent >> 7) & 3u) * 128 + (ent & 127u)] = v;
            }
            ent = entn;
        }
        LDS_WAIT();
        float gg0[4], gg1[4], su0[4], su1[4], sv0[4], sv1[4];
#pragma unroll
        for (int jj = 0; jj < 4; ++jj) { const int t = tb4 + jj;
            gg0[jj] = GATE[(size_t)t * 128 + c.lane]; gg1[jj] = GATE[(size_t)t * 128 + 64 + c.lane];
            su0[jj] = SU[e0[jj]]; su1[jj] = SU[e1[jj]]; sv0[jj] = SV[e0[jj]]; sv1[jj] = SV[e1[jj]]; }
#pragma unroll
        for (int jj = 0; jj < 4; ++jj) { const int t = tb4 + jj;
            const int ia0 = acc[jj * 128 + c.lane], ia1 = acc[jj * 128 + 64 + c.lane];
            const float a0 = ((float)ia0 + hoffs[jj]) * su0[jj] * shs[jj], a1 = ((float)ia1 + hoffs[jj]) * su1[jj] * shs[jj];
            const float c0 = 0.5f * a0 * (1.0f + erff(a0 * 0.70710678118654752f)) * gg0[jj] * sv0[jj];
            const float c1 = 0.5f * a1 * (1.0f + erff(a1 * 0.70710678118654752f)) * gg1[jj] * sv1[jj];
            const float cmx = wave_max(fmaxf(fabsf(c0), fabsf(c1)));
            const float cinv = (cmx > 0.f) ? 127.0f / cmx : 0.f, csc = cmx * (1.0f / 127.0f);
            const int q0 = __float2int_rn(c0 * cinv), q1 = __float2int_rn(c1 * cinv);
            const int cqs = wave_sum_i(q0 + q1);
            const unsigned b0 = (unsigned)q0 & 0xffu, b1 = (unsigned)q1 & 0xffu;
            const int t0 = (int)(b0 | (sh_idx(b0, c.lane + 1) << 8) | (sh_idx(b0, c.lane + 2) << 16) | (sh_idx(b0, c.lane + 3) << 24));
            const int t1 = (int)(b1 | (sh_idx(b1, c.lane + 1) << 8) | (sh_idx(b1, c.lane + 2) << 16) | (sh_idx(b1, c.lane + 3) << 24));
            TQ[(size_t)t * 128 + c.lane] = t0; TQ[(size_t)t * 128 + 64 + c.lane] = t1;
            if (c.lane == 0) { CSC[(size_t)t * 2] = csc; CSC[(size_t)t * 2 + 1] = (float)cqs; }
        }
        LDS_WAIT();
    }
}
typedef int v8i __attribute__((ext_vector_type(8)));
typedef float f32x2 __attribute__((ext_vector_type(2)));
__device__ __forceinline__ void phase_peer4_u_mfma(const Ctx& c, const float* g2vec, unsigned char* ws) {
    const unsigned char* PU = ws + WS_PU; const bf16* X1 = (const bf16*)(ws + WS_X1B);
    LAS float* A2 = (LAS float*)(c.lds + 16384); LAS float* B2 = A2 + D;
    { const float* MODF_ = (const float*)(ws + WS_MODF) + (size_t)(c.vcu >> 7) * NMOD; const int j = 4 * c.tid;
      *(LAS f32x4*)(A2 + j) = *(const f32x4*)(g2vec + j) * (*(const f32x4*)(MODF_ + 4 * D + j) + 1.0f); *(LAS f32x4*)(B2 + j) = *(const f32x4*)(MODF_ + 3 * D + j); }
    __syncthreads();
    const float* SU = (const float*)(ws + WS_SU); const float* SV = (const float*)(ws + WS_SV);
    const int* IDX = (const int*)(ws + WS_IDX); const float* GATE = (const float*)(ws + WS_GATE);
    int* TQ = (int*)(ws + WS_TQ); float* CSC = (float*)(ws + WS_CSC);
    LAS unsigned char* wb = c.lds + 32768 + c.wave * 12288;
    LAS unsigned char* hq = wb; LAS unsigned* lst = (LAS unsigned*)(wb + 8192); LAS int* acc = (LAS int*)(wb + 10240); LAS float* accf = (LAS float*)(wb + 10240);
    const int kg = c.lane >> 4, ncol = c.lane & 15, rho = ncol >> 2, kap = ncol & 3;
#pragma unroll 1
    for (int hf = 0; hf < 2; ++hf) {
        const int tb4 = 64 * c.vcu + 8 * c.wave + 4 * hf;
        int e0[4], e1[4]; float shs[4];
#pragma unroll
        for (int jj = 0; jj < 4; ++jj) { e0[jj] = IDX[(size_t)(tb4 + jj) * 128 + c.lane]; e1[jj] = IDX[(size_t)(tb4 + jj) * 128 + 64 + c.lane]; }
        {
            v2u hraw[4][8];
#pragma unroll
            for (int jj = 0; jj < 4; ++jj) {
#pragma unroll
                for (int j = 0; j < 8; ++j) hraw[jj][j] = __builtin_nontemporal_load((const v2u*)(X1 + (size_t)(tb4 + jj) * D + 256 * j + 4 * c.lane)); }
#pragma unroll
            for (int jj = 0; jj < 4; ++jj) {
                float hf32[32]; float am = 0.f, ssx = 0.f;
#pragma unroll
                for (int j = 0; j < 8; ++j) { hf32[4 * j] = bflo(hraw[jj][j].x); hf32[4 * j + 1] = bfhi(hraw[jj][j].x); hf32[4 * j + 2] = bflo(hraw[jj][j].y); hf32[4 * j + 3] = bfhi(hraw[jj][j].y); }
#pragma unroll
                for (int k = 0; k < 32; ++k) ssx += hf32[k] * hf32[k];
                const float rstd2 = 1.0f / sqrtf(wave_sum(ssx) * (1.0f / D) + NORM_EPS);
#pragma unroll
                for (int j = 0; j < 8; ++j) { const f32x4 av = *(const LAS f32x4*)(A2 + 256 * j + 4 * c.lane), bv = *(const LAS f32x4*)(B2 + 256 * j + 4 * c.lane);
#pragma unroll
                    for (int e = 0; e < 4; ++e) hf32[4 * j + e] = hf32[4 * j + e] * rstd2 * av[e] + bv[e]; }
#pragma unroll
                for (int k = 0; k < 32; ++k) am = fmaxf(am, fabsf(hf32[k]));
                am = wave_max(am);
                const float inv = (am > 0.f) ? 224.0f / am : 0.f;
                unsigned W[8];
#pragma unroll
                for (int w = 0; w < 8; ++w) { const int j0 = 2 * (w >> 1), e0_ = 2 * (w & 1);
                    int pk = __builtin_amdgcn_cvt_pk_fp8_f32(hf32[4 * j0 + e0_] * inv, hf32[4 * (j0 + 1) + e0_] * inv, 0, false);
                    pk = __builtin_amdgcn_cvt_pk_fp8_f32(hf32[4 * j0 + e0_ + 1] * inv, hf32[4 * (j0 + 1) + e0_ + 1] * inv, pk, true);
                    W[w] = (unsigned)pk; }
                { LAS unsigned char* hp = hq + jj * 2048 + c.lane * 32;
                  *(LAS v4u*)hp = (v4u){W[0], W[1], W[2], W[3]}; *(LAS v4u*)(hp + 16) = (v4u){W[4], W[5], W[6], W[7]}; }
                shs[jj] = am * (1.0f / 224.0f);
            }
        }
        acc[c.lane] = 0;
        LDS_WAIT();
        int pos[8];
#pragma unroll
        for (int jj = 0; jj < 4; ++jj) { pos[2 * jj] = __hip_atomic_fetch_add(acc + (e0[jj] >> 8), 1, __ATOMIC_RELAXED, __HIP_MEMORY_SCOPE_WORKGROUP);
                                         pos[2 * jj + 1] = __hip_atomic_fetch_add(acc + (e1[jj] >> 8), 1, __ATOMIC_RELAXED, __HIP_MEMORY_SCOPE_WORKGROUP); }
        LDS_WAIT();
        { int cnt = acc[c.lane], inc = cnt;
#pragma unroll
          for (int o = 1; o < 64; o <<= 1) { const int up = sh_idx(inc, c.lane - o); inc += (c.lane >= o) ? up : 0; }
          LDS_WAIT(); acc[64 + c.lane] = inc - cnt; }
        LDS_WAIT();
#pragma unroll
        for (int jj = 0; jj < 4; ++jj) {
            lst[acc[64 + (e0[jj] >> 8)] + pos[2 * jj]] = ((unsigned)e0[jj] << 10) | ((unsigned)jj << 7) | (unsigned)c.lane;
            lst[acc[64 + (e1[jj] >> 8)] + pos[2 * jj + 1]] = ((unsigned)e1[jj] << 10) | ((unsigned)jj << 7) | (unsigned)(64 + c.lane);
        }
        LDS_WAIT();
        v8i Bp[4];
#pragma unroll
        for (int s4 = 0; s4 < 4; ++s4) { const LAS unsigned char* bp = hq + rho * 2048 + (16 * s4 + 4 * (kg >> 1) + kap) * 32 + (kg & 1) * 16;
            const v4u lo = *(const LAS v4u*)bp, hi = *(const LAS v4u*)(bp + 8 * 32);
            Bp[s4] = (v8i){(int)lo.x, (int)lo.y, (int)lo.z, (int)lo.w, (int)hi.x, (int)hi.y, (int)hi.z, (int)hi.w}; }
        const unsigned lane_off = 64u * (unsigned)kg + 16u * (unsigned)kap;
        v4u r[16];
#pragma unroll
        for (int G = 0; G < 4; ++G) { const unsigned vo = (lst[4 * G + rho] & ~1023u) + lane_off;
#pragma unroll
            for (int s4 = 0; s4 < 4; ++s4) r[4 * G + s4] = *(const v4u*)(PU + vo + 256 * s4); }
#pragma unroll 1
        for (int m = 0; m < 32; ++m) {
#pragma unroll
            for (int G = 0; G < 4; ++G) {
                const unsigned von = (lst[((16 * (m + 1)) & 511) + 4 * G + rho] & ~1023u) + lane_off;
                const unsigned erow = lst[16 * m + 4 * G + kg];
                f32x4 cacc = {0.f, 0.f, 0.f, 0.f};
#pragma unroll
                for (int s4 = 0; s4 < 4; ++s4) {
                    v8i av; av[0] = (int)r[4 * G + s4].x; av[1] = (int)r[4 * G + s4].y; av[2] = (int)r[4 * G + s4].z; av[3] = (int)r[4 * G + s4].w; av[4] = 0; av[5] = 0; av[6] = 0; av[7] = 0;
                    cacc = __builtin_amdgcn_mfma_scale_f32_16x16x128_f8f6f4(av, Bp[s4], cacc, 4, 0, 0, 0x7f7f7f7f, 0, 0x7f7f7f7f);
                }
                SCHED_FENCE();
#pragma unroll
                for (int s4 = 0; s4 < 4; ++s4) r[4 * G + s4] = *(const v4u*)(PU + von + 256 * s4);
                SCHED_FENCE();
                float v = (kap == 0) ? cacc[0] : (kap == 1) ? cacc[1] : (kap == 2) ? cacc[2] : cacc[3];
                v += SXOR(v, 1, c.lane); v += SXOR(v, 2, c.lane);
                const unsigned tk = (erow >> 7) & 3u;
                if (kap == 0 && (unsigned)rho == tk) accf[tk * 128 + (erow & 127u)] = v;
            }
        }
        LDS_WAIT();
        float gg0[4], gg1[4], su0[4], su1[4], sv0[4], sv1[4];
#pragma unroll
        for (int jj = 0; jj < 4; ++jj) { const int t = tb4 + jj;
            gg0[jj] = GATE[(size_t)t * 128 + c.lane]; gg1[jj] = GATE[(size_t)t * 128 + 64 + c.lane];
            su0[jj] = SU[e0[jj]]; su1[jj] = SU[e1[jj]]; sv0[jj] = SV[e0[jj]]; sv1[jj] = SV[e1[jj]]; }
#pragma unroll
        for (int jj = 0; jj < 4; ++jj) { const int t = tb4 + jj;
            const float a0 = accf[jj * 128 + c.lane] * su0[jj] * shs[jj], a1 = accf[jj * 128 + 64 + c.lane] * su1[jj] * shs[jj];
            const float c0 = 0.5f * a0 * (1.0f + erff(a0 * 0.70710678118654752f)) * gg0[jj] * sv0[jj];
            const float c1 = 0.5f * a1 * (1.0f + erff(a1 * 0.70710678118654752f)) * gg1[jj] * sv1[jj];
            const float cmx = wave_max(fmaxf(fabsf(c0), fabsf(c1)));
#if V_MFMA
            const float cinv = (cmx > 0.f) ? 224.0f / cmx : 0.f;
            ((float*)TQ)[(size_t)t * 128 + c.lane] = c0 * cinv; ((float*)TQ)[(size_t)t * 128 + 64 + c.lane] = c1 * cinv;
            if (c.lane == 0) { CSC[(size_t)t * 2] = cmx * (1.0f / 224.0f); CSC[(size_t)t * 2 + 1] = 0.f; }
#else
            const float cinv = (cmx > 0.f) ? 127.0f / cmx : 0.f, csc = cmx * (1.0f / 127.0f);
            const int q0 = __float2int_rn(c0 * cinv), q1 = __float2int_rn(c1 * cinv);
            const int cqs = wave_sum_i(q0 + q1);
            const unsigned b0_ = (unsigned)q0 & 0xffu, b1_ = (unsigned)q1 & 0xffu;
            const int t0 = (int)(b0_ | (sh_idx(b0_, c.lane + 1) << 8) | (sh_idx(b0_, c.lane + 2) << 16) | (sh_idx(b0_, c.lane + 3) << 24));
            const int t1 = (int)(b1_ | (sh_idx(b1_, c.lane + 1) << 8) | (sh_idx(b1_, c.lane + 2) << 16) | (sh_idx(b1_, c.lane + 3) << 24));
            TQ[(size_t)t * 128 + c.lane] = t0; TQ[(size_t)t * 128 + 64 + c.lane] = t1;
            if (c.lane == 0) { CSC[(size_t)t * 2] = csc; CSC[(size_t)t * 2 + 1] = (float)cqs; }
#endif
        }
        LDS_WAIT();
    }
}
__device__ __forceinline__ void phase_peer4_v_mfma(const Ctx& c, const float* final_g, float* out, unsigned char* ws) {
    const bf16* X1 = (const bf16*)(ws + WS_X1B);
    const unsigned char* PV = ws + WS_PV;
    const int* IDX = (const int*)(ws + WS_IDX); const float* CF = (const float*)(ws + WS_TQ); const float* CSC = (const float*)(ws + WS_CSC); const float* MODF = (const float*)(ws + WS_MODF);
    LAS float* G2 = (LAS float*)c.lds; LAS float* FG = G2 + D;
    const int b = c.vcu >> 7;
    { const int j = 4 * c.tid; *(LAS f32x4*)(G2 + j) = *(const f32x4*)(MODF + (size_t)b * NMOD + 5 * D + j); *(LAS f32x4*)(FG + j) = *(const f32x4*)(final_g + j); }
    __syncthreads();
    const int n = c.lane & 15, g = c.lane >> 4;
    const int tbase = 64 * c.vcu + 8 * c.wave;
    const unsigned nb8 = 8u * (unsigned)n;
    const int F0 = 256 * (4 * (n & 1) + 2 * (g >> 1)) + 4 * (n >> 1) + 2 * (g & 1);
    int e0n = IDX[(size_t)tbase * 128 + c.lane], e1n = IDX[(size_t)tbase * 128 + 64 + c.lane];
    float cf0n = CF[(size_t)tbase * 128 + c.lane], cf1n = CF[(size_t)tbase * 128 + 64 + c.lane];
    v2u br[2][8][2];
#pragma unroll
    for (int bf = 0; bf < 2; ++bf) {
        const unsigned o0 = ((unsigned)sh_idx(e0n, 8 * bf + 2 * g) << 10) + nb8, o1 = ((unsigned)sh_idx(e0n, 8 * bf + 2 * g + 1) << 10) + nb8;
#pragma unroll
        for (int s8 = 0; s8 < 8; ++s8) { br[bf][s8][0] = *(const v2u*)(PV + o0 + 128 * s8); br[bf][s8][1] = *(const v2u*)(PV + o1 + 128 * s8); }
    }
#pragma unroll 1
    for (int i = 0; i < 8; ++i) {
        const int t = tbase + i, tn = tbase + ((i + 1) & 7);
        const int e0 = e0n, e1 = e1n; const float cf0 = cf0n, cf1 = cf1n;
        const float csc = CSC[(size_t)t * 2];
        e0n = IDX[(size_t)tn * 128 + c.lane]; e1n = IDX[(size_t)tn * 128 + 64 + c.lane];
        cf0n = CF[(size_t)tn * 128 + c.lane]; cf1n = CF[(size_t)tn * 128 + 64 + c.lane];
        f32x4 C[8];
#pragma unroll
        for (int s8 = 0; s8 < 8; ++s8) C[s8] = (f32x4){0.f, 0.f, 0.f, 0.f};
#pragma unroll 1
        for (int gp = 0; gp < 8; ++gp) {
#pragma unroll
            for (int bf = 0; bf < 2; ++bf) {
                const int grp = 2 * gp + bf;
                const float cfs = (gp < 4) ? cf0 : cf1;
                const float ca = sh_idx(cfs, (8 * grp + g) & 63), cb = sh_idx(cfs, (8 * grp + 4 + g) & 63);
                const unsigned pk = (unsigned)__builtin_amdgcn_cvt_pk_fp8_f32(ca, cb, 0, false);
                const unsigned wlo = (pk & 0xffu) << (8 * (n & 3)), whi = ((pk >> 8) & 0xffu) << (8 * (n & 3));
                const int q = n >> 2;
                const v8i av = {(int)(q == 0 ? wlo : 0u), (int)(q == 1 ? wlo : 0u), (int)(q == 2 ? wlo : 0u), (int)(q == 3 ? wlo : 0u),
                                (int)(q == 0 ? whi : 0u), (int)(q == 1 ? whi : 0u), (int)(q == 2 ? whi : 0u), (int)(q == 3 ? whi : 0u)};
#pragma unroll
                for (int s8 = 0; s8 < 8; ++s8) {
                    v8i bv; bv[0] = (int)br[bf][s8][0].x; bv[1] = (int)br[bf][s8][0].y; bv[2] = (int)br[bf][s8][1].x; bv[3] = (int)br[bf][s8][1].y; bv[4] = 0; bv[5] = 0; bv[6] = 0; bv[7] = 0;
                    C[s8] = __builtin_amdgcn_mfma_scale_f32_16x16x128_f8f6f4(av, bv, C[s8], 0, 4, 0, 0x7f7f7f7f, 0, 0x7f7f7f7f);
                }
                SCHED_FENCE();
                {
                    const int gn = grp + 2;
                    const int es = (gn < 8) ? e0 : ((gn < 16) ? e1 : e0n);
                    const unsigned o0 = ((unsigned)sh_idx(es, (8 * gn + 2 * g) & 63) << 10) + nb8, o1 = ((unsigned)sh_idx(es, (8 * gn + 2 * g + 1) & 63) << 10) + nb8;
#pragma unroll
                    for (int s8 = 0; s8 < 8; ++s8) { br[bf][s8][0] = *(const v2u*)(PV + o0 + 128 * s8); br[bf][s8][1] = *(const v2u*)(PV + o1 + 128 * s8); }
                }
                SCHED_FENCE();
            }
        }
        const bf16* xr = X1 + (size_t)t * D + F0; float* orow = out + (size_t)t * D + F0;
        float ss = 0.f;
#pragma unroll
        for (int s8 = 0; s8 < 8; ++s8) {
            const unsigned xa = __builtin_nontemporal_load((const unsigned*)(xr + 32 * s8)), xb = __builtin_nontemporal_load((const unsigned*)(xr + 256 + 32 * s8));
            const f32x2 ga = *(const LAS f32x2*)(G2 + F0 + 32 * s8), gb = *(const LAS f32x2*)(G2 + F0 + 256 + 32 * s8);
            const float v0 = bflo(xa) + ga[0] * (csc * C[s8][0]), v2 = bfhi(xa) + ga[1] * (csc * C[s8][2]);
            const float v1 = bflo(xb) + gb[0] * (csc * C[s8][1]), v3 = bfhi(xb) + gb[1] * (csc * C[s8][3]);
            C[s8] = (f32x4){v0, v1, v2, v3}; ss += (v0 * v0 + v1 * v1) + (v2 * v2 + v3 * v3);
        }
        const float rstd = 1.0f / sqrtf(wave_sum(ss) * (1.0f / D) + NORM_EPS);
#pragma unroll
        for (int s8 = 0; s8 < 8; ++s8) {
            const f32x2 fa = *(const LAS f32x2*)(FG + F0 + 32 * s8), fb = *(const LAS f32x2*)(FG + F0 + 256 + 32 * s8);
            const f32x2 oa = {C[s8][0] * rstd * fa[0], C[s8][2] * rstd * fa[1]}, ob = {C[s8][1] * rstd * fb[0], C[s8][3] * rstd * fb[1]};
            __builtin_nontemporal_store(oa, (f32x2*)(orow + 32 * s8)); __builtin_nontemporal_store(ob, (f32x2*)(orow + 256 + 32 * s8));
        }
    }
}
__device__ __forceinline__ void phase_peer4_v_sorted(const Ctx& c, const float* final_g, float* out, unsigned char* ws) {
    const bf16* X1 = (const bf16*)(ws + WS_X1B);
    const unsigned char* PV = ws + WS_PV;
    const int* IDX = (const int*)(ws + WS_IDX); const float* CF = (const float*)(ws + WS_TQ); const float* CSC = (const float*)(ws + WS_CSC); const float* MODF = (const float*)(ws + WS_MODF);
    LAS float* G2 = (LAS float*)c.lds; LAS float* FG = G2 + D;
    const int b = c.vcu >> 7;
    { const int j = 4 * c.tid; *(LAS f32x4*)(G2 + j) = *(const f32x4*)(MODF + (size_t)b * NMOD + 5 * D + j); *(LAS f32x4*)(FG + j) = *(const f32x4*)(final_g + j); }
    __syncthreads();
    LAS unsigned char* wb = c.lds + 32768 + c.wave * 12288;
    LAS v2u* lst2 = (LAS v2u*)wb; LAS int* hist = (LAS int*)(wb + 4096);
    const int n = c.lane & 15, g = c.lane >> 4;
    const unsigned nb16 = 16u * (unsigned)n;
    const int F0 = 512 * (g >> 1) + 4 * n + 2 * (g & 1);
    const int q4 = n >> 2, sh8 = 8 * (n & 3);
#pragma unroll 1
    for (int hf = 0; hf < 2; ++hf) {
        const int tb4 = 64 * c.vcu + 8 * c.wave + 4 * hf;
        {
            int e0[4], e1[4]; float w0[4], w1[4];
#pragma unroll
            for (int jj = 0; jj < 4; ++jj) { const size_t o = (size_t)(tb4 + jj) * 128 + c.lane; e0[jj] = IDX[o]; e1[jj] = IDX[o + 64]; w0[jj] = CF[o]; w1[jj] = CF[o + 64]; }
            hist[c.lane] = 0;
            LDS_WAIT();
            int pos[8];
#pragma unroll
            for (int jj = 0; jj < 4; ++jj) { pos[2 * jj] = __hip_atomic_fetch_add(hist + ((e0[jj] >> 10) * 4 + jj), 1, __ATOMIC_RELAXED, __HIP_MEMORY_SCOPE_WORKGROUP);
                                             pos[2 * jj + 1] = __hip_atomic_fetch_add(hist + ((e1[jj] >> 10) * 4 + jj), 1, __ATOMIC_RELAXED, __HIP_MEMORY_SCOPE_WORKGROUP); }
            LDS_WAIT();
            { int cnt = hist[c.lane], inc = cnt;
#pragma unroll
              for (int o = 1; o < 64; o <<= 1) { const int up = sh_idx(inc, c.lane - o); inc += (c.lane >= o) ? up : 0; }
              LDS_WAIT(); hist[64 + c.lane] = inc - cnt; }
            LDS_WAIT();
#pragma unroll
            for (int jj = 0; jj < 4; ++jj) {
                lst2[hist[64 + (e0[jj] >> 10) * 4 + jj] + pos[2 * jj]] = (v2u){((unsigned)e0[jj] << 2) | (unsigned)jj, __float_as_uint(w0[jj])};
                lst2[hist[64 + (e1[jj] >> 10) * 4 + jj] + pos[2 * jj + 1]] = (v2u){((unsigned)e1[jj] << 2) | (unsigned)jj, __float_as_uint(w1[jj])};
            }
            LDS_WAIT();
        }
        f32x4 C[4][8];
#pragma unroll
        for (int jj = 0; jj < 4; ++jj)
#pragma unroll
            for (int s8 = 0; s8 < 8; ++s8) C[jj][s8] = (f32x4){0.f, 0.f, 0.f, 0.f};
        v4u br[2][4][2];
#pragma unroll
        for (int bf = 0; bf < 2; ++bf) {
            const v4u qe = *(const LAS v4u*)(lst2 + 8 * bf + 2 * g);
            const unsigned o0 = ((qe.x >> 2) << 10) + nb16, o1 = ((qe.z >> 2) << 10) + nb16;
#pragma unroll
            for (int s4 = 0; s4 < 4; ++s4) { br[bf][s4][0] = *(const v4u*)(PV + o0 + 256 * s4); br[bf][s4][1] = *(const v4u*)(PV + o1 + 256 * s4); }
        }
#pragma unroll 1
        for (int gp = 0; gp < 32; ++gp) {
#pragma unroll
            for (int bf = 0; bf < 2; ++bf) {
                const int G = 2 * gp + bf;
                const v2u ea = lst2[8 * G + g], eb = lst2[8 * G + 4 + g];
                const unsigned tokA = ea.x & 3u, tokB = eb.x & 3u; const float cA = __uint_as_float(ea.y), cB = __uint_as_float(eb.y);
                const v4u qn = *(const LAS v4u*)(lst2 + ((8 * (G + 2)) & 511) + 2 * g);
#pragma unroll
                for (int jj = 0; jj < 4; ++jj) {
                    const bool hasA = (tokA == (unsigned)jj), hasB = (tokB == (unsigned)jj);
                    if (__builtin_amdgcn_ballot_w64(hasA || hasB) != 0ull) {
                        const unsigned pk = (unsigned)__builtin_amdgcn_cvt_pk_fp8_f32(hasA ? cA : 0.f, hasB ? cB : 0.f, 0, false);
                        const unsigned wlo = (pk & 0xffu) << sh8, whi = ((pk >> 8) & 0xffu) << sh8;
                        const v8i av = {(int)(q4 == 0 ? wlo : 0u), (int)(q4 == 1 ? wlo : 0u), (int)(q4 == 2 ? wlo : 0u), (int)(q4 == 3 ? wlo : 0u),
                                        (int)(q4 == 0 ? whi : 0u), (int)(q4 == 1 ? whi : 0u), (int)(q4 == 2 ? whi : 0u), (int)(q4 == 3 ? whi : 0u)};
#pragma unroll
                        for (int s8 = 0; s8 < 8; ++s8) {
                            const v4u r0 = br[bf][s8 >> 1][0], r1 = br[bf][s8 >> 1][1];
                            v8i bv; bv[0] = (int)((s8 & 1) ? r0.z : r0.x); bv[1] = (int)((s8 & 1) ? r0.w : r0.y); bv[2] = (int)((s8 & 1) ? r1.z : r1.x); bv[3] = (int)((s8 & 1) ? r1.w : r1.y); bv[4] = 0; bv[5] = 0; bv[6] = 0; bv[7] = 0;
                            C[jj][s8] = __builtin_amdgcn_mfma_scale_f32_16x16x128_f8f6f4(av, bv, C[jj][s8], 0, 4, 0, 0x7f7f7f7f, 0, 0x7f7f7f7f);
                        }
                    }
                }
                SCHED_FENCE();
                { const unsigned o0 = ((qn.x >> 2) << 10) + nb16, o1 = ((qn.z >> 2) << 10) + nb16;
#pragma unroll
                  for (int s4 = 0; s4 < 4; ++s4) { br[bf][s4][0] = *(const v4u*)(PV + o0 + 256 * s4); br[bf][s4][1] = *(const v4u*)(PV + o1 + 256 * s4); } }
                SCHED_FENCE();
            }
        }
#pragma unroll
        for (int jj = 0; jj < 4; ++jj) {
            const int t = tb4 + jj;
            const float csc = CSC[(size_t)t * 2];
            const bf16* xr = X1 + (size_t)t * D + F0; float* orow = out + (size_t)t * D + F0;
            float ss = 0.f;
#pragma unroll
            for (int s8 = 0; s8 < 8; ++s8) {
                const unsigned xa = __builtin_nontemporal_load((const unsigned*)(xr + (1024 * (s8 & 1) + 64 * (s8 >> 1)))), xb = __builtin_nontemporal_load((const unsigned*)(xr + 256 + (1024 * (s8 & 1) + 64 * (s8 >> 1))));
                const f32x2 ga = *(const LAS f32x2*)(G2 + F0 + (1024 * (s8 & 1) + 64 * (s8 >> 1))), gb = *(const LAS f32x2*)(G2 + F0 + 256 + (1024 * (s8 & 1) + 64 * (s8 >> 1)));
                const float v0 = bflo(xa) + ga[0] * (csc * C[jj][s8][0]), v2 = bfhi(xa) + ga[1] * (csc * C[jj][s8][2]);
                const float v1 = bflo(xb) + gb[0] * (csc * C[jj][s8][1]), v3 = bfhi(xb) + gb[1] * (csc * C[jj][s8][3]);
                C[jj][s8] = (f32x4){v0, v1, v2, v3}; ss += (v0 * v0 + v1 * v1) + (v2 * v2 + v3 * v3);
            }
            const float rstd = 1.0f / sqrtf(wave_sum(ss) * (1.0f / D) + NORM_EPS);
#pragma unroll
            for (int s8 = 0; s8 < 8; ++s8) {
                const f32x2 fa = *(const LAS f32x2*)(FG + F0 + (1024 * (s8 & 1) + 64 * (s8 >> 1))), fb = *(const LAS f32x2*)(FG + F0 + 256 + (1024 * (s8 & 1) + 64 * (s8 >> 1)));
                const f32x2 oa = {C[jj][s8][0] * rstd * fa[0], C[jj][s8][2] * rstd * fa[1]}, ob = {C[jj][s8][1] * rstd * fb[0], C[jj][s8][3] * rstd * fb[1]};
                __builtin_nontemporal_store(oa, (f32x2*)(orow + (1024 * (s8 & 1) + 64 * (s8 >> 1)))); __builtin_nontemporal_store(ob, (f32x2*)(orow + 256 + (1024 * (s8 & 1) + 64 * (s8 >> 1))));
            }
        }
        LDS_WAIT();
    }
}
__device__ __forceinline__ void phase_peer4_v(const Ctx& c, const float* final_g, float* out, unsigned char* ws) {
    const bf16* X1 = (const bf16*)(ws + WS_X1B);
    const unsigned char* PV = ws + WS_PV;
    const int* IDX = (const int*)(ws + WS_IDX); const int* TQ = (const int*)(ws + WS_TQ); const float* CSC = (const float*)(ws + WS_CSC); const float* MODF = (const float*)(ws + WS_MODF);
    LAS float* G2 = (LAS float*)c.lds; LAS float* FG = G2 + D;
    const int b = c.vcu >> 7;
    { const int j = 4 * c.tid; *(LAS f32x4*)(G2 + j) = *(const f32x4*)(MODF + (size_t)b * NMOD + 5 * D + j); *(LAS f32x4*)(FG + j) = *(const f32x4*)(final_g + j); }
    __syncthreads();
    const int tbase = 64 * c.vcu + 8 * c.wave;
    int e0n = IDX[(size_t)tbase * 128 + c.lane], e1n = IDX[(size_t)tbase * 128 + 64 + c.lane];
    int t0n = TQ[(size_t)tbase * 128 + c.lane], t1n = TQ[(size_t)tbase * 128 + 64 + c.lane];
    v4u r[16];
#pragma unroll
    for (int q = 0; q < 16; ++q) r[q] = ld_row4(PV, __builtin_amdgcn_readlane(e0n, q), c.lane);
#pragma unroll 1
    for (int i = (DUP & 2048) ? -8 : 0; i < 8; ++i) {
        const int t = tbase + (i & 7), tn = tbase + ((i + 1) & 7);
        const int e0 = e0n, e1 = e1n, t0 = t0n, t1 = t1n;
        const float csc = CSC[(size_t)t * 2], cqsf = CSC[(size_t)t * 2 + 1];
        e0n = IDX[(size_t)tn * 128 + c.lane]; e1n = IDX[(size_t)tn * 128 + 64 + c.lane];
        t0n = TQ[(size_t)tn * 128 + c.lane]; t1n = TQ[(size_t)tn * 128 + 64 + c.lane];
        int y[32];
#pragma unroll
        for (int q = 0; q < 32; ++q) y[q] = 0;
#pragma unroll 1
        for (int m = 0; m < 8; ++m) {
            const int esrc = (m + 1 < 4) ? e0 : ((m + 1 < 8) ? e1 : e0n);
            const int tsrc = (m < 4) ? t0 : t1;
#pragma unroll
            for (int gq = 0; gq < 4; ++gq) {
                const int cq4 = __builtin_amdgcn_readlane(tsrc, (16 * m + 4 * gq) & 63);
                vacc4(y, r[4 * gq], r[4 * gq + 1], r[4 * gq + 2], r[4 * gq + 3], cq4);
                SCHED_FENCE();
#pragma unroll
                for (int q = 0; q < 4; ++q) r[4 * gq + q] = ld_row4(PV, __builtin_amdgcn_readlane(esrc, (16 * (m + 1) + 4 * gq + q) & 63), c.lane);
                SCHED_FENCE();
            }
        }
        const bf16* xr = X1 + (size_t)t * D + 4 * c.lane; float* orow = ((DUP & 2048) && i < 0 ? (float*)(ws + WS_HC) : out) + (size_t)t * D + 4 * c.lane;
        float yf[32]; float ss = 0.f;
#pragma unroll
        for (int j = 0; j < 8; ++j) {
            const v2u xw = __builtin_nontemporal_load((const v2u*)(xr + 256 * j)); const f32x4 xa = {bflo(xw.x), bfhi(xw.x), bflo(xw.y), bfhi(xw.y)};
            const f32x4 ga = *(const LAS f32x4*)(G2 + 256 * j + 4 * c.lane);
#pragma unroll
            for (int e = 0; e < 4; ++e) {
                const int d = j >> 1;
                const float yv = (j & 1) ? (float)((y[8 * d + 4 + e] - y[8 * d + e]) >> 4) + 0.5f * cqsf : (float)y[8 * d + e] - 7.5f * cqsf;
                const float v = xa[e] + ga[e] * (csc * yv); yf[4 * j + e] = v; ss += v * v; }
        }
        const float rstd = 1.0f / sqrtf(wave_sum(ss) * (1.0f / D) + NORM_EPS);
#pragma unroll
        for (int j = 0; j < 8; ++j) {
            const f32x4 fa = *(const LAS f32x4*)(FG + 256 * j + 4 * c.lane);
            f32x4 o;
#pragma unroll
            for (int e = 0; e < 4; ++e) o[e] = yf[4 * j + e] * rstd * fa[e];
            __builtin_nontemporal_store(o, (f32x4*)(orow + 256 * j));
        }
    }
}

struct Args { const float* in[16]; float* out; unsigned char* ws; };
__device__ __forceinline__ int lane_id() { unsigned ones = ~0u; asm volatile("" : "+s"(ones)); return (int)__builtin_amdgcn_mbcnt_hi(ones, __builtin_amdgcn_mbcnt_lo(ones, 0u)); }
__global__ void __launch_bounds__(NTHREADS, 2) fwd_kernel(Args args_unused) {
    extern __shared__ __attribute__((aligned(16))) unsigned char lds_raw[];
    const int wave_s = __builtin_amdgcn_readfirstlane((int)(threadIdx.x >> 6));
#define CAS __attribute__((address_space(4)))
#define KARGS() const CAS unsigned char* ka_ = (const CAS unsigned char*)__builtin_amdgcn_kernarg_segment_ptr(); asm volatile("" : "+s"(ka_));
#define ARG_IN(i) (*(const float* const CAS*)(ka_ + 8 * (i)))
#define ARG_OUT() (*(float* const CAS*)(ka_ + 128))
#define ARG_WS() (*(unsigned char* const CAS*)(ka_ + 136))
#define MKCTX() KARGS(); unsigned char* ws = ARG_WS(); Ctx c; { c.lds = (LAS unsigned char*)lds_raw; int l_ = lane_id(); asm volatile("" : "+v"(l_)); c.lane = l_; c.wave = wave_s; c.tid = wave_s * 64 + l_; \
    c.G = 256; { const int bx = blockIdx.x; c.vcu = (bx % 8) * 32 + bx / 8; } c.gw = c.vcu * NWAVES + c.wave; c.ngw = 256 * NWAVES; }
#define IS_T0() (wave_s == 0 && lane_id() == 0)
#define GRID_BAR() xcd_barrier(bar, IS_T0())
    LAS unsigned char* const ldsb = (LAS unsigned char*)lds_raw;
    volatile LAS unsigned* misc = (volatile LAS unsigned*)(ldsb + MISC_OFF);
    if (threadIdx.x < 4) misc[threadIdx.x] = 0u;
    __syncthreads();
    XcdBarrier bar;
    { KARGS(); bar = xcd_barrier_post((unsigned*)(ARG_WS() + WS_CTL), misc, IS_T0()); }
    if (gridDim.x != 256) return;

    { MKCTX(); const float* inp[16];
#pragma unroll
      for (int i = 0; i < 16; ++i) inp[i] = ARG_IN(i);
      phase0(c, inp, ws); if (DUP & 1) phase0(c, inp, ws); }
    GRID_BAR();
    { MKCTX(); phase_rows<true>(c, ARG_IN(0), nullptr, ARG_IN(5), ARG_IN(4), (const int*)ARG_IN(2), ws, 0, 1, ARG_IN(10), ARG_IN(11)); if (DUP & 2) phase_rows<true>(c, ARG_IN(0), nullptr, ARG_IN(5), ARG_IN(4), (const int*)ARG_IN(2), ws, 0, 1, ARG_IN(10), ARG_IN(11)); }
    GRID_BAR();
    { KARGS(); unsigned char* ws = ARG_WS();
      pg8::Gemm g{(const bf16*)(ws + WS_HB), (const bf16*)(ws + WS_WTIN), T, INW, D, D, D, 0}; pg8::StaticOrder S; S.init(T, INW, 256, (int)blockIdx.x);
      Epi1 E{(bf16*)(ws + WS_Q), (const float*)(ws + WS_CS)};
      int nrep_ = (DUP & 4) ? 2 : 1; asm volatile("" : "+s"(nrep_));
#pragma unroll 1
      for (int rep_ = 0; rep_ < nrep_; ++rep_) { pg8::gemm_phase<Epi1, pg8::StaticOrder, false>(ldsb, g, S, E, nullptr, wave_s); } }
    GRID_BAR();
    { MKCTX(); phase_poolr(c, ws); if (DUP & 256) phase_poolr(c, ws); }
#if ATTN_SIMPLE
    { MKCTX(); phase_attn_simple(c, ws); }
#else
    { MKCTX(); phase_attn_mfma(c, ws); if (DUP & 8) phase_attn_mfma(c, ws); }
#endif
    GRID_BAR();
#if !ATTN_SIMPLE
    { MKCTX(); phase_combine(c, ws); if (DUP & 16384) phase_combine(c, ws); }
#endif
    { KARGS(); unsigned char* ws = ARG_WS();
      pg8::Gemm g{(const bf16*)(ws + WS_RB), (const bf16*)(ws + WS_WTPOOL), T, PW, 256, PW, 256, 512}; pg8::StaticOrder S; S.init(T, PW, 256, (int)blockIdx.x);
      EpiPool E{(bf16*)(ws + WS_HC), ARG_IN(8)};
      int nrep_ = (DUP & 16) ? 2 : 1; asm volatile("" : "+s"(nrep_));
#pragma unroll 1
      for (int rep_ = 0; rep_ < nrep_; ++rep_) { pg8::gemm_phase<EpiPool, pg8::StaticOrder, false>(ldsb, g, S, E, nullptr, wave_s); } }
    GRID_BAR();
    { KARGS(); unsigned char* ws = ARG_WS();
      pg8::Gemm g{(const bf16*)(ws + WS_HC), (const bf16*)(ws + WS_WTOUT), T, D, D, D, D, 0}; pg8::StaticOrder S; S.init(T, D, 256, (int)blockIdx.x);
      EpiOut E{ARG_IN(0), (bf16*)(ws + WS_X1B), (const float*)(ws + WS_MODF), (float*)(ws + WS_RSQP)};
      int nrep_ = (DUP & 32) ? 2 : 1; asm volatile("" : "+s"(nrep_));
#pragma unroll 1
      for (int rep_ = 0; rep_ < nrep_; ++rep_) { pg8::gemm_phase<EpiOut, pg8::StaticOrder, false>(ldsb, g, S, E, nullptr, wave_s); } }
    GRID_BAR();
    { KARGS(); unsigned char* ws = ARG_WS();
      pg8::StaticOrder S; S.init(T, D, 256, (int)blockIdx.x);
      pg8::Unit u0, u1; S.next(0, u0); S.next(1, u1);
      LAS float* rstdT = (LAS float*)(ldsb + 131072 + 256); LAS float* biasT = rstdT + 512;
      { const int l_ = lane_id(), tid_ = wave_s * 64 + l_, slot = tid_ >> 8, i_ = tid_ & 255; const pg8::Unit uu = slot ? u1 : u0;
        const float* rp = (const float*)(ws + WS_RSQP) + (size_t)(uu.pm * 256 + i_) * 32; float ssum = 0.f;
#pragma unroll
        for (int q = 0; q < 8; ++q) { const f32x4 v = *(const f32x4*)(rp + 4 * q); ssum += (v[0] + v[1]) + (v[2] + v[3]); }
        rstdT[slot * 256 + i_] = 1.0f / sqrtf(ssum * (1.0f / D) + NORM_EPS);
        const float* bp = (const float*)(ws + WS_BIASP) + (size_t)(uu.pm >= 32 ? 1 : 0) * D + uu.pn * 256 + i_; float bsum = 0.f;
#pragma unroll 8
        for (int kb = 0; kb < 32; ++kb) bsum += bp[(size_t)kb * 2 * D];
        biasT[slot * 256 + i_] = bsum; }
      __syncthreads();
      pg8::Gemm g{(const bf16*)(ws + WS_X1B), (const bf16*)(ws + WS_WQ2), T, D, D, D, D, 0, D * D * 2};
      EpiQ E{(bf16*)(ws + WS_QP), rstdT, biasT, u0.pm, u0.pn};
      int nrep_ = (DUP & 128) ? 2 : 1; asm volatile("" : "+s"(nrep_));
#pragma unroll 1
      for (int rep_ = 0; rep_ < nrep_; ++rep_) { pg8::gemm_phase<EpiQ, pg8::StaticOrder, false>(ldsb, g, S, E, nullptr, wave_s); } }
    GRID_BAR();
#if TOPK_SIMPLE
    { KARGS(); unsigned char* ws = ARG_WS();
      pg8::Gemm g{(const bf16*)(ws + WS_QP), (const bf16*)(ws + WS_SKP), T, D, 256, D, 256, 512}; pg8::StaticOrder S; S.init(T, D, 256, (int)blockIdx.x);
      EpiF E{(float*)(ws + WS_SC), D};
      pg8::gemm_phase<EpiF, pg8::StaticOrder, false>(ldsb, g, S, E, nullptr, wave_s); }
    GRID_BAR();
    { MKCTX(); phase_topk_simple(c, ws); if (DUP & 512) phase_topk_simple(c, ws); }
    GRID_BAR();
#else
    { MKCTX(); phase_scores_topk(c, ws); if (DUP & 512) phase_scores_topk(c, ws); }
    GRID_BAR();
#endif
#if PEER_BITS == 8
    { MKCTX(); phase_peer(c, ARG_OUT(), ARG_IN(15), ARG_OUT(), ws); }
#else
#if U_MFMA
    { MKCTX(); int nrep_ = (DUP & 8192) ? 2 : 1; asm volatile("" : "+s"(nrep_));
#pragma unroll 1
      for (int rep_ = 0; rep_ < nrep_; ++rep_) phase_peer4_u_mfma(c, ARG_IN(10), ws); }
#elif U_SORTED
    { MKCTX(); int nrep_ = (DUP & 8192) ? 2 : 1; asm volatile("" : "+s"(nrep_));
#pragma unroll 1
      for (int rep_ = 0; rep_ < nrep_; ++rep_) phase_peer4_u_sorted(c, ARG_IN(10), ws); }
#else
    { MKCTX(); phase_peer4_u<false>(c, ARG_IN(10), ws); }
#endif
    if (DUP & 4096) { MKCTX(); phase_peer4_u<true>(c, ARG_IN(10), ws); }
    asm volatile("s_waitcnt vmcnt(0)" ::: "memory");
#if V_MFMA && V_SORTED
    { MKCTX(); phase_peer4_v_sorted(c, ARG_IN(15), ARG_OUT(), ws); }
#elif V_MFMA
    { MKCTX(); phase_peer4_v_mfma(c, ARG_IN(15), ARG_OUT(), ws); }
#else
    { MKCTX(); phase_peer4_v(c, ARG_IN(15), ARG_OUT(), ws); }
#endif
#endif
}

extern "C" void kernel_launch(void* const* d_in, const int* in_sizes, int n_in, void* d_out, int out_size, void* d_ws, size_t ws_size, hipStream_t stream) {
    static int grid = 0;
    if (grid == 0) {
        if (n_in != 16 || in_sizes[0] != T * D || out_size != T * D || ws_size < WS_END) { fprintf(stderr, "kernel_launch: unexpected shapes (n_in %d, in0 %d, out %d, ws %zu)\n", n_in, n_in > 0 ? in_sizes[0] : -1, out_size, ws_size); grid = -1; return; }
        int dev = 0, cus = 0, per_cu = 0;
        if (hipGetDevice(&dev) != hipSuccess || hipDeviceGetAttribute(&cus, hipDeviceAttributeMultiprocessorCount, dev) != hipSuccess) { grid = -1; return; }
        if (hipFuncSetAttribute((const void*)fwd_kernel, hipFuncAttributeMaxDynamicSharedMemorySize, LDS_BYTES) != hipSuccess) { fprintf(stderr, "kernel_launch: hipFuncSetAttribute failed\n"); grid = -1; return; }
        if (hipOccupancyMaxActiveBlocksPerMultiprocessor(&per_cu, (const void*)fwd_kernel, NTHREADS, LDS_BYTES) != hipSuccess || per_cu < 1) { fprintf(stderr, "kernel_launch: occupancy query reports %d workgroups per CU\n", per_cu); }
        (void)hipGetLastError();
        grid = (cus < 256) ? cus : 256;
    }
    if (grid < 0) return;
    if (hipMemsetAsync((char*)d_ws + WS_CTL, 0, CTL_ZERO_BYTES, stream) != hipSuccess) return;
    Args a{};
    for (int i = 0; i < 16; ++i) a.in[i] = (const float*)d_in[i];
    a.out = (float*)d_out; a.ws = (unsigned char*)d_ws;
    hipLaunchKernelGGL(fwd_kernel, dim3(grid), dim3(NTHREADS), LDS_BYTES, stream, a);
}
```

```cpp
#include <hip/hip_runtime.h>
#include <cstdio>
#include <cstdint>
#ifndef ATTN_SIMPLE
#define ATTN_SIMPLE 0
#endif
#ifndef TOPK_SIMPLE
#define TOPK_SIMPLE 0
#endif
#ifndef PEER_BITS
#define PEER_BITS 4
#endif
#ifndef V_BSH
#define V_BSH 11
#endif
#ifndef V_SORTED
#define V_SORTED 1
#endif
#ifndef V_MFMA
#define V_MFMA 1
#endif
#ifndef U_MFMA
#define U_MFMA 1
#endif
#ifndef U_SORTED
#define U_SORTED 1
#endif
#ifndef DUP
#define DUP 0
#endif
namespace pg8 {
#define PG8_LAS __attribute__((address_space(3)))
typedef unsigned short bf16_t;
typedef short bf16x8 __attribute__((ext_vector_type(8)));
typedef float f32x4 __attribute__((ext_vector_type(4)));
typedef unsigned u32x4 __attribute__((ext_vector_type(4)));
constexpr int BM = 256, BK = 64, HALF = 128, HTB = HALF * BK * 2  , STAGE_BYTES = 8 * HTB, NXCD = 8, WGM = 8;

__host__ __device__ __forceinline__ int lds_byte(int r, int c) { const int st = (r >> 4) * 2 + (c >> 5), rr = r & 15, cc = c & 31, ob = rr * 64 + cc * 2; return st * 1024 + (ob ^ (((ob >> 9) & 1) << 5)); }
__host__ __device__ __forceinline__ void stage_rc(int b, int& R, int& C) { const int st = b / 1024, sb = b % 1024, swz = sb ^ (((sb >> 9) & 1) << 5); R = (st >> 1) * 16 + swz / 64; C = (st & 1) * 32 + (swz % 64) / 2; }
__host__ __device__ __forceinline__ int perm32(int rho) { const int n = rho >> 4, i = rho & 15; return 8 * (i >> 2) + 4 * n + (i & 3); }

struct Unit { int pm, pn; };
struct Gemm { const bf16_t* A; const bf16_t* Bt; int M, N, K, lda, ldb, apn, bhalf; };

struct StaticOrder {
    int nM, nN, nwg, G, c;
    __host__ __device__ __forceinline__ void init(int M, int N, int G_, int c_) { nM = M / BM; nN = N / BM; nwg = nM * nN; G = G_; c = c_; }
    __host__ __device__ __forceinline__ bool next(int i, Unit& u) const {
        const long L = (long)i * G + c; if (L >= nwg) return false;
        int wgid = (int)L; { const int q = nwg / NXCD, r = nwg % NXCD, xcd = wgid % NXCD, off = wgid / NXCD; wgid = (xcd < r ? xcd * (q + 1) : r * (q + 1) + (xcd - r) * q) + off; }
        const int nig = WGM * nN, gid = wgid / nig, fm = gid * WGM, gsz = (nM - fm) < WGM ? (nM - fm) : WGM;
        u.pm = fm + ((wgid % nig) % gsz); u.pn = (wgid % nig) / gsz; return true;
    }
    __device__ __forceinline__ void a_ready(const Unit&) const {}
    __device__ __forceinline__ void done(const Unit&) const {}
};
__device__ __forceinline__ unsigned cvt_pk_bf16(float lo, float hi) { typedef __bf16 bf2_ __attribute__((ext_vector_type(2))); bf2_ v; v[0] = (__bf16)lo; v[1] = (__bf16)hi; return __builtin_bit_cast(unsigned, v); }
template <class Epi, class Sched, bool STAMP = false>
__device__ __forceinline__ void gemm_phase(PG8_LAS unsigned char* lds, const Gemm g, const Sched& S, const Epi& E, unsigned long long* stamps, int wid_in) {
    unsigned ones_ = ~0u; asm volatile("" : "+s"(ones_)); int lane_ = (int)__builtin_amdgcn_mbcnt_hi(ones_, __builtin_amdgcn_mbcnt_lo(ones_, 0u)); asm volatile("" : "+v"(lane_));
    const int wid = __builtin_amdgcn_readfirstlane(wid_in), lane = lane_, tid = wid * 64 + lane, wr = wid >> 2, wc = wid & 3, fr = lane & 15, fq = lane >> 4;
    int K_ = g.K; asm volatile("" : "+s"(K_));
    const int K = K_, nt = K / BK;
    int ts_lo = 0, ts_hi = 0, nts = 0; const unsigned long long rt_entry = STAMP ? (unsigned long long)wall_clock64() : 0ull;
#define PG8_STAMP() do { if (STAMP && wid == 0 && nts < 64) { const unsigned long long _c = (unsigned long long)clock64(); \
        ts_lo = (lane == nts) ? (int)(unsigned)_c : ts_lo; ts_hi = (lane == nts) ? (int)(unsigned)(_c >> 32) : ts_hi; ++nts; } } while (0)
    PG8_STAMP();
    unsigned voffA[2], voffB[2];
#pragma unroll
    for (int i = 0; i < 2; ++i) { int R, C; stage_rc(tid * 16 + i * 8192, R, C); const int Rb = Epi::PERM ? ((R & ~31) + perm32(R & 31)) : R;
        voffA[i] = (unsigned)(R * g.lda + C) * 2u; voffB[i] = (unsigned)(Rb * g.ldb + C) * 2u; }
    const size_t kstep = (size_t)(BK * 2);
    const size_t hstepA = (size_t)HALF * g.lda * 2, hstepB = (size_t)HALF * g.ldb * 2;
    const size_t tstepA = 2 * hstepA, tstepB = 2 * hstepB;
    const unsigned ldsw = (unsigned)wid * 1024u;
    const int aoff = lds_byte(wr * 64 + fr, fq * 8), boff = lds_byte(wc * 32 + fr, fq * 8);
#define PG8_SA(b, h) (((b) * 2 + (h)) * HTB)
#define PG8_SB(b, h) ((4 + (b) * 2 + (h)) * HTB)
#define PG8_STAGE(bufoff, gbase, voff) do { _Pragma("unroll") for (int _i = 0; _i < 2; ++_i) \
        __builtin_amdgcn_global_load_lds((const unsigned*)((const char*)(gbase) + (voff)[_i]), (PG8_LAS unsigned*)(lds + (bufoff) + ldsw + _i * 8192), 16, 0, 0); } while (0)
#define PG8_LDA(dst, b, h) do { _Pragma("unroll") for (int m = 0; m < 4; ++m) _Pragma("unroll") for (int k = 0; k < 2; ++k) dst[m][k] = *(const PG8_LAS bf16x8*)(lds + PG8_SA(b, h) + aoff + m * 2048 + k * 1024); } while (0)
#define PG8_LDB(dst, b, h) do { _Pragma("unroll") for (int n = 0; n < 2; ++n) _Pragma("unroll") for (int k = 0; k < 2; ++k) dst[n][k] = *(const PG8_LAS bf16x8*)(lds + PG8_SB(b, h) + boff + n * 2048 + k * 1024); } while (0)
#define PG8_MMA(ai, bj, At, Bt) do { __builtin_amdgcn_s_setprio(1); _Pragma("unroll") for (int m = 0; m < 4; ++m) _Pragma("unroll") for (int n = 0; n < 2; ++n) _Pragma("unroll") for (int k = 0; k < 2; ++k) \
        acc[ai][bj][m][n] = __builtin_amdgcn_mfma_f32_16x16x32_bf16(Bt[n][k], At[m][k], acc[ai][bj][m][n], 0, 0, 0); __builtin_amdgcn_s_setprio(0); } while (0)
#define PG8_WAIT_V(n) asm volatile("s_waitcnt vmcnt(" #n ")" ::: "memory")
#define PG8_WAIT_L(n) asm volatile("s_waitcnt lgkmcnt(" #n ")" ::: "memory")
#define PG8_BAR __builtin_amdgcn_s_barrier()
#define PG8_SCHED __builtin_amdgcn_sched_barrier(0)
    Unit cur, nxt; int ui = 0;
    if (!S.next(0, cur)) return;
    f32x4 acc[2][2][4][2];
#pragma unroll
    for (int a = 0; a < 2; ++a)
#pragma unroll
        for (int b = 0; b < 2; ++b)
#pragma unroll
            for (int m = 0; m < 4; ++m)
#pragma unroll
                for (int n = 0; n < 2; ++n) acc[a][b][m][n] = (f32x4){0.f, 0.f, 0.f, 0.f};
    bf16x8 At[4][2], B0[2][2], B1[2][2];
    const char* cA = (const char*)g.A + (size_t)cur.pm * tstepA + (size_t)cur.pn * g.apn; const char* cB = (const char*)g.Bt + (size_t)cur.pn * tstepB + ((2 * cur.pm * BM >= g.M) ? (size_t)g.bhalf : (size_t)0);
    S.a_ready(cur);
    PG8_STAGE(PG8_SB(0, 0), cB, voffB); PG8_STAGE(PG8_SA(0, 0), cA, voffA); PG8_STAGE(PG8_SB(0, 1), cB + hstepB, voffB); PG8_STAGE(PG8_SA(0, 1), cA + hstepA, voffA);
    if (wr == 1) PG8_BAR;
    PG8_WAIT_V(4); PG8_BAR;
    PG8_STAGE(PG8_SB(1, 0), cB + kstep, voffB); PG8_STAGE(PG8_SA(1, 0), cA + kstep, voffA); PG8_STAGE(PG8_SB(1, 1), cB + hstepB + kstep, voffB);
    PG8_WAIT_V(6); PG8_BAR;
    PG8_STAMP();
    for (;;) {
        const bool has_next = S.next(ui + 1, nxt);
        const char* nA = has_next ? (const char*)g.A + (size_t)nxt.pm * tstepA + (size_t)nxt.pn * g.apn : cA; const char* nB = has_next ? (const char*)g.Bt + (size_t)nxt.pn * tstepB + ((2 * nxt.pm * BM >= g.M) ? (size_t)g.bhalf : (size_t)0) : cB;
        for (int t = 0; t < nt; t += 2) {
            const bool last = (t == nt - 2);
            const char* a1 = cA + (size_t)(t + 1) * kstep;
            const char* a2 = last ? nA : cA + (size_t)(t + 2) * kstep; const char* b2 = last ? nB : cB + (size_t)(t + 2) * kstep;
            const char* a3 = a2 + kstep; const char* b3 = b2 + kstep;
            if (last && has_next) S.a_ready(nxt);
            PG8_LDB(B0, 0, 0); PG8_SCHED; PG8_LDA(At, 0, 0); PG8_STAGE(PG8_SA(1, 1), a1 + hstepA, voffA);
            PG8_WAIT_L(8); PG8_BAR; PG8_WAIT_L(0); PG8_MMA(0, 0, At, B0); PG8_BAR; PG8_SCHED;
            PG8_LDB(B1, 0, 1); PG8_STAGE(PG8_SB(0, 0), b2, voffB);
            PG8_BAR; PG8_WAIT_L(0); PG8_MMA(0, 1, At, B1); PG8_BAR;
            PG8_LDA(At, 0, 1); PG8_STAGE(PG8_SA(0, 0), a2, voffA);
            PG8_BAR; PG8_WAIT_L(0); PG8_MMA(1, 0, At, B0); PG8_BAR; PG8_SCHED;
            PG8_STAGE(PG8_SB(0, 1), b2 + hstepB, voffB);
            PG8_WAIT_V(6); PG8_BAR; PG8_MMA(1, 1, At, B1); PG8_BAR;
            PG8_LDB(B0, 1, 0); PG8_SCHED; PG8_LDA(At, 1, 0); PG8_STAGE(PG8_SA(0, 1), a2 + hstepA, voffA);
            PG8_WAIT_L(8); PG8_BAR; PG8_WAIT_L(0); PG8_MMA(0, 0, At, B0); PG8_BAR; PG8_SCHED;
            PG8_LDB(B1, 1, 1); PG8_STAGE(PG8_SB(1, 0), b3, voffB);
            PG8_BAR; PG8_WAIT_L(0); PG8_MMA(0, 1, At, B1); PG8_BAR;
            PG8_LDA(At, 1, 1); PG8_STAGE(PG8_SA(1, 0), a3, voffA);
            PG8_BAR; PG8_WAIT_L(0); PG8_MMA(1, 0, At, B0); PG8_BAR; PG8_SCHED;
            PG8_STAGE(PG8_SB(1, 1), b3 + hstepB, voffB);
            PG8_WAIT_V(6); PG8_BAR; PG8_MMA(1, 1, At, B1); PG8_BAR;
        }
        PG8_STAMP();
        if constexpr (!Epi::AFTER_DRAIN) { E(acc, cur, wr, wc, fr, fq); S.done(cur); }
        PG8_STAMP();
        if (!has_next) break;
#pragma unroll
        for (int a = 0; a < 2; ++a)
#pragma unroll
            for (int b = 0; b < 2; ++b)
#pragma unroll
                for (int m = 0; m < 4; ++m)
#pragma unroll
                    for (int n = 0; n < 2; ++n) acc[a][b][m][n] = (f32x4){0.f, 0.f, 0.f, 0.f};
        cur = nxt; cA = nA; cB = nB; ++ui;
    }
    PG8_WAIT_V(0);
    if (wr == 0) PG8_BAR;
    PG8_BAR;
    if constexpr (Epi::AFTER_DRAIN) { E.fused(acc, cur, wr, wc, fr, fq, lds, wid, lane); S.done(cur); }
    PG8_STAMP();
    if (STAMP && wid == 0) { stamps[lane] = lane < nts ? (((unsigned long long)(unsigned)ts_hi << 32) | (unsigned)ts_lo) : 0ull;
        if (lane == 62) stamps[62] = rt_entry; if (lane == 63) stamps[63] = (unsigned long long)wall_clock64(); }
#undef PG8_STAMP
#undef PG8_SA
#undef PG8_SB
#undef PG8_STAGE
#undef PG8_LDA
#undef PG8_LDB
#undef PG8_MMA
#undef PG8_WAIT_V
#undef PG8_WAIT_L
#undef PG8_BAR
#undef PG8_SCHED
}
}


constexpr int NWAVES = 8, NTHREADS = 512;
constexpr int BATCH = 2, SEQ = 8192, T = BATCH * SEQ, D = 2048;
constexpr int AW = 1024, NH = 8, HD = 128, PW = 1024, INW = 4096;
constexpr int NMOD = 6 * D;
constexpr int PE_HEADS = 8, PE_NK = 128, PE_EXP = 16384, PE_K = 16;
constexpr float NORM_EPS = 1e-6f;
constexpr float QSCALE = 0.08838834764831845f * 1.4426950408889634f;

constexpr size_t MiB = 1u << 20;
constexpr size_t WS_CTL = 0, CTL_ZERO_BYTES = 64 * 1024;
constexpr size_t WS_MODP = 1 * MiB;
constexpr size_t WS_MODF = 1 * MiB + 832 * 1024;
constexpr size_t WS_CS = 2 * MiB;
constexpr size_t WS_WTIN = 4 * MiB;
constexpr size_t WS_WTOUT = 20 * MiB;
constexpr size_t WS_WTQ = 28 * MiB;
constexpr size_t WS_WTPOOL = 36 * MiB;
constexpr size_t WS_SKP = 37 * MiB;
constexpr size_t WS_SU = 38 * MiB, WS_SV = 38 * MiB + 64 * 1024;
constexpr size_t WS_PU = 40 * MiB, WS_PV = 104 * MiB;
constexpr size_t WS_HB = 168 * MiB;
constexpr size_t WS_Q = 232 * MiB, WS_K = 264 * MiB, WS_V = 296 * MiB, WS_U = 328 * MiB;
constexpr size_t WS_HC = 360 * MiB;
constexpr size_t WS_RB = 424 * MiB;
constexpr size_t WS_QP = WS_Q;
constexpr size_t WS_SC = WS_V;
constexpr size_t WS_IDX = WS_RB, WS_GATE = WS_RB + 8 * MiB;
constexpr size_t WS_TQ = WS_RB + 16 * MiB, WS_CSC = WS_RB + 24 * MiB;
constexpr size_t WS_OP0 = WS_HB, WS_OP1 = WS_HB + 32 * MiB, WS_OP2 = 456 * MiB;
constexpr size_t WS_X1B = WS_V;
constexpr size_t WS_LSE = 488 * MiB;
constexpr size_t WS_WQ2 = 490 * MiB;
constexpr size_t WS_BIASP = 506 * MiB;
constexpr size_t WS_RSQP = 507 * MiB;
constexpr size_t WS_END = 509 * MiB;

constexpr int RING_BYTES = 131072, MISC_OFF = RING_BYTES, LDS_BYTES = 147456;

#define GAS __attribute__((address_space(1)))
typedef unsigned short bf16;
typedef unsigned v4u __attribute__((ext_vector_type(4)));
typedef unsigned v2u __attribute__((ext_vector_type(2)));
typedef float f32x4 __attribute__((ext_vector_type(4)));
typedef __bf16 bf2 __attribute__((ext_vector_type(2)));
#define LDS_WAIT() asm volatile("s_waitcnt lgkmcnt(0)" ::: "memory")
#define VM_WAIT() asm volatile("s_waitcnt vmcnt(0)" ::: "memory")
__device__ __forceinline__ unsigned pk2(float lo, float hi) { return pg8::cvt_pk_bf16(lo, hi); }
__device__ __forceinline__ float bflo(unsigned w) { return __uint_as_float(w << 16); }
__device__ __forceinline__ float bfhi(unsigned w) { return __uint_as_float(w & 0xffff0000u); }
__device__ __forceinline__ float dot2(unsigned a, unsigned b, float c) { return __builtin_amdgcn_fdot2_f32_bf16(__builtin_bit_cast(bf2, a), __builtin_bit_cast(bf2, b), c, false); }
__device__ __forceinline__ int my_lane() { unsigned ones = ~0u; asm volatile("" : "+s"(ones)); return (int)__builtin_amdgcn_mbcnt_hi(ones, __builtin_amdgcn_mbcnt_lo(ones, 0u)); }
__device__ __forceinline__ int sh_idx(int v, int idx) { return __builtin_amdgcn_ds_bpermute(idx << 2, v); }
__device__ __forceinline__ unsigned sh_idx(unsigned v, int idx) { return (unsigned)__builtin_amdgcn_ds_bpermute(idx << 2, (int)v); }
__device__ __forceinline__ float sh_idx(float v, int idx) { return __int_as_float(__builtin_amdgcn_ds_bpermute(idx << 2, __float_as_int(v))); }
#define SXOR(v, m, lane) sh_idx((v), (lane) ^ (m))
__device__ __forceinline__ float wave_sum(float v) {
    const int lane = my_lane();
#pragma unroll
    for (int o = 1; o < 64; o <<= 1) v += SXOR(v, o, lane);
    return v;
}
__device__ __forceinline__ int wave_sum_i(int v) {
    const int lane = my_lane();
#pragma unroll
    for (int o = 1; o < 64; o <<= 1) v += SXOR(v, o, lane);
    return v;
}
__device__ __forceinline__ float wave_max(float v) {
    const int lane = my_lane();
#pragma unroll
    for (int o = 1; o < 64; o <<= 1) v = fmaxf(v, SXOR(v, o, lane));
    return v;
}

#define XB_TMO      128
#define XB_XCNT(j)  (256  + 64 * (j))
#define XB_XSUB(j)  (1280 + 64 * (j))
#define XB_XGEN(j)  (2304 + 64 * (j))
#define XB_TOP      3328
#define XB_TOPGEN   3392
#define XCD_BAR_WORDS 3456
#define XB_SPIN_CAP (1u << 18)
#define LAS __attribute__((address_space(3)))

__device__ __forceinline__ unsigned xb_ld(unsigned* p)              { return __hip_atomic_load(p, __ATOMIC_RELAXED, __HIP_MEMORY_SCOPE_AGENT); }
__device__ __forceinline__ unsigned xb_add(unsigned* p, unsigned v) { return __hip_atomic_fetch_add(p, v, __ATOMIC_RELAXED, __HIP_MEMORY_SCOPE_AGENT); }
__device__ __forceinline__ unsigned xb_xcc_id() { return (unsigned)__builtin_amdgcn_s_getreg((3 << 11) | 20) & 0xFu; }
#define XB_SPIN(cond, bar) do { unsigned _sp = 0; while (cond) { __builtin_amdgcn_s_sleep(1); \
    if ((++_sp & 255u) == 0u) { if (xb_ld(&(bar)[XB_TMO])) break; if (_sp > XB_SPIN_CAP) { atomicAdd(&(bar)[XB_TMO], 1u); break; } } } } while (0)

struct XcdBarrier {
    unsigned* bar; unsigned x;
    volatile LAS unsigned* st;
};

__device__ __forceinline__ XcdBarrier xcd_barrier_post(unsigned* bar, volatile LAS unsigned* st, bool is_t0) {
    XcdBarrier b; b.bar = bar; b.x = xb_xcc_id(); b.st = st;
    if (is_t0) (void)xb_add(&bar[XB_XCNT(b.x)], 1u);
    return b;
}
__device__ __forceinline__ void xcd_barrier_complete(unsigned* bar, unsigned x, unsigned& nloc, unsigned& nx) {
    const unsigned G = gridDim.x * gridDim.y * gridDim.z;
    unsigned sum, cnt, mine, sp = 0u;
    for (;;) {
        sum = 0u; cnt = 0u; mine = 0u;
#pragma unroll
        for (unsigned j = 0; j < 16; ++j) { const unsigned c = xb_ld(&bar[XB_XCNT(j)]); sum += c; cnt += (c > 0u) ? 1u : 0u; mine = (j == x) ? c : mine; }
        if (sum == G) break;
        __builtin_amdgcn_s_sleep(1);
        if ((++sp & 255u) == 0u) { if (xb_ld(&bar[XB_TMO])) break; if (sp > XB_SPIN_CAP) { atomicAdd(&bar[XB_TMO], 1u); break; } }
    }
    nloc = mine > 0u ? mine : 1u; nx = cnt > 0u ? cnt : 1u;
}

__device__ __forceinline__ void xcd_barrier(const XcdBarrier& b, bool is_t0) {
    asm volatile("s_waitcnt vmcnt(0)" ::: "memory");
    __syncthreads();
    if (is_t0) {
        unsigned* bar = b.bar;
        __builtin_amdgcn_s_waitcnt(0);
        unsigned nloc = b.st[0], nx = b.st[1];
        if (nloc == 0u) { xcd_barrier_complete(bar, b.x, nloc, nx); b.st[0] = nloc; b.st[1] = nx; }
        const unsigned old = xb_add(&bar[XB_XSUB(b.x)], 1u);
        const unsigned gen = old / nloc;
        if (old + 1u == (gen + 1u) * nloc) {
            __builtin_amdgcn_fence(__ATOMIC_RELEASE, "agent");
            asm volatile("s_waitcnt vmcnt(0)" ::: "memory");
            const unsigned og = xb_add(&bar[XB_TOP], 1u);
            const unsigned tg = og / nx;
            if (og + 1u == (tg + 1u) * nx) xb_add(&bar[XB_TOPGEN], 1u);
            else XB_SPIN(xb_ld(&bar[XB_TOPGEN]) == tg, bar);
            __builtin_amdgcn_fence(__ATOMIC_ACQUIRE, "agent");
            xb_add(&bar[XB_XGEN(b.x)], 1u);
            asm volatile("s_waitcnt vmcnt(0)" ::: "memory");
        } else {
            XB_SPIN(xb_ld(&bar[XB_XGEN(b.x)]) == gen, bar);
            __builtin_amdgcn_fence(__ATOMIC_ACQUIRE, "agent");
            asm volatile("s_waitcnt vmcnt(0)" ::: "memory");
        }
    }
    __syncthreads();
}

struct Ctx { LAS unsigned char* lds; int tid, lane, wave, vcu, G, gw, ngw; };

struct Epi1 {
    static constexpr bool PERM = true, AFTER_DRAIN = false;
    bf16* QKVU; const float* CS;
    __device__ __forceinline__ void operator()(const pg8::f32x4 (&acc)[2][2][4][2], const pg8::Unit& u, int wr, int wc, int fr, int fq) const {
        const int row0 = u.pm * 256 + wr * 64 + fr; const int tt = u.pn >> 2; const int colt = (u.pn & 3) * 256;
        bf16* base = QKVU + (size_t)tt * ((size_t)T * 1024);
        const int col0 = colt + wc * 32 + 8 * fq;
        const bool rot = (tt < 2) && (wc == 0);
        const float sc = (tt == 0) ? QSCALE : 1.0f;
        const float sgn = (fq < 2) ? -1.0f : 1.0f;
#pragma unroll
        for (int ai = 0; ai < 2; ++ai)
#pragma unroll
            for (int m = 0; m < 4; ++m) {
                const int row = row0 + ai * 128 + m * 16;
                bf16* rowp = base + (size_t)row * 1024 + col0;
                f32x4 c0 = {1.f, 1.f, 1.f, 1.f}, c1 = c0, s0 = {0.f, 0.f, 0.f, 0.f}, s1 = s0;
                if (rot) { const float* cs = CS + (size_t)row * 32 + 8 * (fq & 1);
                    c0 = *(const f32x4*)(cs); c1 = *(const f32x4*)(cs + 4); s0 = *(const f32x4*)(cs + 16); s1 = *(const f32x4*)(cs + 20); }
#pragma unroll
                for (int bj = 0; bj < 2; ++bj) {
                    f32x4 v0 = acc[ai][bj][m][0], v1 = acc[ai][bj][m][1];
                    if (rot) {
#pragma unroll
                        for (int e = 0; e < 4; ++e) {
                            const float p0 = SXOR(v0[e], 32, 16 * fq + fr), p1 = SXOR(v1[e], 32, 16 * fq + fr);
                            v0[e] = v0[e] * c0[e] + sgn * p0 * s0[e];
                            v1[e] = v1[e] * c1[e] + sgn * p1 * s1[e];
                        }
                    }
                    pg8::u32x4 w; w.x = pk2(v0[0] * sc, v0[1] * sc); w.y = pk2(v0[2] * sc, v0[3] * sc); w.z = pk2(v1[0] * sc, v1[1] * sc); w.w = pk2(v1[2] * sc, v1[3] * sc);
                    *(pg8::u32x4*)(rowp + bj * 128) = w;
                }
            }
    }
};
struct EpiPool {
    static constexpr bool PERM = true, AFTER_DRAIN = false;
    bf16* HC; const float* pscale;
    __device__ __forceinline__ void operator()(const pg8::f32x4 (&acc)[2][2][4][2], const pg8::Unit& u, int wr, int wc, int fr, int fq) const {
        const int row0 = u.pm * 256 + wr * 64 + fr, col0 = u.pn * 256 + wc * 32 + 8 * fq;
        f32x4 ps[2][2];
#pragma unroll
        for (int bj = 0; bj < 2; ++bj) { ps[bj][0] = *(const f32x4*)(pscale + col0 + bj * 128); ps[bj][1] = *(const f32x4*)(pscale + col0 + bj * 128 + 4); }
#pragma unroll
        for (int ai = 0; ai < 2; ++ai)
#pragma unroll
            for (int m = 0; m < 4; ++m) {
                bf16* rowp = HC + (size_t)(row0 + ai * 128 + m * 16) * 2048 + 1024 + col0;
#pragma unroll
                for (int bj = 0; bj < 2; ++bj) {
                    const f32x4 v0 = acc[ai][bj][m][0] * ps[bj][0], v1 = acc[ai][bj][m][1] * ps[bj][1];
                    pg8::u32x4 w; w.x = pk2(v0[0], v0[1]); w.y = pk2(v0[2], v0[3]); w.z = pk2(v1[0], v1[1]); w.w = pk2(v1[2], v1[3]);
                    *(pg8::u32x4*)(rowp + bj * 128) = w;
                }
            }
    }
};
struct EpiBf {
    static constexpr bool PERM = true, AFTER_DRAIN = false;
    bf16* O; int ldc;
    __device__ __forceinline__ void operator()(const pg8::f32x4 (&acc)[2][2][4][2], const pg8::Unit& u, int wr, int wc, int fr, int fq) const {
        const int row0 = u.pm * 256 + wr * 64 + fr, col0 = u.pn * 256 + wc * 32 + 8 * fq;
#pragma unroll
        for (int ai = 0; ai < 2; ++ai)
#pragma unroll
            for (int m = 0; m < 4; ++m) {
                bf16* rowp = O + (size_t)(row0 + ai * 128 + m * 16) * ldc + col0;
#pragma unroll
                for (int bj = 0; bj < 2; ++bj) {
                    const f32x4 v0 = acc[ai][bj][m][0], v1 = acc[ai][bj][m][1];
                    pg8::u32x4 w; w.x = pk2(v0[0], v0[1]); w.y = pk2(v0[2], v0[3]); w.z = pk2(v1[0], v1[1]); w.w = pk2(v1[2], v1[3]);
                    *(pg8::u32x4*)(rowp + bj * 128) = w;
                }
            }
    }
};
struct EpiQ {
    static constexpr bool PERM = true, AFTER_DRAIN = false;
    bf16* O; const LAS float* rstdT; const LAS float* biasT; int pm0, pn0;
    __device__ __forceinline__ void operator()(const pg8::f32x4 (&acc)[2][2][4][2], const pg8::Unit& u, int wr, int wc, int fr, int fq) const {
        const int slot = (u.pm == pm0 && u.pn == pn0) ? 0 : 1;
        const int row0 = u.pm * 256 + wr * 64 + fr, col0 = u.pn * 256 + wc * 32 + 8 * fq;
        f32x4 bv[2][2];
#pragma unroll
        for (int bj = 0; bj < 2; ++bj) { bv[bj][0] = *(const LAS f32x4*)(biasT + slot * 256 + bj * 128 + wc * 32 + 8 * fq); bv[bj][1] = *(const LAS f32x4*)(biasT + slot * 256 + bj * 128 + wc * 32 + 8 * fq + 4); }
#pragma unroll
        for (int ai = 0; ai < 2; ++ai)
#pragma unroll
            for (int m = 0; m < 4; ++m) {
                const float rs = rstdT[slot * 256 + ai * 128 + wr * 64 + m * 16 + fr];
                bf16* rowp = O + (size_t)(row0 + ai * 128 + m * 16) * D + col0;
#pragma unroll
                for (int bj = 0; bj < 2; ++bj) {
                    const f32x4 v0 = acc[ai][bj][m][0] * rs + bv[bj][0], v1 = acc[ai][bj][m][1] * rs + bv[bj][1];
                    pg8::u32x4 w; w.x = pk2(v0[0], v0[1]); w.y = pk2(v0[2], v0[3]); w.z = pk2(v1[0], v1[1]); w.w = pk2(v1[2], v1[3]);
                    *(pg8::u32x4*)(rowp + bj * 128) = w;
                }
            }
    }
};
struct EpiF {
    static constexpr bool PERM = false, AFTER_DRAIN = false;
    float* C; int ldc;
    __device__ __forceinline__ void operator()(const pg8::f32x4 (&acc)[2][2][4][2], const pg8::Unit& u, int wr, int wc, int fr, int fq) const {
        const int row0 = u.pm * 256 + wr * 64 + fr, col0 = u.pn * 256 + wc * 32 + 4 * fq;
#pragma unroll
        for (int ai = 0; ai < 2; ++ai)
#pragma unroll
            for (int m = 0; m < 4; ++m) { float* rowp = C + (size_t)(row0 + ai * 128 + m * 16) * ldc + col0;
#pragma unroll
                for (int bj = 0; bj < 2; ++bj)
#pragma unroll
                    for (int n = 0; n < 2; ++n) *(f32x4*)(rowp + bj * 128 + n * 16) = acc[ai][bj][m][n]; }
    }
};
struct EpiOut {
    static constexpr bool PERM = true, AFTER_DRAIN = false;
    const float* X; bf16* X1; const float* MODF; float* RSQP;
    __device__ __forceinline__ void operator()(const pg8::f32x4 (&acc)[2][2][4][2], const pg8::Unit& u, int wr, int wc, int fr, int fq) const {
        const int row0 = u.pm * 256 + wr * 64 + fr, col0 = u.pn * 256 + wc * 32 + 8 * fq;
        const float* gp = MODF + (size_t)(u.pm >= 32 ? 1 : 0) * NMOD + 2 * D + col0;
        f32x4 gv[2][2];
#pragma unroll
        for (int bj = 0; bj < 2; ++bj)
#pragma unroll
            for (int n = 0; n < 2; ++n) gv[bj][n] = *(const f32x4*)(gp + bj * 128 + 4 * n);
#pragma unroll
        for (int ai = 0; ai < 2; ++ai)
#pragma unroll
            for (int m = 0; m < 4; ++m) { const size_t off = (size_t)(row0 + ai * 128 + m * 16) * D + col0; float ssr = 0.f;
#pragma unroll
                for (int bj = 0; bj < 2; ++bj) {
                    const f32x4 v0 = __builtin_nontemporal_load((const f32x4*)(X + off + bj * 128)) + gv[bj][0] * acc[ai][bj][m][0], v1 = __builtin_nontemporal_load((const f32x4*)(X + off + bj * 128 + 4)) + gv[bj][1] * acc[ai][bj][m][1];
                    pg8::u32x4 w; w.x = pk2(v0[0], v0[1]); w.y = pk2(v0[2], v0[3]); w.z = pk2(v1[0], v1[1]); w.w = pk2(v1[2], v1[3]);
                    *(pg8::u32x4*)(X1 + off + bj * 128) = w;
                    ssr += (v0[0] * v0[0] + v0[1] * v0[1]) + (v0[2] * v0[2] + v0[3] * v0[3]) + (v1[0] * v1[0] + v1[1] * v1[1]) + (v1[2] * v1[2] + v1[3] * v1[3]); }
                ssr += SXOR(ssr, 16, 16 * fq + fr); ssr += SXOR(ssr, 32, 16 * fq + fr);
                if (fq == 0) RSQP[(size_t)(row0 + ai * 128 + m * 16) * 32 + u.pn * 4 + wc] = ssr; }
    }
};

__device__ __forceinline__ void p0_transpose_item(const float* W, int K, int N, bf16* WT, int row_off, LAS float* scr, int item, int lane) {
    const int nblk = N / 32, kb = item / nblk, nb = item % nblk, k0 = 64 * kb, n0 = 32 * nb;
#pragma unroll 8
    for (int i = 0; i < 32; ++i) { const int kk = 2 * i + (lane >> 5); scr[kk * 33 + (lane & 31)] = W[(size_t)(k0 + kk) * N + n0 + (lane & 31)]; }
    LDS_WAIT(); asm volatile("" ::: "memory");
    const int c = lane & 7;
#pragma unroll
    for (int j = 0; j < 4; ++j) { const int n = (lane >> 3) + 8 * j; const LAS float* s = scr + (8 * c) * 33 + n;
        v4u o; o.x = pk2(s[0 * 33], s[1 * 33]); o.y = pk2(s[2 * 33], s[3 * 33]); o.z = pk2(s[4 * 33], s[5 * 33]); o.w = pk2(s[6 * 33], s[7 * 33]);
        *(v4u*)(WT + (size_t)(row_off + n0 + n) * K + k0 + 8 * c) = o; }
    LDS_WAIT(); asm volatile("" ::: "memory");
}
__device__ __forceinline__ float silu_f(float x) { return x / (1.0f + __expf(-x)); }
constexpr int MOD_ITEMS = 48 * 8;
__device__ __forceinline__ void p0_mod_item(const float* cvec, const float* w_mod, float* MODP, int item, int lane) {
    const int cb = item % 48, kc = item / 48, col = 256 * cb + 4 * lane, k0 = 256 * kc;
    f32x4 a0 = {0.f, 0.f, 0.f, 0.f}, a1 = a0;
    const float* wp = w_mod + (size_t)k0 * NMOD + col;
#pragma unroll 32
    for (int k = 0; k < 256; ++k) {
        const f32x4 w = __builtin_nontemporal_load((const f32x4*)(wp + (size_t)k * NMOD));
        const float s0 = silu_f(cvec[k0 + k]), s1 = silu_f(cvec[D + k0 + k]);
        a0 += w * s0; a1 += w * s1;
    }
    *(f32x4*)(MODP + ((size_t)kc * 2 + 0) * NMOD + col) = a0;
    *(f32x4*)(MODP + ((size_t)kc * 2 + 1) * NMOD + col) = a1;
}
template <int OFFS>
__device__ __forceinline__ void p0_quant_row(const float* src, unsigned char* dst, float* scale_out, int lane) {
    f32x4 v[8]; float am = 0.f;
#pragma unroll
    for (int j = 0; j < 8; ++j) { v[j] = *(const f32x4*)(src + 256 * j + 4 * lane); am = fmaxf(fmaxf(am, fmaxf(fabsf(v[j][0]), fabsf(v[j][1]))), fmaxf(fabsf(v[j][2]), fabsf(v[j][3]))); }
    am = wave_max(am);
    const float inv = (am > 0.f) ? 127.0f / am : 0.f;
    if (lane == 0) *scale_out = am * (1.0f / 127.0f);
#pragma unroll
    for (int j = 0; j < 8; ++j) {
        unsigned w = 0u;
#pragma unroll
        for (int e = 0; e < 4; ++e) { int q = __float2int_rn(v[j][e] * inv); q = q > 127 ? 127 : (q < -127 ? -127 : q); w |= ((unsigned)(q + OFFS) & 0xffu) << (8 * e); }
        *(unsigned*)(dst + 256 * j + 4 * lane) = w;
    }
}
__device__ __forceinline__ void p0_quant_load4(const float* src, int lane, f32x4 (&v)[8]) {
#pragma unroll
    for (int j = 0; j < 8; ++j) v[j] = __builtin_nontemporal_load((const f32x4*)(src + 256 * j + 4 * lane));
}
template <unsigned XR>
__device__ __forceinline__ void p0_quant_finish4(const f32x4 (&v)[8], unsigned char* dst, float* scale_out, int lane) {
    float am = 0.f, sq = 0.f;
#pragma unroll
    for (int j = 0; j < 8; ++j)
#pragma unroll
        for (int e = 0; e < 4; ++e) { am = fmaxf(am, fabsf(v[j][e])); sq += v[j][e] * v[j][e]; }
    am = wave_max(am); sq = wave_sum(sq);
    const float step = fmaxf(0.335f * sqrtf(sq * (1.0f / D)), am * (1.0f / 24.0f));
    const float inv = (step > 0.f) ? 1.0f / step : 0.f;
    if (lane == 0) *scale_out = step;
    v4u o;
#pragma unroll
    for (int d = 0; d < 4; ++d) {
        unsigned w = 0u;
#pragma unroll
        for (int e = 0; e < 4; ++e) {
            int lo = (int)floorf(v[2 * d][e] * inv) + 8, hi = (int)floorf(v[2 * d + 1][e] * inv) + 8;
            lo = lo < 0 ? 0 : (lo > 15 ? 15 : lo); hi = hi < 0 ? 0 : (hi > 15 ? 15 : hi);
            w |= ((unsigned)lo | ((unsigned)hi << 4)) << (8 * e);
        }
        w ^= XR * 0x01010101u;
        if (d == 0) o.x = w; else if (d == 1) o.y = w; else if (d == 2) o.z = w; else o.w = w;
    }
    *(v4u*)(dst + 16 * lane) = o;
}
__device__ __forceinline__ unsigned fp4_code(float x) {
    const float a = fabsf(x);
    const unsigned m = (unsigned)(a > 0.25f) + (unsigned)(a > 0.75f) + (unsigned)(a > 1.25f) + (unsigned)(a > 1.75f) + (unsigned)(a > 2.5f) + (unsigned)(a > 3.5f) + (unsigned)(a > 5.0f);
    return m | (x < 0.f ? 8u : 0u);
}
__device__ __forceinline__ void p0_quant_finish_fp4(const f32x4 (&v)[8], unsigned char* dst, float* scale_out, int lane) {
    float am = 0.f, sq = 0.f;
#pragma unroll
    for (int j = 0; j < 8; ++j)
#pragma unroll
        for (int e = 0; e < 4; ++e) { am = fmaxf(am, fabsf(v[j][e])); sq += v[j][e] * v[j][e]; }
    am = wave_max(am); sq = wave_sum(sq);
    const float step = fmaxf(0.48f * sqrtf(sq * (1.0f / D)), am * (1.0f / 18.0f));
    const float inv = (step > 0.f) ? 1.0f / step : 0.f;
    if (lane == 0) *scale_out = step;
    v4u o;
#pragma unroll
    for (int d = 0; d < 4; ++d) {
        unsigned w = 0u;
#pragma unroll
        for (int e = 0; e < 4; ++e) w |= (fp4_code(v[2 * d][e] * inv) | (fp4_code(v[2 * d + 1][e] * inv) << 4)) << (8 * e);
        if (d == 0) o.x = w; else if (d == 1) o.y = w; else if (d == 2) o.z = w; else o.w = w;
    }
    *(v4u*)(dst + 16 * lane) = o;
}
__device__ __forceinline__ void phase0(const Ctx& c, const float* const* in, unsigned char* ws) {
    const float* cvec = in[1]; const float* w_mod = in[3]; const float* w_in = in[6]; const float* w_pool = in[7]; const float* w_out = in[9];
    const float* w_query = in[11]; const float* sub_keys = in[12]; const float* peer_u = in[13]; const float* peer_v = in[14];
    LAS float* scr = (LAS float*)(c.lds + c.wave * 16384);
    if (c.gw < MOD_ITEMS) p0_mod_item(cvec, w_mod, (float*)(ws + WS_MODP), c.gw, c.lane);
    constexpr int I_IN = 32 * 128, I_OUT = 32 * 64, I_POOL = 4 * 32;
    for (int it = c.gw; it < I_IN + I_OUT + I_POOL; it += c.ngw) {
        int r = it;
        if (r < I_IN) { p0_transpose_item(w_in, D, INW, (bf16*)(ws + WS_WTIN), 0, scr, r, c.lane); continue; } r -= I_IN;
        if (r < I_OUT) { p0_transpose_item(w_out, D, D, (bf16*)(ws + WS_WTOUT), 0, scr, r, c.lane); continue; } r -= I_OUT;
        { const int g = r >> 5; p0_transpose_item(w_pool + (size_t)g * 65536, 256, 256, (bf16*)(ws + WS_WTPOOL), g * 256, scr, r & 31, c.lane); }
    }
#if TOPK_SIMPLE
    for (int r = c.gw; r < 2048; r += c.ngw) {
        const int p = (r >> 7) & 1, k = 4 * c.lane; v2u o = {0u, 0u};
        if ((k >> 7) == p) { const f32x4 s = *(const f32x4*)(sub_keys + (size_t)r * 128 + (k & 127)); o.x = pk2(s[0], s[1]); o.y = pk2(s[2], s[3]); }
        *(v2u*)((bf16*)(ws + WS_SKP) + (size_t)r * 256 + k) = o;
    }
#else
    for (int r = c.gw; r < 2048; r += c.ngw) {
        const float a = sub_keys[(size_t)r * 128 + 2 * c.lane], b = sub_keys[(size_t)r * 128 + 2 * c.lane + 1];
        *(unsigned*)((bf16*)(ws + WS_SKP) + (size_t)r * 128 + 2 * c.lane) = pk2(a, b);
    }
#endif
    if (c.gw >= MOD_ITEMS) {
        const int stride = c.ngw - MOD_ITEMS;
        int r = c.gw - MOD_ITEMS;
        f32x4 va[8], vb[8];
#define P0_SRC(R) (((R) < PE_EXP) ? peer_u + (size_t)(R) * D : peer_v + (size_t)((R) - PE_EXP) * D)
#define P0_FIN(V, R) do { if ((R) < PE_EXP) { if (U_MFMA) p0_quant_finish_fp4(V, ws + WS_PU + (size_t)(R) * 1024, (float*)(ws + WS_SU) + (R), c.lane); else p0_quant_finish4<0x88u>(V, ws + WS_PU + (size_t)(R) * 1024, (float*)(ws + WS_SU) + (R), c.lane); } \
                          else { if (V_MFMA) p0_quant_finish_fp4(V, ws + WS_PV + (size_t)((R) - PE_EXP) * 1024, (float*)(ws + WS_SV) + ((R) - PE_EXP), c.lane); else p0_quant_finish4<0x80u>(V, ws + WS_PV + (size_t)((R) - PE_EXP) * 1024, (float*)(ws + WS_SV) + ((R) - PE_EXP), c.lane); } } while (0)
        if (r < 2 * PE_EXP) p0_quant_load4(P0_SRC(r), c.lane, va);
        while (r < 2 * PE_EXP) {
            const int r1 = r + stride, r2 = r + 2 * stride;
            if (r1 < 2 * PE_EXP) p0_quant_load4(P0_SRC(r1), c.lane, vb);
            P0_FIN(va, r);
            if (r1 >= 2 * PE_EXP) break;
            if (r2 < 2 * PE_EXP) p0_quant_load4(P0_SRC(r2), c.lane, va);
            P0_FIN(vb, r1);
            r = r2;
        }
#undef P0_SRC
#undef P0_FIN
    }
}

__device__ __forceinline__ void p1_fold_q_item(const float* W, bf16* WQ2, float* BIASP, const LAS float* A2s, const LAS float* B2s, LAS float* scr, int item, int lane) {
    const int kb = item >> 6, nb = item & 63, k0 = 64 * kb, n0 = 32 * nb;
#pragma unroll 8
    for (int i = 0; i < 32; ++i) { const int kk = 2 * i + (lane >> 5); scr[kk * 33 + (lane & 31)] = W[(size_t)(k0 + kk) * D + n0 + (lane & 31)]; }
    LDS_WAIT(); asm volatile("" ::: "memory");
    {
        const int bb = lane >> 5, n = lane & 31; float sacc = 0.f;
#pragma unroll 8
        for (int kk = 0; kk < 64; ++kk) sacc += B2s[bb * D + k0 + kk] * scr[kk * 33 + n];
        BIASP[((size_t)kb * 2 + bb) * D + n0 + n] = sacc;
    }
    const int c8 = lane & 7;
#pragma unroll
    for (int bb = 0; bb < 2; ++bb) {
        const f32x4 a0 = *(const LAS f32x4*)(A2s + bb * D + k0 + 8 * c8), a1 = *(const LAS f32x4*)(A2s + bb * D + k0 + 8 * c8 + 4);
#pragma unroll
        for (int j = 0; j < 4; ++j) { const int n = (lane >> 3) + 8 * j; const LAS float* t = scr + (8 * c8) * 33 + n;
            v4u o; o.x = pk2(t[0 * 33] * a0[0], t[1 * 33] * a0[1]); o.y = pk2(t[2 * 33] * a0[2], t[3 * 33] * a0[3]); o.z = pk2(t[4 * 33] * a1[0], t[5 * 33] * a1[1]); o.w = pk2(t[6 * 33] * a1[2], t[7 * 33] * a1[3]);
            *(v4u*)(WQ2 + ((size_t)bb * D + n0 + n) * D + k0 + 8 * c8) = o; }
    }
    LDS_WAIT(); asm volatile("" ::: "memory");
}
template <bool FIRST>
__device__ __forceinline__ void phase_rows(const Ctx& c, const float* X, const bf16* XB, const float* gvec, const float* b_mod, const int* positions, unsigned char* ws, int shift_chunk, int scale_chunk, const float* gvec2 = nullptr, const float* w_query = nullptr) {
    LAS float* A1 = (LAS float*)c.lds; LAS float* B1 = A1 + D;
    const int b = c.vcu >> 7;
    const float* MODP = (const float*)(ws + WS_MODP); float* MODF = (float*)(ws + WS_MODF);
    {
        const int j = 4 * c.tid;
        f32x4 sh, sc;
        if (FIRST) {
            sh = *(const f32x4*)(b_mod + shift_chunk * D + j); sc = *(const f32x4*)(b_mod + scale_chunk * D + j);
#pragma unroll
            for (int s = 0; s < 8; ++s) { sh += *(const f32x4*)(MODP + ((size_t)s * 2 + b) * NMOD + shift_chunk * D + j); sc += *(const f32x4*)(MODP + ((size_t)s * 2 + b) * NMOD + scale_chunk * D + j); }
        } else { sh = *(const f32x4*)(MODF + (size_t)b * NMOD + shift_chunk * D + j); sc = *(const f32x4*)(MODF + (size_t)b * NMOD + scale_chunk * D + j); }
        const f32x4 g = *(const f32x4*)(gvec + j);
        *(LAS f32x4*)(A1 + j) = g * (sc + 1.0f); *(LAS f32x4*)(B1 + j) = sh;
    }
    LAS float* A2s = (LAS float*)(c.lds + 16384); LAS float* B2s = A2s + 2 * D;
    if (FIRST) {
        const int j = 4 * c.tid; const f32x4 g2v = *(const f32x4*)(gvec2 + j);
#pragma unroll
        for (int bb = 0; bb < 2; ++bb) {
            f32x4 sh = *(const f32x4*)(b_mod + 3 * D + j), sc = *(const f32x4*)(b_mod + 4 * D + j);
#pragma unroll
            for (int sx = 0; sx < 8; ++sx) { sh += *(const f32x4*)(MODP + ((size_t)sx * 2 + bb) * NMOD + 3 * D + j); sc += *(const f32x4*)(MODP + ((size_t)sx * 2 + bb) * NMOD + 4 * D + j); }
            *(LAS f32x4*)(A2s + bb * D + j) = g2v * (sc + 1.0f); *(LAS f32x4*)(B2s + bb * D + j) = sh;
        }
    }
    if (FIRST && c.vcu < 48 && c.tid < 256) {
        const int col = 256 * c.vcu + c.tid;
#pragma unroll
        for (int bb = 0; bb < 2; ++bb) { float v = b_mod[col];
#pragma unroll
            for (int s = 0; s < 8; ++s) v += MODP[((size_t)s * 2 + bb) * NMOD + col];
            MODF[(size_t)bb * NMOD + col] = v; }
    }
    __syncthreads();
    if (FIRST) {
        LAS float* scr = (LAS float*)(c.lds + 49152 + c.wave * 8448);
        p1_fold_q_item(w_query, (bf16*)(ws + WS_WQ2), (float*)(ws + WS_BIASP), A2s, B2s, scr, c.gw, c.lane);
    }
    bf16* HB = (bf16*)(ws + WS_HB);
    for (int i = 0; i < 8; ++i) {
        const int t = 64 * c.vcu + 8 * c.wave + i;
        f32x4 v[8]; float ss = 0.f;
#pragma unroll
        for (int q = 0; q < 8; ++q) {
            if (FIRST) v[q] = __builtin_nontemporal_load((const f32x4*)(X + (size_t)t * D + 4 * c.lane + 256 * q));
            else { const v2u w = *(const v2u*)(XB + (size_t)t * D + 4 * c.lane + 256 * q); v[q] = (f32x4){bflo(w.x), bfhi(w.x), bflo(w.y), bfhi(w.y)}; }
            ss += (v[q][0] * v[q][0] + v[q][1] * v[q][1]) + (v[q][2] * v[q][2] + v[q][3] * v[q][3]); }
        const float rstd = 1.0f / sqrtf(wave_sum(ss) * (1.0f / D) + NORM_EPS);
        bf16* hr = HB + (size_t)t * D + 4 * c.lane;
#pragma unroll
        for (int q = 0; q < 8; ++q) {
            const f32x4 a = *(const LAS f32x4*)(A1 + 256 * q + 4 * c.lane), bb = *(const LAS f32x4*)(B1 + 256 * q + 4 * c.lane);
            const f32x4 y = v[q] * rstd * a + bb;
            v2u o; o.x = pk2(y[0], y[1]); o.y = pk2(y[2], y[3]);
            *(v2u*)(hr + 256 * q) = o;
        }
        if (FIRST && c.lane < 32) {
            const int fi = c.lane & 15;
            const float inv = (float)pow(500000.0, -(double)fi / 16.0);
            const float ang = (float)positions[t] * inv;
            ((float*)(ws + WS_CS))[(size_t)t * 32 + c.lane] = (c.lane < 16) ? cosf(ang) : sinf(ang);
        }
    }
    __syncthreads();
}

template <int P>
__device__ __forceinline__ void poolr_item(const bf16* U, bf16* RB, int t, int c0) {
    const int tb = t & (SEQ - 1);
    float s[8] = {0.f, 0.f, 0.f, 0.f, 0.f, 0.f, 0.f, 0.f}, u0[8];
    v4u w[P];
#pragma unroll
    for (int j = 0; j < P; ++j) w[j] = *(const v4u*)(U + (size_t)(t - (j <= tb ? j : tb)) * 1024 + c0);
#pragma unroll
    for (int j = 0; j < P; ++j) {
        const float m = (j <= tb) ? 1.0f : 0.0f;
        const float f[8] = {bflo(w[j].x), bfhi(w[j].x), bflo(w[j].y), bfhi(w[j].y), bflo(w[j].z), bfhi(w[j].z), bflo(w[j].w), bfhi(w[j].w)};
#pragma unroll
        for (int e = 0; e < 8; ++e) { s[e] += m * f[e]; if (j == 0) u0[e] = f[e]; }
    }
    const int cnt = (tb + 1 < P) ? tb + 1 : P;
    const float ic = 1.0f / (float)cnt;
    v4u o; o.x = pk2(s[0] * ic - u0[0], s[1] * ic - u0[1]); o.y = pk2(s[2] * ic - u0[2], s[3] * ic - u0[3]);
    o.z = pk2(s[4] * ic - u0[4], s[5] * ic - u0[5]); o.w = pk2(s[6] * ic - u0[6], s[7] * ic - u0[7]);
    *(v4u*)(RB + (size_t)t * 1024 + c0) = o;
}
__device__ __forceinline__ void phase_poolr(const Ctx& c, unsigned char* ws) {
    const bf16* U = (const bf16*)(ws + WS_U); bf16* RB = (bf16*)(ws + WS_RB);
    LAS unsigned char* tile = c.lds;
    const int ch = c.tid & 31, rg = c.tid >> 5;
    for (int it = c.vcu; it < 1024; it += c.G) {
        const int g = it & 3, t0 = 64 * (it >> 2), P = 2 << g, tb0 = t0 & (SEQ - 1), nrows = 63 + P;
        __syncthreads();
        for (int id = c.tid; id < nrows * 32; id += NTHREADS) {
            const int lr = id >> 5, cc = id & 31, dt = lr - (P - 1);
            v4u w = {0u, 0u, 0u, 0u};
            if (tb0 + dt >= 0) w = *(const v4u*)(U + (size_t)(t0 + dt) * 1024 + 256 * g + 8 * cc);
            *(LAS v4u*)(tile + lr * 512 + cc * 16) = w;
        }
        __syncthreads();
        float sacc[8];
#pragma unroll
        for (int e = 0; e < 8; ++e) sacc[e] = 0.f;
        const int r0 = 4 * rg;
        for (int j = 0; j < P; ++j) {
            const v4u w = *(const LAS v4u*)(tile + (r0 + P - 1 - j) * 512 + ch * 16);
            sacc[0] += bflo(w.x); sacc[1] += bfhi(w.x); sacc[2] += bflo(w.y); sacc[3] += bfhi(w.y); sacc[4] += bflo(w.z); sacc[5] += bfhi(w.z); sacc[6] += bflo(w.w); sacc[7] += bfhi(w.w);
        }
#pragma unroll
        for (int i = 0; i < 4; ++i) {
            const int r = r0 + i, tb = tb0 + r;
            const v4u wu = *(const LAS v4u*)(tile + (r + P - 1) * 512 + ch * 16);
            const float u0[8] = {bflo(wu.x), bfhi(wu.x), bflo(wu.y), bfhi(wu.y), bflo(wu.z), bfhi(wu.z), bflo(wu.w), bfhi(wu.w)};
            if (i > 0) {
                const v4u wo = *(const LAS v4u*)(tile + (r - 1) * 512 + ch * 16);
                const float uo[8] = {bflo(wo.x), bfhi(wo.x), bflo(wo.y), bfhi(wo.y), bflo(wo.z), bfhi(wo.z), bflo(wo.w), bfhi(wo.w)};
#pragma unroll
                for (int e = 0; e < 8; ++e) sacc[e] += u0[e] - uo[e];
            }
            const int cnt = (tb + 1 < P) ? tb + 1 : P;
            const float ic = 1.0f / (float)cnt;
            v4u o; o.x = pk2(sacc[0] * ic - u0[0], sacc[1] * ic - u0[1]); o.y = pk2(sacc[2] * ic - u0[2], sacc[3] * ic - u0[3]);
            o.z = pk2(sacc[4] * ic - u0[4], sacc[5] * ic - u0[5]); o.w = pk2(sacc[6] * ic - u0[6], sacc[7] * ic - u0[7]);
            *(v4u*)(RB + (size_t)(t0 + r) * 1024 + 256 * g + 8 * ch) = o;
        }
    }
    __syncthreads();
}

__device__ __forceinline__ void phase_attn_simple(const Ctx& c, unsigned char* ws) {
    const bf16* QB = (const bf16*)(ws + WS_Q); const bf16* KB = (const bf16*)(ws + WS_K); const bf16* VB = (const bf16*)(ws + WS_V); bf16* HC = (bf16*)(ws + WS_HC);
    LAS float* pb = (LAS float*)(c.lds + c.wave * 2048);
    const float NEG = -3.0e38f;
    for (int item = c.gw; item < T * NH; item += c.ngw) {
        const int t = item >> 3, h = item & 7, tb = t & (SEQ - 1);
        const v4u* qp = (const v4u*)(QB + (size_t)t * 1024 + h * 128);
        v4u q[16];
#pragma unroll
        for (int i = 0; i < 16; ++i) q[i] = qp[i];
        float sv[7]; float mx = NEG;
#pragma unroll
        for (int r = 0; r < 7; ++r) {
            const int e = c.lane + 64 * r, pat = e / 129, j = e - pat * 129, off = j << (2 * pat);
            const bool valid = (e < 387) && (off <= tb);
            float s = NEG;
            if (valid) {
                const v4u* kp = (const v4u*)(KB + (size_t)(t - off) * 1024 + h * 128);
                float a0 = 0.f, a1 = 0.f;
#pragma unroll
                for (int i = 0; i < 16; ++i) { const v4u kk = kp[i]; a0 = dot2(q[i].x, kk.x, a0); a1 = dot2(q[i].y, kk.y, a1); a0 = dot2(q[i].z, kk.z, a0); a1 = dot2(q[i].w, kk.w, a1); }
                s = a0 + a1;
            }
            sv[r] = s; mx = fmaxf(mx, s);
        }
        mx = wave_max(mx);
        float l = 0.f;
#pragma unroll
        for (int r = 0; r < 7; ++r) { const float p = (sv[r] > -1.0e38f) ? exp2f(sv[r] - mx) : 0.f; l += p; pb[c.lane + 64 * r] = p; }
        l = wave_sum(l);
        LDS_WAIT();
        float o0 = 0.f, o1 = 0.f;
        for (int e = 0; e < 387; ++e) {
            const int pat = e / 129, j = e - pat * 129, off = j << (2 * pat);
            if (off > tb) continue;
            const float pe = pb[e];
            const unsigned w = *(const unsigned*)(VB + (size_t)(t - off) * 1024 + h * 128 + 2 * c.lane);
            o0 += pe * bflo(w); o1 += pe * bfhi(w);
        }
        const float il = 1.0f / l;
        *(unsigned*)(HC + (size_t)t * 2048 + h * 128 + 2 * c.lane) = pk2(o0 * il, o1 * il);
        LDS_WAIT();
    }
}

__device__ __forceinline__ unsigned off_k(unsigned row, unsigned ch) { return 256u * row + 16u * (ch ^ ((row & 3u) | (((row >> 3) & 3u) << 2))); }
__device__ __forceinline__ unsigned off_b(unsigned row, unsigned ch) { return 256u * row + 16u * (ch ^ (((row & 3u) << 2) | ((row >> 2) & 3u))); }
typedef short s4v __attribute__((ext_vector_type(4)));
__device__ __forceinline__ void phase_attn_mfma(const Ctx& c, unsigned char* ws) {
    const bf16* QB = (const bf16*)(ws + WS_Q); const bf16* KB = (const bf16*)(ws + WS_K); const bf16* VB = (const bf16*)(ws + WS_V);
    float* LSE = (float*)(ws + WS_LSE);
    const int g = c.lane >> 4, lq = c.lane & 15;
    const float NEG = -3.0e38f;
    const int i0 = 16 * c.wave, jb = 32 * (c.wave >> 1), iq = i0 + lq;
    unsigned kaddr[2][4], vbase[2], vxor[2];
    {
        const unsigned rowa = (unsigned)(jb + 8 * (lq >> 2) + (lq & 3));
        const unsigned q4 = (unsigned)(lq >> 2), p4 = (unsigned)(c.lane & 3);
#pragma unroll
        for (int s4 = 0; s4 < 4; ++s4) { kaddr[0][s4] = off_k(rowa, (unsigned)(4 * s4 + g)); kaddr[1][s4] = off_k(rowa + 4u, (unsigned)(4 * s4 + g)); }
#pragma unroll
        for (int t = 0; t < 2; ++t) {
            const unsigned row = (unsigned)(jb + 8 * g + 4 * t) + q4, f = ((row & 3u) << 2) | ((row >> 2) & 3u);
            vxor[t] = 16u * (f & 14u);
            vbase[t] = 65536u + 256u * row + 16u * ((p4 >> 1) ^ (f & 1u)) + 8u * (p4 & 1u);
        }
    }
    v4u kreg[8], vreg[8]; pg8::bf16x8 qnext[4];
#define ATTN_DECODE(U) const int p_ = (U) >> 10, rem_ = (U) & 1023, bh_ = rem_ >> 6, rn_ = rem_ & 63, b_ = bh_ >> 3, h_ = bh_ & 7; \
        const int dsh_ = 2 * p_, nbl_ = 64 >> dsh_, r_ = rn_ / nbl_, n_ = rn_ - r_ * nbl_; \
        const int tok0q_ = b_ * SEQ + r_ + ((n_ * 128) << dsh_), tok0k_ = tok0q_ - (128 << dsh_);
#define ATTN_ISSUE(U) do { ATTN_DECODE(U) \
        const unsigned rstr_ = 2048u << dsh_;                         \
        const unsigned off0_ = (unsigned)(tok0k_ + ((c.tid >> 4) << dsh_)) * 2048u + (unsigned)(h_ * 256 + (c.tid & 15) * 16); \
        _Pragma("unroll") for (int i_ = 0; i_ < 8; ++i_) {           \
            v4u kv_ = {0u, 0u, 0u, 0u}, vv_ = kv_; \
            if (i_ >= 4 || n_ > 0) { const unsigned o_ = off0_ + (unsigned)(32 * i_) * rstr_; kv_ = *(const v4u*)((const unsigned char*)KB + o_); vv_ = *(const v4u*)((const unsigned char*)VB + o_); } \
            kreg[i_] = kv_; vreg[i_] = vv_; } \
        const int tokq_ = tok0q_ + (iq << dsh_); \
        _Pragma("unroll") for (int s_ = 0; s_ < 4; ++s_) qnext[s_] = *(const pg8::bf16x8*)(QB + (size_t)tokq_ * 1024 + h_ * 128 + 32 * s_ + 8 * g); } while (0)
    ATTN_ISSUE(c.vcu);
    for (int unit = c.vcu; unit < 3072; unit += c.G) {
        ATTN_DECODE(unit)
        const int p = p_, h = h_, n = n_, dsh = dsh_, tok0q = tok0q_;
        bf16* OP = (bf16*)(ws + (p == 0 ? WS_OP0 : (p == 1 ? WS_OP1 : WS_OP2)));
        __syncthreads();
#pragma unroll
        for (int i = 0; i < 8; ++i) {
            const int id = c.tid + 512 * i, row = id >> 4, ch = id & 15;
            *(LAS v4u*)(c.lds + off_k((unsigned)row, (unsigned)ch)) = kreg[i]; *(LAS v4u*)(c.lds + 65536u + off_b((unsigned)row, (unsigned)ch)) = vreg[i];
        }
        const int tokq = tok0q + (iq << dsh);
        pg8::bf16x8 qf[4];
#pragma unroll
        for (int s4 = 0; s4 < 4; ++s4) qf[s4] = qnext[s4];
        __syncthreads();
        if (unit + c.G < 3072) ATTN_ISSUE(unit + c.G);
        f32x4 sa[5], sb[5];
#pragma unroll
        for (int kt = 0; kt < 5; ++kt) {
            f32x4 aa = {0.f, 0.f, 0.f, 0.f}, ab = aa;
#pragma unroll
            for (int s4 = 0; s4 < 4; ++s4) {
                const pg8::bf16x8 ka = *(const LAS pg8::bf16x8*)(c.lds + kaddr[0][s4] + 8192u * kt);
                const pg8::bf16x8 kb = *(const LAS pg8::bf16x8*)(c.lds + kaddr[1][s4] + 8192u * kt);
                aa = __builtin_amdgcn_mfma_f32_16x16x32_bf16(ka, qf[s4], aa, 0, 0, 0);
                ab = __builtin_amdgcn_mfma_f32_16x16x32_bf16(kb, qf[s4], ab, 0, 0, 0);
            }
            sa[kt] = aa; sb[kt] = ab;
        }
        const int jlo = (n > 0) ? iq : (iq > 128 ? iq : 128);
#pragma unroll
        for (int i = 0; i < 4; ++i) {
            const int ja = jb + 8 * g + i;
            sa[0][i] = (ja >= jlo) ? sa[0][i] : NEG; sb[0][i] = (ja + 4 >= jlo) ? sb[0][i] : NEG;
            sa[4][i] = (ja + 128 <= iq + 128) ? sa[4][i] : NEG; sb[4][i] = (ja + 132 <= iq + 128) ? sb[4][i] : NEG;
        }
        if (n == 0) {
#pragma unroll
            for (int kt = 1; kt < 5; ++kt)
#pragma unroll
                for (int i = 0; i < 4; ++i) { const int ja = jb + 32 * kt + 8 * g + i; sa[kt][i] = (ja >= jlo) ? sa[kt][i] : NEG; sb[kt][i] = (ja + 4 >= jlo) ? sb[kt][i] : NEG; }
        }
        float mx = NEG;
#pragma unroll
        for (int kt = 0; kt < 5; ++kt)
#pragma unroll
            for (int i = 0; i < 4; ++i) mx = fmaxf(mx, fmaxf(sa[kt][i], sb[kt][i]));
        mx = fmaxf(mx, SXOR(mx, 16, c.lane)); mx = fmaxf(mx, SXOR(mx, 32, c.lane));
        float l = 0.f;
#pragma unroll
        for (int kt = 0; kt < 5; ++kt)
#pragma unroll
            for (int i = 0; i < 4; ++i) { sa[kt][i] = __builtin_amdgcn_exp2f(sa[kt][i] - mx); sb[kt][i] = __builtin_amdgcn_exp2f(sb[kt][i] - mx); l += sa[kt][i] + sb[kt][i]; }
        l += SXOR(l, 16, c.lane); l += SXOR(l, 32, c.lane);
        f32x4 o[8];
#pragma unroll
        for (int c8 = 0; c8 < 8; ++c8) o[c8] = (f32x4){0.f, 0.f, 0.f, 0.f};
#pragma unroll
        for (int kt = 0; kt < 5; ++kt) {
            pg8::u32x4 pw; pw.x = pk2(sa[kt][0], sa[kt][1]); pw.y = pk2(sa[kt][2], sa[kt][3]); pw.z = pk2(sb[kt][0], sb[kt][1]); pw.w = pk2(sb[kt][2], sb[kt][3]);
            const pg8::bf16x8 pf = __builtin_bit_cast(pg8::bf16x8, pw);
#pragma unroll
            for (int c8 = 0; c8 < 8; ++c8) {
                const s4v t0 = __builtin_amdgcn_ds_read_tr16_b64_v4i16((LAS s4v*)(c.lds + (vbase[0] + ((32u * c8) ^ vxor[0])) + 8192u * kt));
                const s4v t1 = __builtin_amdgcn_ds_read_tr16_b64_v4i16((LAS s4v*)(c.lds + (vbase[1] + ((32u * c8) ^ vxor[1])) + 8192u * kt));
                const pg8::bf16x8 vf = __builtin_shufflevector(t0, t1, 0, 1, 2, 3, 4, 5, 6, 7);
                o[c8] = __builtin_amdgcn_mfma_f32_16x16x32_bf16(vf, pf, o[c8], 0, 0, 0);
            }
        }
        const float il = 1.0f / l;
        bf16* orow = OP + (size_t)tokq * 1024 + h * 128 + 4 * g;
#pragma unroll
        for (int c8 = 0; c8 < 8; ++c8) { v2u w; w.x = pk2(o[c8][0] * il, o[c8][1] * il); w.y = pk2(o[c8][2] * il, o[c8][3] * il); *(v2u*)(orow + 16 * c8) = w; }
        if (g == 0) LSE[((size_t)p * T + tokq) * 8 + h] = mx + __builtin_amdgcn_logf(l);
    }
    __syncthreads();
}
__device__ __forceinline__ void phase_combine(const Ctx& c, unsigned char* ws) {
    const float* LSE = (const float*)(ws + WS_LSE); bf16* HC = (bf16*)(ws + WS_HC);
    const bf16* OP0 = (const bf16*)(ws + WS_OP0); const bf16* OP1 = (const bf16*)(ws + WS_OP1); const bf16* OP2 = (const bf16*)(ws + WS_OP2);
    for (int t = c.gw; t < T; t += c.ngw) {
        const int h = c.lane >> 3;
        const float l0 = LSE[((size_t)0 * T + t) * 8 + h], l1 = LSE[((size_t)1 * T + t) * 8 + h], l2 = LSE[((size_t)2 * T + t) * 8 + h];
        const float m = fmaxf(l0, fmaxf(l1, l2));
        float w0 = exp2f(l0 - m), w1 = exp2f(l1 - m), w2 = exp2f(l2 - m);
        const float inv = 1.0f / (w0 + w1 + w2); w0 *= inv; w1 *= inv; w2 *= inv;
        const size_t off = (size_t)t * 1024 + 16 * c.lane;
#pragma unroll
        for (int hh = 0; hh < 2; ++hh) {
            const v4u a = *(const v4u*)(OP0 + off + 8 * hh), bq = *(const v4u*)(OP1 + off + 8 * hh), cq = *(const v4u*)(OP2 + off + 8 * hh);
            v4u o;
            o.x = pk2(w0 * bflo(a.x) + w1 * bflo(bq.x) + w2 * bflo(cq.x), w0 * bfhi(a.x) + w1 * bfhi(bq.x) + w2 * bfhi(cq.x));
            o.y = pk2(w0 * bflo(a.y) + w1 * bflo(bq.y) + w2 * bflo(cq.y), w0 * bfhi(a.y) + w1 * bfhi(bq.y) + w2 * bfhi(cq.y));
            o.z = pk2(w0 * bflo(a.z) + w1 * bflo(bq.z) + w2 * bflo(cq.z), w0 * bfhi(a.z) + w1 * bfhi(bq.z) + w2 * bfhi(cq.z));
            o.w = pk2(w0 * bflo(a.w) + w1 * bflo(bq.w) + w2 * bflo(cq.w), w0 * bfhi(a.w) + w1 * bfhi(bq.w) + w2 * bfhi(cq.w));
            *(v4u*)(HC + (size_t)t * 2048 + 16 * c.lane + 8 * hh) = o;
        }
    }
}

__device__ __forceinline__ int f2sort(float f) { const int b = __float_as_int(f); return b ^ ((b >> 31) & 0x7fffffff); }
__device__ __forceinline__ float sort2f(int k) { return __int_as_float(k ^ ((k >> 31) & 0x7fffffff)); }
#define CE_DESC(a, b) do { const int hi_ = max((a), (b)), lo_ = min((a), (b)); (a) = hi_; (b) = lo_; } while (0)
__device__ __forceinline__ void bitonic_merge16(int (&v)[16]) {
#pragma unroll
    for (int j = 8; j > 0; j >>= 1)
#pragma unroll
        for (int i = 0; i < 16; ++i) { const int l = i ^ j; if (l > i) CE_DESC(v[i], v[l]); }
}
__device__ __forceinline__ void sort16(int (&v)[16]) {
#pragma unroll
    for (int k = 2; k <= 16; k <<= 1)
#pragma unroll
        for (int j = k >> 1; j > 0; j >>= 1)
#pragma unroll
            for (int i = 0; i < 16; ++i) { const int l = i ^ j; if (l > i) { if ((i & k) == 0) CE_DESC(v[i], v[l]); else CE_DESC(v[l], v[i]); } }
}
__device__ __forceinline__ void merge_top16(int (&a)[16], const int (&b)[16]) {
#pragma unroll
    for (int k = 0; k < 16; ++k) a[k] = max(a[k], b[15 - k]);
    bitonic_merge16(a);
}
__device__ __forceinline__ void xlane_merge(int (&a)[16], int xr, int lane) {
    int b[16];
#pragma unroll
    for (int k = 0; k < 16; ++k) b[k] = SXOR(a[k], xr, lane);
    merge_top16(a, b);
}
__device__ __forceinline__ void phase_scores_topk(const Ctx& c, unsigned char* ws) {
    const bf16* QP = (const bf16*)(ws + WS_QP); const bf16* SKB = (const bf16*)(ws + WS_SKP);
    int* IDX = (int*)(ws + WS_IDX); float* GATE = (float*)(ws + WS_GATE);
    const int g = c.lane >> 4, lq = c.lane & 15;
    const int h = c.vcu & 7, tb = c.vcu >> 3;
    LAS unsigned char* lut = c.lds + 65536 + c.wave * 2560 + c.lane * 36;
#pragma unroll
    for (int i = 0; i < 8; ++i) {
        const int id = c.tid + 512 * i, row = id >> 4, ch = id & 15;
        *(LAS v4u*)(c.lds + off_b((unsigned)row, (unsigned)ch)) = *(const v4u*)(SKB + ((size_t)h * 256 + row) * 128 + ch * 8);
    }
    unsigned ka[4];
#pragma unroll
    for (int s4 = 0; s4 < 4; ++s4) ka[s4] = off_b((unsigned)lq, (unsigned)(4 * s4 + g));
    __syncthreads();
    for (int it = 0; it < 4; ++it) {
        const int t = 512 * tb + 128 * it + 16 * c.wave + lq;
        int top[2][16];
#pragma unroll
        for (int p = 0; p < 2; ++p) {
            pg8::bf16x8 qf[4];
#pragma unroll
            for (int s4 = 0; s4 < 4; ++s4) qf[s4] = *(const pg8::bf16x8*)(QP + (size_t)t * 2048 + h * 256 + p * 128 + 32 * s4 + 8 * g);
            int lo[16], hi[16];
#pragma unroll
            for (int c8 = 0; c8 < 8; ++c8) {
                f32x4 acc = {0.f, 0.f, 0.f, 0.f};
#pragma unroll
                for (int s4 = 0; s4 < 4; ++s4) {
                    const pg8::bf16x8 kf = *(const LAS pg8::bf16x8*)(c.lds + ka[s4] + (unsigned)(32768 * p + 4096 * c8));
                    acc = __builtin_amdgcn_mfma_f32_16x16x32_bf16(kf, qf[s4], acc, 0, 0, 0);
                }
#pragma unroll
                for (int i = 0; i < 4; ++i) { const int key = (f2sort(acc[i]) & ~127) | (16 * c8 + 4 * g + i); if (c8 < 4) lo[4 * c8 + i] = key; else hi[4 * (c8 - 4) + i] = key; }
            }
            sort16(lo); sort16(hi); merge_top16(lo, hi);
            xlane_merge(lo, 16, c.lane); xlane_merge(lo, 32, c.lane);
#pragma unroll
            for (int k = 0; k < 16; ++k) top[p][k] = lo[k];
        }
#pragma unroll
        for (int p = 0; p < 2; ++p)
#pragma unroll
            for (int q = 0; q < 4; ++q)
                *(LAS unsigned*)(lut + 16 * p + 4 * q) = (unsigned)(top[p][4 * q] & 127) | ((unsigned)(top[p][4 * q + 1] & 127) << 8) | ((unsigned)(top[p][4 * q + 2] & 127) << 16) | ((unsigned)(top[p][4 * q + 3] & 127) << 24);
        float f0[16], f1[16];
#pragma unroll
        for (int k = 0; k < 16; ++k) { f0[k] = sort2f(top[0][k] & ~127); f1[k] = sort2f(top[1][k] & ~127); }
#define CAND(a, b) ((f2sort(f0[a] + f1[b]) & ~255) | ((a) << 4) | (b))
        int X[16], Y[16], Z[16];
#pragma unroll
        for (int b2 = 0; b2 < 16; ++b2) X[b2] = CAND(0, b2);
#pragma unroll
        for (int b2 = 0; b2 < 8; ++b2) Y[b2] = CAND(1, b2);
#pragma unroll
        for (int a2 = 8; a2 < 16; ++a2) Y[23 - a2] = CAND(a2, 0);
        Z[0] = CAND(2, 0); Z[1] = CAND(2, 1); Z[2] = CAND(2, 2); Z[3] = CAND(2, 3); Z[4] = CAND(2, 4);
        Z[5] = CAND(3, 0); Z[6] = CAND(3, 1); Z[7] = CAND(3, 2); Z[8] = CAND(3, 3);
        Z[9] = CAND(4, 0); Z[10] = CAND(4, 1); Z[11] = CAND(4, 2);
        Z[12] = CAND(5, 0); Z[13] = CAND(5, 1); Z[14] = CAND(6, 0); Z[15] = CAND(6, 1);
        const int w0 = CAND(7, 0), w1 = CAND(7, 1);
#undef CAND
        bitonic_merge16(Y); sort16(Z);
        merge_top16(X, Y); merge_top16(X, Z);
        X[14] = max(X[14], w1); X[15] = max(X[15], w0); bitonic_merge16(X);
        LDS_WAIT();
        float e[16], sum = 0.f; const float fmx = sort2f(X[0] & ~255);
#pragma unroll
        for (int k = 0; k < 16; ++k) { e[k] = __expf(sort2f(X[k] & ~255) - fmx); sum += e[k]; }
        const float inv = 1.0f / sum;
        int ex[16];
#pragma unroll
        for (int k = 0; k < 16; ++k) { const int a2 = (X[k] >> 4) & 15, b2 = X[k] & 15; ex[k] = (int)(*(const LAS unsigned char*)(lut + a2)) * PE_NK + (int)(*(const LAS unsigned char*)(lut + 16 + b2)); }
        if (g == 0) {
            int* ip = IDX + (size_t)t * 128 + h * 16; float* gp = GATE + (size_t)t * 128 + h * 16;
#pragma unroll
            for (int q = 0; q < 4; ++q) {
                *(int4*)(ip + 4 * q) = make_int4(ex[4 * q], ex[4 * q + 1], ex[4 * q + 2], ex[4 * q + 3]);
                *(f32x4*)(gp + 4 * q) = (f32x4){e[4 * q] * inv, e[4 * q + 1] * inv, e[4 * q + 2] * inv, e[4 * q + 3] * inv};
            }
        }
        LDS_WAIT();
    }
    __syncthreads();
}

__device__ __forceinline__ void phase_topk_simple(const Ctx& c, unsigned char* ws) {
    const float* SC = (const float*)(ws + WS_SC); int* IDX = (int*)(ws + WS_IDX); float* GATE = (float*)(ws + WS_GATE);
    const float NEG = -3.0e38f;
    for (int item = c.gw; item < T * PE_HEADS; item += c.ngw) {
        const int t = item >> 3, h = item & 7;
        const float* sc = SC + (size_t)t * 2048 + h * 256;
        float sh[2] = {0.f, 0.f}; int ih[2] = {0, 0};
#pragma unroll
        for (int p = 0; p < 2; ++p) {
            float va = sc[128 * p + c.lane], vb = sc[128 * p + 64 + c.lane];
            for (int r = 0; r < PE_K; ++r) {
                const float M = wave_max(fmaxf(va, vb));
                const unsigned long long ba = __ballot(va == M), bb = __ballot(vb == M);
                const int n = ba ? (int)__builtin_ctzll(ba) : 64 + (int)__builtin_ctzll(bb);
                if (c.lane == r) { sh[p] = M; ih[p] = n; }
                if (n < 64) { if (c.lane == n) va = NEG; } else { if (c.lane == n - 64) vb = NEG; }
            }
        }
        float cv[4];
#pragma unroll
        for (int q = 0; q < 4; ++q) { const int cc = c.lane + 64 * q; cv[q] = sh_idx(sh[0], cc >> 4) + sh_idx(sh[1], cc & 15); }
        float ts = NEG; int tc = 0;
        for (int r = 0; r < PE_K; ++r) {
            const float M = wave_max(fmaxf(fmaxf(cv[0], cv[1]), fmaxf(cv[2], cv[3])));
            int cc = -1;
#pragma unroll
            for (int q = 3; q >= 0; --q) { const unsigned long long bq = __ballot(cv[q] == M); if (bq) cc = 64 * q + (int)__builtin_ctzll(bq); }
            if (c.lane == r) { ts = M; tc = cc; }
#pragma unroll
            for (int q = 0; q < 4; ++q) if (cc == c.lane + 64 * q) cv[q] = NEG;
        }
        const int i0 = sh_idx(ih[0], tc >> 4), i1 = sh_idx(ih[1], tc & 15);
        const float tmax = sh_idx(ts, 0);
        const float ex = (c.lane < PE_K) ? __expf(ts - tmax) : 0.f;
        const float sum = wave_sum(ex);
        if (c.lane < PE_K) { IDX[(size_t)t * 128 + h * 16 + c.lane] = i0 * PE_NK + i1; GATE[(size_t)t * 128 + h * 16 + c.lane] = ex / sum; }
    }
}

__device__ __forceinline__ void ld_row8(const unsigned char* tab, int e, int lane, v4u (&r)[2]) {
    const v4u* p = (const v4u*)(tab + (size_t)e * D) + lane;
    r[0] = p[0]; r[1] = p[64];
}
__device__ __forceinline__ int idot_row(const int (&h)[8], const v4u (&r)[2]) {
    int a = 0, b = 0;
    a = __builtin_amdgcn_sdot4(h[0], (int)r[0].x, a, false); b = __builtin_amdgcn_sdot4(h[1], (int)r[0].y, b, false);
    a = __builtin_amdgcn_sdot4(h[2], (int)r[0].z, a, false); b = __builtin_amdgcn_sdot4(h[3], (int)r[0].w, b, false);
    a = __builtin_amdgcn_sdot4(h[4], (int)r[1].x, a, false); b = __builtin_amdgcn_sdot4(h[5], (int)r[1].y, b, false);
    a = __builtin_amdgcn_sdot4(h[6], (int)r[1].z, a, false); b = __builtin_amdgcn_sdot4(h[7], (int)r[1].w, b, false);
    return a + b;
}
__device__ __forceinline__ int reduce8(const int (&p)[8], int lane) {
    const bool b0 = lane & 1, b1 = lane & 2, b2 = lane & 4;
    int q[4], r2[2];
#pragma unroll
    for (int i = 0; i < 4; ++i) { const int keep = b0 ? p[2 * i + 1] : p[2 * i], send = b0 ? p[2 * i] : p[2 * i + 1]; q[i] = keep + SXOR(send, 1, lane); }
#pragma unroll
    for (int i = 0; i < 2; ++i) { const int keep = b1 ? q[2 * i + 1] : q[2 * i], send = b1 ? q[2 * i] : q[2 * i + 1]; r2[i] = keep + SXOR(send, 2, lane); }
    int v = (b2 ? r2[1] : r2[0]) + SXOR(b2 ? r2[0] : r2[1], 4, lane);
    v += SXOR(v, 8, lane); v += SXOR(v, 16, lane); v += SXOR(v, 32, lane);
    return v;
}
__device__ __forceinline__ void axpy_row8(float (&y)[32], float a, const v4u (&r)[2]) {
#pragma unroll
    for (int q = 0; q < 2; ++q) {
        const unsigned w[4] = {r[q].x, r[q].y, r[q].z, r[q].w};
#pragma unroll
        for (int d = 0; d < 4; ++d) {
            y[16 * q + 4 * d + 0] += a * (float)(w[d] & 0xffu); y[16 * q + 4 * d + 1] += a * (float)((w[d] >> 8) & 0xffu);
            y[16 * q + 4 * d + 2] += a * (float)((w[d] >> 16) & 0xffu); y[16 * q + 4 * d + 3] += a * (float)(w[d] >> 24);
        }
    }
}
__device__ __forceinline__ void phase_peer(const Ctx& c, const float* X1, const float* final_g, float* out, unsigned char* ws) {
    const unsigned char* PU = ws + WS_PU; const unsigned char* PV = ws + WS_PV; const bf16* HB = (const bf16*)(ws + WS_HB);
    const float* SU = (const float*)(ws + WS_SU); const float* SV = (const float*)(ws + WS_SV);
    const int* IDX = (const int*)(ws + WS_IDX); const float* GATE = (const float*)(ws + WS_GATE); const float* MODF = (const float*)(ws + WS_MODF);
    LAS float* G2 = (LAS float*)c.lds; LAS float* FG = G2 + D;
    const int b = c.vcu >> 7;
    { const int j = 4 * c.tid; *(LAS f32x4*)(G2 + j) = *(const f32x4*)(MODF + (size_t)b * NMOD + 5 * D + j); *(LAS f32x4*)(FG + j) = *(const f32x4*)(final_g + j); }
    __syncthreads();
#pragma unroll 1
    for (int i = (DUP & 1024) ? -8 : 0; i < 8; ++i) {
        const int t = 64 * c.vcu + 8 * c.wave + (i & 7);
        const int e0 = IDX[(size_t)t * 128 + c.lane], e1 = IDX[(size_t)t * 128 + 64 + c.lane];
        const float g0 = GATE[(size_t)t * 128 + c.lane], g1 = GATE[(size_t)t * 128 + 64 + c.lane];
        v4u r[8][2];
#pragma unroll
        for (int q = 0; q < 8; ++q) ld_row8(PU, __builtin_amdgcn_readlane(e0, q), c.lane, r[q]);
        const float su0 = SU[e0], su1 = SU[e1], sv0 = SV[e0], sv1 = SV[e1];
        int hq[8]; float sh;
        {
            float hf[32]; float am = 0.f;
#pragma unroll
            for (int q = 0; q < 2; ++q)
#pragma unroll
                for (int rr = 0; rr < 2; ++rr) {
                    const v4u w = *(const v4u*)(HB + (size_t)t * D + 1024 * q + 16 * c.lane + 8 * rr);
                    float* f = hf + 16 * q + 8 * rr;
                    f[0] = bflo(w.x); f[1] = bfhi(w.x); f[2] = bflo(w.y); f[3] = bfhi(w.y); f[4] = bflo(w.z); f[5] = bfhi(w.z); f[6] = bflo(w.w); f[7] = bfhi(w.w);
                }
#pragma unroll
            for (int k = 0; k < 32; ++k) am = fmaxf(am, fabsf(hf[k]));
            am = wave_max(am);
            const float inv = (am > 0.f) ? 127.0f / am : 0.f; sh = am * (1.0f / 127.0f);
#pragma unroll
            for (int d = 0; d < 8; ++d) { unsigned w = 0u;
#pragma unroll
                for (int e = 0; e < 4; ++e) { const int qv = __float2int_rn(hf[4 * d + e] * inv); w |= ((unsigned)qv & 0xffu) << (8 * e); }
                hq[d] = (int)w; }
        }
        int ia0 = 0, ia1 = 0;
#pragma unroll 1
        for (int m = 0; m < 16; ++m) {
            int part[8];
#pragma unroll
            for (int q = 0; q < 8; ++q) {
                part[q] = idot_row(hq, r[q]);
                const int kn = 8 * (m + 1) + q;
                if (m < 15) { const int en = (kn < 64) ? __builtin_amdgcn_readlane(e0, kn & 63) : __builtin_amdgcn_readlane(e1, kn & 63); ld_row8(PU, en, c.lane, r[q]); }
            }
            const int v = reduce8(part, c.lane);
            if (m < 8) { if ((c.lane >> 3) == m) ia0 = v; } else { if ((c.lane >> 3) == m - 8) ia1 = v; }
        }
#pragma unroll
        for (int q = 0; q < 8; ++q) ld_row8(PV, __builtin_amdgcn_readlane(e0, q), c.lane, r[q]);
        const float a0 = (float)ia0 * su0 * sh, a1 = (float)ia1 * su1 * sh;
        const float c0 = 0.5f * a0 * (1.0f + erff(a0 * 0.70710678118654752f)) * g0 * sv0;
        const float c1 = 0.5f * a1 * (1.0f + erff(a1 * 0.70710678118654752f)) * g1 * sv1;
        const float csum = wave_sum(c0 + c1);
        float y[32];
#pragma unroll
        for (int q = 0; q < 32; ++q) y[q] = 0.f;
#pragma unroll 1
        for (int m = 0; m < 16; ++m) {
#pragma unroll
            for (int q = 0; q < 8; ++q) {
                const int k = 8 * m + q;
                const float ck = __uint_as_float((k < 64) ? __builtin_amdgcn_readlane(__float_as_uint(c0), k & 63) : __builtin_amdgcn_readlane(__float_as_uint(c1), k & 63));
                axpy_row8(y, ck, r[q]);
                const int kn = k + 8;
                if (m < 15) { const int en = (kn < 64) ? __builtin_amdgcn_readlane(e0, kn & 63) : __builtin_amdgcn_readlane(e1, kn & 63); ld_row8(PV, en, c.lane, r[q]); }
            }
        }
        const float* xr = X1 + (size_t)t * D + 16 * c.lane; float* orow = ((DUP & 1024) && i < 0 ? (float*)(ws + WS_HC) : out) + (size_t)t * D + 16 * c.lane;
        const float yoff = 128.0f * csum;
        float ss = 0.f;
#pragma unroll
        for (int q = 0; q < 2; ++q)
#pragma unroll
            for (int d = 0; d < 4; ++d) {
                const f32x4 xa = *(const f32x4*)(xr + 1024 * q + 4 * d);
                const f32x4 ga = *(const LAS f32x4*)(G2 + 1024 * q + 16 * c.lane + 4 * d);
#pragma unroll
                for (int e = 0; e < 4; ++e) { const float v = xa[e] + ga[e] * (y[16 * q + 4 * d + e] - yoff); y[16 * q + 4 * d + e] = v; ss += v * v; }
            }
        const float rstd = 1.0f / sqrtf(wave_sum(ss) * (1.0f / D) + NORM_EPS);
#pragma unroll
        for (int q = 0; q < 2; ++q)
#pragma unroll
            for (int d = 0; d < 4; ++d) {
                const f32x4 fa = *(const LAS f32x4*)(FG + 1024 * q + 16 * c.lane + 4 * d);
                f32x4 o;
#pragma unroll
                for (int e = 0; e < 4; ++e) o[e] = y[16 * q + 4 * d + e] * rstd * fa[e];
                *(f32x4*)(orow + 1024 * q + 4 * d) = o;
            }
    }
}

__device__ __forceinline__ v4u ld_row4(const unsigned char* tab, int e, int lane) { return *((const v4u*)(tab + (size_t)e * 1024) + lane); }
__device__ __forceinline__ int idot_row4(const int (&h)[8], const v4u& r) {
    const int w[4] = {(int)r.x, (int)r.y, (int)r.z, (int)r.w}; int ah = 0, al = 0;
#pragma unroll
    for (int d = 0; d < 4; ++d) { ah = __builtin_amdgcn_sdot8(h[d], w[d], ah, false); al = __builtin_amdgcn_sdot8(h[4 + d], w[d], al, false); }
    return 16 * ah + al;
}
__device__ __forceinline__ void vacc4(int (&y)[32], const v4u& ra, const v4u& rb, const v4u& rc, const v4u& rd, int cq4) {
    const unsigned A[4] = {ra.x, ra.y, ra.z, ra.w}, B[4] = {rb.x, rb.y, rb.z, rb.w}, C[4] = {rc.x, rc.y, rc.z, rc.w}, Dd[4] = {rd.x, rd.y, rd.z, rd.w};
#pragma unroll
    for (int d = 0; d < 4; ++d) {
        const unsigned t0 = __builtin_amdgcn_perm(A[d], B[d], 0x01050004u), t1 = __builtin_amdgcn_perm(A[d], B[d], 0x03070206u);
        const unsigned t2 = __builtin_amdgcn_perm(C[d], Dd[d], 0x01050004u), t3 = __builtin_amdgcn_perm(C[d], Dd[d], 0x03070206u);
        const unsigned T[4] = {__builtin_amdgcn_perm(t0, t2, 0x01000504u), __builtin_amdgcn_perm(t0, t2, 0x03020706u),
                               __builtin_amdgcn_perm(t1, t3, 0x01000504u), __builtin_amdgcn_perm(t1, t3, 0x03020706u)};
#pragma unroll
        for (int e = 0; e < 4; ++e) {
            y[8 * d + e] = __builtin_amdgcn_sdot4((int)(T[e] & 0x0f0f0f0fu), cq4, y[8 * d + e], false);
            y[8 * d + 4 + e] = __builtin_amdgcn_sdot4((int)T[e], cq4, y[8 * d + 4 + e], false);
        }
    }
}
#define SCHED_FENCE() __builtin_amdgcn_sched_barrier(0)
template <bool REMAP>
__device__ __forceinline__ void phase_peer4_u(const Ctx& c, const float* g2vec, unsigned char* ws) {
    const unsigned char* PU = ws + WS_PU; const bf16* HB = (const bf16*)(ws + WS_X1B);
    LAS float* A2 = (LAS float*)(c.lds + 16384); LAS float* B2 = A2 + D;
    { const float* MODF_ = (const float*)(ws + WS_MODF) + (size_t)(c.vcu >> 7) * NMOD; const int j = 4 * c.tid;
      *(LAS f32x4*)(A2 + j) = *(const f32x4*)(g2vec + j) * (*(const f32x4*)(MODF_ + 4 * D + j) + 1.0f); *(LAS f32x4*)(B2 + j) = *(const f32x4*)(MODF_ + 3 * D + j); }
    __syncthreads();
    const float* SU = (const float*)(ws + WS_SU); const float* SV = (const float*)(ws + WS_SV);
    const int* IDX = (const int*)(ws + WS_IDX); const float* GATE = (const float*)(ws + WS_GATE);
    int* TQ = (int*)(ws + (REMAP ? WS_HC : WS_TQ)); float* CSC = (float*)(ws + (REMAP ? WS_HC + 16 * MiB : WS_CSC));
    const int rm_or = (int)(blockIdx.x & 7) << 11;
#define RM(e) (REMAP ? (((e) & 2047) | rm_or) : (e))
    const int tbase = 64 * c.vcu + 8 * c.wave;
    int e0n = RM(IDX[(size_t)tbase * 128 + c.lane]), e1n = RM(IDX[(size_t)tbase * 128 + 64 + c.lane]);
    float g0n = GATE[(size_t)tbase * 128 + c.lane], g1n = GATE[(size_t)tbase * 128 + 64 + c.lane];
    v2u hraw[8];
#pragma unroll
    for (int j = 0; j < 8; ++j) hraw[j] = __builtin_nontemporal_load((const v2u*)(HB + (size_t)tbase * D + 256 * j + 4 * c.lane));
    v4u r[16];
#pragma unroll
    for (int q = 0; q < 16; ++q) r[q] = ld_row4(PU, __builtin_amdgcn_readlane(e0n, q), c.lane);
#pragma unroll 1
    for (int i = (DUP & 1024) ? -8 : 0; i < 8; ++i) {
        const int t = tbase + (i & 7), tn = tbase + ((i + 1) & 7);
        const int e0 = e0n, e1 = e1n; const float g0 = g0n, g1 = g1n;
        const float su0 = SU[e0], su1 = SU[e1], sv0 = SV[e0], sv1 = SV[e1];
        int hq[8]; float sh; int hsum;
        {
            float hf[32]; float am = 0.f, ssx = 0.f;
#pragma unroll
            for (int j = 0; j < 8; ++j) { hf[4 * j] = bflo(hraw[j].x); hf[4 * j + 1] = bfhi(hraw[j].x); hf[4 * j + 2] = bflo(hraw[j].y); hf[4 * j + 3] = bfhi(hraw[j].y); }
#pragma unroll
            for (int k = 0; k < 32; ++k) ssx += hf[k] * hf[k];
            const float rstd2 = 1.0f / sqrtf(wave_sum(ssx) * (1.0f / D) + NORM_EPS);
#pragma unroll
            for (int j = 0; j < 8; ++j) { const f32x4 av = *(const LAS f32x4*)(A2 + 256 * j + 4 * c.lane), bv = *(const LAS f32x4*)(B2 + 256 * j + 4 * c.lane);
#pragma unroll
                for (int e = 0; e < 4; ++e) hf[4 * j + e] = hf[4 * j + e] * rstd2 * av[e] + bv[e]; }
#pragma unroll
            for (int k = 0; k < 32; ++k) am = fmaxf(am, fabsf(hf[k]));
            am = wave_max(am);
            const float inv = (am > 0.f) ? 119.0f / am : 0.f; sh = am * (1.0f / 119.0f);
            int hs = 0;
#pragma unroll
            for (int d = 0; d < 4; ++d) { unsigned wh = 0u, wl = 0u;
#pragma unroll
                for (int e = 0; e < 4; ++e)
#pragma unroll
                    for (int odd = 0; odd < 2; ++odd) {
                        const int qv = __float2int_rn(hf[4 * (2 * d + odd) + e] * inv), hh = (qv + 8) >> 4, hl = qv - 16 * hh;
                        hs += qv; wh |= ((unsigned)hh & 15u) << (8 * e + 4 * odd); wl |= ((unsigned)hl & 15u) << (8 * e + 4 * odd);
                    }
                hq[d] = (int)wh; hq[4 + d] = (int)wl; }
            hsum = wave_sum_i(hs);
        }
        e0n = RM(IDX[(size_t)tn * 128 + c.lane]); e1n = RM(IDX[(size_t)tn * 128 + 64 + c.lane]);
        g0n = GATE[(size_t)tn * 128 + c.lane]; g1n = GATE[(size_t)tn * 128 + 64 + c.lane];
#pragma unroll
        for (int j = 0; j < 8; ++j) hraw[j] = __builtin_nontemporal_load((const v2u*)(HB + (size_t)tn * D + 256 * j + 4 * c.lane));
        int ia0 = 0, ia1 = 0;
#pragma unroll 1
        for (int m = 0; m < 8; ++m) {
            const int esrc = (m + 1 < 4) ? e0 : ((m + 1 < 8) ? e1 : e0n);
            int part[16];
#pragma unroll
            for (int q = 0; q < 16; ++q) {
                part[q] = idot_row4(hq, r[q]);
                SCHED_FENCE();
                r[q] = ld_row4(PU, __builtin_amdgcn_readlane(esrc, (16 * (m + 1) + q) & 63), c.lane);
                SCHED_FENCE();
            }
            int pa[8], pb[8];
#pragma unroll
            for (int q = 0; q < 8; ++q) { pa[q] = part[q]; pb[q] = part[8 + q]; }
            const int va = reduce8(pa, c.lane), vb = reduce8(pb, c.lane);
            const int grp = c.lane >> 3;
            if (m < 4) { if (grp == 2 * m) ia0 = va; if (grp == 2 * m + 1) ia0 = vb; } else { if (grp == 2 * (m - 4)) ia1 = va; if (grp == 2 * (m - 4) + 1) ia1 = vb; }
        }
        const float hoff = 0.5f * (float)hsum;
        const float a0 = ((float)ia0 + hoff) * su0 * sh, a1 = ((float)ia1 + hoff) * su1 * sh;
        const float c0 = 0.5f * a0 * (1.0f + erff(a0 * 0.70710678118654752f)) * g0 * sv0;
        const float c1 = 0.5f * a1 * (1.0f + erff(a1 * 0.70710678118654752f)) * g1 * sv1;
        const float cmx = wave_max(fmaxf(fabsf(c0), fabsf(c1)));
        const float cinv = (cmx > 0.f) ? 127.0f / cmx : 0.f, csc = cmx * (1.0f / 127.0f);
        const int q0 = __float2int_rn(c0 * cinv), q1 = __float2int_rn(c1 * cinv);
        const int cqs = wave_sum_i(q0 + q1);
        const unsigned b0 = (unsigned)q0 & 0xffu, b1 = (unsigned)q1 & 0xffu;
        const int t0 = (int)(b0 | (sh_idx(b0, c.lane + 1) << 8) | (sh_idx(b0, c.lane + 2) << 16) | (sh_idx(b0, c.lane + 3) << 24));
        const int t1 = (int)(b1 | (sh_idx(b1, c.lane + 1) << 8) | (sh_idx(b1, c.lane + 2) << 16) | (sh_idx(b1, c.lane + 3) << 24));
        TQ[(size_t)t * 128 + c.lane] = t0; TQ[(size_t)t * 128 + 64 + c.lane] = t1;
        if (c.lane == 0) { CSC[(size_t)t * 2] = csc; CSC[(size_t)t * 2 + 1] = (float)cqs; }
    }
#undef RM
}
__device__ __forceinline__ void phase_peer4_u_sorted(const Ctx& c, const float* g2vec, unsigned char* ws) {
    const unsigned char* PU = ws + WS_PU; const bf16* X1 = (const bf16*)(ws + WS_X1B);
    LAS float* A2 = (LAS float*)(c.lds + 16384); LAS float* B2 = A2 + D;
    { const float* MODF_ = (const float*)(ws + WS_MODF) + (size_t)(c.vcu >> 7) * NMOD; const int j = 4 * c.tid;
      *(LAS f32x4*)(A2 + j) = *(const f32x4*)(g2vec + j) * (*(const f32x4*)(MODF_ + 4 * D + j) + 1.0f); *(LAS f32x4*)(B2 + j) = *(const f32x4*)(MODF_ + 3 * D + j); }
    __syncthreads();
    const float* SU = (const float*)(ws + WS_SU); const float* SV = (const float*)(ws + WS_SV);
    const int* IDX = (const int*)(ws + WS_IDX); const float* GATE = (const float*)(ws + WS_GATE);
    int* TQ = (int*)(ws + WS_TQ); float* CSC = (float*)(ws + WS_CSC);
    LAS unsigned char* wb = c.lds + 32768 + c.wave * 12288;
    LAS v4u* hqv = (LAS v4u*)wb; LAS unsigned* lst = (LAS unsigned*)(wb + 8192); LAS int* acc = (LAS int*)(wb + 10240);
    v2u hraw[4][8];
#pragma unroll
    for (int jj = 0; jj < 4; ++jj) { const int t = 64 * c.vcu + 8 * c.wave + jj;
#pragma unroll
        for (int j = 0; j < 8; ++j) hraw[jj][j] = __builtin_nontemporal_load((const v2u*)(X1 + (size_t)t * D + 256 * j + 4 * c.lane)); }
#pragma unroll 1
    for (int hf = 0; hf < 2; ++hf) {
        const int tb4 = 64 * c.vcu + 8 * c.wave + 4 * hf;
        int e0[4], e1[4]; float shs[4], hoffs[4];
#pragma unroll
        for (int jj = 0; jj < 4; ++jj) { e0[jj] = IDX[(size_t)(tb4 + jj) * 128 + c.lane]; e1[jj] = IDX[(size_t)(tb4 + jj) * 128 + 64 + c.lane]; }
        {
#pragma unroll
            for (int jj = 0; jj < 4; ++jj) {
                float hf32[32]; float am = 0.f, ssx = 0.f;
#pragma unroll
                for (int j = 0; j < 8; ++j) { hf32[4 * j] = bflo(hraw[jj][j].x); hf32[4 * j + 1] = bfhi(hraw[jj][j].x); hf32[4 * j + 2] = bflo(hraw[jj][j].y); hf32[4 * j + 3] = bfhi(hraw[jj][j].y); }
#pragma unroll
                for (int k = 0; k < 32; ++k) ssx += hf32[k] * hf32[k];
                const float rstd2 = 1.0f / sqrtf(wave_sum(ssx) * (1.0f / D) + NORM_EPS);
#pragma unroll
                for (int j = 0; j < 8; ++j) { const f32x4 av = *(const LAS f32x4*)(A2 + 256 * j + 4 * c.lane), bv = *(const LAS f32x4*)(B2 + 256 * j + 4 * c.lane);
#pragma unroll
                    for (int e = 0; e < 4; ++e) hf32[4 * j + e] = hf32[4 * j + e] * rstd2 * av[e] + bv[e]; }
#pragma unroll
                for (int k = 0; k < 32; ++k) am = fmaxf(am, fabsf(hf32[k]));
                am = wave_max(am);
                const float inv = (am > 0.f) ? 119.0f / am : 0.f;
                unsigned W[8]; unsigned hsu = 0u;
#pragma unroll
                for (int j = 0; j < 8; ++j) { W[j] = 0u;
#pragma unroll
                    for (int e = 0; e < 4; ++e) W[j] = __builtin_amdgcn_cvt_pk_u8_f32(__builtin_rintf(fmaf(hf32[4 * j + e], inv, 136.0f)), e, W[j]);
                    hsu = __builtin_amdgcn_sad_u8(W[j], 0u, hsu); }
                const int hs = (int)hsu - 136 * 32;
                unsigned wh[4], wl[4];
#pragma unroll
                for (int d = 0; d < 4; ++d) {
                    wh[d] = (((W[2 * d] >> 4) & 0x0f0f0f0fu) | (W[2 * d + 1] & 0xf0f0f0f0u)) ^ 0x88888888u;
                    wl[d] = ((W[2 * d] & 0x0f0f0f0fu) | ((W[2 * d + 1] << 4) & 0xf0f0f0f0u)) ^ 0x88888888u; }
                hqv[(jj * 2 + 0) * 64 + c.lane] = (v4u){wh[0], wh[1], wh[2], wh[3]}; hqv[(jj * 2 + 1) * 64 + c.lane] = (v4u){wl[0], wl[1], wl[2], wl[3]};
                shs[jj] = am * (1.0f / 119.0f); hoffs[jj] = 0.5f * (float)wave_sum_i(hs);
            }
        }
        acc[c.lane] = 0;
        LDS_WAIT();
        int pos[8];
#pragma unroll
        for (int jj = 0; jj < 4; ++jj) { pos[2 * jj] = __hip_atomic_fetch_add(acc + (e0[jj] >> 8), 1, __ATOMIC_RELAXED, __HIP_MEMORY_SCOPE_WORKGROUP);
                                         pos[2 * jj + 1] = __hip_atomic_fetch_add(acc + (e1[jj] >> 8), 1, __ATOMIC_RELAXED, __HIP_MEMORY_SCOPE_WORKGROUP); }
        LDS_WAIT();
        { int cnt = acc[c.lane], inc = cnt;
#pragma unroll
          for (int o = 1; o < 64; o <<= 1) { const int up = sh_idx(inc, c.lane - o); inc += (c.lane >= o) ? up : 0; }
          LDS_WAIT(); acc[64 + c.lane] = inc - cnt; }
        LDS_WAIT();
#pragma unroll
        for (int jj = 0; jj < 4; ++jj) {
            lst[acc[64 + (e0[jj] >> 8)] + pos[2 * jj]] = ((unsigned)e0[jj] << 10) | ((unsigned)jj << 7) | (unsigned)c.lane;
            lst[acc[64 + (e1[jj] >> 8)] + pos[2 * jj + 1]] = ((unsigned)e1[jj] << 10) | ((unsigned)jj << 7) | (unsigned)(64 + c.lane);
        }
        LDS_WAIT();
        { const int tbn = 64 * c.vcu + 8 * c.wave + 4;
#pragma unroll
          for (int jj = 0; jj < 4; ++jj) { const int t = tbn + jj;
#pragma unroll
              for (int j = 0; j < 8; ++j) hraw[jj][j] = __builtin_nontemporal_load((const v2u*)(X1 + (size_t)t * D + 256 * j + 4 * c.lane)); } }
        SCHED_FENCE();
        unsigned ent = lst[c.lane & 15];
        v4u r[16];
#pragma unroll
        for (int q = 0; q < 16; ++q) r[q] = ld_row4(PU, (int)(__builtin_amdgcn_readlane(ent, q) >> 10), c.lane);
        v4u hh, hl;
        { const int jj = (int)((__builtin_amdgcn_readlane(ent, 0) >> 7) & 3u); hh = hqv[(jj * 2 + 0) * 64 + c.lane]; hl = hqv[(jj * 2 + 1) * 64 + c.lane]; }
#pragma unroll 1
        for (int m = 0; m < 32; ++m) {
            const unsigned entn = lst[((16 * (m + 1)) & 511) + (c.lane & 15)];
#pragma unroll
            for (int hb = 0; hb < 2; ++hb) {
                int pa[8];
#pragma unroll
                for (int q = 0; q < 8; ++q) {
                    const int s16 = 8 * hb + q;
                    const int jn = (int)(((s16 < 15 ? __builtin_amdgcn_readlane(ent, (s16 + 1) & 15) : __builtin_amdgcn_readlane(entn, 0)) >> 7) & 3u);
                    const v4u hhn = hqv[(jn * 2 + 0) * 64 + c.lane], hln = hqv[(jn * 2 + 1) * 64 + c.lane];
                    const int h8[8] = {(int)hh.x, (int)hh.y, (int)hh.z, (int)hh.w, (int)hl.x, (int)hl.y, (int)hl.z, (int)hl.w};
                    pa[q] = idot_row4(h8, r[s16]);
                    SCHED_FENCE();
                    r[s16] = ld_row4(PU, (int)(__builtin_amdgcn_readlane(entn, s16) >> 10), c.lane);
                    SCHED_FENCE();
                    hh = hhn; hl = hln;
                }
                const int v = reduce8(pa, c.lane);
                if ((c.lane >> 3) == hb) acc[((ent >> 7) & 3u) * 128 + (ent & 127u)] = v;
            }
            ent = entn;
        }
        LDS_WAIT();
        float gg0[4], gg1[4], su0[4], su1[4], sv0[4], sv1[4];
#pragma unroll
        for (int jj = 0; jj < 4; ++jj) { const int t = tb4 + jj;
            gg0[jj] = GATE[(size_t)t * 128 + c.lane]; gg1[jj] = GATE[(size_t)t * 128 + 64 + c.lane];
            su0[jj] = SU[e0[jj]]; su1[jj] = SU[e1[jj]]; sv0[jj] = SV[e0[jj]]; sv1[jj] = SV[e1[jj]]; }
#pragma unroll
        for (int jj = 0; jj < 4; ++jj) { const int t = tb4 + jj;
            const int ia0 = acc[jj * 128 + c.lane], ia1 = acc[jj * 128 + 64 + c.lane];
            const float a0 = ((float)ia0 + hoffs[jj]) * su0[jj] * shs[jj], a1 = ((float)ia1 + hoffs[jj]) * su1[jj] * shs[jj];
            const float c0 = 0.5f * a0 * (1.0f + erff(a0 * 0.70710678118654752f)) * gg0[jj] * sv0[jj];
            const float c1 = 0.5f * a1 * (1.0f + erff(a1 * 0.70710678118654752f)) * gg1[jj] * sv1[jj];
            const float cmx = wave_max(fmaxf(fabsf(c0), fabsf(c1)));
            const float cinv = (cmx > 0.f) ? 127.0f / cmx : 0.f, csc = cmx * (1.0f / 127.0f);
            const int q0 = __float2int_rn(c0 * cinv), q1 = __float2int_rn(c1 * cinv);
            const int cqs = wave_sum_i(q0 + q1);
            const unsigned b0 = (unsigned)q0 & 0xffu, b1 = (unsigned)q1 & 0xffu;
            const int t0 = (int)(b0 | (sh_idx(b0, c.lane + 1) << 8) | (sh_idx(b0, c.lane + 2) << 16) | (sh_idx(b0, c.lane + 3) << 24));
            const int t1 = (int)(b1 | (sh_idx(b1, c.lane + 1) << 8) | (sh_idx(b1, c.lane + 2) << 16) | (sh_idx(b1, c.lane + 3) << 24));
            TQ[(size_t)t * 128 + c.lane] = t0; TQ[(size_t)t * 128 + 64 + c.lane] = t1;
            if (c.lane == 0) { CSC[(size_t)t * 2] = csc; CSC[(size_t)t * 2 + 1] = (float)cqs; }
        }
        LDS_WAIT();
    }
}
typedef int v8i __attribute__((ext_vector_type(8)));
typedef float f32x2 __attribute__((ext_vector_type(2)));
__device__ __forceinline__ void phase_peer4_u_mfma(const Ctx& c, const float* g2vec, unsigned char* ws) {
    const unsigned char* PU = ws + WS_PU; const bf16* X1 = (const bf16*)(ws + WS_X1B);
    LAS float* A2 = (LAS float*)(c.lds + 16384); LAS float* B2 = A2 + D;
    { const float* MODF_ = (const float*)(ws + WS_MODF) + (size_t)(c.vcu >> 7) * NMOD; const int j = 4 * c.tid;
      *(LAS f32x4*)(A2 + j) = *(const f32x4*)(g2vec + j) * (*(const f32x4*)(MODF_ + 4 * D + j) + 1.0f); *(LAS f32x4*)(B2 + j) = *(const f32x4*)(MODF_ + 3 * D + j); }
    __syncthreads();
    const float* SU = (const float*)(ws + WS_SU); const float* SV = (const float*)(ws + WS_SV);
    const int* IDX = (const int*)(ws + WS_IDX); const float* GATE = (const float*)(ws + WS_GATE);
    int* TQ = (int*)(ws + WS_TQ); float* CSC = (float*)(ws + WS_CSC);
    LAS unsigned char* wb = c.lds + 32768 + c.wave * 12288;
    LAS unsigned char* hq = wb; LAS unsigned* lst = (LAS unsigned*)(wb + 8192); LAS int* acc = (LAS int*)(wb + 10240); LAS float* accf = (LAS float*)(wb + 10240);
    const int kg = c.lane >> 4, ncol = c.lane & 15, rho = ncol >> 2, kap = ncol & 3;
#pragma unroll 1
    for (int hf = 0; hf < 2; ++hf) {
        const int tb4 = 64 * c.vcu + 8 * c.wave + 4 * hf;
        int e0[4], e1[4]; float shs[4];
#pragma unroll
        for (int jj = 0; jj < 4; ++jj) { e0[jj] = IDX[(size_t)(tb4 + jj) * 128 + c.lane]; e1[jj] = IDX[(size_t)(tb4 + jj) * 128 + 64 + c.lane]; }
        {
            v2u hraw[4][8];
#pragma unroll
            for (int jj = 0; jj < 4; ++jj) {
#pragma unroll
                for (int j = 0; j < 8; ++j) hraw[jj][j] = __builtin_nontemporal_load((const v2u*)(X1 + (size_t)(tb4 + jj) * D + 256 * j + 4 * c.lane)); }
#pragma unroll
            for (int jj = 0; jj < 4; ++jj) {
                float hf32[32]; float am = 0.f, ssx = 0.f;
#pragma unroll
                for (int j = 0; j < 8; ++j) { hf32[4 * j] = bflo(hraw[jj][j].x); hf32[4 * j + 1] = bfhi(hraw[jj][j].x); hf32[4 * j + 2] = bflo(hraw[jj][j].y); hf32[4 * j + 3] = bfhi(hraw[jj][j].y); }
#pragma unroll
                for (int k = 0; k < 32; ++k) ssx += hf32[k] * hf32[k];
                const float rstd2 = 1.0f / sqrtf(wave_sum(ssx) * (1.0f / D) + NORM_EPS);
#pragma unroll
                for (int j = 0; j < 8; ++j) { const f32x4 av = *(const LAS f32x4*)(A2 + 256 * j + 4 * c.lane), bv = *(const LAS f32x4*)(B2 + 256 * j + 4 * c.lane);
#pragma unroll
                    for (int e = 0; e < 4; ++e) hf32[4 * j + e] = hf32[4 * j + e] * rstd2 * av[e] + bv[e]; }
#pragma unroll
                for (int k = 0; k < 32; ++k) am = fmaxf(am, fabsf(hf32[k]));
                am = wave_max(am);
                const float inv = (am > 0.f) ? 224.0f / am : 0.f;
                unsigned W[8];
#pragma unroll
                for (int w = 0; w < 8; ++w) { const int j0 = 2 * (w >> 1), e0_ = 2 * (w & 1);
                    int pk = __builtin_amdgcn_cvt_pk_fp8_f32(hf32[4 * j0 + e0_] * inv, hf32[4 * (j0 + 1) + e0_] * inv, 0, false);
                    pk = __builtin_amdgcn_cvt_pk_fp8_f32(hf32[4 * j0 + e0_ + 1] * inv, hf32[4 * (j0 + 1) + e0_ + 1] * inv, pk, true);
                    W[w] = (unsigned)pk; }
                { LAS unsigned char* hp = hq + jj * 2048 + c.lane * 32;
                  *(LAS v4u*)hp = (v4u){W[0], W[1], W[2], W[3]}; *(LAS v4u*)(hp + 16) = (v4u){W[4], W[5], W[6], W[7]}; }
                shs[jj] = am * (1.0f / 224.0f);
            }
        }
        acc[c.lane] = 0;
        LDS_WAIT();
        int pos[8];
#pragma unroll
        for (int jj = 0; jj < 4; ++jj) { pos[2 * jj] = __hip_atomic_fetch_add(acc + (e0[jj] >> 8), 1, __ATOMIC_RELAXED, __HIP_MEMORY_SCOPE_WORKGROUP);
                                         pos[2 * jj + 1] = __hip_atomic_fetch_add(acc + (e1[jj] >> 8), 1, __ATOMIC_RELAXED, __HIP_MEMORY_SCOPE_WORKGROUP); }
        LDS_WAIT();
        { int cnt = acc[c.lane], inc = cnt;
#pragma unroll
          for (int o = 1; o < 64; o <<= 1) { const int up = sh_idx(inc, c.lane - o); inc += (c.lane >= o) ? up : 0; }
          LDS_WAIT(); acc[64 + c.lane] = inc - cnt; }
        LDS_WAIT();
#pragma unroll
        for (int jj = 0; jj < 4; ++jj) {
            lst[acc[64 + (e0[jj] >> 8)] + pos[2 * jj]] = ((unsigned)e0[jj] << 10) | ((unsigned)jj << 7) | (unsigned)c.lane;
            lst[acc[64 + (e1[jj] >> 8)] + pos[2 * jj + 1]] = ((unsigned)e1[jj] << 10) | ((unsigned)jj << 7) | (unsigned)(64 + c.lane);
        }
        LDS_WAIT();
        v8i Bp[4];
#pragma unroll
        for (int s4 = 0; s4 < 4; ++s4) { const LAS unsigned char* bp = hq + rho * 2048 + (16 * s4 + 4 * (kg >> 1) + kap) * 32 + (kg & 1) * 16;
            const v4u lo = *(const LAS v4u*)bp, hi = *(const LAS v4u*)(bp + 8 * 32);
            Bp[s4] = (v8i){(int)lo.x, (int)lo.y, (int)lo.z, (int)lo.w, (int)hi.x, (int)hi.y, (int)hi.z, (int)hi.w}; }
        const unsigned lane_off = 64u * (unsigned)kg + 16u * (unsigned)kap;
        v4u r[16];
#pragma unroll
        for (int G = 0; G < 4; ++G) { const unsigned vo = (lst[4 * G + rho] & ~1023u) + lane_off;
#pragma unroll
            for (int s4 = 0; s4 < 4; ++s4) r[4 * G + s4] = *(const v4u*)(PU + vo + 256 * s4); }
#pragma unroll 1
        for (int m = 0; m < 32; ++m) {
#pragma unroll
            for (int G = 0; G < 4; ++G) {
                const unsigned von = (lst[((16 * (m + 1)) & 511) + 4 * G + rho] & ~1023u) + lane_off;
                const unsigned erow = lst[16 * m + 4 * G + kg];
                f32x4 cacc = {0.f, 0.f, 0.f, 0.f};
#pragma unroll
                for (int s4 = 0; s4 < 4; ++s4) {
                    v8i av; av[0] = (int)r[4 * G + s4].x; av[1] = (int)r[4 * G + s4].y; av[2] = (int)r[4 * G + s4].z; av[3] = (int)r[4 * G + s4].w; av[4] = 0; av[5] = 0; av[6] = 0; av[7] = 0;
                    cacc = __builtin_amdgcn_mfma_scale_f32_16x16x128_f8f6f4(av, Bp[s4], cacc, 4, 0, 0, 0x7f7f7f7f, 0, 0x7f7f7f7f);
                }
                SCHED_FENCE();
#pragma unroll
                for (int s4 = 0; s4 < 4; ++s4) r[4 * G + s4] = *(const v4u*)(PU + von + 256 * s4);
                SCHED_FENCE();
                float v = (kap == 0) ? cacc[0] : (kap == 1) ? cacc[1] : (kap == 2) ? cacc[2] : cacc[3];
                v += SXOR(v, 1, c.lane); v += SXOR(v, 2, c.lane);
                const unsigned tk = (erow >> 7) & 3u;
                if (kap == 0 && (unsigned)rho == tk) accf[tk * 128 + (erow & 127u)] = v;
            }
        }
        LDS_WAIT();
        float gg0[4], gg1[4], su0[4], su1[4], sv0[4], sv1[4];
#pragma unroll
        for (int jj = 0; jj < 4; ++jj) { const int t = tb4 + jj;
            gg0[jj] = GATE[(size_t)t * 128 + c.lane]; gg1[jj] = GATE[(size_t)t * 128 + 64 + c.lane];
            su0[jj] = SU[e0[jj]]; su1[jj] = SU[e1[jj]]; sv0[jj] = SV[e0[jj]]; sv1[jj] = SV[e1[jj]]; }
#pragma unroll
        for (int jj = 0; jj < 4; ++jj) { const int t = tb4 + jj;
            const float a0 = accf[jj * 128 + c.lane] * su0[jj] * shs[jj], a1 = accf[jj * 128 + 64 + c.lane] * su1[jj] * shs[jj];
            const float c0 = 0.5f * a0 * (1.0f + erff(a0 * 0.70710678118654752f)) * gg0[jj] * sv0[jj];
            const float c1 = 0.5f * a1 * (1.0f + erff(a1 * 0.70710678118654752f)) * gg1[jj] * sv1[jj];
            const float cmx = wave_max(fmaxf(fabsf(c0), fabsf(c1)));
#if V_MFMA
            const float cinv = (cmx > 0.f) ? 224.0f / cmx : 0.f;
            ((float*)TQ)[(size_t)t * 128 + c.lane] = c0 * cinv; ((float*)TQ)[(size_t)t * 128 + 64 + c.lane] = c1 * cinv;
            if (c.lane == 0) { CSC[(size_t)t * 2] = cmx * (1.0f / 224.0f); CSC[(size_t)t * 2 + 1] = 0.f; }
#else
            const float cinv = (cmx > 0.f) ? 127.0f / cmx : 0.f, csc = cmx * (1.0f / 127.0f);
            const int q0 = __float2int_rn(c0 * cinv), q1 = __float2int_rn(c1 * cinv);
            const int cqs = wave_sum_i(q0 + q1);
            const unsigned b0_ = (unsigned)q0 & 0xffu, b1_ = (unsigned)q1 & 0xffu;
            const int t0 = (int)(b0_ | (sh_idx(b0_, c.lane + 1) << 8) | (sh_idx(b0_, c.lane + 2) << 16) | (sh_idx(b0_, c.lane + 3) << 24));
            const int t1 = (int)(b1_ | (sh_idx(b1_, c.lane + 1) << 8) | (sh_idx(b1_, c.lane + 2) << 16) | (sh_idx(b1_, c.lane + 3) << 24));
            TQ[(size_t)t * 128 + c.lane] = t0; TQ[(size_t)t * 128 + 64 + c.lane] = t1;
            if (c.lane == 0) { CSC[(size_t)t * 2] = csc; CSC[(size_t)t * 2 + 1] = (float)cqs; }
#endif
        }
        LDS_WAIT();
    }
}
__device__ __forceinline__ void phase_peer4_v_mfma(const Ctx& c, const float* final_g, float* out, unsigned char* ws) {
    const bf16* X1 = (const bf16*)(ws + WS_X1B);
    const unsigned char* PV = ws + WS_PV;
    const int* IDX = (const int*)(ws + WS_IDX); const float* CF = (const float*)(ws + WS_TQ); const float* CSC = (const float*)(ws + WS_CSC); const float* MODF = (const float*)(ws + WS_MODF);
    LAS float* G2 = (LAS float*)c.lds; LAS float* FG = G2 + D;
    const int b = c.vcu >> 7;
    { const int j = 4 * c.tid; *(LAS f32x4*)(G2 + j) = *(const f32x4*)(MODF + (size_t)b * NMOD + 5 * D + j); *(LAS f32x4*)(FG + j) = *(const f32x4*)(final_g + j); }
    __syncthreads();
    const int n = c.lane & 15, g = c.lane >> 4;
    const int tbase = 64 * c.vcu + 8 * c.wave;
    const unsigned nb8 = 8u * (unsigned)n;
    const int F0 = 256 * (4 * (n & 1) + 2 * (g >> 1)) + 4 * (n >> 1) + 2 * (g & 1);
    int e0n = IDX[(size_t)tbase * 128 + c.lane], e1n = IDX[(size_t)tbase * 128 + 64 + c.lane];
    float cf0n = CF[(size_t)tbase * 128 + c.lane], cf1n = CF[(size_t)tbase * 128 + 64 + c.lane];
    v2u br[2][8][2];
#pragma unroll
    for (int bf = 0; bf < 2; ++bf) {
        const unsigned o0 = ((unsigned)sh_idx(e0n, 8 * bf + 2 * g) << 10) + nb8, o1 = ((unsigned)sh_idx(e0n, 8 * bf + 2 * g + 1) << 10) + nb8;
#pragma unroll
        for (int s8 = 0; s8 < 8; ++s8) { br[bf][s8][0] = *(const v2u*)(PV + o0 + 128 * s8); br[bf][s8][1] = *(const v2u*)(PV + o1 + 128 * s8); }
    }
#pragma unroll 1
    for (int i = 0; i < 8; ++i) {
        const int t = tbase + i, tn = tbase + ((i + 1) & 7);
        const int e0 = e0n, e1 = e1n; const float cf0 = cf0n, cf1 = cf1n;
        const float csc = CSC[(size_t)t * 2];
        e0n = IDX[(size_t)tn * 128 + c.lane]; e1n = IDX[(size_t)tn * 128 + 64 + c.lane];
        cf0n = CF[(size_t)tn * 128 + c.lane]; cf1n = CF[(size_t)tn * 128 + 64 + c.lane];
        f32x4 C[8];
#pragma unroll
        for (int s8 = 0; s8 < 8; ++s8) C[s8] = (f32x4){0.f, 0.f, 0.f, 0.f};
#pragma unroll 1
        for (int gp = 0; gp < 8; ++gp) {
#pragma unroll
            for (int bf = 0; bf < 2; ++bf) {
                const int grp = 2 * gp + bf;
                const float cfs = (gp < 4) ? cf0 : cf1;
                const float ca = sh_idx(cfs, (8 * grp + g) & 63), cb = sh_idx(cfs, (8 * grp + 4 + g) & 63);
                const unsigned pk = (unsigned)__builtin_amdgcn_cvt_pk_fp8_f32(ca, cb, 0, false);
                const unsigned wlo = (pk & 0xffu) << (8 * (n & 3)), whi = ((pk >> 8) & 0xffu) << (8 * (n & 3));
                const int q = n >> 2;
                const v8i av = {(int)(q == 0 ? wlo : 0u), (int)(q == 1 ? wlo : 0u), (int)(q == 2 ? wlo : 0u), (int)(q == 3 ? wlo : 0u),
                                (int)(q == 0 ? whi : 0u), (int)(q == 1 ? whi : 0u), (int)(q == 2 ? whi : 0u), (int)(q == 3 ? whi : 0u)};
#pragma unroll
                for (int s8 = 0; s8 < 8; ++s8) {
                    v8i bv; bv[0] = (int)br[bf][s8][0].x; bv[1] = (int)br[bf][s8][0].y; bv[2] = (int)br[bf][s8][1].x; bv[3] = (int)br[bf][s8][1].y; bv[4] = 0; bv[5] = 0; bv[6] = 0; bv[7] = 0;
                    C[s8] = __builtin_amdgcn_mfma_scale_f32_16x16x128_f8f6f4(av, bv, C[s8], 0, 4, 0, 0x7f7f7f7f, 0, 0x7f7f7f7f);
                }
                SCHED_FENCE();
                {
                    const int gn = grp + 2;
                    const int es = (gn < 8) ? e0 : ((gn < 16) ? e1 : e0n);
                    const unsigned o0 = ((unsigned)sh_idx(es, (8 * gn + 2 * g) & 63) << 10) + nb8, o1 = ((unsigned)sh_idx(es, (8 * gn + 2 * g + 1) & 63) << 10) + nb8;
#pragma unroll
                    for (int s8 = 0; s8 < 8; ++s8) { br[bf][s8][0] = *(const v2u*)(PV + o0 + 128 * s8); br[bf][s8][1] = *(const v2u*)(PV + o1 + 128 * s8); }
                }
                SCHED_FENCE();
            }
        }
        const bf16* xr = X1 + (size_t)t * D + F0; float* orow = out + (size_t)t * D + F0;
        float ss = 0.f;
#pragma unroll
        for (int s8 = 0; s8 < 8; ++s8) {
            const unsigned xa = __builtin_nontemporal_load((const unsigned*)(xr + 32 * s8)), xb = __builtin_nontemporal_load((const unsigned*)(xr + 256 + 32 * s8));
            const f32x2 ga = *(const LAS f32x2*)(G2 + F0 + 32 * s8), gb = *(const LAS f32x2*)(G2 + F0 + 256 + 32 * s8);
            const float v0 = bflo(xa) + ga[0] * (csc * C[s8][0]), v2 = bfhi(xa) + ga[1] * (csc * C[s8][2]);
            const float v1 = bflo(xb) + gb[0] * (csc * C[s8][1]), v3 = bfhi(xb) + gb[1] * (csc * C[s8][3]);
            C[s8] = (f32x4){v0, v1, v2, v3}; ss += (v0 * v0 + v1 * v1) + (v2 * v2 + v3 * v3);
        }
        const float rstd = 1.0f / sqrtf(wave_sum(ss) * (1.0f / D) + NORM_EPS);
#pragma unroll
        for (int s8 = 0; s8 < 8; ++s8) {
            const f32x2 fa = *(const LAS f32x2*)(FG + F0 + 32 * s8), fb = *(const LAS f32x2*)(FG + F0 + 256 + 32 * s8);
            const f32x2 oa = {C[s8][0] * rstd * fa[0], C[s8][2] * rstd * fa[1]}, ob = {C[s8][1] * rstd * fb[0], C[s8][3] * rstd * fb[1]};
            __builtin_nontemporal_store(oa, (f32x2*)(orow + 32 * s8)); __builtin_nontemporal_store(ob, (f32x2*)(orow + 256 + 32 * s8));
        }
    }
}
__device__ __forceinline__ void phase_peer4_v_sorted(const Ctx& c, const float* final_g, float* out, unsigned char* ws) {
    const bf16* X1 = (const bf16*)(ws + WS_X1B);
    const unsigned char* PV = ws + WS_PV;
    const int* IDX = (const int*)(ws + WS_IDX); const float* CF = (const float*)(ws + WS_TQ); const float* CSC = (const float*)(ws + WS_CSC); const float* MODF = (const float*)(ws + WS_MODF);
    LAS float* G2 = (LAS float*)c.lds; LAS float* FG = G2 + D;
    const int b = c.vcu >> 7;
    { const int j = 4 * c.tid; *(LAS f32x4*)(G2 + j) = *(const f32x4*)(MODF + (size_t)b * NMOD + 5 * D + j); *(LAS f32x4*)(FG + j) = *(const f32x4*)(final_g + j); }
    __syncthreads();
    LAS unsigned char* wb = c.lds + 32768 + c.wave * 12288;
    LAS v2u* lst2 = (LAS v2u*)wb; LAS int* hist = (LAS int*)(wb + 4096);
    const int n = c.lane & 15, g = c.lane >> 4;
    const unsigned nb16 = 16u * (unsigned)n;
    const int F0 = 512 * (g >> 1) + 4 * n + 2 * (g & 1);
    const int q4 = n >> 2, sh8 = 8 * (n & 3);
#pragma unroll 1
    for (int hf = 0; hf < 2; ++hf) {
        const int tb4 = 64 * c.vcu + 8 * c.wave + 4 * hf;
        {
            int e0[4], e1[4]; float w0[4], w1[4];
#pragma unroll
            for (int jj = 0; jj < 4; ++jj) { const size_t o = (size_t)(tb4 + jj) * 128 + c.lane; e0[jj] = IDX[o]; e1[jj] = IDX[o + 64]; w0[jj] = CF[o]; w1[jj] = CF[o + 64]; }
            hist[c.lane] = 0;
            LDS_WAIT();
            int pos[8];
#pragma unroll
            for (int jj = 0; jj < 4; ++jj) { pos[2 * jj] = __hip_atomic_fetch_add(hist + ((e0[jj] >> V_BSH) * 4 + jj), 1, __ATOMIC_RELAXED, __HIP_MEMORY_SCOPE_WORKGROUP);
                                             pos[2 * jj + 1] = __hip_atomic_fetch_add(hist + ((e1[jj] >> V_BSH) * 4 + jj), 1, __ATOMIC_RELAXED, __HIP_MEMORY_SCOPE_WORKGROUP); }
            LDS_WAIT();
            { int cnt = hist[c.lane], inc = cnt;
#pragma unroll
              for (int o = 1; o < 64; o <<= 1) { const int up = sh_idx(inc, c.lane - o); inc += (c.lane >= o) ? up : 0; }
              LDS_WAIT(); hist[64 + c.lane] = inc - cnt; }
            LDS_WAIT();
#pragma unroll
            for (int jj = 0; jj < 4; ++jj) {
                lst2[hist[64 + (e0[jj] >> V_BSH) * 4 + jj] + pos[2 * jj]] = (v2u){((unsigned)e0[jj] << 2) | (unsigned)jj, __float_as_uint(w0[jj])};
                lst2[hist[64 + (e1[jj] >> V_BSH) * 4 + jj] + pos[2 * jj + 1]] = (v2u){((unsigned)e1[jj] << 2) | (unsigned)jj, __float_as_uint(w1[jj])};
            }
            LDS_WAIT();
        }
        f32x4 C[4][8];
#pragma unroll
        for (int jj = 0; jj < 4; ++jj)
#pragma unroll
            for (int s8 = 0; s8 < 8; ++s8) C[jj][s8] = (f32x4){0.f, 0.f, 0.f, 0.f};
        v4u br[2][4][2];
#pragma unroll
        for (int bf = 0; bf < 2; ++bf) {
            const v4u qe = *(const LAS v4u*)(lst2 + 8 * bf + 2 * g);
            const unsigned o0 = ((qe.x >> 2) << 10) + nb16, o1 = ((qe.z >> 2) << 10) + nb16;
#pragma unroll
            for (int s4 = 0; s4 < 4; ++s4) { br[bf][s4][0] = *(const v4u*)(PV + o0 + 256 * s4); br[bf][s4][1] = *(const v4u*)(PV + o1 + 256 * s4); }
        }
#pragma unroll 1
        for (int gp = 0; gp < 32; ++gp) {
#pragma unroll
            for (int bf = 0; bf < 2; ++bf) {
                const int G = 2 * gp + bf;
                const v2u ea = lst2[8 * G + g], eb = lst2[8 * G + 4 + g];
                const unsigned tokA = ea.x & 3u, tokB = eb.x & 3u; const float cA = __uint_as_float(ea.y), cB = __uint_as_float(eb.y);
                const v4u qn = *(const LAS v4u*)(lst2 + ((8 * (G + 2)) & 511) + 2 * g);
#pragma unroll
                for (int jj = 0; jj < 4; ++jj) {
                    const bool hasA = (tokA == (unsigned)jj), hasB = (tokB == (unsigned)jj);
                    if (__builtin_amdgcn_ballot_w64(hasA || hasB) != 0ull) {
                        const unsigned pk = (unsigned)__builtin_amdgcn_cvt_pk_fp8_f32(hasA ? cA : 0.f, hasB ? cB : 0.f, 0, false);
                        const unsigned wlo = (pk & 0xffu) << sh8, whi = ((pk >> 8) & 0xffu) << sh8;
                        const v8i av = {(int)(q4 == 0 ? wlo : 0u), (int)(q4 == 1 ? wlo : 0u), (int)(q4 == 2 ? wlo : 0u), (int)(q4 == 3 ? wlo : 0u),
                                        (int)(q4 == 0 ? whi : 0u), (int)(q4 == 1 ? whi : 0u), (int)(q4 == 2 ? whi : 0u), (int)(q4 == 3 ? whi : 0u)};
#pragma unroll
                        for (int s8 = 0; s8 < 8; ++s8) {
                            const v4u r0 = br[bf][s8 >> 1][0], r1 = br[bf][s8 >> 1][1];
                            v8i bv; bv[0] = (int)((s8 & 1) ? r0.z : r0.x); bv[1] = (int)((s8 & 1) ? r0.w : r0.y); bv[2] = (int)((s8 & 1) ? r1.z : r1.x); bv[3] = (int)((s8 & 1) ? r1.w : r1.y); bv[4] = 0; bv[5] = 0; bv[6] = 0; bv[7] = 0;
                            C[jj][s8] = __builtin_amdgcn_mfma_scale_f32_16x16x128_f8f6f4(av, bv, C[jj][s8], 0, 4, 0, 0x7f7f7f7f, 0, 0x7f7f7f7f);
                        }
                    }
                }
                SCHED_FENCE();
                { const unsigned o0 = ((qn.x >> 2) << 10) + nb16, o1 = ((qn.z >> 2) << 10) + nb16;
#pragma unroll
                  for (int s4 = 0; s4 < 4; ++s4) { br[bf][s4][0] = *(const v4u*)(PV + o0 + 256 * s4); br[bf][s4][1] = *(const v4u*)(PV + o1 + 256 * s4); } }
                SCHED_FENCE();
            }
        }
#pragma unroll
        for (int jj = 0; jj < 4; ++jj) {
            const int t = tb4 + jj;
            const float csc = CSC[(size_t)t * 2];
            const bf16* xr = X1 + (size_t)t * D + F0; float* orow = out + (size_t)t * D + F0;
            float ss = 0.f;
#pragma unroll
            for (int s8 = 0; s8 < 8; ++s8) {
                const unsigned xa = __builtin_nontemporal_load((const unsigned*)(xr + (1024 * (s8 & 1) + 64 * (s8 >> 1)))), xb = __builtin_nontemporal_load((const unsigned*)(xr + 256 + (1024 * (s8 & 1) + 64 * (s8 >> 1))));
                const f32x2 ga = *(const LAS f32x2*)(G2 + F0 + (1024 * (s8 & 1) + 64 * (s8 >> 1))), gb = *(const LAS f32x2*)(G2 + F0 + 256 + (1024 * (s8 & 1) + 64 * (s8 >> 1)));
                const float v0 = bflo(xa) + ga[0] * (csc * C[jj][s8][0]), v2 = bfhi(xa) + ga[1] * (csc * C[jj][s8][2]);
                const float v1 = bflo(xb) + gb[0] * (csc * C[jj][s8][1]), v3 = bfhi(xb) + gb[1] * (csc * C[jj][s8][3]);
                C[jj][s8] = (f32x4){v0, v1, v2, v3}; ss += (v0 * v0 + v1 * v1) + (v2 * v2 + v3 * v3);
            }
            const float rstd = 1.0f / sqrtf(wave_sum(ss) * (1.0f / D) + NORM_EPS);
#pragma unroll
            for (int s8 = 0; s8 < 8; ++s8) {
                const f32x2 fa = *(const LAS f32x2*)(FG + F0 + (1024 * (s8 & 1) + 64 * (s8 >> 1))), fb = *(const LAS f32x2*)(FG + F0 + 256 + (1024 * (s8 & 1) + 64 * (s8 >> 1)));
                const f32x2 oa = {C[jj][s8][0] * rstd * fa[0], C[jj][s8][2] * rstd * fa[1]}, ob = {C[jj][s8][1] * rstd * fb[0], C[jj][s8][3] * rstd * fb[1]};
                __builtin_nontemporal_store(oa, (f32x2*)(orow + (1024 * (s8 & 1) + 64 * (s8 >> 1)))); __builtin_nontemporal_store(ob, (f32x2*)(orow + 256 + (1024 * (s8 & 1) + 64 * (s8 >> 1))));
            }
        }
        LDS_WAIT();
    }
}
__device__ __forceinline__ void phase_peer4_v(const Ctx& c, const float* final_g, float* out, unsigned char* ws) {
    const bf16* X1 = (const bf16*)(ws + WS_X1B);
    const unsigned char* PV = ws + WS_PV;
    const int* IDX = (const int*)(ws + WS_IDX); const int* TQ = (const int*)(ws + WS_TQ); const float* CSC = (const float*)(ws + WS_CSC); const float* MODF = (const float*)(ws + WS_MODF);
    LAS float* G2 = (LAS float*)c.lds; LAS float* FG = G2 + D;
    const int b = c.vcu >> 7;
    { const int j = 4 * c.tid; *(LAS f32x4*)(G2 + j) = *(const f32x4*)(MODF + (size_t)b * NMOD + 5 * D + j); *(LAS f32x4*)(FG + j) = *(const f32x4*)(final_g + j); }
    __syncthreads();
    const int tbase = 64 * c.vcu + 8 * c.wave;
    int e0n = IDX[(size_t)tbase * 128 + c.lane], e1n = IDX[(size_t)tbase * 128 + 64 + c.lane];
    int t0n = TQ[(size_t)tbase * 128 + c.lane], t1n = TQ[(size_t)tbase * 128 + 64 + c.lane];
    v4u r[16];
#pragma unroll
    for (int q = 0; q < 16; ++q) r[q] = ld_row4(PV, __builtin_amdgcn_readlane(e0n, q), c.lane);
#pragma unroll 1
    for (int i = (DUP & 2048) ? -8 : 0; i < 8; ++i) {
        const int t = tbase + (i & 7), tn = tbase + ((i + 1) & 7);
        const int e0 = e0n, e1 = e1n, t0 = t0n, t1 = t1n;
        const float csc = CSC[(size_t)t * 2], cqsf = CSC[(size_t)t * 2 + 1];
        e0n = IDX[(size_t)tn * 128 + c.lane]; e1n = IDX[(size_t)tn * 128 + 64 + c.lane];
        t0n = TQ[(size_t)tn * 128 + c.lane]; t1n = TQ[(size_t)tn * 128 + 64 + c.lane];
        int y[32];
#pragma unroll
        for (int q = 0; q < 32; ++q) y[q] = 0;
#pragma unroll 1
        for (int m = 0; m < 8; ++m) {
            const int esrc = (m + 1 < 4) ? e0 : ((m + 1 < 8) ? e1 : e0n);
            const int tsrc = (m < 4) ? t0 : t1;
#pragma unroll
            for (int gq = 0; gq < 4; ++gq) {
                const int cq4 = __builtin_amdgcn_readlane(tsrc, (16 * m + 4 * gq) & 63);
                vacc4(y, r[4 * gq], r[4 * gq + 1], r[4 * gq + 2], r[4 * gq + 3], cq4);
                SCHED_FENCE();
#pragma unroll
                for (int q = 0; q < 4; ++q) r[4 * gq + q] = ld_row4(PV, __builtin_amdgcn_readlane(esrc, (16 * (m + 1) + 4 * gq + q) & 63), c.lane);
                SCHED_FENCE();
            }
        }
        const bf16* xr = X1 + (size_t)t * D + 4 * c.lane; float* orow = ((DUP & 2048) && i < 0 ? (float*)(ws + WS_HC) : out) + (size_t)t * D + 4 * c.lane;
        float yf[32]; float ss = 0.f;
#pragma unroll
        for (int j = 0; j < 8; ++j) {
            const v2u xw = __builtin_nontemporal_load((const v2u*)(xr + 256 * j)); const f32x4 xa = {bflo(xw.x), bfhi(xw.x), bflo(xw.y), bfhi(xw.y)};
            const f32x4 ga = *(const LAS f32x4*)(G2 + 256 * j + 4 * c.lane);
#pragma unroll
            for (int e = 0; e < 4; ++e) {
                const int d = j >> 1;
                const float yv = (j & 1) ? (float)((y[8 * d + 4 + e] - y[8 * d + e]) >> 4) + 0.5f * cqsf : (float)y[8 * d + e] - 7.5f * cqsf;
                const float v = xa[e] + ga[e] * (csc * yv); yf[4 * j + e] = v; ss += v * v; }
        }
        const float rstd = 1.0f / sqrtf(wave_sum(ss) * (1.0f / D) + NORM_EPS);
#pragma unroll
        for (int j = 0; j < 8; ++j) {
            const f32x4 fa = *(const LAS f32x4*)(FG + 256 * j + 4 * c.lane);
            f32x4 o;
#pragma unroll
            for (int e = 0; e < 4; ++e) o[e] = yf[4 * j + e] * rstd * fa[e];
            __builtin_nontemporal_store(o, (f32x4*)(orow + 256 * j));
        }
    }
}

struct Args { const float* in[16]; float* out; unsigned char* ws; };
__device__ __forceinline__ int lane_id() { unsigned ones = ~0u; asm volatile("" : "+s"(ones)); return (int)__builtin_amdgcn_mbcnt_hi(ones, __builtin_amdgcn_mbcnt_lo(ones, 0u)); }
__global__ void __launch_bounds__(NTHREADS, 2) fwd_kernel(Args args_unused) {
    extern __shared__ __attribute__((aligned(16))) unsigned char lds_raw[];
    const int wave_s = __builtin_amdgcn_readfirstlane((int)(threadIdx.x >> 6));
#define CAS __attribute__((address_space(4)))
#define KARGS() const CAS unsigned char* ka_ = (const CAS unsigned char*)__builtin_amdgcn_kernarg_segment_ptr(); asm volatile("" : "+s"(ka_));
#define ARG_IN(i) (*(const float* const CAS*)(ka_ + 8 * (i)))
#define ARG_OUT() (*(float* const CAS*)(ka_ + 128))
#define ARG_WS() (*(unsigned char* const CAS*)(ka_ + 136))
#define MKCTX() KARGS(); unsigned char* ws = ARG_WS(); Ctx c; { c.lds = (LAS unsigned char*)lds_raw; int l_ = lane_id(); asm volatile("" : "+v"(l_)); c.lane = l_; c.wave = wave_s; c.tid = wave_s * 64 + l_; \
    c.G = 256; { const int bx = blockIdx.x; c.vcu = (bx % 8) * 32 + bx / 8; } c.gw = c.vcu * NWAVES + c.wave; c.ngw = 256 * NWAVES; }
#define IS_T0() (wave_s == 0 && lane_id() == 0)
#define GRID_BAR() xcd_barrier(bar, IS_T0())
    LAS unsigned char* const ldsb = (LAS unsigned char*)lds_raw;
    volatile LAS unsigned* misc = (volatile LAS unsigned*)(ldsb + MISC_OFF);
    if (threadIdx.x < 4) misc[threadIdx.x] = 0u;
    __syncthreads();
    XcdBarrier bar;
    { KARGS(); bar = xcd_barrier_post((unsigned*)(ARG_WS() + WS_CTL), misc, IS_T0()); }
    if (gridDim.x != 256) return;

    { MKCTX(); const float* inp[16];
#pragma unroll
      for (int i = 0; i < 16; ++i) inp[i] = ARG_IN(i);
      phase0(c, inp, ws); if (DUP & 1) phase0(c, inp, ws); }
    GRID_BAR();
    { MKCTX(); phase_rows<true>(c, ARG_IN(0), nullptr, ARG_IN(5), ARG_IN(4), (const int*)ARG_IN(2), ws, 0, 1, ARG_IN(10), ARG_IN(11)); if (DUP & 2) phase_rows<true>(c, ARG_IN(0), nullptr, ARG_IN(5), ARG_IN(4), (const int*)ARG_IN(2), ws, 0, 1, ARG_IN(10), ARG_IN(11)); }
    GRID_BAR();
    { KARGS(); unsigned char* ws = ARG_WS();
      pg8::Gemm g{(const bf16*)(ws + WS_HB), (const bf16*)(ws + WS_WTIN), T, INW, D, D, D, 0}; pg8::StaticOrder S; S.init(T, INW, 256, (int)blockIdx.x);
      Epi1 E{(bf16*)(ws + WS_Q), (const float*)(ws + WS_CS)};
      int nrep_ = (DUP & 4) ? 2 : 1; asm volatile("" : "+s"(nrep_));
#pragma unroll 1
      for (int rep_ = 0; rep_ < nrep_; ++rep_) { pg8::gemm_phase<Epi1, pg8::StaticOrder, false>(ldsb, g, S, E, nullptr, wave_s); } }
    GRID_BAR();
    { MKCTX(); phase_poolr(c, ws); if (DUP & 256) phase_poolr(c, ws); }
#if ATTN_SIMPLE
    { MKCTX(); phase_attn_simple(c, ws); }
#else
    { MKCTX(); phase_attn_mfma(c, ws); if (DUP & 8) phase_attn_mfma(c, ws); }
#endif
    GRID_BAR();
#if !ATTN_SIMPLE
    { MKCTX(); phase_combine(c, ws); if (DUP & 16384) phase_combine(c, ws); }
#endif
    { KARGS(); unsigned char* ws = ARG_WS();
      pg8::Gemm g{(const bf16*)(ws + WS_RB), (const bf16*)(ws + WS_WTPOOL), T, PW, 256, PW, 256, 512}; pg8::StaticOrder S; S.init(T, PW, 256, (int)blockIdx.x);
      EpiPool E{(bf16*)(ws + WS_HC), ARG_IN(8)};
      int nrep_ = (DUP & 16) ? 2 : 1; asm volatile("" : "+s"(nrep_));
#pragma unroll 1
      for (int rep_ = 0; rep_ < nrep_; ++rep_) { pg8::gemm_phase<EpiPool, pg8::StaticOrder, false>(ldsb, g, S, E, nullptr, wave_s); } }
    GRID_BAR();
    { KARGS(); unsigned char* ws = ARG_WS();
      pg8::Gemm g{(const bf16*)(ws + WS_HC), (const bf16*)(ws + WS_WTOUT), T, D, D, D, D, 0}; pg8::StaticOrder S; S.init(T, D, 256, (int)blockIdx.x);
      EpiOut E{ARG_IN(0), (bf16*)(ws + WS_X1B), (const float*)(ws + WS_MODF), (float*)(ws + WS_RSQP)};
      int nrep_ = (DUP & 32) ? 2 : 1; asm volatile("" : "+s"(nrep_));
#pragma unroll 1
      for (int rep_ = 0; rep_ < nrep_; ++rep_) { pg8::gemm_phase<EpiOut, pg8::StaticOrder, false>(ldsb, g, S, E, nullptr, wave_s); } }
    GRID_BAR();
    { KARGS(); unsigned char* ws = ARG_WS();
      pg8::StaticOrder S; S.init(T, D, 256, (int)blockIdx.x);
      pg8::Unit u0, u1; S.next(0, u0); S.next(1, u1);
      LAS float* rstdT = (LAS float*)(ldsb + 131072 + 256); LAS float* biasT = rstdT + 512;
      { const int l_ = lane_id(), tid_ = wave_s * 64 + l_, slot = tid_ >> 8, i_ = tid_ & 255; const pg8::Unit uu = slot ? u1 : u0;
        const float* rp = (const float*)(ws + WS_RSQP) + (size_t)(uu.pm * 256 + i_) * 32; float ssum = 0.f;
#pragma unroll
        for (int q = 0; q < 8; ++q) { const f32x4 v = *(const f32x4*)(rp + 4 * q); ssum += (v[0] + v[1]) + (v[2] + v[3]); }
        rstdT[slot * 256 + i_] = 1.0f / sqrtf(ssum * (1.0f / D) + NORM_EPS);
        const float* bp = (const float*)(ws + WS_BIASP) + (size_t)(uu.pm >= 32 ? 1 : 0) * D + uu.pn * 256 + i_; float bsum = 0.f;
#pragma unroll 8
        for (int kb = 0; kb < 32; ++kb) bsum += bp[(size_t)kb * 2 * D];
        biasT[slot * 256 + i_] = bsum; }
      __syncthreads();
      pg8::Gemm g{(const bf16*)(ws + WS_X1B), (const bf16*)(ws + WS_WQ2), T, D, D, D, D, 0, D * D * 2};
      EpiQ E{(bf16*)(ws + WS_QP), rstdT, biasT, u0.pm, u0.pn};
      int nrep_ = (DUP & 128) ? 2 : 1; asm volatile("" : "+s"(nrep_));
#pragma unroll 1
      for (int rep_ = 0; rep_ < nrep_; ++rep_) { pg8::gemm_phase<EpiQ, pg8::StaticOrder, false>(ldsb, g, S, E, nullptr, wave_s); } }
    GRID_BAR();
#if TOPK_SIMPLE
    { KARGS(); unsigned char* ws = ARG_WS();
      pg8::Gemm g{(const bf16*)(ws + WS_QP), (const bf16*)(ws + WS_SKP), T, D, 256, D, 256, 512}; pg8::StaticOrder S; S.init(T, D, 256, (int)blockIdx.x);
      EpiF E{(float*)(ws + WS_SC), D};
      pg8::gemm_phase<EpiF, pg8::StaticOrder, false>(ldsb, g, S, E, nullptr, wave_s); }
    GRID_BAR();
    { MKCTX(); phase_topk_simple(c, ws); if (DUP & 512) phase_topk_simple(c, ws); }
    GRID_BAR();
#else
    { MKCTX(); phase_scores_topk(c, ws); if (DUP & 512) phase_scores_topk(c, ws); }
    GRID_BAR();
#endif
#if PEER_BITS == 8
    { MKCTX(); phase_peer(c, ARG_OUT(), ARG_IN(15), ARG_OUT(), ws); }
#else
#if U_MFMA
    { MKCTX(); int nrep_ = (DUP & 8192) ? 2 : 1; asm volatile("" : "+s"(nrep_));
#pragma unroll 1
      for (int rep_ = 0; rep_ < nrep_; ++rep_) phase_peer4_u_mfma(c, ARG_IN(10), ws); }
#elif U_SORTED
    { MKCTX(); int nrep_ = (DUP & 8192) ? 2 : 1; asm volatile("" : "+s"(nrep_));
#pragma unroll 1
      for (int rep_ = 0; rep_ < nrep_; ++rep_) phase_peer4_u_sorted(c, ARG_IN(10), ws); }
#else
    { MKCTX(); phase_peer4_u<false>(c, ARG_IN(10), ws); }
#endif
    if (DUP & 4096) { MKCTX(); phase_peer4_u<true>(c, ARG_IN(10), ws); }
    asm volatile("s_waitcnt vmcnt(0)" ::: "memory");
#if V_MFMA && V_SORTED
    { MKCTX(); phase_peer4_v_sorted(c, ARG_IN(15), ARG_OUT(), ws); }
#elif V_MFMA
    { MKCTX(); phase_peer4_v_mfma(c, ARG_IN(15), ARG_OUT(), ws); }
#else
    { MKCTX(); phase_peer4_v(c, ARG_IN(15), ARG_OUT(), ws); }
#endif
#endif
}

extern "C" void kernel_launch(void* const* d_in, const int* in_sizes, int n_in, void* d_out, int out_size, void* d_ws, size_t ws_size, hipStream_t stream) {
    static int grid = 0;
    if (grid == 0) {
        if (n_in != 16 || in_sizes[0] != T * D || out_size != T * D || ws_size < WS_END) { fprintf(stderr, "kernel_launch: unexpected shapes (n_in %d, in0 %d, out %d, ws %zu)\n", n_in, n_in > 0 ? in_sizes[0] : -1, out_size, ws_size); grid = -1; return; }
        int dev = 0, cus = 0, per_cu = 0;
        if (hipGetDevice(&dev) != hipSuccess || hipDeviceGetAttribute(&cus, hipDeviceAttributeMultiprocessorCount, dev) != hipSuccess) { grid = -1; return; }
        if (hipFuncSetAttribute((const void*)fwd_kernel, hipFuncAttributeMaxDynamicSharedMemorySize, LDS_BYTES) != hipSuccess) { fprintf(stderr, "kernel_launch: hipFuncSetAttribute failed\n"); grid = -1; return; }
        if (hipOccupancyMaxActiveBlocksPerMultiprocessor(&per_cu, (const void*)fwd_kernel, NTHREADS, LDS_BYTES) != hipSuccess || per_cu < 1) { fprintf(stderr, "kernel_launch: occupancy query reports %d workgroups per CU\n", per_cu); }
        (void)hipGetLastError();
        grid = (cus < 256) ? cus : 256;
    }
    if (grid < 0) return;
    if (hipMemsetAsync((char*)d_ws + WS_CTL, 0, CTL_ZERO_BYTES, stream) != hipSuccess) return;
    Args a{};
    for (int i = 0; i < 16; ++i) a.in[i] = (const float*)d_in[i];
    a.out = (float*)d_out; a.ws = (unsigned char*)d_ws;
    hipLaunchKernelGGL(fwd_kernel, dim3(grid), dim3(NTHREADS), LDS_BYTES, stream, a);
}
```

```cpp
#include <hip/hip_runtime.h>
#include <cstdio>
#include <cstdint>
#ifndef ATTN_SIMPLE
#define ATTN_SIMPLE 0
#endif
#ifndef TOPK_SIMPLE
#define TOPK_SIMPLE 0
#endif
#ifndef PEER_BITS
#define PEER_BITS 4
#endif
#ifndef V_BSH
#define V_BSH 11
#endif
#ifndef V_SORTED
#define V_SORTED 1
#endif
#ifndef V_MFMA
#define V_MFMA 1
#endif
#ifndef P2_I8
#define P2_I8 1
#endif
#ifndef U_MFMA
#define U_MFMA 1
#endif
#ifndef U_SORTED
#define U_SORTED 1
#endif
#ifndef DUP
#define DUP 0
#endif
namespace pg8 {
#define PG8_LAS __attribute__((address_space(3)))
typedef unsigned short bf16_t;
typedef short bf16x8 __attribute__((ext_vector_type(8)));
typedef float f32x4 __attribute__((ext_vector_type(4)));
typedef unsigned u32x4 __attribute__((ext_vector_type(4)));
constexpr int BM = 256, BK = 64, HALF = 128, HTB = HALF * BK * 2  , STAGE_BYTES = 8 * HTB, NXCD = 8, WGM = 8;

__host__ __device__ __forceinline__ int lds_byte(int r, int c) { const int st = (r >> 4) * 2 + (c >> 5), rr = r & 15, cc = c & 31, ob = rr * 64 + cc * 2; return st * 1024 + (ob ^ (((ob >> 9) & 1) << 5)); }
__host__ __device__ __forceinline__ void stage_rc(int b, int& R, int& C) { const int st = b / 1024, sb = b % 1024, swz = sb ^ (((sb >> 9) & 1) << 5); R = (st >> 1) * 16 + swz / 64; C = (st & 1) * 32 + (swz % 64) / 2; }
__host__ __device__ __forceinline__ int perm32(int rho) { const int n = rho >> 4, i = rho & 15; return 8 * (i >> 2) + 4 * n + (i & 3); }

struct Unit { int pm, pn; };
struct Gemm { const bf16_t* A; const bf16_t* Bt; int M, N, K, lda, ldb, apn, bhalf; };

struct StaticOrder {
    int nM, nN, nwg, G, c;
    __host__ __device__ __forceinline__ void init(int M, int N, int G_, int c_) { nM = M / BM; nN = N / BM; nwg = nM * nN; G = G_; c = c_; }
    __host__ __device__ __forceinline__ bool next(int i, Unit& u) const {
        const long L = (long)i * G + c; if (L >= nwg) return false;
        int wgid = (int)L; { const int q = nwg / NXCD, r = nwg % NXCD, xcd = wgid % NXCD, off = wgid / NXCD; wgid = (xcd < r ? xcd * (q + 1) : r * (q + 1) + (xcd - r) * q) + off; }
        const int nig = WGM * nN, gid = wgid / nig, fm = gid * WGM, gsz = (nM - fm) < WGM ? (nM - fm) : WGM;
        u.pm = fm + ((wgid % nig) % gsz); u.pn = (wgid % nig) / gsz; return true;
    }
    __device__ __forceinline__ void a_ready(const Unit&) const {}
    __device__ __forceinline__ void done(const Unit&) const {}
};
__device__ __forceinline__ unsigned cvt_pk_bf16(float lo, float hi) { typedef __bf16 bf2_ __attribute__((ext_vector_type(2))); bf2_ v; v[0] = (__bf16)lo; v[1] = (__bf16)hi; return __builtin_bit_cast(unsigned, v); }
template <int MODE> __device__ __forceinline__ f32x4 mma1(bf16x8 a, bf16x8 b, f32x4 c) {
    typedef int i32x4_ __attribute__((ext_vector_type(4)));
    if constexpr (MODE == 2) return __builtin_bit_cast(f32x4, __builtin_amdgcn_mfma_i32_16x16x64_i8(__builtin_bit_cast(i32x4_, a), __builtin_bit_cast(i32x4_, b), __builtin_bit_cast(i32x4_, c), 0, 0, 0));
    else return __builtin_amdgcn_mfma_f32_16x16x32_bf16(a, b, c, 0, 0, 0);
}
template <class Epi, class Sched, bool STAMP = false, int MODE = 0>
__device__ __forceinline__ void gemm_phase(PG8_LAS unsigned char* lds, const Gemm g, const Sched& S, const Epi& E, unsigned long long* stamps, int wid_in) {
    unsigned ones_ = ~0u; asm volatile("" : "+s"(ones_)); int lane_ = (int)__builtin_amdgcn_mbcnt_hi(ones_, __builtin_amdgcn_mbcnt_lo(ones_, 0u)); asm volatile("" : "+v"(lane_));
    const int wid = __builtin_amdgcn_readfirstlane(wid_in), lane = lane_, tid = wid * 64 + lane, wr = wid >> 2, wc = wid & 3, fr = lane & 15, fq = lane >> 4;
    int K_ = g.K; asm volatile("" : "+s"(K_));
    const int K = K_, nt = K / BK;
    int ts_lo = 0, ts_hi = 0, nts = 0; const unsigned long long rt_entry = STAMP ? (unsigned long long)wall_clock64() : 0ull;
#define PG8_STAMP() do { if (STAMP && wid == 0 && nts < 64) { const unsigned long long _c = (unsigned long long)clock64(); \
        ts_lo = (lane == nts) ? (int)(unsigned)_c : ts_lo; ts_hi = (lane == nts) ? (int)(unsigned)(_c >> 32) : ts_hi; ++nts; } } while (0)
    PG8_STAMP();
    unsigned voffA[2], voffB[2];
#pragma unroll
    for (int i = 0; i < 2; ++i) { int R, C; stage_rc(tid * 16 + i * 8192, R, C); const int Rb = Epi::PERM ? ((R & ~31) + perm32(R & 31)) : R;
        voffA[i] = (unsigned)(R * g.lda + C) * 2u; voffB[i] = (unsigned)(Rb * g.ldb + C) * 2u; }
    const size_t kstep = (size_t)(BK * 2);
    const size_t hstepA = (size_t)HALF * g.lda * 2, hstepB = (size_t)HALF * g.ldb * 2;
    const size_t tstepA = 2 * hstepA, tstepB = 2 * hstepB;
    const unsigned ldsw = (unsigned)wid * 1024u;
    const int aoff = lds_byte(wr * 64 + fr, fq * 8), boff = lds_byte(wc * 32 + fr, fq * 8);
#define PG8_SA(b, h) (((b) * 2 + (h)) * HTB)
#define PG8_SB(b, h) ((4 + (b) * 2 + (h)) * HTB)
#define PG8_STAGE(bufoff, gbase, voff) do { _Pragma("unroll") for (int _i = 0; _i < 2; ++_i) \
        __builtin_amdgcn_global_load_lds((const unsigned*)((const char*)(gbase) + (voff)[_i]), (PG8_LAS unsigned*)(lds + (bufoff) + ldsw + _i * 8192), 16, 0, 0); } while (0)
#define PG8_LDA(dst, b, h) do { _Pragma("unroll") for (int m = 0; m < 4; ++m) _Pragma("unroll") for (int k = 0; k < 2; ++k) dst[m][k] = *(const PG8_LAS bf16x8*)(lds + PG8_SA(b, h) + aoff + m * 2048 + k * 1024); } while (0)
#define PG8_LDB(dst, b, h) do { _Pragma("unroll") for (int n = 0; n < 2; ++n) _Pragma("unroll") for (int k = 0; k < 2; ++k) dst[n][k] = *(const PG8_LAS bf16x8*)(lds + PG8_SB(b, h) + boff + n * 2048 + k * 1024); } while (0)
#define PG8_MMA(ai, bj, At, Bt) do { __builtin_amdgcn_s_setprio(1); _Pragma("unroll") for (int m = 0; m < 4; ++m) _Pragma("unroll") for (int n = 0; n < 2; ++n) _Pragma("unroll") for (int k = 0; k < 2; ++k) \
        acc[ai][bj][m][n] = mma1<MODE>(Bt[n][k], At[m][k], acc[ai][bj][m][n]); __builtin_amdgcn_s_setprio(0); } while (0)
#define PG8_WAIT_V(n) asm volatile("s_waitcnt vmcnt(" #n ")" ::: "memory")
#define PG8_WAIT_L(n) asm volatile("s_waitcnt lgkmcnt(" #n ")" ::: "memory")
#define PG8_BAR __builtin_amdgcn_s_barrier()
#define PG8_SCHED __builtin_amdgcn_sched_barrier(0)
    Unit cur, nxt; int ui = 0;
    if (!S.next(0, cur)) return;
    f32x4 acc[2][2][4][2];
#pragma unroll
    for (int a = 0; a < 2; ++a)
#pragma unroll
        for (int b = 0; b < 2; ++b)
#pragma unroll
            for (int m = 0; m < 4; ++m)
#pragma unroll
                for (int n = 0; n < 2; ++n) acc[a][b][m][n] = (f32x4){0.f, 0.f, 0.f, 0.f};
    bf16x8 At[4][2], B0[2][2], B1[2][2];
    const char* cA = (const char*)g.A + (size_t)cur.pm * tstepA + (size_t)cur.pn * g.apn; const char* cB = (const char*)g.Bt + (size_t)cur.pn * tstepB + ((2 * cur.pm * BM >= g.M) ? (size_t)g.bhalf : (size_t)0);
    S.a_ready(cur);
    PG8_STAGE(PG8_SB(0, 0), cB, voffB); PG8_STAGE(PG8_SA(0, 0), cA, voffA); PG8_STAGE(PG8_SB(0, 1), cB + hstepB, voffB); PG8_STAGE(PG8_SA(0, 1), cA + hstepA, voffA);
    if (wr == 1) PG8_BAR;
    PG8_WAIT_V(4); PG8_BAR;
    PG8_STAGE(PG8_SB(1, 0), cB + kstep, voffB); PG8_STAGE(PG8_SA(1, 0), cA + kstep, voffA); PG8_STAGE(PG8_SB(1, 1), cB + hstepB + kstep, voffB);
    PG8_WAIT_V(6); PG8_BAR;
    PG8_STAMP();
    for (;;) {
        const bool has_next = S.next(ui + 1, nxt);
        const char* nA = has_next ? (const char*)g.A + (size_t)nxt.pm * tstepA + (size_t)nxt.pn * g.apn : cA; const char* nB = has_next ? (const char*)g.Bt + (size_t)nxt.pn * tstepB + ((2 * nxt.pm * BM >= g.M) ? (size_t)g.bhalf : (size_t)0) : cB;
        for (int t = 0; t < nt; t += 2) {
            const bool last = (t == nt - 2);
            const char* a1 = cA + (size_t)(t + 1) * kstep;
            const char* a2 = last ? nA : cA + (size_t)(t + 2) * kstep; const char* b2 = last ? nB : cB + (size_t)(t + 2) * kstep;
            const char* a3 = a2 + kstep; const char* b3 = b2 + kstep;
            if (last && has_next) S.a_ready(nxt);
            PG8_LDB(B0, 0, 0); PG8_SCHED; PG8_LDA(At, 0, 0); PG8_STAGE(PG8_SA(1, 1), a1 + hstepA, voffA);
            PG8_WAIT_L(8); PG8_BAR; PG8_WAIT_L(0); PG8_MMA(0, 0, At, B0); PG8_BAR; PG8_SCHED;
            PG8_LDB(B1, 0, 1); PG8_STAGE(PG8_SB(0, 0), b2, voffB);
            PG8_BAR; PG8_WAIT_L(0); PG8_MMA(0, 1, At, B1); PG8_BAR;
            PG8_LDA(At, 0, 1); PG8_STAGE(PG8_SA(0, 0), a2, voffA);
            PG8_BAR; PG8_WAIT_L(0); PG8_MMA(1, 0, At, B0); PG8_BAR; PG8_SCHED;
            PG8_STAGE(PG8_SB(0, 1), b2 + hstepB, voffB);
            PG8_WAIT_V(6); PG8_BAR; PG8_MMA(1, 1, At, B1); PG8_BAR;
            PG8_LDB(B0, 1, 0); PG8_SCHED; PG8_LDA(At, 1, 0); PG8_STAGE(PG8_SA(0, 1), a2 + hstepA, voffA);
            PG8_WAIT_L(8); PG8_BAR; PG8_WAIT_L(0); PG8_MMA(0, 0, At, B0); PG8_BAR; PG8_SCHED;
            PG8_LDB(B1, 1, 1); PG8_STAGE(PG8_SB(1, 0), b3, voffB);
            PG8_BAR; PG8_WAIT_L(0); PG8_MMA(0, 1, At, B1); PG8_BAR;
            PG8_LDA(At, 1, 1); PG8_STAGE(PG8_SA(1, 0), a3, voffA);
            PG8_BAR; PG8_WAIT_L(0); PG8_MMA(1, 0, At, B0); PG8_BAR; PG8_SCHED;
            PG8_STAGE(PG8_SB(1, 1), b3 + hstepB, voffB);
            PG8_WAIT_V(6); PG8_BAR; PG8_MMA(1, 1, At, B1); PG8_BAR;
        }
        PG8_STAMP();
        if constexpr (!Epi::AFTER_DRAIN) { E(acc, cur, wr, wc, fr, fq); S.done(cur); }
        PG8_STAMP();
        if (!has_next) break;
#pragma unroll
        for (int a = 0; a < 2; ++a)
#pragma unroll
            for (int b = 0; b < 2; ++b)
#pragma unroll
                for (int m = 0; m < 4; ++m)
#pragma unroll
                    for (int n = 0; n < 2; ++n) acc[a][b][m][n] = (f32x4){0.f, 0.f, 0.f, 0.f};
        cur = nxt; cA = nA; cB = nB; ++ui;
    }
    PG8_WAIT_V(0);
    if (wr == 0) PG8_BAR;
    PG8_BAR;
    if constexpr (Epi::AFTER_DRAIN) { E.fused(acc, cur, wr, wc, fr, fq, lds, wid, lane); S.done(cur); }
    PG8_STAMP();
    if (STAMP && wid == 0) { stamps[lane] = lane < nts ? (((unsigned long long)(unsigned)ts_hi << 32) | (unsigned)ts_lo) : 0ull;
        if (lane == 62) stamps[62] = rt_entry; if (lane == 63) stamps[63] = (unsigned long long)wall_clock64(); }
#undef PG8_STAMP
#undef PG8_SA
#undef PG8_SB
#undef PG8_STAGE
#undef PG8_LDA
#undef PG8_LDB
#undef PG8_MMA
#undef PG8_WAIT_V
#undef PG8_WAIT_L
#undef PG8_BAR
#undef PG8_SCHED
}
}


constexpr int NWAVES = 8, NTHREADS = 512;
constexpr int BATCH = 2, SEQ = 8192, T = BATCH * SEQ, D = 2048;
constexpr int AW = 1024, NH = 8, HD = 128, PW = 1024, INW = 4096;
constexpr int NMOD = 6 * D;
constexpr int PE_HEADS = 8, PE_NK = 128, PE_EXP = 16384, PE_K = 16;
constexpr float NORM_EPS = 1e-6f;
constexpr float QSCALE = 0.08838834764831845f * 1.4426950408889634f;

constexpr size_t MiB = 1u << 20;
constexpr size_t WS_CTL = 0, CTL_ZERO_BYTES = 64 * 1024;
constexpr size_t WS_MODP = 1 * MiB;
constexpr size_t WS_MODF = 1 * MiB + 832 * 1024;
constexpr size_t WS_SA = 1 * MiB + 928 * 1024, WS_SB = 1 * MiB + 992 * 1024;
constexpr size_t WS_CS = 2 * MiB;
constexpr size_t WS_WTIN = 4 * MiB;
constexpr size_t WS_WTOUT = 20 * MiB;
constexpr size_t WS_WTQ = 28 * MiB, WS_W8 = WS_WTQ;
constexpr size_t WS_WTPOOL = 36 * MiB;
constexpr size_t WS_SKP = 37 * MiB;
constexpr size_t WS_SU = 38 * MiB, WS_SV = 38 * MiB + 64 * 1024;
constexpr size_t WS_PU = 40 * MiB, WS_PV = 104 * MiB;
constexpr size_t WS_HB = 168 * MiB, WS_H8 = WS_HB;
constexpr size_t WS_Q = 232 * MiB, WS_K = 264 * MiB, WS_V = 296 * MiB, WS_U = 328 * MiB;
constexpr size_t WS_HC = 360 * MiB;
constexpr size_t WS_RB = 424 * MiB;
constexpr size_t WS_QP = WS_Q;
constexpr size_t WS_SC = WS_V;
constexpr size_t WS_IDX = WS_RB, WS_GATE = WS_RB + 8 * MiB;
constexpr size_t WS_TQ = WS_RB + 16 * MiB, WS_CSC = WS_RB + 24 * MiB;
constexpr size_t WS_OP0 = WS_HB, WS_OP1 = WS_HB + 32 * MiB, WS_OP2 = 456 * MiB;
constexpr size_t WS_X1B = WS_V;
constexpr size_t WS_LSE = 488 * MiB;
constexpr size_t WS_WQ2 = 490 * MiB;
constexpr size_t WS_BIASP = 506 * MiB;
constexpr size_t WS_RSQP = 507 * MiB;
constexpr size_t WS_END = 509 * MiB;

constexpr int RING_BYTES = 131072, MISC_OFF = RING_BYTES, LDS_BYTES = 147456;

#define GAS __attribute__((address_space(1)))
typedef unsigned short bf16;
typedef unsigned v4u __attribute__((ext_vector_type(4)));
typedef unsigned v2u __attribute__((ext_vector_type(2)));
typedef float f32x4 __attribute__((ext_vector_type(4)));
typedef __bf16 bf2 __attribute__((ext_vector_type(2)));
#define LDS_WAIT() asm volatile("s_waitcnt lgkmcnt(0)" ::: "memory")
#define VM_WAIT() asm volatile("s_waitcnt vmcnt(0)" ::: "memory")
__device__ __forceinline__ unsigned pk2(float lo, float hi) { return pg8::cvt_pk_bf16(lo, hi); }
__device__ __forceinline__ float bflo(unsigned w) { return __uint_as_float(w << 16); }
__device__ __forceinline__ float bfhi(unsigned w) { return __uint_as_float(w & 0xffff0000u); }
__device__ __forceinline__ float dot2(unsigned a, unsigned b, float c) { return __builtin_amdgcn_fdot2_f32_bf16(__builtin_bit_cast(bf2, a), __builtin_bit_cast(bf2, b), c, false); }
__device__ __forceinline__ int my_lane() { unsigned ones = ~0u; asm volatile("" : "+s"(ones)); return (int)__builtin_amdgcn_mbcnt_hi(ones, __builtin_amdgcn_mbcnt_lo(ones, 0u)); }
__device__ __forceinline__ int sh_idx(int v, int idx) { return __builtin_amdgcn_ds_bpermute(idx << 2, v); }
__device__ __forceinline__ unsigned sh_idx(unsigned v, int idx) { return (unsigned)__builtin_amdgcn_ds_bpermute(idx << 2, (int)v); }
__device__ __forceinline__ float sh_idx(float v, int idx) { return __int_as_float(__builtin_amdgcn_ds_bpermute(idx << 2, __float_as_int(v))); }
#define SXOR(v, m, lane) sh_idx((v), (lane) ^ (m))
__device__ __forceinline__ float wave_sum(float v) {
    const int lane = my_lane();
#pragma unroll
    for (int o = 1; o < 64; o <<= 1) v += SXOR(v, o, lane);
    return v;
}
__device__ __forceinline__ int wave_sum_i(int v) {
    const int lane = my_lane();
#pragma unroll
    for (int o = 1; o < 64; o <<= 1) v += SXOR(v, o, lane);
    return v;
}
__device__ __forceinline__ float wave_max(float v) {
    const int lane = my_lane();
#pragma unroll
    for (int o = 1; o < 64; o <<= 1) v = fmaxf(v, SXOR(v, o, lane));
    return v;
}

#define XB_TMO      128
#define XB_XCNT(j)  (256  + 64 * (j))
#define XB_XSUB(j)  (1280 + 64 * (j))
#define XB_XGEN(j)  (2304 + 64 * (j))
#define XB_TOP      3328
#define XB_TOPGEN   3392
#define XCD_BAR_WORDS 3456
#define XB_SPIN_CAP (1u << 18)
#define LAS __attribute__((address_space(3)))

__device__ __forceinline__ unsigned xb_ld(unsigned* p)              { return __hip_atomic_load(p, __ATOMIC_RELAXED, __HIP_MEMORY_SCOPE_AGENT); }
__device__ __forceinline__ unsigned xb_add(unsigned* p, unsigned v) { return __hip_atomic_fetch_add(p, v, __ATOMIC_RELAXED, __HIP_MEMORY_SCOPE_AGENT); }
__device__ __forceinline__ unsigned xb_xcc_id() { return (unsigned)__builtin_amdgcn_s_getreg((3 << 11) | 20) & 0xFu; }
#define XB_SPIN(cond, bar) do { unsigned _sp = 0; while (cond) { __builtin_amdgcn_s_sleep(1); \
    if ((++_sp & 255u) == 0u) { if (xb_ld(&(bar)[XB_TMO])) break; if (_sp > XB_SPIN_CAP) { atomicAdd(&(bar)[XB_TMO], 1u); break; } } } } while (0)

struct XcdBarrier {
    unsigned* bar; unsigned x;
    volatile LAS unsigned* st;
};

__device__ __forceinline__ XcdBarrier xcd_barrier_post(unsigned* bar, volatile LAS unsigned* st, bool is_t0) {
    XcdBarrier b; b.bar = bar; b.x = xb_xcc_id(); b.st = st;
    if (is_t0) (void)xb_add(&bar[XB_XCNT(b.x)], 1u);
    return b;
}
__device__ __forceinline__ void xcd_barrier_complete(unsigned* bar, unsigned x, unsigned& nloc, unsigned& nx) {
    const unsigned G = gridDim.x * gridDim.y * gridDim.z;
    unsigned sum, cnt, mine, sp = 0u;
    for (;;) {
        sum = 0u; cnt = 0u; mine = 0u;
#pragma unroll
        for (unsigned j = 0; j < 16; ++j) { const unsigned c = xb_ld(&bar[XB_XCNT(j)]); sum += c; cnt += (c > 0u) ? 1u : 0u; mine = (j == x) ? c : mine; }
        if (sum == G) break;
        __builtin_amdgcn_s_sleep(1);
        if ((++sp & 255u) == 0u) { if (xb_ld(&bar[XB_TMO])) break; if (sp > XB_SPIN_CAP) { atomicAdd(&bar[XB_TMO], 1u); break; } }
    }
    nloc = mine > 0u ? mine : 1u; nx = cnt > 0u ? cnt : 1u;
}

__device__ __forceinline__ void xcd_barrier(const XcdBarrier& b, bool is_t0) {
    asm volatile("s_waitcnt vmcnt(0)" ::: "memory");
    __syncthreads();
    if (is_t0) {
        unsigned* bar = b.bar;
        __builtin_amdgcn_s_waitcnt(0);
        unsigned nloc = b.st[0], nx = b.st[1];
        if (nloc == 0u) { xcd_barrier_complete(bar, b.x, nloc, nx); b.st[0] = nloc; b.st[1] = nx; }
        const unsigned old = xb_add(&bar[XB_XSUB(b.x)], 1u);
        const unsigned gen = old / nloc;
        if (old + 1u == (gen + 1u) * nloc) {
            __builtin_amdgcn_fence(__ATOMIC_RELEASE, "agent");
            asm volatile("s_waitcnt vmcnt(0)" ::: "memory");
            const unsigned og = xb_add(&bar[XB_TOP], 1u);
            const unsigned tg = og / nx;
            if (og + 1u == (tg + 1u) * nx) xb_add(&bar[XB_TOPGEN], 1u);
            else XB_SPIN(xb_ld(&bar[XB_TOPGEN]) == tg, bar);
            __builtin_amdgcn_fence(__ATOMIC_ACQUIRE, "agent");
            xb_add(&bar[XB_XGEN(b.x)], 1u);
            asm volatile("s_waitcnt vmcnt(0)" ::: "memory");
        } else {
            XB_SPIN(xb_ld(&bar[XB_XGEN(b.x)]) == gen, bar);
            __builtin_amdgcn_fence(__ATOMIC_ACQUIRE, "agent");
            asm volatile("s_waitcnt vmcnt(0)" ::: "memory");
        }
    }
    __syncthreads();
}

struct Ctx { LAS unsigned char* lds; int tid, lane, wave, vcu, G, gw, ngw; };

struct Epi1 {
    static constexpr bool PERM = true, AFTER_DRAIN = false;
    bf16* QKVU; const float* CS; const float* SA; const float* SB;
    __device__ __forceinline__ void operator()(const pg8::f32x4 (&acc)[2][2][4][2], const pg8::Unit& u, int wr, int wc, int fr, int fq) const {
        const int row0 = u.pm * 256 + wr * 64 + fr; const int tt = u.pn >> 2; const int colt = (u.pn & 3) * 256;
        bf16* base = QKVU + (size_t)tt * ((size_t)T * 1024);
        const int col0 = colt + wc * 32 + 8 * fq;
        const bool rot = (tt < 2) && (wc == 0);
        const float sc = (tt == 0) ? QSCALE : 1.0f;
        const float sgn = (fq < 2) ? -1.0f : 1.0f;
        f32x4 sb[2][2];
        if (P2_I8) { const int gcol0 = u.pn * 256 + wc * 32 + 8 * fq;
#pragma unroll
            for (int bj = 0; bj < 2; ++bj) { sb[bj][0] = *(const f32x4*)(SB + gcol0 + bj * 128); sb[bj][1] = *(const f32x4*)(SB + gcol0 + bj * 128 + 4); } }
#pragma unroll
        for (int ai = 0; ai < 2; ++ai)
#pragma unroll
            for (int m = 0; m < 4; ++m) {
                const int row = row0 + ai * 128 + m * 16;
                bf16* rowp = base + (size_t)row * 1024 + col0;
                const float sr = P2_I8 ? SA[row] : 1.0f;
                f32x4 c0 = {1.f, 1.f, 1.f, 1.f}, c1 = c0, s0 = {0.f, 0.f, 0.f, 0.f}, s1 = s0;
                if (rot) { const float* cs = CS + (size_t)row * 32 + 8 * (fq & 1);
                    c0 = *(const f32x4*)(cs); c1 = *(const f32x4*)(cs + 4); s0 = *(const f32x4*)(cs + 16); s1 = *(const f32x4*)(cs + 20); }
#pragma unroll
                for (int bj = 0; bj < 2; ++bj) {
                    f32x4 v0 = acc[ai][bj][m][0], v1 = acc[ai][bj][m][1];
                    if (P2_I8) { typedef int i32x4_ __attribute__((ext_vector_type(4))); const i32x4_ i0 = __builtin_bit_cast(i32x4_, v0), i1 = __builtin_bit_cast(i32x4_, v1);
#pragma unroll
                        for (int e = 0; e < 4; ++e) { v0[e] = (float)i0[e] * (sr * sb[bj][0][e]); v1[e] = (float)i1[e] * (sr * sb[bj][1][e]); } }
                    if (rot) {
#pragma unroll
                        for (int e = 0; e < 4; ++e) {
                            const float p0 = SXOR(v0[e], 32, 16 * fq + fr), p1 = SXOR(v1[e], 32, 16 * fq + fr);
                            v0[e] = v0[e] * c0[e] + sgn * p0 * s0[e];
                            v1[e] = v1[e] * c1[e] + sgn * p1 * s1[e];
                        }
                    }
                    pg8::u32x4 w; w.x = pk2(v0[0] * sc, v0[1] * sc); w.y = pk2(v0[2] * sc, v0[3] * sc); w.z = pk2(v1[0] * sc, v1[1] * sc); w.w = pk2(v1[2] * sc, v1[3] * sc);
                    *(pg8::u32x4*)(rowp + bj * 128) = w;
                }
            }
    }
};
struct EpiPool {
    static constexpr bool PERM = true, AFTER_DRAIN = false;
    bf16* HC; const float* pscale;
    __device__ __forceinline__ void operator()(const pg8::f32x4 (&acc)[2][2][4][2], const pg8::Unit& u, int wr, int wc, int fr, int fq) const {
        const int row0 = u.pm * 256 + wr * 64 + fr, col0 = u.pn * 256 + wc * 32 + 8 * fq;
        f32x4 ps[2][2];
#pragma unroll
        for (int bj = 0; bj < 2; ++bj) { ps[bj][0] = *(const f32x4*)(pscale + col0 + bj * 128); ps[bj][1] = *(const f32x4*)(pscale + col0 + bj * 128 + 4); }
#pragma unroll
        for (int ai = 0; ai < 2; ++ai)
#pragma unroll
            for (int m = 0; m < 4; ++m) {
                bf16* rowp = HC + (size_t)(row0 + ai * 128 + m * 16) * 2048 + 1024 + col0;
#pragma unroll
                for (int bj = 0; bj < 2; ++bj) {
                    const f32x4 v0 = acc[ai][bj][m][0] * ps[bj][0], v1 = acc[ai][bj][m][1] * ps[bj][1];
                    pg8::u32x4 w; w.x = pk2(v0[0], v0[1]); w.y = pk2(v0[2], v0[3]); w.z = pk2(v1[0], v1[1]); w.w = pk2(v1[2], v1[3]);
                    *(pg8::u32x4*)(rowp + bj * 128) = w;
                }
            }
    }
};
struct EpiBf {
    static constexpr bool PERM = true, AFTER_DRAIN = false;
    bf16* O; int ldc;
    __device__ __forceinline__ void operator()(const pg8::f32x4 (&acc)[2][2][4][2], const pg8::Unit& u, int wr, int wc, int fr, int fq) const {
        const int row0 = u.pm * 256 + wr * 64 + fr, col0 = u.pn * 256 + wc * 32 + 8 * fq;
#pragma unroll
        for (int ai = 0; ai < 2; ++ai)
#pragma unroll
            for (int m = 0; m < 4; ++m) {
                bf16* rowp = O + (size_t)(row0 + ai * 128 + m * 16) * ldc + col0;
#pragma unroll
                for (int bj = 0; bj < 2; ++bj) {
                    const f32x4 v0 = acc[ai][bj][m][0], v1 = acc[ai][bj][m][1];
                    pg8::u32x4 w; w.x = pk2(v0[0], v0[1]); w.y = pk2(v0[2], v0[3]); w.z = pk2(v1[0], v1[1]); w.w = pk2(v1[2], v1[3]);
                    *(pg8::u32x4*)(rowp + bj * 128) = w;
                }
            }
    }
};
struct EpiQ {
    static constexpr bool PERM = true, AFTER_DRAIN = false;
    bf16* O; const LAS float* rstdT; const LAS float* biasT; int pm0, pn0;
    __device__ __forceinline__ void operator()(const pg8::f32x4 (&acc)[2][2][4][2], const pg8::Unit& u, int wr, int wc, int fr, int fq) const {
        const int slot = (u.pm == pm0 && u.pn == pn0) ? 0 : 1;
        const int row0 = u.pm * 256 + wr * 64 + fr, col0 = u.pn * 256 + wc * 32 + 8 * fq;
        f32x4 bv[2][2];
#pragma unroll
        for (int bj = 0; bj < 2; ++bj) { bv[bj][0] = *(const LAS f32x4*)(biasT + slot * 256 + bj * 128 + wc * 32 + 8 * fq); bv[bj][1] = *(const LAS f32x4*)(biasT + slot * 256 + bj * 128 + wc * 32 + 8 * fq + 4); }
#pragma unroll
        for (int ai = 0; ai < 2; ++ai)
#pragma unroll
            for (int m = 0; m < 4; ++m) {
                const float rs = rstdT[slot * 256 + ai * 128 + wr * 64 + m * 16 + fr];
                bf16* rowp = O + (size_t)(row0 + ai * 128 + m * 16) * D + col0;
#pragma unroll
                for (int bj = 0; bj < 2; ++bj) {
                    const f32x4 v0 = acc[ai][bj][m][0] * rs + bv[bj][0], v1 = acc[ai][bj][m][1] * rs + bv[bj][1];
                    pg8::u32x4 w; w.x = pk2(v0[0], v0[1]); w.y = pk2(v0[2], v0[3]); w.z = pk2(v1[0], v1[1]); w.w = pk2(v1[2], v1[3]);
                    *(pg8::u32x4*)(rowp + bj * 128) = w;
                }
            }
    }
};
struct EpiF {
    static constexpr bool PERM = false, AFTER_DRAIN = false;
    float* C; int ldc;
    __device__ __forceinline__ void operator()(const pg8::f32x4 (&acc)[2][2][4][2], const pg8::Unit& u, int wr, int wc, int fr, int fq) const {
        const int row0 = u.pm * 256 + wr * 64 + fr, col0 = u.pn * 256 + wc * 32 + 4 * fq;
#pragma unroll
        for (int ai = 0; ai < 2; ++ai)
#pragma unroll
            for (int m = 0; m < 4; ++m) { float* rowp = C + (size_t)(row0 + ai * 128 + m * 16) * ldc + col0;
#pragma unroll
                for (int bj = 0; bj < 2; ++bj)
#pragma unroll
                    for (int n = 0; n < 2; ++n) *(f32x4*)(rowp + bj * 128 + n * 16) = acc[ai][bj][m][n]; }
    }
};
struct EpiOut {
    static constexpr bool PERM = true, AFTER_DRAIN = false;
    const float* X; bf16* X1; const float* MODF; float* RSQP;
    __device__ __forceinline__ void operator()(const pg8::f32x4 (&acc)[2][2][4][2], const pg8::Unit& u, int wr, int wc, int fr, int fq) const {
        const int row0 = u.pm * 256 + wr * 64 + fr, col0 = u.pn * 256 + wc * 32 + 8 * fq;
        const float* gp = MODF + (size_t)(u.pm >= 32 ? 1 : 0) * NMOD + 2 * D + col0;
        f32x4 gv[2][2];
#pragma unroll
        for (int bj = 0; bj < 2; ++bj)
#pragma unroll
            for (int n = 0; n < 2; ++n) gv[bj][n] = *(const f32x4*)(gp + bj * 128 + 4 * n);
#pragma unroll
        for (int ai = 0; ai < 2; ++ai)
#pragma unroll
            for (int m = 0; m < 4; ++m) { const size_t off = (size_t)(row0 + ai * 128 + m * 16) * D + col0; float ssr = 0.f;
#pragma unroll
                for (int bj = 0; bj < 2; ++bj) {
                    const f32x4 v0 = __builtin_nontemporal_load((const f32x4*)(X + off + bj * 128)) + gv[bj][0] * acc[ai][bj][m][0], v1 = __builtin_nontemporal_load((const f32x4*)(X + off + bj * 128 + 4)) + gv[bj][1] * acc[ai][bj][m][1];
                    pg8::u32x4 w; w.x = pk2(v0[0], v0[1]); w.y = pk2(v0[2], v0[3]); w.z = pk2(v1[0], v1[1]); w.w = pk2(v1[2], v1[3]);
                    *(pg8::u32x4*)(X1 + off + bj * 128) = w;
                    ssr += (v0[0] * v0[0] + v0[1] * v0[1]) + (v0[2] * v0[2] + v0[3] * v0[3]) + (v1[0] * v1[0] + v1[1] * v1[1]) + (v1[2] * v1[2] + v1[3] * v1[3]); }
                ssr += SXOR(ssr, 16, 16 * fq + fr); ssr += SXOR(ssr, 32, 16 * fq + fr);
                if (fq == 0) RSQP[(size_t)(row0 + ai * 128 + m * 16) * 32 + u.pn * 4 + wc] = ssr; }
    }
};

__device__ __forceinline__ void p0_transpose_item(const float* W, int K, int N, bf16* WT, int row_off, LAS float* scr, int item, int lane) {
    const int nblk = N / 32, kb = item / nblk, nb = item % nblk, k0 = 64 * kb, n0 = 32 * nb;
#pragma unroll 8
    for (int i = 0; i < 32; ++i) { const int kk = 2 * i + (lane >> 5); scr[kk * 33 + (lane & 31)] = W[(size_t)(k0 + kk) * N + n0 + (lane & 31)]; }
    LDS_WAIT(); asm volatile("" ::: "memory");
    const int c = lane & 7;
#pragma unroll
    for (int j = 0; j < 4; ++j) { const int n = (lane >> 3) + 8 * j; const LAS float* s = scr + (8 * c) * 33 + n;
        v4u o; o.x = pk2(s[0 * 33], s[1 * 33]); o.y = pk2(s[2 * 33], s[3 * 33]); o.z = pk2(s[4 * 33], s[5 * 33]); o.w = pk2(s[6 * 33], s[7 * 33]);
        *(v4u*)(WT + (size_t)(row_off + n0 + n) * K + k0 + 8 * c) = o; }
    LDS_WAIT(); asm volatile("" ::: "memory");
}
__device__ __forceinline__ float silu_f(float x) { return x / (1.0f + __expf(-x)); }
constexpr int MOD_ITEMS = 48 * 8;
__device__ __forceinline__ void p0_mod_item(const float* cvec, const float* w_mod, float* MODP, int item, int lane) {
    const int cb = item % 48, kc = item / 48, col = 256 * cb + 4 * lane, k0 = 256 * kc;
    f32x4 a0 = {0.f, 0.f, 0.f, 0.f}, a1 = a0;
    const float* wp = w_mod + (size_t)k0 * NMOD + col;
#pragma unroll 32
    for (int k = 0; k < 256; ++k) {
        const f32x4 w = __builtin_nontemporal_load((const f32x4*)(wp + (size_t)k * NMOD));
        const float s0 = silu_f(cvec[k0 + k]), s1 = silu_f(cvec[D + k0 + k]);
        a0 += w * s0; a1 += w * s1;
    }
    *(f32x4*)(MODP + ((size_t)kc * 2 + 0) * NMOD + col) = a0;
    *(f32x4*)(MODP + ((size_t)kc * 2 + 1) * NMOD + col) = a1;
}
template <int OFFS>
__device__ __forceinline__ void p0_quant_row(const float* src, unsigned char* dst, float* scale_out, int lane) {
    f32x4 v[8]; float am = 0.f;
#pragma unroll
    for (int j = 0; j < 8; ++j) { v[j] = *(const f32x4*)(src + 256 * j + 4 * lane); am = fmaxf(fmaxf(am, fmaxf(fabsf(v[j][0]), fabsf(v[j][1]))), fmaxf(fabsf(v[j][2]), fabsf(v[j][3]))); }
    am = wave_max(am);
    const float inv = (am > 0.f) ? 127.0f / am : 0.f;
    if (lane == 0) *scale_out = am * (1.0f / 127.0f);
#pragma unroll
    for (int j = 0; j < 8; ++j) {
        unsigned w = 0u;
#pragma unroll
        for (int e = 0; e < 4; ++e) { int q = __float2int_rn(v[j][e] * inv); q = q > 127 ? 127 : (q < -127 ? -127 : q); w |= ((unsigned)(q + OFFS) & 0xffu) << (8 * e); }
        *(unsigned*)(dst + 256 * j + 4 * lane) = w;
    }
}
__device__ __forceinline__ void p0_quant_load4(const float* src, int lane, f32x4 (&v)[8]) {
#pragma unroll
    for (int j = 0; j < 8; ++j) v[j] = __builtin_nontemporal_load((const f32x4*)(src + 256 * j + 4 * lane));
}
template <unsigned XR>
__device__ __forceinline__ void p0_quant_finish4(const f32x4 (&v)[8], unsigned char* dst, float* scale_out, int lane) {
    float am = 0.f, sq = 0.f;
#pragma unroll
    for (int j = 0; j < 8; ++j)
#pragma unroll
        for (int e = 0; e < 4; ++e) { am = fmaxf(am, fabsf(v[j][e])); sq += v[j][e] * v[j][e]; }
    am = wave_max(am); sq = wave_sum(sq);
    const float step = fmaxf(0.335f * sqrtf(sq * (1.0f / D)), am * (1.0f / 24.0f));
    const float inv = (step > 0.f) ? 1.0f / step : 0.f;
    if (lane == 0) *scale_out = step;
    v4u o;
#pragma unroll
    for (int d = 0; d < 4; ++d) {
        unsigned w = 0u;
#pragma unroll
        for (int e = 0; e < 4; ++e) {
            int lo = (int)floorf(v[2 * d][e] * inv) + 8, hi = (int)floorf(v[2 * d + 1][e] * inv) + 8;
            lo = lo < 0 ? 0 : (lo > 15 ? 15 : lo); hi = hi < 0 ? 0 : (hi > 15 ? 15 : hi);
            w |= ((unsigned)lo | ((unsigned)hi << 4)) << (8 * e);
        }
        w ^= XR * 0x01010101u;
        if (d == 0) o.x = w; else if (d == 1) o.y = w; else if (d == 2) o.z = w; else o.w = w;
    }
    *(v4u*)(dst + 16 * lane) = o;
}
__device__ __forceinline__ unsigned fp4_code(float x) {
    const float a = fabsf(x);
    const unsigned m = (unsigned)(a > 0.25f) + (unsigned)(a > 0.75f) + (unsigned)(a > 1.25f) + (unsigned)(a > 1.75f) + (unsigned)(a > 2.5f) + (unsigned)(a > 3.5f) + (unsigned)(a > 5.0f);
    return m | (x < 0.f ? 8u : 0u);
}
__device__ __forceinline__ void p0_quant_finish_fp4(const f32x4 (&v)[8], unsigned char* dst, float* scale_out, int lane) {
    float am = 0.f, sq = 0.f;
#pragma unroll
    for (int j = 0; j < 8; ++j)
#pragma unroll
        for (int e = 0; e < 4; ++e) { am = fmaxf(am, fabsf(v[j][e])); sq += v[j][e] * v[j][e]; }
    am = wave_max(am); sq = wave_sum(sq);
    const float step = fmaxf(0.48f * sqrtf(sq * (1.0f / D)), am * (1.0f / 18.0f));
    const float inv = (step > 0.f) ? 1.0f / step : 0.f;
    if (lane == 0) *scale_out = step;
    v4u o;
#pragma unroll
    for (int d = 0; d < 4; ++d) {
        unsigned w = 0u;
#pragma unroll
        for (int e = 0; e < 4; ++e) w |= (fp4_code(v[2 * d][e] * inv) | (fp4_code(v[2 * d + 1][e] * inv) << 4)) << (8 * e);
        if (d == 0) o.x = w; else if (d == 1) o.y = w; else if (d == 2) o.z = w; else o.w = w;
    }
    *(v4u*)(dst + 16 * lane) = o;
}
__device__ __forceinline__ void phase0(const Ctx& c, const float* const* in, unsigned char* ws) {
    const float* cvec = in[1]; const float* w_mod = in[3]; const float* w_in = in[6]; const float* w_pool = in[7]; const float* w_out = in[9];
    const float* w_query = in[11]; const float* sub_keys = in[12]; const float* peer_u = in[13]; const float* peer_v = in[14];
    LAS float* scr = (LAS float*)(c.lds + c.wave * 16384);
    if (c.gw < MOD_ITEMS) p0_mod_item(cvec, w_mod, (float*)(ws + WS_MODP), c.gw, c.lane);
    constexpr int I_IN = 32 * 128, I_OUT = 32 * 64, I_POOL = 4 * 32;
    for (int it = c.gw; it < I_IN + I_OUT + I_POOL; it += c.ngw) {
        int r = it;
        if (r < I_IN) { p0_transpose_item(w_in, D, INW, (bf16*)(ws + WS_WTIN), 0, scr, r, c.lane); continue; } r -= I_IN;
        if (r < I_OUT) { p0_transpose_item(w_out, D, D, (bf16*)(ws + WS_WTOUT), 0, scr, r, c.lane); continue; } r -= I_OUT;
        { const int g = r >> 5; p0_transpose_item(w_pool + (size_t)g * 65536, 256, 256, (bf16*)(ws + WS_WTPOOL), g * 256, scr, r & 31, c.lane); }
    }
#if TOPK_SIMPLE
    for (int r = c.gw; r < 2048; r += c.ngw) {
        const int p = (r >> 7) & 1, k = 4 * c.lane; v2u o = {0u, 0u};
        if ((k >> 7) == p) { const f32x4 s = *(const f32x4*)(sub_keys + (size_t)r * 128 + (k & 127)); o.x = pk2(s[0], s[1]); o.y = pk2(s[2], s[3]); }
        *(v2u*)((bf16*)(ws + WS_SKP) + (size_t)r * 256 + k) = o;
    }
#else
    for (int r = c.gw; r < 2048; r += c.ngw) {
        const float a = sub_keys[(size_t)r * 128 + 2 * c.lane], b = sub_keys[(size_t)r * 128 + 2 * c.lane + 1];
        *(unsigned*)((bf16*)(ws + WS_SKP) + (size_t)r * 128 + 2 * c.lane) = pk2(a, b);
    }
#endif
    if (c.gw >= MOD_ITEMS) {
        const int stride = c.ngw - MOD_ITEMS;
        int r = c.gw - MOD_ITEMS;
        f32x4 va[8], vb[8];
#define P0_SRC(R) (((R) < PE_EXP) ? peer_u + (size_t)(R) * D : peer_v + (size_t)((R) - PE_EXP) * D)
#define P0_FIN(V, R) do { if ((R) < PE_EXP) { if (U_MFMA) p0_quant_finish_fp4(V, ws + WS_PU + (size_t)(R) * 1024, (float*)(ws + WS_SU) + (R), c.lane); else p0_quant_finish4<0x88u>(V, ws + WS_PU + (size_t)(R) * 1024, (float*)(ws + WS_SU) + (R), c.lane); } \
                          else { if (V_MFMA) p0_quant_finish_fp4(V, ws + WS_PV + (size_t)((R) - PE_EXP) * 1024, (float*)(ws + WS_SV) + ((R) - PE_EXP), c.lane); else p0_quant_finish4<0x80u>(V, ws + WS_PV + (size_t)((R) - PE_EXP) * 1024, (float*)(ws + WS_SV) + ((R) - PE_EXP), c.lane); } } while (0)
        if (r < 2 * PE_EXP) p0_quant_load4(P0_SRC(r), c.lane, va);
        while (r < 2 * PE_EXP) {
            const int r1 = r + stride, r2 = r + 2 * stride;
            if (r1 < 2 * PE_EXP) p0_quant_load4(P0_SRC(r1), c.lane, vb);
            P0_FIN(va, r);
            if (r1 >= 2 * PE_EXP) break;
            if (r2 < 2 * PE_EXP) p0_quant_load4(P0_SRC(r2), c.lane, va);
            P0_FIN(vb, r1);
            r = r2;
        }
#undef P0_SRC
#undef P0_FIN
    }
}

__device__ __forceinline__ void p1_fold_q_item(const float* W, bf16* WQ2, float* BIASP, const LAS float* A2s, const LAS float* B2s, LAS float* scr, int item, int lane) {
    const int kb = item >> 6, nb = item & 63, k0 = 64 * kb, n0 = 32 * nb;
#pragma unroll 8
    for (int i = 0; i < 32; ++i) { const int kk = 2 * i + (lane >> 5); scr[kk * 33 + (lane & 31)] = W[(size_t)(k0 + kk) * D + n0 + (lane & 31)]; }
    LDS_WAIT(); asm volatile("" ::: "memory");
    {
        const int bb = lane >> 5, n = lane & 31; float sacc = 0.f;
#pragma unroll 8
        for (int kk = 0; kk < 64; ++kk) sacc += B2s[bb * D + k0 + kk] * scr[kk * 33 + n];
        BIASP[((size_t)kb * 2 + bb) * D + n0 + n] = sacc;
    }
    const int c8 = lane & 7;
#pragma unroll
    for (int bb = 0; bb < 2; ++bb) {
        const f32x4 a0 = *(const LAS f32x4*)(A2s + bb * D + k0 + 8 * c8), a1 = *(const LAS f32x4*)(A2s + bb * D + k0 + 8 * c8 + 4);
#pragma unroll
        for (int j = 0; j < 4; ++j) { const int n = (lane >> 3) + 8 * j; const LAS float* t = scr + (8 * c8) * 33 + n;
            v4u o; o.x = pk2(t[0 * 33] * a0[0], t[1 * 33] * a0[1]); o.y = pk2(t[2 * 33] * a0[2], t[3 * 33] * a0[3]); o.z = pk2(t[4 * 33] * a1[0], t[5 * 33] * a1[1]); o.w = pk2(t[6 * 33] * a1[2], t[7 * 33] * a1[3]);
            *(v4u*)(WQ2 + ((size_t)bb * D + n0 + n) * D + k0 + 8 * c8) = o; }
    }
    LDS_WAIT(); asm volatile("" ::: "memory");
}
template <bool FIRST>
__device__ __forceinline__ void phase_rows(const Ctx& c, const float* X, const bf16* XB, const float* gvec, const float* b_mod, const int* positions, unsigned char* ws, int shift_chunk, int scale_chunk, const float* gvec2 = nullptr, const float* w_query = nullptr) {
    LAS float* A1 = (LAS float*)c.lds; LAS float* B1 = A1 + D;
    const int b = c.vcu >> 7;
    const float* MODP = (const float*)(ws + WS_MODP); float* MODF = (float*)(ws + WS_MODF);
    {
        const int j = 4 * c.tid;
        f32x4 sh, sc;
        if (FIRST) {
            sh = *(const f32x4*)(b_mod + shift_chunk * D + j); sc = *(const f32x4*)(b_mod + scale_chunk * D + j);
#pragma unroll
            for (int s = 0; s < 8; ++s) { sh += *(const f32x4*)(MODP + ((size_t)s * 2 + b) * NMOD + shift_chunk * D + j); sc += *(const f32x4*)(MODP + ((size_t)s * 2 + b) * NMOD + scale_chunk * D + j); }
        } else { sh = *(const f32x4*)(MODF + (size_t)b * NMOD + shift_chunk * D + j); sc = *(const f32x4*)(MODF + (size_t)b * NMOD + scale_chunk * D + j); }
        const f32x4 g = *(const f32x4*)(gvec + j);
        *(LAS f32x4*)(A1 + j) = g * (sc + 1.0f); *(LAS f32x4*)(B1 + j) = sh;
    }
    LAS float* A2s = (LAS float*)(c.lds + 16384); LAS float* B2s = A2s + 2 * D;
    if (FIRST) {
        const int j = 4 * c.tid; const f32x4 g2v = *(const f32x4*)(gvec2 + j);
#pragma unroll
        for (int bb = 0; bb < 2; ++bb) {
            f32x4 sh = *(const f32x4*)(b_mod + 3 * D + j), sc = *(const f32x4*)(b_mod + 4 * D + j);
#pragma unroll
            for (int sx = 0; sx < 8; ++sx) { sh += *(const f32x4*)(MODP + ((size_t)sx * 2 + bb) * NMOD + 3 * D + j); sc += *(const f32x4*)(MODP + ((size_t)sx * 2 + bb) * NMOD + 4 * D + j); }
            *(LAS f32x4*)(A2s + bb * D + j) = g2v * (sc + 1.0f); *(LAS f32x4*)(B2s + bb * D + j) = sh;
        }
    }
    if (FIRST && c.vcu < 48 && c.tid < 256) {
        const int col = 256 * c.vcu + c.tid;
#pragma unroll
        for (int bb = 0; bb < 2; ++bb) { float v = b_mod[col];
#pragma unroll
            for (int s = 0; s < 8; ++s) v += MODP[((size_t)s * 2 + bb) * NMOD + col];
            MODF[(size_t)bb * NMOD + col] = v; }
    }
    __syncthreads();
    if (FIRST) {
        LAS float* scr = (LAS float*)(c.lds + 49152 + c.wave * 8448);
        p1_fold_q_item(w_query, (bf16*)(ws + WS_WQ2), (float*)(ws + WS_BIASP), A2s, B2s, scr, c.gw, c.lane);
    }
    bf16* HB = (bf16*)(ws + WS_HB);
    for (int i = 0; i < 8; ++i) {
        const int t = 64 * c.vcu + 8 * c.wave + i;
        f32x4 v[8]; float ss = 0.f;
#pragma unroll
        for (int q = 0; q < 8; ++q) {
            if (FIRST) v[q] = __builtin_nontemporal_load((const f32x4*)(X + (size_t)t * D + 4 * c.lane + 256 * q));
            else { const v2u w = *(const v2u*)(XB + (size_t)t * D + 4 * c.lane + 256 * q); v[q] = (f32x4){bflo(w.x), bfhi(w.x), bflo(w.y), bfhi(w.y)}; }
            ss += (v[q][0] * v[q][0] + v[q][1] * v[q][1]) + (v[q][2] * v[q][2] + v[q][3] * v[q][3]); }
        const float rstd = 1.0f / sqrtf(wave_sum(ss) * (1.0f / D) + NORM_EPS);
        bf16* hr = HB + (size_t)t * D + 4 * c.lane;
        if (FIRST && P2_I8) {
            float am = 0.f;
#pragma unroll
            for (int q = 0; q < 8; ++q) {
                const f32x4 a = *(const LAS f32x4*)(A1 + 256 * q + 4 * c.lane), bb = *(const LAS f32x4*)(B1 + 256 * q + 4 * c.lane);
                v[q] = v[q] * rstd * a + bb;
                am = fmaxf(fmaxf(am, fmaxf(fabsf(v[q][0]), fabsf(v[q][1]))), fmaxf(fabsf(v[q][2]), fabsf(v[q][3]))); }
            am = wave_max(am);
            const float inv = (am > 0.f) ? 127.0f / am : 0.f;
            unsigned w8[8];
#pragma unroll
            for (int q = 0; q < 8; ++q) { unsigned w = 0u;
                w = __builtin_amdgcn_cvt_pk_u8_f32(__builtin_rintf(fmaf(v[q][0], inv, 128.0f)), 0, w); w = __builtin_amdgcn_cvt_pk_u8_f32(__builtin_rintf(fmaf(v[q][1], inv, 128.0f)), 1, w);
                w = __builtin_amdgcn_cvt_pk_u8_f32(__builtin_rintf(fmaf(v[q][2], inv, 128.0f)), 2, w); w = __builtin_amdgcn_cvt_pk_u8_f32(__builtin_rintf(fmaf(v[q][3], inv, 128.0f)), 3, w);
                w8[q] = w ^ 0x80808080u; }
            unsigned char* h8 = ws + WS_H8 + (size_t)t * D + 32 * c.lane;
            *(v4u*)h8 = (v4u){w8[0], w8[1], w8[2], w8[3]}; *(v4u*)(h8 + 16) = (v4u){w8[4], w8[5], w8[6], w8[7]};
            if (c.lane == 0) ((float*)(ws + WS_SA))[t] = am * (1.0f / 127.0f);
        } else {
#pragma unroll
        for (int q = 0; q < 8; ++q) {
            const f32x4 a = *(const LAS f32x4*)(A1 + 256 * q + 4 * c.lane), bb = *(const LAS f32x4*)(B1 + 256 * q + 4 * c.lane);
            const f32x4 y = v[q] * rstd * a + bb;
            v2u o; o.x = pk2(y[0], y[1]); o.y = pk2(y[2], y[3]);
            *(v2u*)(hr + 256 * q) = o;
        }
        }
        if (FIRST && c.lane < 32) {
            const int fi = c.lane & 15;
            const float inv = (float)pow(500000.0, -(double)fi / 16.0);
            const float ang = (float)positions[t] * inv;
            ((float*)(ws + WS_CS))[(size_t)t * 32 + c.lane] = (c.lane < 16) ? cosf(ang) : sinf(ang);
        }
    }
    if (FIRST && P2_I8) {
#pragma unroll 1
        for (int n = c.gw; n < INW; n += c.ngw) {
            const bf16* wr = (const bf16*)(ws + WS_WTIN) + (size_t)n * D + 4 * c.lane;
            v2u w[8]; float f[32]; float am = 0.f;
#pragma unroll
            for (int q = 0; q < 8; ++q) w[q] = *(const v2u*)(wr + 256 * q);
#pragma unroll
            for (int q = 0; q < 8; ++q) { f[4 * q] = bflo(w[q].x); f[4 * q + 1] = bfhi(w[q].x); f[4 * q + 2] = bflo(w[q].y); f[4 * q + 3] = bfhi(w[q].y); }
#pragma unroll
            for (int k = 0; k < 32; ++k) am = fmaxf(am, fabsf(f[k]));
            am = wave_max(am);
            const float inv = (am > 0.f) ? 127.0f / am : 0.f;
            unsigned w8[8];
#pragma unroll
            for (int q = 0; q < 8; ++q) { unsigned ww = 0u;
                ww = __builtin_amdgcn_cvt_pk_u8_f32(__builtin_rintf(fmaf(f[4 * q], inv, 128.0f)), 0, ww); ww = __builtin_amdgcn_cvt_pk_u8_f32(__builtin_rintf(fmaf(f[4 * q + 1], inv, 128.0f)), 1, ww);
                ww = __builtin_amdgcn_cvt_pk_u8_f32(__builtin_rintf(fmaf(f[4 * q + 2], inv, 128.0f)), 2, ww); ww = __builtin_amdgcn_cvt_pk_u8_f32(__builtin_rintf(fmaf(f[4 * q + 3], inv, 128.0f)), 3, ww);
                w8[q] = ww ^ 0x80808080u; }
            unsigned char* o8 = ws + WS_W8 + (size_t)n * D + 32 * c.lane;
            *(v4u*)o8 = (v4u){w8[0], w8[1], w8[2], w8[3]}; *(v4u*)(o8 + 16) = (v4u){w8[4], w8[5], w8[6], w8[7]};
            if (c.lane == 0) ((float*)(ws + WS_SB))[n] = am * (1.0f / 127.0f);
        }
    }
    __syncthreads();
}

template <int P>
__device__ __forceinline__ void poolr_item(const bf16* U, bf16* RB, int t, int c0) {
    const int tb = t & (SEQ - 1);
    float s[8] = {0.f, 0.f, 0.f, 0.f, 0.f, 0.f, 0.f, 0.f}, u0[8];
    v4u w[P];
#pragma unroll
    for (int j = 0; j < P; ++j) w[j] = *(const v4u*)(U + (size_t)(t - (j <= tb ? j : tb)) * 1024 + c0);
#pragma unroll
    for (int j = 0; j < P; ++j) {
        const float m = (j <= tb) ? 1.0f : 0.0f;
        const float f[8] = {bflo(w[j].x), bfhi(w[j].x), bflo(w[j].y), bfhi(w[j].y), bflo(w[j].z), bfhi(w[j].z), bflo(w[j].w), bfhi(w[j].w)};
#pragma unroll
        for (int e = 0; e < 8; ++e) { s[e] += m * f[e]; if (j == 0) u0[e] = f[e]; }
    }
    const int cnt = (tb + 1 < P) ? tb + 1 : P;
    const float ic = 1.0f / (float)cnt;
    v4u o; o.x = pk2(s[0] * ic - u0[0], s[1] * ic - u0[1]); o.y = pk2(s[2] * ic - u0[2], s[3] * ic - u0[3]);
    o.z = pk2(s[4] * ic - u0[4], s[5] * ic - u0[5]); o.w = pk2(s[6] * ic - u0[6], s[7] * ic - u0[7]);
    *(v4u*)(RB + (size_t)t * 1024 + c0) = o;
}
__device__ __forceinline__ void phase_poolr(const Ctx& c, unsigned char* ws) {
    const bf16* U = (const bf16*)(ws + WS_U); bf16* RB = (bf16*)(ws + WS_RB);
    LAS unsigned char* tile = c.lds;
    const int ch = c.tid & 31, rg = c.tid >> 5;
    for (int it = c.vcu; it < 1024; it += c.G) {
        const int g = it & 3, t0 = 64 * (it >> 2), P = 2 << g, tb0 = t0 & (SEQ - 1), nrows = 63 + P;
        __syncthreads();
        for (int id = c.tid; id < nrows * 32; id += NTHREADS) {
            const int lr = id >> 5, cc = id & 31, dt = lr - (P - 1);
            v4u w = {0u, 0u, 0u, 0u};
            if (tb0 + dt >= 0) w = *(const v4u*)(U + (size_t)(t0 + dt) * 1024 + 256 * g + 8 * cc);
            *(LAS v4u*)(tile + lr * 512 + cc * 16) = w;
        }
        __syncthreads();
        float sacc[8];
#pragma unroll
        for (int e = 0; e < 8; ++e) sacc[e] = 0.f;
        const int r0 = 4 * rg;
        for (int j = 0; j < P; ++j) {
            const v4u w = *(const LAS v4u*)(tile + (r0 + P - 1 - j) * 512 + ch * 16);
            sacc[0] += bflo(w.x); sacc[1] += bfhi(w.x); sacc[2] += bflo(w.y); sacc[3] += bfhi(w.y); sacc[4] += bflo(w.z); sacc[5] += bfhi(w.z); sacc[6] += bflo(w.w); sacc[7] += bfhi(w.w);
        }
#pragma unroll
        for (int i = 0; i < 4; ++i) {
            const int r = r0 + i, tb = tb0 + r;
            const v4u wu = *(const LAS v4u*)(tile + (r + P - 1) * 512 + ch * 16);
            const float u0[8] = {bflo(wu.x), bfhi(wu.x), bflo(wu.y), bfhi(wu.y), bflo(wu.z), bfhi(wu.z), bflo(wu.w), bfhi(wu.w)};
            if (i > 0) {
                const v4u wo = *(const LAS v4u*)(tile + (r - 1) * 512 + ch * 16);
                const float uo[8] = {bflo(wo.x), bfhi(wo.x), bflo(wo.y), bfhi(wo.y), bflo(wo.z), bfhi(wo.z), bflo(wo.w), bfhi(wo.w)};
#pragma unroll
                for (int e = 0; e < 8; ++e) sacc[e] += u0[e] - uo[e];
            }
            const int cnt = (tb + 1 < P) ? tb + 1 : P;
            const float ic = 1.0f / (float)cnt;
            v4u o; o.x = pk2(sacc[0] * ic - u0[0], sacc[1] * ic - u0[1]); o.y = pk2(sacc[2] * ic - u0[2], sacc[3] * ic - u0[3]);
            o.z = pk2(sacc[4] * ic - u0[4], sacc[5] * ic - u0[5]); o.w = pk2(sacc[6] * ic - u0[6], sacc[7] * ic - u0[7]);
            *(v4u*)(RB + (size_t)(t0 + r) * 1024 + 256 * g + 8 * ch) = o;
        }
    }
    __syncthreads();
}

__device__ __forceinline__ void phase_attn_simple(const Ctx& c, unsigned char* ws) {
    const bf16* QB = (const bf16*)(ws + WS_Q); const bf16* KB = (const bf16*)(ws + WS_K); const bf16* VB = (const bf16*)(ws + WS_V); bf16* HC = (bf16*)(ws + WS_HC);
    LAS float* pb = (LAS float*)(c.lds + c.wave * 2048);
    const float NEG = -3.0e38f;
    for (int item = c.gw; item < T * NH; item += c.ngw) {
        const int t = item >> 3, h = item & 7, tb = t & (SEQ - 1);
        const v4u* qp = (const v4u*)(QB + (size_t)t * 1024 + h * 128);
        v4u q[16];
#pragma unroll
        for (int i = 0; i < 16; ++i) q[i] = qp[i];
        float sv[7]; float mx = NEG;
#pragma unroll
        for (int r = 0; r < 7; ++r) {
            const int e = c.lane + 64 * r, pat = e / 129, j = e - pat * 129, off = j << (2 * pat);
            const bool valid = (e < 387) && (off <= tb);
            float s = NEG;
            if (valid) {
                const v4u* kp = (const v4u*)(KB + (size_t)(t - off) * 1024 + h * 128);
                float a0 = 0.f, a1 = 0.f;
#pragma unroll
                for (int i = 0; i < 16; ++i) { const v4u kk = kp[i]; a0 = dot2(q[i].x, kk.x, a0); a1 = dot2(q[i].y, kk.y, a1); a0 = dot2(q[i].z, kk.z, a0); a1 = dot2(q[i].w, kk.w, a1); }
                s = a0 + a1;
            }
            sv[r] = s; mx = fmaxf(mx, s);
        }
        mx = wave_max(mx);
        float l = 0.f;
#pragma unroll
        for (int r = 0; r < 7; ++r) { const float p = (sv[r] > -1.0e38f) ? exp2f(sv[r] - mx) : 0.f; l += p; pb[c.lane + 64 * r] = p; }
        l = wave_sum(l);
        LDS_WAIT();
        float o0 = 0.f, o1 = 0.f;
        for (int e = 0; e < 387; ++e) {
            const int pat = e / 129, j = e - pat * 129, off = j << (2 * pat);
            if (off > tb) continue;
            const float pe = pb[e];
            const unsigned w = *(const unsigned*)(VB + (size_t)(t - off) * 1024 + h * 128 + 2 * c.lane);
            o0 += pe * bflo(w); o1 += pe * bfhi(w);
        }
        const float il = 1.0f / l;
        *(unsigned*)(HC + (size_t)t * 2048 + h * 128 + 2 * c.lane) = pk2(o0 * il, o1 * il);
        LDS_WAIT();
    }
}

__device__ __forceinline__ unsigned off_k(unsigned row, unsigned ch) { return 256u * row + 16u * (ch ^ ((row & 3u) | (((row >> 3) & 3u) << 2))); }
__device__ __forceinline__ unsigned off_b(unsigned row, unsigned ch) { return 256u * row + 16u * (ch ^ (((row & 3u) << 2) | ((row >> 2) & 3u))); }
typedef short s4v __attribute__((ext_vector_type(4)));
__device__ __forceinline__ void phase_attn_mfma(const Ctx& c, unsigned char* ws) {
    const bf16* QB = (const bf16*)(ws + WS_Q); const bf16* KB = (const bf16*)(ws + WS_K); const bf16* VB = (const bf16*)(ws + WS_V);
    float* LSE = (float*)(ws + WS_LSE);
    const int g = c.lane >> 4, lq = c.lane & 15;
    const float NEG = -3.0e38f;
    const int i0 = 16 * c.wave, jb = 32 * (c.wave >> 1), iq = i0 + lq;
    unsigned kaddr[2][4], vbase[2], vxor[2];
    {
        const unsigned rowa = (unsigned)(jb + 8 * (lq >> 2) + (lq & 3));
        const unsigned q4 = (unsigned)(lq >> 2), p4 = (unsigned)(c.lane & 3);
#pragma unroll
        for (int s4 = 0; s4 < 4; ++s4) { kaddr[0][s4] = off_k(rowa, (unsigned)(4 * s4 + g)); kaddr[1][s4] = off_k(rowa + 4u, (unsigned)(4 * s4 + g)); }
#pragma unroll
        for (int t = 0; t < 2; ++t) {
            const unsigned row = (unsigned)(jb + 8 * g + 4 * t) + q4, f = ((row & 3u) << 2) | ((row >> 2) & 3u);
            vxor[t] = 16u * (f & 14u);
            vbase[t] = 65536u + 256u * row + 16u * ((p4 >> 1) ^ (f & 1u)) + 8u * (p4 & 1u);
        }
    }
    v4u kreg[8], vreg[8]; pg8::bf16x8 qnext[4];
#define ATTN_DECODE(U) const int p_ = (U) >> 10, rem_ = (U) & 1023, bh_ = rem_ >> 6, rn_ = rem_ & 63, b_ = bh_ >> 3, h_ = bh_ & 7; \
        const int dsh_ = 2 * p_, nbl_ = 64 >> dsh_, r_ = rn_ / nbl_, n_ = rn_ - r_ * nbl_; \
        const int tok0q_ = b_ * SEQ + r_ + ((n_ * 128) << dsh_), tok0k_ = tok0q_ - (128 << dsh_);
#define ATTN_ISSUE(U) do { ATTN_DECODE(U) \
        const unsigned rstr_ = 2048u << dsh_;                         \
        const unsigned off0_ = (unsigned)(tok0k_ + ((c.tid >> 4) << dsh_)) * 2048u + (unsigned)(h_ * 256 + (c.tid & 15) * 16); \
        _Pragma("unroll") for (int i_ = 0; i_ < 8; ++i_) {           \
            v4u kv_ = {0u, 0u, 0u, 0u}, vv_ = kv_; \
            if (i_ >= 4 || n_ > 0) { const unsigned o_ = off0_ + (unsigned)(32 * i_) * rstr_; kv_ = *(const v4u*)((const unsigned char*)KB + o_); vv_ = *(const v4u*)((const unsigned char*)VB + o_); } \
            kreg[i_] = kv_; vreg[i_] = vv_; } \
        const int tokq_ = tok0q_ + (iq << dsh_); \
        _Pragma("unroll") for (int s_ = 0; s_ < 4; ++s_) qnext[s_] = *(const pg8::bf16x8*)(QB + (size_t)tokq_ * 1024 + h_ * 128 + 32 * s_ + 8 * g); } while (0)
    ATTN_ISSUE(c.vcu);
    for (int unit = c.vcu; unit < 3072; unit += c.G) {
        ATTN_DECODE(unit)
        const int p = p_, h = h_, n = n_, dsh = dsh_, tok0q = tok0q_;
        bf16* OP = (bf16*)(ws + (p == 0 ? WS_OP0 : (p == 1 ? WS_OP1 : WS_OP2)));
        __syncthreads();
#pragma unroll
        for (int i = 0; i < 8; ++i) {
            const int id = c.tid + 512 * i, row = id >> 4, ch = id & 15;
            *(LAS v4u*)(c.lds + off_k((unsigned)row, (unsigned)ch)) = kreg[i]; *(LAS v4u*)(c.lds + 65536u + off_b((unsigned)row, (unsigned)ch)) = vreg[i];
        }
        const int tokq = tok0q + (iq << dsh);
        pg8::bf16x8 qf[4];
#pragma unroll
        for (int s4 = 0; s4 < 4; ++s4) qf[s4] = qnext[s4];
        __syncthreads();
        if (unit + c.G < 3072) ATTN_ISSUE(unit + c.G);
        f32x4 sa[5], sb[5];
#pragma unroll
        for (int kt = 0; kt < 5; ++kt) {
            f32x4 aa = {0.f, 0.f, 0.f, 0.f}, ab = aa;
#pragma unroll
            for (int s4 = 0; s4 < 4; ++s4) {
                const pg8::bf16x8 ka = *(const LAS pg8::bf16x8*)(c.lds + kaddr[0][s4] + 8192u * kt);
                const pg8::bf16x8 kb = *(const LAS pg8::bf16x8*)(c.lds + kaddr[1][s4] + 8192u * kt);
                aa = __builtin_amdgcn_mfma_f32_16x16x32_bf16(ka, qf[s4], aa, 0, 0, 0);
                ab = __builtin_amdgcn_mfma_f32_16x16x32_bf16(kb, qf[s4], ab, 0, 0, 0);
            }
            sa[kt] = aa; sb[kt] = ab;
        }
        const int jlo = (n > 0) ? iq : (iq > 128 ? iq : 128);
#pragma unroll
        for (int i = 0; i < 4; ++i) {
            const int ja = jb + 8 * g + i;
            sa[0][i] = (ja >= jlo) ? sa[0][i] : NEG; sb[0][i] = (ja + 4 >= jlo) ? sb[0][i] : NEG;
            sa[4][i] = (ja + 128 <= iq + 128) ? sa[4][i] : NEG; sb[4][i] = (ja + 132 <= iq + 128) ? sb[4][i] : NEG;
        }
        if (n == 0) {
#pragma unroll
            for (int kt = 1; kt < 5; ++kt)
#pragma unroll
                for (int i = 0; i < 4; ++i) { const int ja = jb + 32 * kt + 8 * g + i; sa[kt][i] = (ja >= jlo) ? sa[kt][i] : NEG; sb[kt][i] = (ja + 4 >= jlo) ? sb[kt][i] : NEG; }
        }
        float mx = NEG;
#pragma unroll
        for (int kt = 0; kt < 5; ++kt)
#pragma unroll
            for (int i = 0; i < 4; ++i) mx = fmaxf(mx, fmaxf(sa[kt][i], sb[kt][i]));
        mx = fmaxf(mx, SXOR(mx, 16, c.lane)); mx = fmaxf(mx, SXOR(mx, 32, c.lane));
        float l = 0.f;
#pragma unroll
        for (int kt = 0; kt < 5; ++kt)
#pragma unroll
            for (int i = 0; i < 4; ++i) { sa[kt][i] = __builtin_amdgcn_exp2f(sa[kt][i] - mx); sb[kt][i] = __builtin_amdgcn_exp2f(sb[kt][i] - mx); l += sa[kt][i] + sb[kt][i]; }
        l += SXOR(l, 16, c.lane); l += SXOR(l, 32, c.lane);
        f32x4 o[8];
#pragma unroll
        for (int c8 = 0; c8 < 8; ++c8) o[c8] = (f32x4){0.f, 0.f, 0.f, 0.f};
#pragma unroll
        for (int kt = 0; kt < 5; ++kt) {
            pg8::u32x4 pw; pw.x = pk2(sa[kt][0], sa[kt][1]); pw.y = pk2(sa[kt][2], sa[kt][3]); pw.z = pk2(sb[kt][0], sb[kt][1]); pw.w = pk2(sb[kt][2], sb[kt][3]);
            const pg8::bf16x8 pf = __builtin_bit_cast(pg8::bf16x8, pw);
#pragma unroll
            for (int c8 = 0; c8 < 8; ++c8) {
                const s4v t0 = __builtin_amdgcn_ds_read_tr16_b64_v4i16((LAS s4v*)(c.lds + (vbase[0] + ((32u * c8) ^ vxor[0])) + 8192u * kt));
                const s4v t1 = __builtin_amdgcn_ds_read_tr16_b64_v4i16((LAS s4v*)(c.lds + (vbase[1] + ((32u * c8) ^ vxor[1])) + 8192u * kt));
                const pg8::bf16x8 vf = __builtin_shufflevector(t0, t1, 0, 1, 2, 3, 4, 5, 6, 7);
                o[c8] = __builtin_amdgcn_mfma_f32_16x16x32_bf16(vf, pf, o[c8], 0, 0, 0);
            }
        }
        const float il = 1.0f / l;
        bf16* orow = OP + (size_t)tokq * 1024 + h * 128 + 4 * g;
#pragma unroll
        for (int c8 = 0; c8 < 8; ++c8) { v2u w; w.x = pk2(o[c8][0] * il, o[c8][1] * il); w.y = pk2(o[c8][2] * il, o[c8][3] * il); *(v2u*)(orow + 16 * c8) = w; }
        if (g == 0) LSE[((size_t)p * T + tokq) * 8 + h] = mx + __builtin_amdgcn_logf(l);
    }
    __syncthreads();
}
__device__ __forceinline__ void phase_combine(const Ctx& c, unsigned char* ws) {
    const float* LSE = (const float*)(ws + WS_LSE); bf16* HC = (bf16*)(ws + WS_HC);
    const bf16* OP0 = (const bf16*)(ws + WS_OP0); const bf16* OP1 = (const bf16*)(ws + WS_OP1); const bf16* OP2 = (const bf16*)(ws + WS_OP2);
    for (int t = c.gw; t < T; t += c.ngw) {
        const int h = c.lane >> 3;
        const float l0 = LSE[((size_t)0 * T + t) * 8 + h], l1 = LSE[((size_t)1 * T + t) * 8 + h], l2 = LSE[((size_t)2 * T + t) * 8 + h];
        const float m = fmaxf(l0, fmaxf(l1, l2));
        float w0 = exp2f(l0 - m), w1 = exp2f(l1 - m), w2 = exp2f(l2 - m);
        const float inv = 1.0f / (w0 + w1 + w2); w0 *= inv; w1 *= inv; w2 *= inv;
        const size_t off = (size_t)t * 1024 + 16 * c.lane;
#pragma unroll
        for (int hh = 0; hh < 2; ++hh) {
            const v4u a = *(const v4u*)(OP0 + off + 8 * hh), bq = *(const v4u*)(OP1 + off + 8 * hh), cq = *(const v4u*)(OP2 + off + 8 * hh);
            v4u o;
            o.x = pk2(w0 * bflo(a.x) + w1 * bflo(bq.x) + w2 * bflo(cq.x), w0 * bfhi(a.x) + w1 * bfhi(bq.x) + w2 * bfhi(cq.x));
            o.y = pk2(w0 * bflo(a.y) + w1 * bflo(bq.y) + w2 * bflo(cq.y), w0 * bfhi(a.y) + w1 * bfhi(bq.y) + w2 * bfhi(cq.y));
            o.z = pk2(w0 * bflo(a.z) + w1 * bflo(bq.z) + w2 * bflo(cq.z), w0 * bfhi(a.z) + w1 * bfhi(bq.z) + w2 * bfhi(cq.z));
            o.w = pk2(w0 * bflo(a.w) + w1 * bflo(bq.w) + w2 * bflo(cq.w), w0 * bfhi(a.w) + w1 * bfhi(bq.w) + w2 * bfhi(cq.w));
            *(v4u*)(HC + (size_t)t * 2048 + 16 * c.lane + 8 * hh) = o;
        }
    }
}

__device__ __forceinline__ int f2sort(float f) { const int b = __float_as_int(f); return b ^ ((b >> 31) & 0x7fffffff); }
__device__ __forceinline__ float sort2f(int k) { return __int_as_float(k ^ ((k >> 31) & 0x7fffffff)); }
#define CE_DESC(a, b) do { const int hi_ = max((a), (b)), lo_ = min((a), (b)); (a) = hi_; (b) = lo_; } while (0)
__device__ __forceinline__ void bitonic_merge16(int (&v)[16]) {
#pragma unroll
    for (int j = 8; j > 0; j >>= 1)
#pragma unroll
        for (int i = 0; i < 16; ++i) { const int l = i ^ j; if (l > i) CE_DESC(v[i], v[l]); }
}
__device__ __forceinline__ void sort16(int (&v)[16]) {
#pragma unroll
    for (int k = 2; k <= 16; k <<= 1)
#pragma unroll
        for (int j = k >> 1; j > 0; j >>= 1)
#pragma unroll
            for (int i = 0; i < 16; ++i) { const int l = i ^ j; if (l > i) { if ((i & k) == 0) CE_DESC(v[i], v[l]); else CE_DESC(v[l], v[i]); } }
}
__device__ __forceinline__ void merge_top16(int (&a)[16], const int (&b)[16]) {
#pragma unroll
    for (int k = 0; k < 16; ++k) a[k] = max(a[k], b[15 - k]);
    bitonic_merge16(a);
}
__device__ __forceinline__ void xlane_merge(int (&a)[16], int xr, int lane) {
    int b[16];
#pragma unroll
    for (int k = 0; k < 16; ++k) b[k] = SXOR(a[k], xr, lane);
    merge_top16(a, b);
}
__device__ __forceinline__ void phase_scores_topk(const Ctx& c, unsigned char* ws) {
    const bf16* QP = (const bf16*)(ws + WS_QP); const bf16* SKB = (const bf16*)(ws + WS_SKP);
    int* IDX = (int*)(ws + WS_IDX); float* GATE = (float*)(ws + WS_GATE);
    const int g = c.lane >> 4, lq = c.lane & 15;
    const int h = c.vcu & 7, tb = c.vcu >> 3;
    LAS unsigned char* lut = c.lds + 65536 + c.wave * 2560 + c.lane * 36;
#pragma unroll
    for (int i = 0; i < 8; ++i) {
        const int id = c.tid + 512 * i, row = id >> 4, ch = id & 15;
        *(LAS v4u*)(c.lds + off_b((unsigned)row, (unsigned)ch)) = *(const v4u*)(SKB + ((size_t)h * 256 + row) * 128 + ch * 8);
    }
    unsigned ka[4];
#pragma unroll
    for (int s4 = 0; s4 < 4; ++s4) ka[s4] = off_b((unsigned)lq, (unsigned)(4 * s4 + g));
    __syncthreads();
    for (int it = 0; it < 4; ++it) {
        const int t = 512 * tb + 128 * it + 16 * c.wave + lq;
        int top[2][16];
#pragma unroll
        for (int p = 0; p < 2; ++p) {
            pg8::bf16x8 qf[4];
#pragma unroll
            for (int s4 = 0; s4 < 4; ++s4) qf[s4] = *(const pg8::bf16x8*)(QP + (size_t)t * 2048 + h * 256 + p * 128 + 32 * s4 + 8 * g);
            int lo[16], hi[16];
#pragma unroll
            for (int c8 = 0; c8 < 8; ++c8) {
                f32x4 acc = {0.f, 0.f, 0.f, 0.f};
#pragma unroll
                for (int s4 = 0; s4 < 4; ++s4) {
                    const pg8::bf16x8 kf = *(const LAS pg8::bf16x8*)(c.lds + ka[s4] + (unsigned)(32768 * p + 4096 * c8));
                    acc = __builtin_amdgcn_mfma_f32_16x16x32_bf16(kf, qf[s4], acc, 0, 0, 0);
                }
#pragma unroll
                for (int i = 0; i < 4; ++i) { const int key = (f2sort(acc[i]) & ~127) | (16 * c8 + 4 * g + i); if (c8 < 4) lo[4 * c8 + i] = key; else hi[4 * (c8 - 4) + i] = key; }
            }
            sort16(lo); sort16(hi); merge_top16(lo, hi);
            xlane_merge(lo, 16, c.lane); xlane_merge(lo, 32, c.lane);
#pragma unroll
            for (int k = 0; k < 16; ++k) top[p][k] = lo[k];
        }
#pragma unroll
        for (int p = 0; p < 2; ++p)
#pragma unroll
            for (int q = 0; q < 4; ++q)
                *(LAS unsigned*)(lut + 16 * p + 4 * q) = (unsigned)(top[p][4 * q] & 127) | ((unsigned)(top[p][4 * q + 1] & 127) << 8) | ((unsigned)(top[p][4 * q + 2] & 127) << 16) | ((unsigned)(top[p][4 * q + 3] & 127) << 24);
        float f0[16], f1[16];
#pragma unroll
        for (int k = 0; k < 16; ++k) { f0[k] = sort2f(top[0][k] & ~127); f1[k] = sort2f(top[1][k] & ~127); }
#define CAND(a, b) ((f2sort(f0[a] + f1[b]) & ~255) | ((a) << 4) | (b))
        int X[16], Y[16], Z[16];
#pragma unroll
        for (int b2 = 0; b2 < 16; ++b2) X[b2] = CAND(0, b2);
#pragma unroll
        for (int b2 = 0; b2 < 8; ++b2) Y[b2] = CAND(1, b2);
#pragma unroll
        for (int a2 = 8; a2 < 16; ++a2) Y[23 - a2] = CAND(a2, 0);
        Z[0] = CAND(2, 0); Z[1] = CAND(2, 1); Z[2] = CAND(2, 2); Z[3] = CAND(2, 3); Z[4] = CAND(2, 4);
        Z[5] = CAND(3, 0); Z[6] = CAND(3, 1); Z[7] = CAND(3, 2); Z[8] = CAND(3, 3);
        Z[9] = CAND(4, 0); Z[10] = CAND(4, 1); Z[11] = CAND(4, 2);
        Z[12] = CAND(5, 0); Z[13] = CAND(5, 1); Z[14] = CAND(6, 0); Z[15] = CAND(6, 1);
        const int w0 = CAND(7, 0), w1 = CAND(7, 1);
#undef CAND
        bitonic_merge16(Y); sort16(Z);
        merge_top16(X, Y); merge_top16(X, Z);
        X[14] = max(X[14], w1); X[15] = max(X[15], w0); bitonic_merge16(X);
        LDS_WAIT();
        float e[16], sum = 0.f; const float fmx = sort2f(X[0] & ~255);
#pragma unroll
        for (int k = 0; k < 16; ++k) { e[k] = __expf(sort2f(X[k] & ~255) - fmx); sum += e[k]; }
        const float inv = 1.0f / sum;
        int ex[16];
#pragma unroll
        for (int k = 0; k < 16; ++k) { const int a2 = (X[k] >> 4) & 15, b2 = X[k] & 15; ex[k] = (int)(*(const LAS unsigned char*)(lut + a2)) * PE_NK + (int)(*(const LAS unsigned char*)(lut + 16 + b2)); }
        if (g == 0) {
            int* ip = IDX + (size_t)t * 128 + h * 16; float* gp = GATE + (size_t)t * 128 + h * 16;
#pragma unroll
            for (int q = 0; q < 4; ++q) {
                *(int4*)(ip + 4 * q) = make_int4(ex[4 * q], ex[4 * q + 1], ex[4 * q + 2], ex[4 * q + 3]);
                *(f32x4*)(gp + 4 * q) = (f32x4){e[4 * q] * inv, e[4 * q + 1] * inv, e[4 * q + 2] * inv, e[4 * q + 3] * inv};
            }
        }
        LDS_WAIT();
    }
    __syncthreads();
}

__device__ __forceinline__ void phase_topk_simple(const Ctx& c, unsigned char* ws) {
    const float* SC = (const float*)(ws + WS_SC); int* IDX = (int*)(ws + WS_IDX); float* GATE = (float*)(ws + WS_GATE);
    const float NEG = -3.0e38f;
    for (int item = c.gw; item < T * PE_HEADS; item += c.ngw) {
        const int t = item >> 3, h = item & 7;
        const float* sc = SC + (size_t)t * 2048 + h * 256;
        float sh[2] = {0.f, 0.f}; int ih[2] = {0, 0};
#pragma unroll
        for (int p = 0; p < 2; ++p) {
            float va = sc[128 * p + c.lane], vb = sc[128 * p + 64 + c.lane];
            for (int r = 0; r < PE_K; ++r) {
                const float M = wave_max(fmaxf(va, vb));
                const unsigned long long ba = __ballot(va == M), bb = __ballot(vb == M);
                const int n = ba ? (int)__builtin_ctzll(ba) : 64 + (int)__builtin_ctzll(bb);
                if (c.lane == r) { sh[p] = M; ih[p] = n; }
                if (n < 64) { if (c.lane == n) va = NEG; } else { if (c.lane == n - 64) vb = NEG; }
            }
        }
        float cv[4];
#pragma unroll
        for (int q = 0; q < 4; ++q) { const int cc = c.lane + 64 * q; cv[q] = sh_idx(sh[0], cc >> 4) + sh_idx(sh[1], cc & 15); }
        float ts = NEG; int tc = 0;
        for (int r = 0; r < PE_K; ++r) {
            const float M = wave_max(fmaxf(fmaxf(cv[0], cv[1]), fmaxf(cv[2], cv[3])));
            int cc = -1;
#pragma unroll
            for (int q = 3; q >= 0; --q) { const unsigned long long bq = __ballot(cv[q] == M); if (bq) cc = 64 * q + (int)__builtin_ctzll(bq); }
            if (c.lane == r) { ts = M; tc = cc; }
#pragma unroll
            for (int q = 0; q < 4; ++q) if (cc == c.lane + 64 * q) cv[q] = NEG;
        }
        const int i0 = sh_idx(ih[0], tc >> 4), i1 = sh_idx(ih[1], tc & 15);
        const float tmax = sh_idx(ts, 0);
        const float ex = (c.lane < PE_K) ? __expf(ts - tmax) : 0.f;
        const float sum = wave_sum(ex);
        if (c.lane < PE_K) { IDX[(size_t)t * 128 + h * 16 + c.lane] = i0 * PE_NK + i1; GATE[(size_t)t * 128 + h * 16 + c.lane] = ex / sum; }
    }
}

__device__ __forceinline__ void ld_row8(const unsigned char* tab, int e, int lane, v4u (&r)[2]) {
    const v4u* p = (const v4u*)(tab + (size_t)e * D) + lane;
    r[0] = p[0]; r[1] = p[64];
}
__device__ __forceinline__ int idot_row(const int (&h)[8], const v4u (&r)[2]) {
    int a = 0, b = 0;
    a = __builtin_amdgcn_sdot4(h[0], (int)r[0].x, a, false); b = __builtin_amdgcn_sdot4(h[1], (int)r[0].y, b, false);
    a = __builtin_amdgcn_sdot4(h[2], (int)r[0].z, a, false); b = __builtin_amdgcn_sdot4(h[3], (int)r[0].w, b, false);
    a = __builtin_amdgcn_sdot4(h[4], (int)r[1].x, a, false); b = __builtin_amdgcn_sdot4(h[5], (int)r[1].y, b, false);
    a = __builtin_amdgcn_sdot4(h[6], (int)r[1].z, a, false); b = __builtin_amdgcn_sdot4(h[7], (int)r[1].w, b, false);
    return a + b;
}
__device__ __forceinline__ int reduce8(const int (&p)[8], int lane) {
    const bool b0 = lane & 1, b1 = lane & 2, b2 = lane & 4;
    int q[4], r2[2];
#pragma unroll
    for (int i = 0; i < 4; ++i) { const int keep = b0 ? p[2 * i + 1] : p[2 * i], send = b0 ? p[2 * i] : p[2 * i + 1]; q[i] = keep + SXOR(send, 1, lane); }
#pragma unroll
    for (int i = 0; i < 2; ++i) { const int keep = b1 ? q[2 * i + 1] : q[2 * i], send = b1 ? q[2 * i] : q[2 * i + 1]; r2[i] = keep + SXOR(send, 2, lane); }
    int v = (b2 ? r2[1] : r2[0]) + SXOR(b2 ? r2[0] : r2[1], 4, lane);
    v += SXOR(v, 8, lane); v += SXOR(v, 16, lane); v += SXOR(v, 32, lane);
    return v;
}
__device__ __forceinline__ void axpy_row8(float (&y)[32], float a, const v4u (&r)[2]) {
#pragma unroll
    for (int q = 0; q < 2; ++q) {
        const unsigned w[4] = {r[q].x, r[q].y, r[q].z, r[q].w};
#pragma unroll
        for (int d = 0; d < 4; ++d) {
            y[16 * q + 4 * d + 0] += a * (float)(w[d] & 0xffu); y[16 * q + 4 * d + 1] += a * (float)((w[d] >> 8) & 0xffu);
            y[16 * q + 4 * d + 2] += a * (float)((w[d] >> 16) & 0xffu); y[16 * q + 4 * d + 3] += a * (float)(w[d] >> 24);
        }
    }
}
__device__ __forceinline__ void phase_peer(const Ctx& c, const float* X1, const float* final_g, float* out, unsigned char* ws) {
    const unsigned char* PU = ws + WS_PU; const unsigned char* PV = ws + WS_PV; const bf16* HB = (const bf16*)(ws + WS_HB);
    const float* SU = (const float*)(ws + WS_SU); const float* SV = (const float*)(ws + WS_SV);
    const int* IDX = (const int*)(ws + WS_IDX); const float* GATE = (const float*)(ws + WS_GATE); const float* MODF = (const float*)(ws + WS_MODF);
    LAS float* G2 = (LAS float*)c.lds; LAS float* FG = G2 + D;
    const int b = c.vcu >> 7;
    { const int j = 4 * c.tid; *(LAS f32x4*)(G2 + j) = *(const f32x4*)(MODF + (size_t)b * NMOD + 5 * D + j); *(LAS f32x4*)(FG + j) = *(const f32x4*)(final_g + j); }
    __syncthreads();
#pragma unroll 1
    for (int i = (DUP & 1024) ? -8 : 0; i < 8; ++i) {
        const int t = 64 * c.vcu + 8 * c.wave + (i & 7);
        const int e0 = IDX[(size_t)t * 128 + c.lane], e1 = IDX[(size_t)t * 128 + 64 + c.lane];
        const float g0 = GATE[(size_t)t * 128 + c.lane], g1 = GATE[(size_t)t * 128 + 64 + c.lane];
        v4u r[8][2];
#pragma unroll
        for (int q = 0; q < 8; ++q) ld_row8(PU, __builtin_amdgcn_readlane(e0, q), c.lane, r[q]);
        const float su0 = SU[e0], su1 = SU[e1], sv0 = SV[e0], sv1 = SV[e1];
        int hq[8]; float sh;
        {
            float hf[32]; float am = 0.f;
#pragma unroll
            for (int q = 0; q < 2; ++q)
#pragma unroll
                for (int rr = 0; rr < 2; ++rr) {
                    const v4u w = *(const v4u*)(HB + (size_t)t * D + 1024 * q + 16 * c.lane + 8 * rr);
                    float* f = hf + 16 * q + 8 * rr;
                    f[0] = bflo(w.x); f[1] = bfhi(w.x); f[2] = bflo(w.y); f[3] = bfhi(w.y); f[4] = bflo(w.z); f[5] = bfhi(w.z); f[6] = bflo(w.w); f[7] = bfhi(w.w);
                }
#pragma unroll
            for (int k = 0; k < 32; ++k) am = fmaxf(am, fabsf(hf[k]));
            am = wave_max(am);
            const float inv = (am > 0.f) ? 127.0f / am : 0.f; sh = am * (1.0f / 127.0f);
#pragma unroll
            for (int d = 0; d < 8; ++d) { unsigned w = 0u;
#pragma unroll
                for (int e = 0; e < 4; ++e) { const int qv = __float2int_rn(hf[4 * d + e] * inv); w |= ((unsigned)qv & 0xffu) << (8 * e); }
                hq[d] = (int)w; }
        }
        int ia0 = 0, ia1 = 0;
#pragma unroll 1
        for (int m = 0; m < 16; ++m) {
            int part[8];
#pragma unroll
            for (int q = 0; q < 8; ++q) {
                part[q] = idot_row(hq, r[q]);
                const int kn = 8 * (m + 1) + q;
                if (m < 15) { const int en = (kn < 64) ? __builtin_amdgcn_readlane(e0, kn & 63) : __builtin_amdgcn_readlane(e1, kn & 63); ld_row8(PU, en, c.lane, r[q]); }
            }
            const int v = reduce8(part, c.lane);
            if (m < 8) { if ((c.lane >> 3) == m) ia0 = v; } else { if ((c.lane >> 3) == m - 8) ia1 = v; }
        }
#pragma unroll
        for (int q = 0; q < 8; ++q) ld_row8(PV, __builtin_amdgcn_readlane(e0, q), c.lane, r[q]);
        const float a0 = (float)ia0 * su0 * sh, a1 = (float)ia1 * su1 * sh;
        const float c0 = 0.5f * a0 * (1.0f + erff(a0 * 0.70710678118654752f)) * g0 * sv0;
        const float c1 = 0.5f * a1 * (1.0f + erff(a1 * 0.70710678118654752f)) * g1 * sv1;
        const float csum = wave_sum(c0 + c1);
        float y[32];
#pragma unroll
        for (int q = 0; q < 32; ++q) y[q] = 0.f;
#pragma unroll 1
        for (int m = 0; m < 16; ++m) {
#pragma unroll
            for (int q = 0; q < 8; ++q) {
                const int k = 8 * m + q;
                const float ck = __uint_as_float((k < 64) ? __builtin_amdgcn_readlane(__float_as_uint(c0), k & 63) : __builtin_amdgcn_readlane(__float_as_uint(c1), k & 63));
                axpy_row8(y, ck, r[q]);
                const int kn = k + 8;
                if (m < 15) { const int en = (kn < 64) ? __builtin_amdgcn_readlane(e0, kn & 63) : __builtin_amdgcn_readlane(e1, kn & 63); ld_row8(PV, en, c.lane, r[q]); }
            }
        }
        const float* xr = X1 + (size_t)t * D + 16 * c.lane; float* orow = ((DUP & 1024) && i < 0 ? (float*)(ws + WS_HC) : out) + (size_t)t * D + 16 * c.lane;
        const float yoff = 128.0f * csum;
        float ss = 0.f;
#pragma unroll
        for (int q = 0; q < 2; ++q)
#pragma unroll
            for (int d = 0; d < 4; ++d) {
                const f32x4 xa = *(const f32x4*)(xr + 1024 * q + 4 * d);
                const f32x4 ga = *(const LAS f32x4*)(G2 + 1024 * q + 16 * c.lane + 4 * d);
#pragma unroll
                for (int e = 0; e < 4; ++e) { const float v = xa[e] + ga[e] * (y[16 * q + 4 * d + e] - yoff); y[16 * q + 4 * d + e] = v; ss += v * v; }
            }
        const float rstd = 1.0f / sqrtf(wave_sum(ss) * (1.0f / D) + NORM_EPS);
#pragma unroll
        for (int q = 0; q < 2; ++q)
#pragma unroll
            for (int d = 0; d < 4; ++d) {
                const f32x4 fa = *(const LAS f32x4*)(FG + 1024 * q + 16 * c.lane + 4 * d);
                f32x4 o;
#pragma unroll
                for (int e = 0; e < 4; ++e) o[e] = y[16 * q + 4 * d + e] * rstd * fa[e];
                *(f32x4*)(orow + 1024 * q + 4 * d) = o;
            }
    }
}

__device__ __forceinline__ v4u ld_row4(const unsigned char* tab, int e, int lane) { return *((const v4u*)(tab + (size_t)e * 1024) + lane); }
__device__ __forceinline__ int idot_row4(const int (&h)[8], const v4u& r) {
    const int w[4] = {(int)r.x, (int)r.y, (int)r.z, (int)r.w}; int ah = 0, al = 0;
#pragma unroll
    for (int d = 0; d < 4; ++d) { ah = __builtin_amdgcn_sdot8(h[d], w[d], ah, false); al = __builtin_amdgcn_sdot8(h[4 + d], w[d], al, false); }
    return 16 * ah + al;
}
__device__ __forceinline__ void vacc4(int (&y)[32], const v4u& ra, const v4u& rb, const v4u& rc, const v4u& rd, int cq4) {
    const unsigned A[4] = {ra.x, ra.y, ra.z, ra.w}, B[4] = {rb.x, rb.y, rb.z, rb.w}, C[4] = {rc.x, rc.y, rc.z, rc.w}, Dd[4] = {rd.x, rd.y, rd.z, rd.w};
#pragma unroll
    for (int d = 0; d < 4; ++d) {
        const unsigned t0 = __builtin_amdgcn_perm(A[d], B[d], 0x01050004u), t1 = __builtin_amdgcn_perm(A[d], B[d], 0x03070206u);
        const unsigned t2 = __builtin_amdgcn_perm(C[d], Dd[d], 0x01050004u), t3 = __builtin_amdgcn_perm(C[d], Dd[d], 0x03070206u);
        const unsigned T[4] = {__builtin_amdgcn_perm(t0, t2, 0x01000504u), __builtin_amdgcn_perm(t0, t2, 0x03020706u),
                               __builtin_amdgcn_perm(t1, t3, 0x01000504u), __builtin_amdgcn_perm(t1, t3, 0x03020706u)};
#pragma unroll
        for (int e = 0; e < 4; ++e) {
            y[8 * d + e] = __builtin_amdgcn_sdot4((int)(T[e] & 0x0f0f0f0fu), cq4, y[8 * d + e], false);
            y[8 * d + 4 + e] = __builtin_amdgcn_sdot4((int)T[e], cq4, y[8 * d + 4 + e], false);
        }
    }
}
#define SCHED_FENCE() __builtin_amdgcn_sched_barrier(0)
template <bool REMAP>
__device__ __forceinline__ void phase_peer4_u(const Ctx& c, const float* g2vec, unsigned char* ws) {
    const unsigned char* PU = ws + WS_PU; const bf16* HB = (const bf16*)(ws + WS_X1B);
    LAS float* A2 = (LAS float*)(c.lds + 16384); LAS float* B2 = A2 + D;
    { const float* MODF_ = (const float*)(ws + WS_MODF) + (size_t)(c.vcu >> 7) * NMOD; const int j = 4 * c.tid;
      *(LAS f32x4*)(A2 + j) = *(const f32x4*)(g2vec + j) * (*(const f32x4*)(MODF_ + 4 * D + j) + 1.0f); *(LAS f32x4*)(B2 + j) = *(const f32x4*)(MODF_ + 3 * D + j); }
    __syncthreads();
    const float* SU = (const float*)(ws + WS_SU); const float* SV = (const float*)(ws + WS_SV);
    const int* IDX = (const int*)(ws + WS_IDX); const float* GATE = (const float*)(ws + WS_GATE);
    int* TQ = (int*)(ws + (REMAP ? WS_HC : WS_TQ)); float* CSC = (float*)(ws + (REMAP ? WS_HC + 16 * MiB : WS_CSC));
    const int rm_or = (int)(blockIdx.x & 7) << 11;
#define RM(e) (REMAP ? (((e) & 2047) | rm_or) : (e))
    const int tbase = 64 * c.vcu + 8 * c.wave;
    int e0n = RM(IDX[(size_t)tbase * 128 + c.lane]), e1n = RM(IDX[(size_t)tbase * 128 + 64 + c.lane]);
    float g0n = GATE[(size_t)tbase * 128 + c.lane], g1n = GATE[(size_t)tbase * 128 + 64 + c.lane];
    v2u hraw[8];
#pragma unroll
    for (int j = 0; j < 8; ++j) hraw[j] = __builtin_nontemporal_load((const v2u*)(HB + (size_t)tbase * D + 256 * j + 4 * c.lane));
    v4u r[16];
#pragma unroll
    for (int q = 0; q < 16; ++q) r[q] = ld_row4(PU, __builtin_amdgcn_readlane(e0n, q), c.lane);
#pragma unroll 1
    for (int i = (DUP & 1024) ? -8 : 0; i < 8; ++i) {
        const int t = tbase + (i & 7), tn = tbase + ((i + 1) & 7);
        const int e0 = e0n, e1 = e1n; const float g0 = g0n, g1 = g1n;
        const float su0 = SU[e0], su1 = SU[e1], sv0 = SV[e0], sv1 = SV[e1];
        int hq[8]; float sh; int hsum;
        {
            float hf[32]; float am = 0.f, ssx = 0.f;
#pragma unroll
            for (int j = 0; j < 8; ++j) { hf[4 * j] = bflo(hraw[j].x); hf[4 * j + 1] = bfhi(hraw[j].x); hf[4 * j + 2] = bflo(hraw[j].y); hf[4 * j + 3] = bfhi(hraw[j].y); }
#pragma unroll
            for (int k = 0; k < 32; ++k) ssx += hf[k] * hf[k];
            const float rstd2 = 1.0f / sqrtf(wave_sum(ssx) * (1.0f / D) + NORM_EPS);
#pragma unroll
            for (int j = 0; j < 8; ++j) { const f32x4 av = *(const LAS f32x4*)(A2 + 256 * j + 4 * c.lane), bv = *(const LAS f32x4*)(B2 + 256 * j + 4 * c.lane);
#pragma unroll
                for (int e = 0; e < 4; ++e) hf[4 * j + e] = hf[4 * j + e] * rstd2 * av[e] + bv[e]; }
#pragma unroll
            for (int k = 0; k < 32; ++k) am = fmaxf(am, fabsf(hf[k]));
            am = wave_max(am);
            const float inv = (am > 0.f) ? 119.0f / am : 0.f; sh = am * (1.0f / 119.0f);
            int hs = 0;
#pragma unroll
            for (int d = 0; d < 4; ++d) { unsigned wh = 0u, wl = 0u;
#pragma unroll
                for (int e = 0; e < 4; ++e)
#pragma unroll
                    for (int odd = 0; odd < 2; ++odd) {
                        const int qv = __float2int_rn(hf[4 * (2 * d + odd) + e] * inv), hh = (qv + 8) >> 4, hl = qv - 16 * hh;
                        hs += qv; wh |= ((unsigned)hh & 15u) << (8 * e + 4 * odd); wl |= ((unsigned)hl & 15u) << (8 * e + 4 * odd);
                    }
                hq[d] = (int)wh; hq[4 + d] = (int)wl; }
            hsum = wave_sum_i(hs);
        }
        e0n = RM(IDX[(size_t)tn * 128 + c.lane]); e1n = RM(IDX[(size_t)tn * 128 + 64 + c.lane]);
        g0n = GATE[(size_t)tn * 128 + c.lane]; g1n = GATE[(size_t)tn * 128 + 64 + c.lane];
#pragma unroll
        for (int j = 0; j < 8; ++j) hraw[j] = __builtin_nontemporal_load((const v2u*)(HB + (size_t)tn * D + 256 * j + 4 * c.lane));
        int ia0 = 0, ia1 = 0;
#pragma unroll 1
        for (int m = 0; m < 8; ++m) {
            const int esrc = (m + 1 < 4) ? e0 : ((m + 1 < 8) ? e1 : e0n);
            int part[16];
#pragma unroll
            for (int q = 0; q < 16; ++q) {
                part[q] = idot_row4(hq, r[q]);
                SCHED_FENCE();
                r[q] = ld_row4(PU, __builtin_amdgcn_readlane(esrc, (16 * (m + 1) + q) & 63), c.lane);
                SCHED_FENCE();
            }
            int pa[8], pb[8];
#pragma unroll
            for (int q = 0; q < 8; ++q) { pa[q] = part[q]; pb[q] = part[8 + q]; }
            const int va = reduce8(pa, c.lane), vb = reduce8(pb, c.lane);
            const int grp = c.lane >> 3;
            if (m < 4) { if (grp == 2 * m) ia0 = va; if (grp == 2 * m + 1) ia0 = vb; } else { if (grp == 2 * (m - 4)) ia1 = va; if (grp == 2 * (m - 4) + 1) ia1 = vb; }
        }
        const float hoff = 0.5f * (float)hsum;
        const float a0 = ((float)ia0 + hoff) * su0 * sh, a1 = ((float)ia1 + hoff) * su1 * sh;
        const float c0 = 0.5f * a0 * (1.0f + erff(a0 * 0.70710678118654752f)) * g0 * sv0;
        const float c1 = 0.5f * a1 * (1.0f + erff(a1 * 0.70710678118654752f)) * g1 * sv1;
        const float cmx = wave_max(fmaxf(fabsf(c0), fabsf(c1)));
        const float cinv = (cmx > 0.f) ? 127.0f / cmx : 0.f, csc = cmx * (1.0f / 127.0f);
        const int q0 = __float2int_rn(c0 * cinv), q1 = __float2int_rn(c1 * cinv);
        const int cqs = wave_sum_i(q0 + q1);
        const unsigned b0 = (unsigned)q0 & 0xffu, b1 = (unsigned)q1 & 0xffu;
        const int t0 = (int)(b0 | (sh_idx(b0, c.lane + 1) << 8) | (sh_idx(b0, c.lane + 2) << 16) | (sh_idx(b0, c.lane + 3) << 24));
        const int t1 = (int)(b1 | (sh_idx(b1, c.lane + 1) << 8) | (sh_idx(b1, c.lane + 2) << 16) | (sh_idx(b1, c.lane + 3) << 24));
        TQ[(size_t)t * 128 + c.lane] = t0; TQ[(size_t)t * 128 + 64 + c.lane] = t1;
        if (c.lane == 0) { CSC[(size_t)t * 2] = csc; CSC[(size_t)t * 2 + 1] = (float)cqs; }
    }
#undef RM
}
__device__ __forceinline__ void phase_peer4_u_sorted(const Ctx& c, const float* g2vec, unsigned char* ws) {
    const unsigned char* PU = ws + WS_PU; const bf16* X1 = (const bf16*)(ws + WS_X1B);
    LAS float* A2 = (LAS float*)(c.lds + 16384); LAS float* B2 = A2 + D;
    { const float* MODF_ = (const float*)(ws + WS_MODF) + (size_t)(c.vcu >> 7) * NMOD; const int j = 4 * c.tid;
      *(LAS f32x4*)(A2 + j) = *(const f32x4*)(g2vec + j) * (*(const f32x4*)(MODF_ + 4 * D + j) + 1.0f); *(LAS f32x4*)(B2 + j) = *(const f32x4*)(MODF_ + 3 * D + j); }
    __syncthreads();
    const float* SU = (const float*)(ws + WS_SU); const float* SV = (const float*)(ws + WS_SV);
    const int* IDX = (const int*)(ws + WS_IDX); const float* GATE = (const float*)(ws + WS_GATE);
    int* TQ = (int*)(ws + WS_TQ); float* CSC = (float*)(ws + WS_CSC);
    LAS unsigned char* wb = c.lds + 32768 + c.wave * 12288;
    LAS v4u* hqv = (LAS v4u*)wb; LAS unsigned* lst = (LAS unsigned*)(wb + 8192); LAS int* acc = (LAS int*)(wb + 10240);
    v2u hraw[4][8];
#pragma unroll
    for (int jj = 0; jj < 4; ++jj) { const int t = 64 * c.vcu + 8 * c.wave + jj;
#pragma unroll
        for (int j = 0; j < 8; ++j) hraw[jj][j] = __builtin_nontemporal_load((const v2u*)(X1 + (size_t)t * D + 256 * j + 4 * c.lane)); }
#pragma unroll 1
    for (int hf = 0; hf < 2; ++hf) {
        const int tb4 = 64 * c.vcu + 8 * c.wave + 4 * hf;
        int e0[4], e1[4]; float shs[4], hoffs[4];
#pragma unroll
        for (int jj = 0; jj < 4; ++jj) { e0[jj] = IDX[(size_t)(tb4 + jj) * 128 + c.lane]; e1[jj] = IDX[(size_t)(tb4 + jj) * 128 + 64 + c.lane]; }
        {
#pragma unroll
            for (int jj = 0; jj < 4; ++jj) {
                float hf32[32]; float am = 0.f, ssx = 0.f;
#pragma unroll
                for (int j = 0; j < 8; ++j) { hf32[4 * j] = bflo(hraw[jj][j].x); hf32[4 * j + 1] = bfhi(hraw[jj][j].x); hf32[4 * j + 2] = bflo(hraw[jj][j].y); hf32[4 * j + 3] = bfhi(hraw[jj][j].y); }
#pragma unroll
                for (int k = 0; k < 32; ++k) ssx += hf32[k] * hf32[k];
                const float rstd2 = 1.0f / sqrtf(wave_sum(ssx) * (1.0f / D) + NORM_EPS);
#pragma unroll
                for (int j = 0; j < 8; ++j) { const f32x4 av = *(const LAS f32x4*)(A2 + 256 * j + 4 * c.lane), bv = *(const LAS f32x4*)(B2 + 256 * j + 4 * c.lane);
#pragma unroll
                    for (int e = 0; e < 4; ++e) hf32[4 * j + e] = hf32[4 * j + e] * rstd2 * av[e] + bv[e]; }
#pragma unroll
                for (int k = 0; k < 32; ++k) am = fmaxf(am, fabsf(hf32[k]));
                am = wave_max(am);
                const float inv = (am > 0.f) ? 119.0f / am : 0.f;
                unsigned W[8]; unsigned hsu = 0u;
#pragma unroll
                for (int j = 0; j < 8; ++j) { W[j] = 0u;
#pragma unroll
                    for (int e = 0; e < 4; ++e) W[j] = __builtin_amdgcn_cvt_pk_u8_f32(__builtin_rintf(fmaf(hf32[4 * j + e], inv, 136.0f)), e, W[j]);
                    hsu = __builtin_amdgcn_sad_u8(W[j], 0u, hsu); }
                const int hs = (int)hsu - 136 * 32;
                unsigned wh[4], wl[4];
#pragma unroll
                for (int d = 0; d < 4; ++d) {
                    wh[d] = (((W[2 * d] >> 4) & 0x0f0f0f0fu) | (W[2 * d + 1] & 0xf0f0f0f0u)) ^ 0x88888888u;
                    wl[d] = ((W[2 * d] & 0x0f0f0f0fu) | ((W[2 * d + 1] << 4) & 0xf0f0f0f0u)) ^ 0x88888888u; }
                hqv[(jj * 2 + 0) * 64 + c.lane] = (v4u){wh[0], wh[1], wh[2], wh[3]}; hqv[(jj * 2 + 1) * 64 + c.lane] = (v4u){wl[0], wl[1], wl[2], wl[3]};
                shs[jj] = am * (1.0f / 119.0f); hoffs[jj] = 0.5f * (float)wave_sum_i(hs);
            }
        }
        acc[c.lane] = 0;
        LDS_WAIT();
        int pos[8];
#pragma unroll
        for (int jj = 0; jj < 4; ++jj) { pos[2 * jj] = __hip_atomic_fetch_add(acc + (e0[jj] >> 8), 1, __ATOMIC_RELAXED, __HIP_MEMORY_SCOPE_WORKGROUP);
                                         pos[2 * jj + 1] = __hip_atomic_fetch_add(acc + (e1[jj] >> 8), 1, __ATOMIC_RELAXED, __HIP_MEMORY_SCOPE_WORKGROUP); }
        LDS_WAIT();
        { int cnt = acc[c.lane], inc = cnt;
#pragma unroll
          for (int o = 1; o < 64; o <<= 1) { const int up = sh_idx(inc, c.lane - o); inc += (c.lane >= o) ? up : 0; }
          LDS_WAIT(); acc[64 + c.lane] = inc - cnt; }
        LDS_WAIT();
#pragma unroll
        for (int jj = 0; jj < 4; ++jj) {
            lst[acc[64 + (e0[jj] >> 8)] + pos[2 * jj]] = ((unsigned)e0[jj] << 10) | ((unsigned)jj << 7) | (unsigned)c.lane;
            lst[acc[64 + (e1[jj] >> 8)] + pos[2 * jj + 1]] = ((unsigned)e1[jj] << 10) | ((unsigned)jj << 7) | (unsigned)(64 + c.lane);
        }
        LDS_WAIT();
        { const int tbn = 64 * c.vcu + 8 * c.wave + 4;
#pragma unroll
          for (int jj = 0; jj < 4; ++jj) { const int t = tbn + jj;
#pragma unroll
              for (int j = 0; j < 8; ++j) hraw[jj][j] = __builtin_nontemporal_load((const v2u*)(X1 + (size_t)t * D + 256 * j + 4 * c.lane)); } }
        SCHED_FENCE();
        unsigned ent = lst[c.lane & 15];
        v4u r[16];
#pragma unroll
        for (int q = 0; q < 16; ++q) r[q] = ld_row4(PU, (int)(__builtin_amdgcn_readlane(ent, q) >> 10), c.lane);
        v4u hh, hl;
        { const int jj = (int)((__builtin_amdgcn_readlane(ent, 0) >> 7) & 3u); hh = hqv[(jj * 2 + 0) * 64 + c.lane]; hl = hqv[(jj * 2 + 1) * 64 + c.lane]; }
#pragma unroll 1
        for (int m = 0; m < 32; ++m) {
            const unsigned entn = lst[((16 * (m + 1)) & 511) + (c.lane & 15)];
#pragma unroll
            for (int hb = 0; hb < 2; ++hb) {
                int pa[8];
#pragma unroll
                for (int q = 0; q < 8; ++q) {
                    const int s16 = 8 * hb + q;
                    const int jn = (int)(((s16 < 15 ? __builtin_amdgcn_readlane(ent, (s16 + 1) & 15) : __builtin_amdgcn_readlane(entn, 0)) >> 7) & 3u);
                    const v4u hhn = hqv[(jn * 2 + 0) * 64 + c.lane], hln = hqv[(jn * 2 + 1) * 64 + c.lane];
                    const int h8[8] = {(int)hh.x, (int)hh.y, (int)hh.z, (int)hh.w, (int)hl.x, (int)hl.y, (int)hl.z, (int)hl.w};
                    pa[q] = idot_row4(h8, r[s16]);
                    SCHED_FENCE();
                    r[s16] = ld_row4(PU, (int)(__builtin_amdgcn_readlane(entn, s16) >> 10), c.lane);
                    SCHED_FENCE();
                    hh = hhn; hl = hln;
                }
                const int v = reduce8(pa, c.lane);
                if ((c.lane >> 3) == hb) acc[((ent >> 7) & 3u) * 128 + (ent & 127u)] = v;
            }
            ent = entn;
        }
        LDS_WAIT();
        float gg0[4], gg1[4], su0[4], su1[4], sv0[4], sv1[4];
#pragma unroll
        for (int jj = 0; jj < 4; ++jj) { const int t = tb4 + jj;
            gg0[jj] = GATE[(size_t)t * 128 + c.lane]; gg1[jj] = GATE[(size_t)t * 128 + 64 + c.lane];
            su0[jj] = SU[e0[jj]]; su1[jj] = SU[e1[jj]]; sv0[jj] = SV[e0[jj]]; sv1[jj] = SV[e1[jj]]; }
#pragma unroll
        for (int jj = 0; jj < 4; ++jj) { const int t = tb4 + jj;
            const int ia0 = acc[jj * 128 + c.lane], ia1 = acc[jj * 128 + 64 + c.lane];
            const float a0 = ((float)ia0 + hoffs[jj]) * su0[jj] * shs[jj], a1 = ((float)ia1 + hoffs[jj]) * su1[jj] * shs[jj];
            const float c0 = 0.5f * a0 * (1.0f + erff(a0 * 0.70710678118654752f)) * gg0[jj] * sv0[jj];
            const float c1 = 0.5f * a1 * (1.0f + erff(a1 * 0.70710678118654752f)) * gg1[jj] * sv1[jj];
            const float cmx = wave_max(fmaxf(fabsf(c0), fabsf(c1)));
            const float cinv = (cmx > 0.f) ? 127.0f / cmx : 0.f, csc = cmx * (1.0f / 127.0f);
            const int q0 = __float2int_rn(c0 * cinv), q1 = __float2int_rn(c1 * cinv);
            const int cqs = wave_sum_i(q0 + q1);
            const unsigned b0 = (unsigned)q0 & 0xffu, b1 = (unsigned)q1 & 0xffu;
            const int t0 = (int)(b0 | (sh_idx(b0, c.lane + 1) << 8) | (sh_idx(b0, c.lane + 2) << 16) | (sh_idx(b0, c.lane + 3) << 24));
            const int t1 = (int)(b1 | (sh_idx(b1, c.lane + 1) << 8) | (sh_idx(b1, c.lane + 2) << 16) | (sh_idx(b1, c.lane + 3) << 24));
            TQ[(size_t)t * 128 + c.lane] = t0; TQ[(size_t)t * 128 + 64 + c.lane] = t1;
            if (c.lane == 0) { CSC[(size_t)t * 2] = csc; CSC[(size_t)t * 2 + 1] = (float)cqs; }
        }
        LDS_WAIT();
    }
}
typedef int v8i __attribute__((ext_vector_type(8)));
typedef float f32x2 __attribute__((ext_vector_type(2)));
__device__ __forceinline__ void phase_peer4_u_mfma(const Ctx& c, const float* g2vec, unsigned char* ws) {
    const unsigned char* PU = ws + WS_PU; const bf16* X1 = (const bf16*)(ws + WS_X1B);
    LAS float* A2 = (LAS float*)(c.lds + 16384); LAS float* B2 = A2 + D;
    { const float* MODF_ = (const float*)(ws + WS_MODF) + (size_t)(c.vcu >> 7) * NMOD; const int j = 4 * c.tid;
      *(LAS f32x4*)(A2 + j) = *(const f32x4*)(g2vec + j) * (*(const f32x4*)(MODF_ + 4 * D + j) + 1.0f); *(LAS f32x4*)(B2 + j) = *(const f32x4*)(MODF_ + 3 * D + j); }
    __syncthreads();
    const float* SU = (const float*)(ws + WS_SU); const float* SV = (const float*)(ws + WS_SV);
    const int* IDX = (const int*)(ws + WS_IDX); const float* GATE = (const float*)(ws + WS_GATE);
    int* TQ = (int*)(ws + WS_TQ); float* CSC = (float*)(ws + WS_CSC);
    LAS unsigned char* wb = c.lds + 32768 + c.wave * 12288;
    LAS unsigned char* hq = wb; LAS unsigned* lst = (LAS unsigned*)(wb + 8192); LAS int* acc = (LAS int*)(wb + 10240); LAS float* accf = (LAS float*)(wb + 10240);
    const int kg = c.lane >> 4, ncol = c.lane & 15, rho = ncol >> 2, kap = ncol & 3;
#pragma unroll 1
    for (int hf = 0; hf < 2; ++hf) {
        const int tb4 = 64 * c.vcu + 8 * c.wave + 4 * hf;
        int e0[4], e1[4]; float shs[4];
#pragma unroll
        for (int jj = 0; jj < 4; ++jj) { e0[jj] = IDX[(size_t)(tb4 + jj) * 128 + c.lane]; e1[jj] = IDX[(size_t)(tb4 + jj) * 128 + 64 + c.lane]; }
        {
            v2u hraw[4][8];
#pragma unroll
            for (int jj = 0; jj < 4; ++jj) {
#pragma unroll
                for (int j = 0; j < 8; ++j) hraw[jj][j] = __builtin_nontemporal_load((const v2u*)(X1 + (size_t)(tb4 + jj) * D + 256 * j + 4 * c.lane)); }
#pragma unroll
            for (int jj = 0; jj < 4; ++jj) {
                float hf32[32]; float am = 0.f, ssx = 0.f;
#pragma unroll
                for (int j = 0; j < 8; ++j) { hf32[4 * j] = bflo(hraw[jj][j].x); hf32[4 * j + 1] = bfhi(hraw[jj][j].x); hf32[4 * j + 2] = bflo(hraw[jj][j].y); hf32[4 * j + 3] = bfhi(hraw[jj][j].y); }
#pragma unroll
                for (int k = 0; k < 32; ++k) ssx += hf32[k] * hf32[k];
                const float rstd2 = 1.0f / sqrtf(wave_sum(ssx) * (1.0f / D) + NORM_EPS);
#pragma unroll
                for (int j = 0; j < 8; ++j) { const f32x4 av = *(const LAS f32x4*)(A2 + 256 * j + 4 * c.lane), bv = *(const LAS f32x4*)(B2 + 256 * j + 4 * c.lane);
#pragma unroll
                    for (int e = 0; e < 4; ++e) hf32[4 * j + e] = hf32[4 * j + e] * rstd2 * av[e] + bv[e]; }
#pragma unroll
                for (int k = 0; k < 32; ++k) am = fmaxf(am, fabsf(hf32[k]));
                am = wave_max(am);
                const float inv = (am > 0.f) ? 224.0f / am : 0.f;
                unsigned W[8];
#pragma unroll
                for (int w = 0; w < 8; ++w) { const int j0 = 2 * (w >> 1), e0_ = 2 * (w & 1);
                    int pk = __builtin_amdgcn_cvt_pk_fp8_f32(hf32[4 * j0 + e0_] * inv, hf32[4 * (j0 + 1) + e0_] * inv, 0, false);
                    pk = __builtin_amdgcn_cvt_pk_fp8_f32(hf32[4 * j0 + e0_ + 1] * inv, hf32[4 * (j0 + 1) + e0_ + 1] * inv, pk, true);
                    W[w] = (unsigned)pk; }
                { LAS unsigned char* hp = hq + jj * 2048 + c.lane * 32;
                  *(LAS v4u*)hp = (v4u){W[0], W[1], W[2], W[3]}; *(LAS v4u*)(hp + 16) = (v4u){W[4], W[5], W[6], W[7]}; }
                shs[jj] = am * (1.0f / 224.0f);
            }
        }
        acc[c.lane] = 0;
        LDS_WAIT();
        int pos[8];
#pragma unroll
        for (int jj = 0; jj < 4; ++jj) { pos[2 * jj] = __hip_atomic_fetch_add(acc + (e0[jj] >> 8), 1, __ATOMIC_RELAXED, __HIP_MEMORY_SCOPE_WORKGROUP);
                                         pos[2 * jj + 1] = __hip_atomic_fetch_add(acc + (e1[jj] >> 8), 1, __ATOMIC_RELAXED, __HIP_MEMORY_SCOPE_WORKGROUP); }
        LDS_WAIT();
        { int cnt = acc[c.lane], inc = cnt;
#pragma unroll
          for (int o = 1; o < 64; o <<= 1) { const int up = sh_idx(inc, c.lane - o); inc += (c.lane >= o) ? up : 0; }
          LDS_WAIT(); acc[64 + c.lane] = inc - cnt; }
        LDS_WAIT();
#pragma unroll
        for (int jj = 0; jj < 4; ++jj) {
            lst[acc[64 + (e0[jj] >> 8)] + pos[2 * jj]] = ((unsigned)e0[jj] << 10) | ((unsigned)jj << 7) | (unsigned)c.lane;
            lst[acc[64 + (e1[jj] >> 8)] + pos[2 * jj + 1]] = ((unsigned)e1[jj] << 10) | ((unsigned)jj << 7) | (unsigned)(64 + c.lane);
        }
        LDS_WAIT();
        v8i Bp[4];
#pragma unroll
        for (int s4 = 0; s4 < 4; ++s4) { const LAS unsigned char* bp = hq + rho * 2048 + (16 * s4 + 4 * (kg >> 1) + kap) * 32 + (kg & 1) * 16;
            const v4u lo = *(const LAS v4u*)bp, hi = *(const LAS v4u*)(bp + 8 * 32);
            Bp[s4] = (v8i){(int)lo.x, (int)lo.y, (int)lo.z, (int)lo.w, (int)hi.x, (int)hi.y, (int)hi.z, (int)hi.w}; }
        const unsigned lane_off = 64u * (unsigned)kg + 16u * (unsigned)kap;
        v4u r[16];
#pragma unroll
        for (int G = 0; G < 4; ++G) { const unsigned vo = (lst[4 * G + rho] & ~1023u) + lane_off;
#pragma unroll
            for (int s4 = 0; s4 < 4; ++s4) r[4 * G + s4] = *(const v4u*)(PU + vo + 256 * s4); }
#pragma unroll 1
        for (int m = 0; m < 32; ++m) {
#pragma unroll
            for (int G = 0; G < 4; ++G) {
                const unsigned von = (lst[((16 * (m + 1)) & 511) + 4 * G + rho] & ~1023u) + lane_off;
                const unsigned erow = lst[16 * m + 4 * G + kg];
                f32x4 cacc = {0.f, 0.f, 0.f, 0.f};
#pragma unroll
                for (int s4 = 0; s4 < 4; ++s4) {
                    v8i av; av[0] = (int)r[4 * G + s4].x; av[1] = (int)r[4 * G + s4].y; av[2] = (int)r[4 * G + s4].z; av[3] = (int)r[4 * G + s4].w; av[4] = 0; av[5] = 0; av[6] = 0; av[7] = 0;
                    cacc = __builtin_amdgcn_mfma_scale_f32_16x16x128_f8f6f4(av, Bp[s4], cacc, 4, 0, 0, 0x7f7f7f7f, 0, 0x7f7f7f7f);
                }
                SCHED_FENCE();
#pragma unroll
                for (int s4 = 0; s4 < 4; ++s4) r[4 * G + s4] = *(const v4u*)(PU + von + 256 * s4);
                SCHED_FENCE();
                float v = (kap == 0) ? cacc[0] : (kap == 1) ? cacc[1] : (kap == 2) ? cacc[2] : cacc[3];
                v += SXOR(v, 1, c.lane); v += SXOR(v, 2, c.lane);
                const unsigned tk = (erow >> 7) & 3u;
                if (kap == 0 && (unsigned)rho == tk) accf[tk * 128 + (erow & 127u)] = v;
            }
        }
        LDS_WAIT();
        float gg0[4], gg1[4], su0[4], su1[4], sv0[4], sv1[4];
#pragma unroll
        for (int jj = 0; jj < 4; ++jj) { const int t = tb4 + jj;
            gg0[jj] = GATE[(size_t)t * 128 + c.lane]; gg1[jj] = GATE[(size_t)t * 128 + 64 + c.lane];
            su0[jj] = SU[e0[jj]]; su1[jj] = SU[e1[jj]]; sv0[jj] = SV[e0[jj]]; sv1[jj] = SV[e1[jj]]; }
#pragma unroll
        for (int jj = 0; jj < 4; ++jj) { const int t = tb4 + jj;
            const float a0 = accf[jj * 128 + c.lane] * su0[jj] * shs[jj], a1 = accf[jj * 128 + 64 + c.lane] * su1[jj] * shs[jj];
            const float c0 = 0.5f * a0 * (1.0f + erff(a0 * 0.70710678118654752f)) * gg0[jj] * sv0[jj];
            const float c1 = 0.5f * a1 * (1.0f + erff(a1 * 0.70710678118654752f)) * gg1[jj] * sv1[jj];
            const float cmx = wave_max(fmaxf(fabsf(c0), fabsf(c1)));
#if V_MFMA
            const float cinv = (cmx > 0.f) ? 224.0f / cmx : 0.f;
            ((float*)TQ)[(size_t)t * 128 + c.lane] = c0 * cinv; ((float*)TQ)[(size_t)t * 128 + 64 + c.lane] = c1 * cinv;
            if (c.lane == 0) { CSC[(size_t)t * 2] = cmx * (1.0f / 224.0f); CSC[(size_t)t * 2 + 1] = 0.f; }
#else
            const float cinv = (cmx > 0.f) ? 127.0f / cmx : 0.f, csc = cmx * (1.0f / 127.0f);
            const int q0 = __float2int_rn(c0 * cinv), q1 = __float2int_rn(c1 * cinv);
            const int cqs = wave_sum_i(q0 + q1);
            const unsigned b0_ = (unsigned)q0 & 0xffu, b1_ = (unsigned)q1 & 0xffu;
            const int t0 = (int)(b0_ | (sh_idx(b0_, c.lane + 1) << 8) | (sh_idx(b0_, c.lane + 2) << 16) | (sh_idx(b0_, c.lane + 3) << 24));
            const int t1 = (int)(b1_ | (sh_idx(b1_, c.lane + 1) << 8) | (sh_idx(b1_, c.lane + 2) << 16) | (sh_idx(b1_, c.lane + 3) << 24));
            TQ[(size_t)t * 128 + c.lane] = t0; TQ[(size_t)t * 128 + 64 + c.lane] = t1;
            if (c.lane == 0) { CSC[(size_t)t * 2] = csc; CSC[(size_t)t * 2 + 1] = (float)cqs; }
#endif
        }
        LDS_WAIT();
    }
}
__device__ __forceinline__ void phase_peer4_v_mfma(const Ctx& c, const float* final_g, float* out, unsigned char* ws) {
    const bf16* X1 = (const bf16*)(ws + WS_X1B);
    const unsigned char* PV = ws + WS_PV;
    const int* IDX = (const int*)(ws + WS_IDX); const float* CF = (const float*)(ws + WS_TQ); const float* CSC = (const float*)(ws + WS_CSC); const float* MODF = (const float*)(ws + WS_MODF);
    LAS float* G2 = (LAS float*)c.lds; LAS float* FG = G2 + D;
    const int b = c.vcu >> 7;
    { const int j = 4 * c.tid; *(LAS f32x4*)(G2 + j) = *(const f32x4*)(MODF + (size_t)b * NMOD + 5 * D + j); *(LAS f32x4*)(FG + j) = *(const f32x4*)(final_g + j); }
    __syncthreads();
    const int n = c.lane & 15, g = c.lane >> 4;
    const int tbase = 64 * c.vcu + 8 * c.wave;
    const unsigned nb8 = 8u * (unsigned)n;
    const int F0 = 256 * (4 * (n & 1) + 2 * (g >> 1)) + 4 * (n >> 1) + 2 * (g & 1);
    int e0n = IDX[(size_t)tbase * 128 + c.lane], e1n = IDX[(size_t)tbase * 128 + 64 + c.lane];
    float cf0n = CF[(size_t)tbase * 128 + c.lane], cf1n = CF[(size_t)tbase * 128 + 64 + c.lane];
    v2u br[2][8][2];
#pragma unroll
    for (int bf = 0; bf < 2; ++bf) {
        const unsigned o0 = ((unsigned)sh_idx(e0n, 8 * bf + 2 * g) << 10) + nb8, o1 = ((unsigned)sh_idx(e0n, 8 * bf + 2 * g + 1) << 10) + nb8;
#pragma unroll
        for (int s8 = 0; s8 < 8; ++s8) { br[bf][s8][0] = *(const v2u*)(PV + o0 + 128 * s8); br[bf][s8][1] = *(const v2u*)(PV + o1 + 128 * s8); }
    }
#pragma unroll 1
    for (int i = 0; i < 8; ++i) {
        const int t = tbase + i, tn = tbase + ((i + 1) & 7);
        const int e0 = e0n, e1 = e1n; const float cf0 = cf0n, cf1 = cf1n;
        const float csc = CSC[(size_t)t * 2];
        e0n = IDX[(size_t)tn * 128 + c.lane]; e1n = IDX[(size_t)tn * 128 + 64 + c.lane];
        cf0n = CF[(size_t)tn * 128 + c.lane]; cf1n = CF[(size_t)tn * 128 + 64 + c.lane];
        f32x4 C[8];
#pragma unroll
        for (int s8 = 0; s8 < 8; ++s8) C[s8] = (f32x4){0.f, 0.f, 0.f, 0.f};
#pragma unroll 1
        for (int gp = 0; gp < 8; ++gp) {
#pragma unroll
            for (int bf = 0; bf < 2; ++bf) {
                const int grp = 2 * gp + bf;
                const float cfs = (gp < 4) ? cf0 : cf1;
                const float ca = sh_idx(cfs, (8 * grp + g) & 63), cb = sh_idx(cfs, (8 * grp + 4 + g) & 63);
                const unsigned pk = (unsigned)__builtin_amdgcn_cvt_pk_fp8_f32(ca, cb, 0, false);
                const unsigned wlo = (pk & 0xffu) << (8 * (n & 3)), whi = ((pk >> 8) & 0xffu) << (8 * (n & 3));
                const int q = n >> 2;
                const v8i av = {(int)(q == 0 ? wlo : 0u), (int)(q == 1 ? wlo : 0u), (int)(q == 2 ? wlo : 0u), (int)(q == 3 ? wlo : 0u),
                                (int)(q == 0 ? whi : 0u), (int)(q == 1 ? whi : 0u), (int)(q == 2 ? whi : 0u), (int)(q == 3 ? whi : 0u)};
#pragma unroll
                for (int s8 = 0; s8 < 8; ++s8) {
                    v8i bv; bv[0] = (int)br[bf][s8][0].x; bv[1] = (int)br[bf][s8][0].y; bv[2] = (int)br[bf][s8][1].x; bv[3] = (int)br[bf][s8][1].y; bv[4] = 0; bv[5] = 0; bv[6] = 0; bv[7] = 0;
                    C[s8] = __builtin_amdgcn_mfma_scale_f32_16x16x128_f8f6f4(av, bv, C[s8], 0, 4, 0, 0x7f7f7f7f, 0, 0x7f7f7f7f);
                }
                SCHED_FENCE();
                {
                    const int gn = grp + 2;
                    const int es = (gn < 8) ? e0 : ((gn < 16) ? e1 : e0n);
                    const unsigned o0 = ((unsigned)sh_idx(es, (8 * gn + 2 * g) & 63) << 10) + nb8, o1 = ((unsigned)sh_idx(es, (8 * gn + 2 * g + 1) & 63) << 10) + nb8;
#pragma unroll
                    for (int s8 = 0; s8 < 8; ++s8) { br[bf][s8][0] = *(const v2u*)(PV + o0 + 128 * s8); br[bf][s8][1] = *(const v2u*)(PV + o1 + 128 * s8); }
                }
                SCHED_FENCE();
            }
        }
        const bf16* xr = X1 + (size_t)t * D + F0; float* orow = out + (size_t)t * D + F0;
        float ss = 0.f;
#pragma unroll
        for (int s8 = 0; s8 < 8; ++s8) {
            const unsigned xa = __builtin_nontemporal_load((const unsigned*)(xr + 32 * s8)), xb = __builtin_nontemporal_load((const unsigned*)(xr + 256 + 32 * s8));
            const f32x2 ga = *(const LAS f32x2*)(G2 + F0 + 32 * s8), gb = *(const LAS f32x2*)(G2 + F0 + 256 + 32 * s8);
            const float v0 = bflo(xa) + ga[0] * (csc * C[s8][0]), v2 = bfhi(xa) + ga[1] * (csc * C[s8][2]);
            const float v1 = bflo(xb) + gb[0] * (csc * C[s8][1]), v3 = bfhi(xb) + gb[1] * (csc * C[s8][3]);
            C[s8] = (f32x4){v0, v1, v2, v3}; ss += (v0 * v0 + v1 * v1) + (v2 * v2 + v3 * v3);
        }
        const float rstd = 1.0f / sqrtf(wave_sum(ss) * (1.0f / D) + NORM_EPS);
#pragma unroll
        for (int s8 = 0; s8 < 8; ++s8) {
            const f32x2 fa = *(const LAS f32x2*)(FG + F0 + 32 * s8), fb = *(const LAS f32x2*)(FG + F0 + 256 + 32 * s8);
            const f32x2 oa = {C[s8][0] * rstd * fa[0], C[s8][2] * rstd * fa[1]}, ob = {C[s8][1] * rstd * fb[0], C[s8][3] * rstd * fb[1]};
            __builtin_nontemporal_store(oa, (f32x2*)(orow + 32 * s8)); __builtin_nontemporal_store(ob, (f32x2*)(orow + 256 + 32 * s8));
        }
    }
}
__device__ __forceinline__ void phase_peer4_v_sorted(const Ctx& c, const float* final_g, float* out, unsigned char* ws) {
    const bf16* X1 = (const bf16*)(ws + WS_X1B);
    const unsigned char* PV = ws + WS_PV;
    const int* IDX = (const int*)(ws + WS_IDX); const float* CF = (const float*)(ws + WS_TQ); const float* CSC = (const float*)(ws + WS_CSC); const float* MODF = (const float*)(ws + WS_MODF);
    LAS float* G2 = (LAS float*)c.lds; LAS float* FG = G2 + D;
    const int b = c.vcu >> 7;
    { const int j = 4 * c.tid; *(LAS f32x4*)(G2 + j) = *(const f32x4*)(MODF + (size_t)b * NMOD + 5 * D + j); *(LAS f32x4*)(FG + j) = *(const f32x4*)(final_g + j); }
    __syncthreads();
    LAS unsigned char* wb = c.lds + 32768 + c.wave * 12288;
    LAS v2u* lst2 = (LAS v2u*)wb; LAS int* hist = (LAS int*)(wb + 4096);
    const int n = c.lane & 15, g = c.lane >> 4;
    const unsigned nb16 = 16u * (unsigned)n;
    const int F0 = 512 * (g >> 1) + 4 * n + 2 * (g & 1);
    const int q4 = n >> 2, sh8 = 8 * (n & 3);
#pragma unroll 1
    for (int hf = 0; hf < 2; ++hf) {
        const int tb4 = 64 * c.vcu + 8 * c.wave + 4 * hf;
        {
            int e0[4], e1[4]; float w0[4], w1[4];
#pragma unroll
            for (int jj = 0; jj < 4; ++jj) { const size_t o = (size_t)(tb4 + jj) * 128 + c.lane; e0[jj] = IDX[o]; e1[jj] = IDX[o + 64]; w0[jj] = CF[o]; w1[jj] = CF[o + 64]; }
            hist[c.lane] = 0;
            LDS_WAIT();
            int pos[8];
#pragma unroll
            for (int jj = 0; jj < 4; ++jj) { pos[2 * jj] = __hip_atomic_fetch_add(hist + ((e0[jj] >> V_BSH) * 4 + jj), 1, __ATOMIC_RELAXED, __HIP_MEMORY_SCOPE_WORKGROUP);
                                             pos[2 * jj + 1] = __hip_atomic_fetch_add(hist + ((e1[jj] >> V_BSH) * 4 + jj), 1, __ATOMIC_RELAXED, __HIP_MEMORY_SCOPE_WORKGROUP); }
            LDS_WAIT();
            { int cnt = hist[c.lane], inc = cnt;
#pragma unroll
              for (int o = 1; o < 64; o <<= 1) { const int up = sh_idx(inc, c.lane - o); inc += (c.lane >= o) ? up : 0; }
              LDS_WAIT(); hist[64 + c.lane] = inc - cnt; }
            LDS_WAIT();
#pragma unroll
            for (int jj = 0; jj < 4; ++jj) {
                lst2[hist[64 + (e0[jj] >> V_BSH) * 4 + jj] + pos[2 * jj]] = (v2u){((unsigned)e0[jj] << 2) | (unsigned)jj, __float_as_uint(w0[jj])};
                lst2[hist[64 + (e1[jj] >> V_BSH) * 4 + jj] + pos[2 * jj + 1]] = (v2u){((unsigned)e1[jj] << 2) | (unsigned)jj, __float_as_uint(w1[jj])};
            }
            LDS_WAIT();
        }
        f32x4 C[4][8];
#pragma unroll
        for (int jj = 0; jj < 4; ++jj)
#pragma unroll
            for (int s8 = 0; s8 < 8; ++s8) C[jj][s8] = (f32x4){0.f, 0.f, 0.f, 0.f};
        v4u br[2][4][2];
#pragma unroll
        for (int bf = 0; bf < 2; ++bf) {
            const v4u qe = *(const LAS v4u*)(lst2 + 8 * bf + 2 * g);
            const unsigned o0 = ((qe.x >> 2) << 10) + nb16, o1 = ((qe.z >> 2) << 10) + nb16;
#pragma unroll
            for (int s4 = 0; s4 < 4; ++s4) { br[bf][s4][0] = *(const v4u*)(PV + o0 + 256 * s4); br[bf][s4][1] = *(const v4u*)(PV + o1 + 256 * s4); }
        }
#pragma unroll 1
        for (int gp = 0; gp < 32; ++gp) {
#pragma unroll
            for (int bf = 0; bf < 2; ++bf) {
                const int G = 2 * gp + bf;
                const v2u ea = lst2[8 * G + g], eb = lst2[8 * G + 4 + g];
                const unsigned tokA = ea.x & 3u, tokB = eb.x & 3u; const float cA = __uint_as_float(ea.y), cB = __uint_as_float(eb.y);
                const v4u qn = *(const LAS v4u*)(lst2 + ((8 * (G + 2)) & 511) + 2 * g);
#pragma unroll
                for (int jj = 0; jj < 4; ++jj) {
                    const bool hasA = (tokA == (unsigned)jj), hasB = (tokB == (unsigned)jj);
                    if (__builtin_amdgcn_ballot_w64(hasA || hasB) != 0ull) {
                        const unsigned pk = (unsigned)__builtin_amdgcn_cvt_pk_fp8_f32(hasA ? cA : 0.f, hasB ? cB : 0.f, 0, false);
                        const unsigned wlo = (pk & 0xffu) << sh8, whi = ((pk >> 8) & 0xffu) << sh8;
                        const v8i av = {(int)(q4 == 0 ? wlo : 0u), (int)(q4 == 1 ? wlo : 0u), (int)(q4 == 2 ? wlo : 0u), (int)(q4 == 3 ? wlo : 0u),
                                        (int)(q4 == 0 ? whi : 0u), (int)(q4 == 1 ? whi : 0u), (int)(q4 == 2 ? whi : 0u), (int)(q4 == 3 ? whi : 0u)};
#pragma unroll
                        for (int s8 = 0; s8 < 8; ++s8) {
                            const v4u r0 = br[bf][s8 >> 1][0], r1 = br[bf][s8 >> 1][1];
                            v8i bv; bv[0] = (int)((s8 & 1) ? r0.z : r0.x); bv[1] = (int)((s8 & 1) ? r0.w : r0.y); bv[2] = (int)((s8 & 1) ? r1.z : r1.x); bv[3] = (int)((s8 & 1) ? r1.w : r1.y); bv[4] = 0; bv[5] = 0; bv[6] = 0; bv[7] = 0;
                            C[jj][s8] = __builtin_amdgcn_mfma_scale_f32_16x16x128_f8f6f4(av, bv, C[jj][s8], 0, 4, 0, 0x7f7f7f7f, 0, 0x7f7f7f7f);
                        }
                    }
                }
                SCHED_FENCE();
                { const unsigned o0 = ((qn.x >> 2) << 10) + nb16, o1 = ((qn.z >> 2) << 10) + nb16;
#pragma unroll
                  for (int s4 = 0; s4 < 4; ++s4) { br[bf][s4][0] = *(const v4u*)(PV + o0 + 256 * s4); br[bf][s4][1] = *(const v4u*)(PV + o1 + 256 * s4); } }
                SCHED_FENCE();
            }
        }
#pragma unroll
        for (int jj = 0; jj < 4; ++jj) {
            const int t = tb4 + jj;
            const float csc = CSC[(size_t)t * 2];
            const bf16* xr = X1 + (size_t)t * D + F0; float* orow = out + (size_t)t * D + F0;
            float ss = 0.f;
#pragma unroll
            for (int s8 = 0; s8 < 8; ++s8) {
                const unsigned xa = __builtin_nontemporal_load((const unsigned*)(xr + (1024 * (s8 & 1) + 64 * (s8 >> 1)))), xb = __builtin_nontemporal_load((const unsigned*)(xr + 256 + (1024 * (s8 & 1) + 64 * (s8 >> 1))));
                const f32x2 ga = *(const LAS f32x2*)(G2 + F0 + (1024 * (s8 & 1) + 64 * (s8 >> 1))), gb = *(const LAS f32x2*)(G2 + F0 + 256 + (1024 * (s8 & 1) + 64 * (s8 >> 1)));
                const float v0 = bflo(xa) + ga[0] * (csc * C[jj][s8][0]), v2 = bfhi(xa) + ga[1] * (csc * C[jj][s8][2]);
                const float v1 = bflo(xb) + gb[0] * (csc * C[jj][s8][1]), v3 = bfhi(xb) + gb[1] * (csc * C[jj][s8][3]);
                C[jj][s8] = (f32x4){v0, v1, v2, v3}; ss += (v0 * v0 + v1 * v1) + (v2 * v2 + v3 * v3);
            }
            const float rstd = 1.0f / sqrtf(wave_sum(ss) * (1.0f / D) + NORM_EPS);
#pragma unroll
            for (int s8 = 0; s8 < 8; ++s8) {
                const f32x2 fa = *(const LAS f32x2*)(FG + F0 + (1024 * (s8 & 1) + 64 * (s8 >> 1))), fb = *(const LAS f32x2*)(FG + F0 + 256 + (1024 * (s8 & 1) + 64 * (s8 >> 1)));
                const f32x2 oa = {C[jj][s8][0] * rstd * fa[0], C[jj][s8][2] * rstd * fa[1]}, ob = {C[jj][s8][1] * rstd * fb[0], C[jj][s8][3] * rstd * fb[1]};
                __builtin_nontemporal_store(oa, (f32x2*)(orow + (1024 * (s8 & 1) + 64 * (s8 >> 1)))); __builtin_nontemporal_store(ob, (f32x2*)(orow + 256 + (1024 * (s8 & 1) + 64 * (s8 >> 1))));
            }
        }
        LDS_WAIT();
    }
}
__device__ __forceinline__ void phase_peer4_v(const Ctx& c, const float* final_g, float* out, unsigned char* ws) {
    const bf16* X1 = (const bf16*)(ws + WS_X1B);
    const unsigned char* PV = ws + WS_PV;
    const int* IDX = (const int*)(ws + WS_IDX); const int* TQ = (const int*)(ws + WS_TQ); const float* CSC = (const float*)(ws + WS_CSC); const float* MODF = (const float*)(ws + WS_MODF);
    LAS float* G2 = (LAS float*)c.lds; LAS float* FG = G2 + D;
    const int b = c.vcu >> 7;
    { const int j = 4 * c.tid; *(LAS f32x4*)(G2 + j) = *(const f32x4*)(MODF + (size_t)b * NMOD + 5 * D + j); *(LAS f32x4*)(FG + j) = *(const f32x4*)(final_g + j); }
    __syncthreads();
    const int tbase = 64 * c.vcu + 8 * c.wave;
    int e0n = IDX[(size_t)tbase * 128 + c.lane], e1n = IDX[(size_t)tbase * 128 + 64 + c.lane];
    int t0n = TQ[(size_t)tbase * 128 + c.lane], t1n = TQ[(size_t)tbase * 128 + 64 + c.lane];
    v4u r[16];
#pragma unroll
    for (int q = 0; q < 16; ++q) r[q] = ld_row4(PV, __builtin_amdgcn_readlane(e0n, q), c.lane);
#pragma unroll 1
    for (int i = (DUP & 2048) ? -8 : 0; i < 8; ++i) {
        const int t = tbase + (i & 7), tn = tbase + ((i + 1) & 7);
        const int e0 = e0n, e1 = e1n, t0 = t0n, t1 = t1n;
        const float csc = CSC[(size_t)t * 2], cqsf = CSC[(size_t)t * 2 + 1];
        e0n = IDX[(size_t)tn * 128 + c.lane]; e1n = IDX[(size_t)tn * 128 + 64 + c.lane];
        t0n = TQ[(size_t)tn * 128 + c.lane]; t1n = TQ[(size_t)tn * 128 + 64 + c.lane];
        int y[32];
#pragma unroll
        for (int q = 0; q < 32; ++q) y[q] = 0;
#pragma unroll 1
        for (int m = 0; m < 8; ++m) {
            const int esrc = (m + 1 < 4) ? e0 : ((m + 1 < 8) ? e1 : e0n);
            const int tsrc = (m < 4) ? t0 : t1;
#pragma unroll
            for (int gq = 0; gq < 4; ++gq) {
                const int cq4 = __builtin_amdgcn_readlane(tsrc, (16 * m + 4 * gq) & 63);
                vacc4(y, r[4 * gq], r[4 * gq + 1], r[4 * gq + 2], r[4 * gq + 3], cq4);
                SCHED_FENCE();
#pragma unroll
                for (int q = 0; q < 4; ++q) r[4 * gq + q] = ld_row4(PV, __builtin_amdgcn_readlane(esrc, (16 * (m + 1) + 4 * gq + q) & 63), c.lane);
                SCHED_FENCE();
            }
        }
        const bf16* xr = X1 + (size_t)t * D + 4 * c.lane; float* orow = ((DUP & 2048) && i < 0 ? (float*)(ws + WS_HC) : out) + (size_t)t * D + 4 * c.lane;
        float yf[32]; float ss = 0.f;
#pragma unroll
        for (int j = 0; j < 8; ++j) {
            const v2u xw = __builtin_nontemporal_load((const v2u*)(xr + 256 * j)); const f32x4 xa = {bflo(xw.x), bfhi(xw.x), bflo(xw.y), bfhi(xw.y)};
            const f32x4 ga = *(const LAS f32x4*)(G2 + 256 * j + 4 * c.lane);
#pragma unroll
            for (int e = 0; e < 4; ++e) {
                const int d = j >> 1;
                const float yv = (j & 1) ? (float)((y[8 * d + 4 + e] - y[8 * d + e]) >> 4) + 0.5f * cqsf : (float)y[8 * d + e] - 7.5f * cqsf;
                const float v = xa[e] + ga[e] * (csc * yv); yf[4 * j + e] = v; ss += v * v; }
        }
        const float rstd = 1.0f / sqrtf(wave_sum(ss) * (1.0f / D) + NORM_EPS);
#pragma unroll
        for (int j = 0; j < 8; ++j) {
            const f32x4 fa = *(const LAS f32x4*)(FG + 256 * j + 4 * c.lane);
            f32x4 o;
#pragma unroll
            for (int e = 0; e < 4; ++e) o[e] = yf[4 * j + e] * rstd * fa[e];
            __builtin_nontemporal_store(o, (f32x4*)(orow + 256 * j));
        }
    }
}

struct Args { const float* in[16]; float* out; unsigned char* ws; };
__device__ __forceinline__ int lane_id() { unsigned ones = ~0u; asm volatile("" : "+s"(ones)); return (int)__builtin_amdgcn_mbcnt_hi(ones, __builtin_amdgcn_mbcnt_lo(ones, 0u)); }
__global__ void __launch_bounds__(NTHREADS, 2) fwd_kernel(Args args_unused) {
    extern __shared__ __attribute__((aligned(16))) unsigned char lds_raw[];
    const int wave_s = __builtin_amdgcn_readfirstlane((int)(threadIdx.x >> 6));
#define CAS __attribute__((address_space(4)))
#define KARGS() const CAS unsigned char* ka_ = (const CAS unsigned char*)__builtin_amdgcn_kernarg_segment_ptr(); asm volatile("" : "+s"(ka_));
#define ARG_IN(i) (*(const float* const CAS*)(ka_ + 8 * (i)))
#define ARG_OUT() (*(float* const CAS*)(ka_ + 128))
#define ARG_WS() (*(unsigned char* const CAS*)(ka_ + 136))
#define MKCTX() KARGS(); unsigned char* ws = ARG_WS(); Ctx c; { c.lds = (LAS unsigned char*)lds_raw; int l_ = lane_id(); asm volatile("" : "+v"(l_)); c.lane = l_; c.wave = wave_s; c.tid = wave_s * 64 + l_; \
    c.G = 256; { const int bx = blockIdx.x; c.vcu = (bx % 8) * 32 + bx / 8; } c.gw = c.vcu * NWAVES + c.wave; c.ngw = 256 * NWAVES; }
#define IS_T0() (wave_s == 0 && lane_id() == 0)
#define GRID_BAR() xcd_barrier(bar, IS_T0())
    LAS unsigned char* const ldsb = (LAS unsigned char*)lds_raw;
    volatile LAS unsigned* misc = (volatile LAS unsigned*)(ldsb + MISC_OFF);
    if (threadIdx.x < 4) misc[threadIdx.x] = 0u;
    __syncthreads();
    XcdBarrier bar;
    { KARGS(); bar = xcd_barrier_post((unsigned*)(ARG_WS() + WS_CTL), misc, IS_T0()); }
    if (gridDim.x != 256) return;

    { MKCTX(); const float* inp[16];
#pragma unroll
      for (int i = 0; i < 16; ++i) inp[i] = ARG_IN(i);
      phase0(c, inp, ws); if (DUP & 1) phase0(c, inp, ws); }
    GRID_BAR();
    { MKCTX(); phase_rows<true>(c, ARG_IN(0), nullptr, ARG_IN(5), ARG_IN(4), (const int*)ARG_IN(2), ws, 0, 1, ARG_IN(10), ARG_IN(11)); if (DUP & 2) phase_rows<true>(c, ARG_IN(0), nullptr, ARG_IN(5), ARG_IN(4), (const int*)ARG_IN(2), ws, 0, 1, ARG_IN(10), ARG_IN(11)); }
    GRID_BAR();
    { KARGS(); unsigned char* ws = ARG_WS();
#if P2_I8
      pg8::Gemm g{(const bf16*)(ws + WS_H8), (const bf16*)(ws + WS_W8), T, INW, D / 2, D / 2, D / 2, 0}; pg8::StaticOrder S; S.init(T, INW, 256, (int)blockIdx.x);
#else
      pg8::Gemm g{(const bf16*)(ws + WS_HB), (const bf16*)(ws + WS_WTIN), T, INW, D, D, D, 0}; pg8::StaticOrder S; S.init(T, INW, 256, (int)blockIdx.x);
#endif
      Epi1 E{(bf16*)(ws + WS_Q), (const float*)(ws + WS_CS), (const float*)(ws + WS_SA), (const float*)(ws + WS_SB)};
      int nrep_ = (DUP & 4) ? 2 : 1; asm volatile("" : "+s"(nrep_));
#pragma unroll 1
      for (int rep_ = 0; rep_ < nrep_; ++rep_) { pg8::gemm_phase<Epi1, pg8::StaticOrder, false, P2_I8 ? 2 : 0>(ldsb, g, S, E, nullptr, wave_s); } }
    GRID_BAR();
    { MKCTX(); phase_poolr(c, ws); if (DUP & 256) phase_poolr(c, ws); }
#if ATTN_SIMPLE
    { MKCTX(); phase_attn_simple(c, ws); }
#else
    { MKCTX(); phase_attn_mfma(c, ws); if (DUP & 8) phase_attn_mfma(c, ws); }
#endif
    GRID_BAR();
#if !ATTN_SIMPLE
    { MKCTX(); phase_combine(c, ws); if (DUP & 16384) phase_combine(c, ws); }
#endif
    { KARGS(); unsigned char* ws = ARG_WS();
      pg8::Gemm g{(const bf16*)(ws + WS_RB), (const bf16*)(ws + WS_WTPOOL), T, PW, 256, PW, 256, 512}; pg8::StaticOrder S; S.init(T, PW, 256, (int)blockIdx.x);
      EpiPool E{(bf16*)(ws + WS_HC), ARG_IN(8)};
      int nrep_ = (DUP & 16) ? 2 : 1; asm volatile("" : "+s"(nrep_));
#pragma unroll 1
      for (int rep_ = 0; rep_ < nrep_; ++rep_) { pg8::gemm_phase<EpiPool, pg8::StaticOrder, false>(ldsb, g, S, E, nullptr, wave_s); } }
    GRID_BAR();
    { KARGS(); unsigned char* ws = ARG_WS();
      pg8::Gemm g{(const bf16*)(ws + WS_HC), (const bf16*)(ws + WS_WTOUT), T, D, D, D, D, 0}; pg8::StaticOrder S; S.init(T, D, 256, (int)blockIdx.x);
      EpiOut E{ARG_IN(0), (bf16*)(ws + WS_X1B), (const float*)(ws + WS_MODF), (float*)(ws + WS_RSQP)};
      int nrep_ = (DUP & 32) ? 2 : 1; asm volatile("" : "+s"(nrep_));
#pragma unroll 1
      for (int rep_ = 0; rep_ < nrep_; ++rep_) { pg8::gemm_phase<EpiOut, pg8::StaticOrder, false>(ldsb, g, S, E, nullptr, wave_s); } }
    GRID_BAR();
    { KARGS(); unsigned char* ws = ARG_WS();
      pg8::StaticOrder S; S.init(T, D, 256, (int)blockIdx.x);
      pg8::Unit u0, u1; S.next(0, u0); S.next(1, u1);
      LAS float* rstdT = (LAS float*)(ldsb + 131072 + 256); LAS float* biasT = rstdT + 512;
      { const int l_ = lane_id(), tid_ = wave_s * 64 + l_, slot = tid_ >> 8, i_ = tid_ & 255; const pg8::Unit uu = slot ? u1 : u0;
        const float* rp = (const float*)(ws + WS_RSQP) + (size_t)(uu.pm * 256 + i_) * 32; float ssum = 0.f;
#pragma unroll
        for (int q = 0; q < 8; ++q) { const f32x4 v = *(const f32x4*)(rp + 4 * q); ssum += (v[0] + v[1]) + (v[2] + v[3]); }
        rstdT[slot * 256 + i_] = 1.0f / sqrtf(ssum * (1.0f / D) + NORM_EPS);
        const float* bp = (const float*)(ws + WS_BIASP) + (size_t)(uu.pm >= 32 ? 1 : 0) * D + uu.pn * 256 + i_; float bsum = 0.f;
#pragma unroll 8
        for (int kb = 0; kb < 32; ++kb) bsum += bp[(size_t)kb * 2 * D];
        biasT[slot * 256 + i_] = bsum; }
      __syncthreads();
      pg8::Gemm g{(const bf16*)(ws + WS_X1B), (const bf16*)(ws + WS_WQ2), T, D, D, D, D, 0, D * D * 2};
      EpiQ E{(bf16*)(ws + WS_QP), rstdT, biasT, u0.pm, u0.pn};
      int nrep_ = (DUP & 128) ? 2 : 1; asm volatile("" : "+s"(nrep_));
#pragma unroll 1
      for (int rep_ = 0; rep_ < nrep_; ++rep_) { pg8::gemm_phase<EpiQ, pg8::StaticOrder, false>(ldsb, g, S, E, nullptr, wave_s); } }
    GRID_BAR();
#if TOPK_SIMPLE
    { KARGS(); unsigned char* ws = ARG_WS();
      pg8::Gemm g{(const bf16*)(ws + WS_QP), (const bf16*)(ws + WS_SKP), T, D, 256, D, 256, 512}; pg8::StaticOrder S; S.init(T, D, 256, (int)blockIdx.x);
      EpiF E{(float*)(ws + WS_SC), D};
      pg8::gemm_phase<EpiF, pg8::StaticOrder, false>(ldsb, g, S, E, nullptr, wave_s); }
    GRID_BAR();
    { MKCTX(); phase_topk_simple(c, ws); if (DUP & 512) phase_topk_simple(c, ws); }
    GRID_BAR();
#else
    { MKCTX(); phase_scores_topk(c, ws); if (DUP & 512) phase_scores_topk(c, ws); }
    GRID_BAR();
#endif
#if PEER_BITS == 8
    { MKCTX(); phase_peer(c, ARG_OUT(), ARG_IN(15), ARG_OUT(), ws); }
#else
#if U_MFMA
    { MKCTX(); int nrep_ = (DUP & 8192) ? 2 : 1; asm volatile("" : "+s"(nrep_));
#pragma unroll 1
      for (int rep_ = 0; rep_ < nrep_; ++rep_) phase_peer4_u_mfma(c, ARG_IN(10), ws); }
#elif U_SORTED
    { MKCTX(); int nrep_ = (DUP & 8192) ? 2 : 1; asm volatile("" : "+s"(nrep_));
#pragma unroll 1
      for (int rep_ = 0; rep_ < nrep_; ++rep_) phase_peer4_u_sorted(c, ARG_IN(10), ws); }
#else
    { MKCTX(); phase_peer4_u<false>(c, ARG_IN(10), ws); }
#endif
    if (DUP & 4096) { MKCTX(); phase_peer4_u<true>(c, ARG_IN(10), ws); }
    asm volatile("s_waitcnt vmcnt(0)" ::: "memory");
#if V_MFMA && V_SORTED
    { MKCTX(); phase_peer4_v_sorted(c, ARG_IN(15), ARG_OUT(), ws); }
#elif V_MFMA
    { MKCTX(); phase_peer4_v_mfma(c, ARG_IN(15), ARG_OUT(), ws); }
#else
    { MKCTX(); phase_peer4_v(c, ARG_IN(15), ARG_OUT(), ws); }
#endif
#endif
}

extern "C" void kernel_launch(void* const* d_in, const int* in_sizes, int n_in, void* d_out, int out_size, void* d_ws, size_t ws_size, hipStream_t stream) {
    static int grid = 0;
    if (grid == 0) {
        if (n_in != 16 || in_sizes[0] != T * D || out_size != T * D || ws_size < WS_END) { fprintf(stderr, "kernel_launch: unexpected shapes (n_in %d, in0 %d, out %d, ws %zu)\n", n_in, n_in > 0 ? in_sizes[0] : -1, out_size, ws_size); grid = -1; return; }
        int dev = 0, cus = 0, per_cu = 0;
        if (hipGetDevice(&dev) != hipSuccess || hipDeviceGetAttribute(&cus, hipDeviceAttributeMultiprocessorCount, dev) != hipSuccess) { grid = -1; return; }
        if (hipFuncSetAttribute((const void*)fwd_kernel, hipFuncAttributeMaxDynamicSharedMemorySize, LDS_BYTES) != hipSuccess) { fprintf(stderr, "kernel_launch: hipFuncSetAttribute failed\n"); grid = -1; return; }
        if (hipOccupancyMaxActiveBlocksPerMultiprocessor(&per_cu, (const void*)fwd_kernel, NTHREADS, LDS_BYTES) != hipSuccess || per_cu < 1) { fprintf(stderr, "kernel_launch: occupancy query reports %d workgroups per CU\n", per_cu); }
        (void)hipGetLastError();
        grid = (cus < 256) ? cus : 256;
    }
    if (grid < 0) return;
    if (hipMemsetAsync((char*)d_ws + WS_CTL, 0, CTL_ZERO_BYTES, stream) != hipSuccess) return;
    Args a{};
    for (int i = 0; i < 16; ++i) a.in[i] = (const float*)d_in[i];
    a.out = (float*)d_out; a.ws = (unsigned char*)d_ws;
    hipLaunchKernelGGL(fwd_kernel, dim3(grid), dim3(NTHREADS), LDS_BYTES, stream, a);
}
```

```cpp
#include <hip/hip_runtime.h>
#include <cstdio>
#include <cstdint>
#ifndef ATTN_SIMPLE
#define ATTN_SIMPLE 0
#endif
#ifndef TOPK_SIMPLE
#define TOPK_SIMPLE 0
#endif
#ifndef PEER_BITS
#define PEER_BITS 4
#endif
#ifndef V_BSH
#define V_BSH 11
#endif
#ifndef V_SORTED
#define V_SORTED 1
#endif
#ifndef V_MFMA
#define V_MFMA 1
#endif
#ifndef P5_I8
#define P5_I8 1
#endif
#ifndef P2_I8
#define P2_I8 1
#endif
#ifndef U_MFMA
#define U_MFMA 1
#endif
#ifndef U_SORTED
#define U_SORTED 1
#endif
#ifndef DUP
#define DUP 0
#endif
namespace pg8 {
#define PG8_LAS __attribute__((address_space(3)))
typedef unsigned short bf16_t;
typedef short bf16x8 __attribute__((ext_vector_type(8)));
typedef float f32x4 __attribute__((ext_vector_type(4)));
typedef unsigned u32x4 __attribute__((ext_vector_type(4)));
constexpr int BM = 256, BK = 64, HALF = 128, HTB = HALF * BK * 2  , STAGE_BYTES = 8 * HTB, NXCD = 8, WGM = 8;

__host__ __device__ __forceinline__ int lds_byte(int r, int c) { const int st = (r >> 4) * 2 + (c >> 5), rr = r & 15, cc = c & 31, ob = rr * 64 + cc * 2; return st * 1024 + (ob ^ (((ob >> 9) & 1) << 5)); }
__host__ __device__ __forceinline__ void stage_rc(int b, int& R, int& C) { const int st = b / 1024, sb = b % 1024, swz = sb ^ (((sb >> 9) & 1) << 5); R = (st >> 1) * 16 + swz / 64; C = (st & 1) * 32 + (swz % 64) / 2; }
__host__ __device__ __forceinline__ int perm32(int rho) { const int n = rho >> 4, i = rho & 15; return 8 * (i >> 2) + 4 * n + (i & 3); }

struct Unit { int pm, pn; };
struct Gemm { const bf16_t* A; const bf16_t* Bt; int M, N, K, lda, ldb, apn, bhalf; };

struct StaticOrder {
    int nM, nN, nwg, G, c;
    __host__ __device__ __forceinline__ void init(int M, int N, int G_, int c_) { nM = M / BM; nN = N / BM; nwg = nM * nN; G = G_; c = c_; }
    __host__ __device__ __forceinline__ bool next(int i, Unit& u) const {
        const long L = (long)i * G + c; if (L >= nwg) return false;
        int wgid = (int)L; { const int q = nwg / NXCD, r = nwg % NXCD, xcd = wgid % NXCD, off = wgid / NXCD; wgid = (xcd < r ? xcd * (q + 1) : r * (q + 1) + (xcd - r) * q) + off; }
        const int nig = WGM * nN, gid = wgid / nig, fm = gid * WGM, gsz = (nM - fm) < WGM ? (nM - fm) : WGM;
        u.pm = fm + ((wgid % nig) % gsz); u.pn = (wgid % nig) / gsz; return true;
    }
    __device__ __forceinline__ void a_ready(const Unit&) const {}
    __device__ __forceinline__ void done(const Unit&) const {}
};
__device__ __forceinline__ unsigned cvt_pk_bf16(float lo, float hi) { typedef __bf16 bf2_ __attribute__((ext_vector_type(2))); bf2_ v; v[0] = (__bf16)lo; v[1] = (__bf16)hi; return __builtin_bit_cast(unsigned, v); }
template <int MODE> __device__ __forceinline__ f32x4 mma1(bf16x8 a, bf16x8 b, f32x4 c) {
    typedef int i32x4_ __attribute__((ext_vector_type(4)));
    if constexpr (MODE == 2) return __builtin_bit_cast(f32x4, __builtin_amdgcn_mfma_i32_16x16x64_i8(__builtin_bit_cast(i32x4_, a), __builtin_bit_cast(i32x4_, b), __builtin_bit_cast(i32x4_, c), 0, 0, 0));
    else return __builtin_amdgcn_mfma_f32_16x16x32_bf16(a, b, c, 0, 0, 0);
}
template <class Epi, class Sched, bool STAMP = false, int MODE = 0>
__device__ __forceinline__ void gemm_phase(PG8_LAS unsigned char* lds, const Gemm g, const Sched& S, const Epi& E, unsigned long long* stamps, int wid_in) {
    unsigned ones_ = ~0u; asm volatile("" : "+s"(ones_)); int lane_ = (int)__builtin_amdgcn_mbcnt_hi(ones_, __builtin_amdgcn_mbcnt_lo(ones_, 0u)); asm volatile("" : "+v"(lane_));
    const int wid = __builtin_amdgcn_readfirstlane(wid_in), lane = lane_, tid = wid * 64 + lane, wr = wid >> 2, wc = wid & 3, fr = lane & 15, fq = lane >> 4;
    int K_ = g.K; asm volatile("" : "+s"(K_));
    const int K = K_, nt = K / BK;
    int ts_lo = 0, ts_hi = 0, nts = 0; const unsigned long long rt_entry = STAMP ? (unsigned long long)wall_clock64() : 0ull;
#define PG8_STAMP() do { if (STAMP && wid == 0 && nts < 64) { const unsigned long long _c = (unsigned long long)clock64(); \
        ts_lo = (lane == nts) ? (int)(unsigned)_c : ts_lo; ts_hi = (lane == nts) ? (int)(unsigned)(_c >> 32) : ts_hi; ++nts; } } while (0)
    PG8_STAMP();
    unsigned voffA[2], voffB[2];
#pragma unroll
    for (int i = 0; i < 2; ++i) { int R, C; stage_rc(tid * 16 + i * 8192, R, C); const int Rb = Epi::PERM ? ((R & ~31) + perm32(R & 31)) : R;
        voffA[i] = (unsigned)(R * g.lda + C) * 2u; voffB[i] = (unsigned)(Rb * g.ldb + C) * 2u; }
    const size_t kstep = (size_t)(BK * 2);
    const size_t hstepA = (size_t)HALF * g.lda * 2, hstepB = (size_t)HALF * g.ldb * 2;
    const size_t tstepA = 2 * hstepA, tstepB = 2 * hstepB;
    const unsigned ldsw = (unsigned)wid * 1024u;
    const int aoff = lds_byte(wr * 64 + fr, fq * 8), boff = lds_byte(wc * 32 + fr, fq * 8);
#define PG8_SA(b, h) (((b) * 2 + (h)) * HTB)
#define PG8_SB(b, h) ((4 + (b) * 2 + (h)) * HTB)
#define PG8_STAGE(bufoff, gbase, voff) do { _Pragma("unroll") for (int _i = 0; _i < 2; ++_i) \
        __builtin_amdgcn_global_load_lds((const unsigned*)((const char*)(gbase) + (voff)[_i]), (PG8_LAS unsigned*)(lds + (bufoff) + ldsw + _i * 8192), 16, 0, 0); } while (0)
#define PG8_LDA(dst, b, h) do { _Pragma("unroll") for (int m = 0; m < 4; ++m) _Pragma("unroll") for (int k = 0; k < 2; ++k) dst[m][k] = *(const PG8_LAS bf16x8*)(lds + PG8_SA(b, h) + aoff + m * 2048 + k * 1024); } while (0)
#define PG8_LDB(dst, b, h) do { _Pragma("unroll") for (int n = 0; n < 2; ++n) _Pragma("unroll") for (int k = 0; k < 2; ++k) dst[n][k] = *(const PG8_LAS bf16x8*)(lds + PG8_SB(b, h) + boff + n * 2048 + k * 1024); } while (0)
#define PG8_MMA(ai, bj, At, Bt) do { __builtin_amdgcn_s_setprio(1); _Pragma("unroll") for (int m = 0; m < 4; ++m) _Pragma("unroll") for (int n = 0; n < 2; ++n) _Pragma("unroll") for (int k = 0; k < 2; ++k) \
        acc[ai][bj][m][n] = mma1<MODE>(Bt[n][k], At[m][k], acc[ai][bj][m][n]); __builtin_amdgcn_s_setprio(0); } while (0)
#define PG8_WAIT_V(n) asm volatile("s_waitcnt vmcnt(" #n ")" ::: "memory")
#define PG8_WAIT_L(n) asm volatile("s_waitcnt lgkmcnt(" #n ")" ::: "memory")
#define PG8_BAR __builtin_amdgcn_s_barrier()
#define PG8_SCHED __builtin_amdgcn_sched_barrier(0)
    Unit cur, nxt; int ui = 0;
    if (!S.next(0, cur)) return;
    f32x4 acc[2][2][4][2];
#pragma unroll
    for (int a = 0; a < 2; ++a)
#pragma unroll
        for (int b = 0; b < 2; ++b)
#pragma unroll
            for (int m = 0; m < 4; ++m)
#pragma unroll
                for (int n = 0; n < 2; ++n) acc[a][b][m][n] = (f32x4){0.f, 0.f, 0.f, 0.f};
    bf16x8 At[4][2], B0[2][2], B1[2][2];
    const char* cA = (const char*)g.A + (size_t)cur.pm * tstepA + (size_t)cur.pn * g.apn; const char* cB = (const char*)g.Bt + (size_t)cur.pn * tstepB + ((2 * cur.pm * BM >= g.M) ? (size_t)g.bhalf : (size_t)0);
    S.a_ready(cur);
    PG8_STAGE(PG8_SB(0, 0), cB, voffB); PG8_STAGE(PG8_SA(0, 0), cA, voffA); PG8_STAGE(PG8_SB(0, 1), cB + hstepB, voffB); PG8_STAGE(PG8_SA(0, 1), cA + hstepA, voffA);
    if (wr == 1) PG8_BAR;
    PG8_WAIT_V(4); PG8_BAR;
    PG8_STAGE(PG8_SB(1, 0), cB + kstep, voffB); PG8_STAGE(PG8_SA(1, 0), cA + kstep, voffA); PG8_STAGE(PG8_SB(1, 1), cB + hstepB + kstep, voffB);
    PG8_WAIT_V(6); PG8_BAR;
    PG8_STAMP();
    for (;;) {
        const bool has_next = S.next(ui + 1, nxt);
        const char* nA = has_next ? (const char*)g.A + (size_t)nxt.pm * tstepA + (size_t)nxt.pn * g.apn : cA; const char* nB = has_next ? (const char*)g.Bt + (size_t)nxt.pn * tstepB + ((2 * nxt.pm * BM >= g.M) ? (size_t)g.bhalf : (size_t)0) : cB;
        for (int t = 0; t < nt; t += 2) {
            const bool last = (t == nt - 2);
            const char* a1 = cA + (size_t)(t + 1) * kstep;
            const char* a2 = last ? nA : cA + (size_t)(t + 2) * kstep; const char* b2 = last ? nB : cB + (size_t)(t + 2) * kstep;
            const char* a3 = a2 + kstep; const char* b3 = b2 + kstep;
            if (last && has_next) S.a_ready(nxt);
            PG8_LDB(B0, 0, 0); PG8_SCHED; PG8_LDA(At, 0, 0); PG8_STAGE(PG8_SA(1, 1), a1 + hstepA, voffA);
            PG8_WAIT_L(8); PG8_BAR; PG8_WAIT_L(0); PG8_MMA(0, 0, At, B0); PG8_BAR; PG8_SCHED;
            PG8_LDB(B1, 0, 1); PG8_STAGE(PG8_SB(0, 0), b2, voffB);
            PG8_BAR; PG8_WAIT_L(0); PG8_MMA(0, 1, At, B1); PG8_BAR;
            PG8_LDA(At, 0, 1); PG8_STAGE(PG8_SA(0, 0), a2, voffA);
            PG8_BAR; PG8_WAIT_L(0); PG8_MMA(1, 0, At, B0); PG8_BAR; PG8_SCHED;
            PG8_STAGE(PG8_SB(0, 1), b2 + hstepB, voffB);
            PG8_WAIT_V(6); PG8_BAR; PG8_MMA(1, 1, At, B1); PG8_BAR;
            PG8_LDB(B0, 1, 0); PG8_SCHED; PG8_LDA(At, 1, 0); PG8_STAGE(PG8_SA(0, 1), a2 + hstepA, voffA);
            PG8_WAIT_L(8); PG8_BAR; PG8_WAIT_L(0); PG8_MMA(0, 0, At, B0); PG8_BAR; PG8_SCHED;
            PG8_LDB(B1, 1, 1); PG8_STAGE(PG8_SB(1, 0), b3, voffB);
            PG8_BAR; PG8_WAIT_L(0); PG8_MMA(0, 1, At, B1); PG8_BAR;
            PG8_LDA(At, 1, 1); PG8_STAGE(PG8_SA(1, 0), a3, voffA);
            PG8_BAR; PG8_WAIT_L(0); PG8_MMA(1, 0, At, B0); PG8_BAR; PG8_SCHED;
            PG8_STAGE(PG8_SB(1, 1), b3 + hstepB, voffB);
            PG8_WAIT_V(6); PG8_BAR; PG8_MMA(1, 1, At, B1); PG8_BAR;
        }
        PG8_STAMP();
        if constexpr (!Epi::AFTER_DRAIN) { E(acc, cur, wr, wc, fr, fq); S.done(cur); }
        PG8_STAMP();
        if (!has_next) break;
#pragma unroll
        for (int a = 0; a < 2; ++a)
#pragma unroll
            for (int b = 0; b < 2; ++b)
#pragma unroll
                for (int m = 0; m < 4; ++m)
#pragma unroll
                    for (int n = 0; n < 2; ++n) acc[a][b][m][n] = (f32x4){0.f, 0.f, 0.f, 0.f};
        cur = nxt; cA = nA; cB = nB; ++ui;
    }
    PG8_WAIT_V(0);
    if (wr == 0) PG8_BAR;
    PG8_BAR;
    if constexpr (Epi::AFTER_DRAIN) { E.fused(acc, cur, wr, wc, fr, fq, lds, wid, lane); S.done(cur); }
    PG8_STAMP();
    if (STAMP && wid == 0) { stamps[lane] = lane < nts ? (((unsigned long long)(unsigned)ts_hi << 32) | (unsigned)ts_lo) : 0ull;
        if (lane == 62) stamps[62] = rt_entry; if (lane == 63) stamps[63] = (unsigned long long)wall_clock64(); }
#undef PG8_STAMP
#undef PG8_SA
#undef PG8_SB
#undef PG8_STAGE
#undef PG8_LDA
#undef PG8_LDB
#undef PG8_MMA
#undef PG8_WAIT_V
#undef PG8_WAIT_L
#undef PG8_BAR
#undef PG8_SCHED
}
}


constexpr int NWAVES = 8, NTHREADS = 512;
constexpr int BATCH = 2, SEQ = 8192, T = BATCH * SEQ, D = 2048;
constexpr int AW = 1024, NH = 8, HD = 128, PW = 1024, INW = 4096;
constexpr int NMOD = 6 * D;
constexpr int PE_HEADS = 8, PE_NK = 128, PE_EXP = 16384, PE_K = 16;
constexpr float NORM_EPS = 1e-6f;
constexpr float QSCALE = 0.08838834764831845f * 1.4426950408889634f;

constexpr size_t MiB = 1u << 20;
constexpr size_t WS_CTL = 0, CTL_ZERO_BYTES = 64 * 1024;
constexpr size_t WS_MODP = 1 * MiB;
constexpr size_t WS_MODF = 1 * MiB + 832 * 1024;
constexpr size_t WS_SA = 1 * MiB + 928 * 1024, WS_SB = 1 * MiB + 992 * 1024;
constexpr size_t WS_CS = 2 * MiB;
constexpr size_t WS_WTIN = 4 * MiB;
constexpr size_t WS_WTOUT = 20 * MiB;
constexpr size_t WS_WTQ = 28 * MiB, WS_W8 = WS_WTQ;
constexpr size_t WS_WTPOOL = 36 * MiB;
constexpr size_t WS_SKP = 37 * MiB;
constexpr size_t WS_SU = 38 * MiB, WS_SV = 38 * MiB + 64 * 1024;
constexpr size_t WS_PU = 40 * MiB, WS_PV = 104 * MiB;
constexpr size_t WS_HB = 168 * MiB, WS_H8 = WS_HB;
constexpr size_t WS_Q = 232 * MiB, WS_K = 264 * MiB, WS_V = 296 * MiB, WS_U = 328 * MiB;
constexpr size_t WS_HC = 360 * MiB;
constexpr size_t WS_RB = 424 * MiB;
constexpr size_t WS_QP = WS_Q;
constexpr size_t WS_SC = WS_V;
constexpr size_t WS_IDX = WS_RB, WS_GATE = WS_RB + 8 * MiB;
constexpr size_t WS_TQ = WS_RB + 16 * MiB, WS_CSC = WS_RB + 24 * MiB;
constexpr size_t WS_OP0 = WS_HB, WS_OP1 = WS_HB + 32 * MiB, WS_OP2 = 456 * MiB;
constexpr size_t WS_X1B = WS_V;
constexpr size_t WS_LSE = 488 * MiB;
constexpr size_t WS_WQ2 = 490 * MiB;
constexpr size_t WS_BIASP = 506 * MiB;
constexpr size_t WS_RSQP = 507 * MiB;
constexpr size_t WS_WOUT8 = 509 * MiB;
constexpr size_t WS_HC8 = WS_Q;
constexpr size_t WS_SA5 = 489 * MiB + 512 * 1024, WS_SB5 = 1 * MiB + 1008 * 1024;
constexpr size_t WS_END = 513 * MiB;

constexpr int RING_BYTES = 131072, MISC_OFF = RING_BYTES, LDS_BYTES = 147456;

#define GAS __attribute__((address_space(1)))
typedef unsigned short bf16;
typedef unsigned v4u __attribute__((ext_vector_type(4)));
typedef unsigned v2u __attribute__((ext_vector_type(2)));
typedef float f32x4 __attribute__((ext_vector_type(4)));
typedef __bf16 bf2 __attribute__((ext_vector_type(2)));
#define LDS_WAIT() asm volatile("s_waitcnt lgkmcnt(0)" ::: "memory")
#define VM_WAIT() asm volatile("s_waitcnt vmcnt(0)" ::: "memory")
__device__ __forceinline__ unsigned pk2(float lo, float hi) { return pg8::cvt_pk_bf16(lo, hi); }
__device__ __forceinline__ float bflo(unsigned w) { return __uint_as_float(w << 16); }
__device__ __forceinline__ float bfhi(unsigned w) { return __uint_as_float(w & 0xffff0000u); }
__device__ __forceinline__ float dot2(unsigned a, unsigned b, float c) { return __builtin_amdgcn_fdot2_f32_bf16(__builtin_bit_cast(bf2, a), __builtin_bit_cast(bf2, b), c, false); }
__device__ __forceinline__ int my_lane() { unsigned ones = ~0u; asm volatile("" : "+s"(ones)); return (int)__builtin_amdgcn_mbcnt_hi(ones, __builtin_amdgcn_mbcnt_lo(ones, 0u)); }
__device__ __forceinline__ int sh_idx(int v, int idx) { return __builtin_amdgcn_ds_bpermute(idx << 2, v); }
__device__ __forceinline__ unsigned sh_idx(unsigned v, int idx) { return (unsigned)__builtin_amdgcn_ds_bpermute(idx << 2, (int)v); }
__device__ __forceinline__ float sh_idx(float v, int idx) { return __int_as_float(__builtin_amdgcn_ds_bpermute(idx << 2, __float_as_int(v))); }
#define SXOR(v, m, lane) sh_idx((v), (lane) ^ (m))
__device__ __forceinline__ float wave_sum(float v) {
    const int lane = my_lane();
#pragma unroll
    for (int o = 1; o < 64; o <<= 1) v += SXOR(v, o, lane);
    return v;
}
__device__ __forceinline__ int wave_sum_i(int v) {
    const int lane = my_lane();
#pragma unroll
    for (int o = 1; o < 64; o <<= 1) v += SXOR(v, o, lane);
    return v;
}
__device__ __forceinline__ float wave_max(float v) {
    const int lane = my_lane();
#pragma unroll
    for (int o = 1; o < 64; o <<= 1) v = fmaxf(v, SXOR(v, o, lane));
    return v;
}

#define XB_TMO      128
#define XB_XCNT(j)  (256  + 64 * (j))
#define XB_XSUB(j)  (1280 + 64 * (j))
#define XB_XGEN(j)  (2304 + 64 * (j))
#define XB_TOP      3328
#define XB_TOPGEN   3392
#define XCD_BAR_WORDS 3456
#define XB_SPIN_CAP (1u << 18)
#define LAS __attribute__((address_space(3)))

__device__ __forceinline__ unsigned xb_ld(unsigned* p)              { return __hip_atomic_load(p, __ATOMIC_RELAXED, __HIP_MEMORY_SCOPE_AGENT); }
__device__ __forceinline__ unsigned xb_add(unsigned* p, unsigned v) { return __hip_atomic_fetch_add(p, v, __ATOMIC_RELAXED, __HIP_MEMORY_SCOPE_AGENT); }
__device__ __forceinline__ unsigned xb_xcc_id() { return (unsigned)__builtin_amdgcn_s_getreg((3 << 11) | 20) & 0xFu; }
#define XB_SPIN(cond, bar) do { unsigned _sp = 0; while (cond) { __builtin_amdgcn_s_sleep(1); \
    if ((++_sp & 255u) == 0u) { if (xb_ld(&(bar)[XB_TMO])) break; if (_sp > XB_SPIN_CAP) { atomicAdd(&(bar)[XB_TMO], 1u); break; } } } } while (0)

struct XcdBarrier {
    unsigned* bar; unsigned x;
    volatile LAS unsigned* st;
};

__device__ __forceinline__ XcdBarrier xcd_barrier_post(unsigned* bar, volatile LAS unsigned* st, bool is_t0) {
    XcdBarrier b; b.bar = bar; b.x = xb_xcc_id(); b.st = st;
    if (is_t0) (void)xb_add(&bar[XB_XCNT(b.x)], 1u);
    return b;
}
__device__ __forceinline__ void xcd_barrier_complete(unsigned* bar, unsigned x, unsigned& nloc, unsigned& nx) {
    const unsigned G = gridDim.x * gridDim.y * gridDim.z;
    unsigned sum, cnt, mine, sp = 0u;
    for (;;) {
        sum = 0u; cnt = 0u; mine = 0u;
#pragma unroll
        for (unsigned j = 0; j < 16; ++j) { const unsigned c = xb_ld(&bar[XB_XCNT(j)]); sum += c; cnt += (c > 0u) ? 1u : 0u; mine = (j == x) ? c : mine; }
        if (sum == G) break;
        __builtin_amdgcn_s_sleep(1);
        if ((++sp & 255u) == 0u) { if (xb_ld(&bar[XB_TMO])) break; if (sp > XB_SPIN_CAP) { atomicAdd(&bar[XB_TMO], 1u); break; } }
    }
    nloc = mine > 0u ? mine : 1u; nx = cnt > 0u ? cnt : 1u;
}

__device__ __forceinline__ void xcd_barrier(const XcdBarrier& b, bool is_t0) {
    asm volatile("s_waitcnt vmcnt(0)" ::: "memory");
    __syncthreads();
    if (is_t0) {
        unsigned* bar = b.bar;
        __builtin_amdgcn_s_waitcnt(0);
        unsigned nloc = b.st[0], nx = b.st[1];
        if (nloc == 0u) { xcd_barrier_complete(bar, b.x, nloc, nx); b.st[0] = nloc; b.st[1] = nx; }
        const unsigned old = xb_add(&bar[XB_XSUB(b.x)], 1u);
        const unsigned gen = old / nloc;
        if (old + 1u == (gen + 1u) * nloc) {
            __builtin_amdgcn_fence(__ATOMIC_RELEASE, "agent");
            asm volatile("s_waitcnt vmcnt(0)" ::: "memory");
            const unsigned og = xb_add(&bar[XB_TOP], 1u);
            const unsigned tg = og / nx;
            if (og + 1u == (tg + 1u) * nx) xb_add(&bar[XB_TOPGEN], 1u);
            else XB_SPIN(xb_ld(&bar[XB_TOPGEN]) == tg, bar);
            __builtin_amdgcn_fence(__ATOMIC_ACQUIRE, "agent");
            xb_add(&bar[XB_XGEN(b.x)], 1u);
            asm volatile("s_waitcnt vmcnt(0)" ::: "memory");
        } else {
            XB_SPIN(xb_ld(&bar[XB_XGEN(b.x)]) == gen, bar);
            __builtin_amdgcn_fence(__ATOMIC_ACQUIRE, "agent");
            asm volatile("s_waitcnt vmcnt(0)" ::: "memory");
        }
    }
    __syncthreads();
}

struct Ctx { LAS unsigned char* lds; int tid, lane, wave, vcu, G, gw, ngw; };

struct Epi1 {
    static constexpr bool PERM = true, AFTER_DRAIN = false;
    bf16* QKVU; const float* CS; const float* SA; const float* SB;
    __device__ __forceinline__ void operator()(const pg8::f32x4 (&acc)[2][2][4][2], const pg8::Unit& u, int wr, int wc, int fr, int fq) const {
        const int row0 = u.pm * 256 + wr * 64 + fr; const int tt = u.pn >> 2; const int colt = (u.pn & 3) * 256;
        bf16* base = QKVU + (size_t)tt * ((size_t)T * 1024);
        const int col0 = colt + wc * 32 + 8 * fq;
        const bool rot = (tt < 2) && (wc == 0);
        const float sc = (tt == 0) ? QSCALE : 1.0f;
        const float sgn = (fq < 2) ? -1.0f : 1.0f;
        f32x4 sb[2][2];
        if (P2_I8) { const int gcol0 = u.pn * 256 + wc * 32 + 8 * fq;
#pragma unroll
            for (int bj = 0; bj < 2; ++bj) { sb[bj][0] = *(const f32x4*)(SB + gcol0 + bj * 128); sb[bj][1] = *(const f32x4*)(SB + gcol0 + bj * 128 + 4); } }
#pragma unroll
        for (int ai = 0; ai < 2; ++ai)
#pragma unroll
            for (int m = 0; m < 4; ++m) {
                const int row = row0 + ai * 128 + m * 16;
                bf16* rowp = base + (size_t)row * 1024 + col0;
                const float sr = P2_I8 ? SA[row] : 1.0f;
                f32x4 c0 = {1.f, 1.f, 1.f, 1.f}, c1 = c0, s0 = {0.f, 0.f, 0.f, 0.f}, s1 = s0;
                if (rot) { const float* cs = CS + (size_t)row * 32 + 8 * (fq & 1);
                    c0 = *(const f32x4*)(cs); c1 = *(const f32x4*)(cs + 4); s0 = *(const f32x4*)(cs + 16); s1 = *(const f32x4*)(cs + 20); }
#pragma unroll
                for (int bj = 0; bj < 2; ++bj) {
                    f32x4 v0 = acc[ai][bj][m][0], v1 = acc[ai][bj][m][1];
                    if (P2_I8) { typedef int i32x4_ __attribute__((ext_vector_type(4))); const i32x4_ i0 = __builtin_bit_cast(i32x4_, v0), i1 = __builtin_bit_cast(i32x4_, v1);
#pragma unroll
                        for (int e = 0; e < 4; ++e) { v0[e] = (float)i0[e] * (sr * sb[bj][0][e]); v1[e] = (float)i1[e] * (sr * sb[bj][1][e]); } }
                    if (rot) {
#pragma unroll
                        for (int e = 0; e < 4; ++e) {
                            const float p0 = SXOR(v0[e], 32, 16 * fq + fr), p1 = SXOR(v1[e], 32, 16 * fq + fr);
                            v0[e] = v0[e] * c0[e] + sgn * p0 * s0[e];
                            v1[e] = v1[e] * c1[e] + sgn * p1 * s1[e];
                        }
                    }
                    pg8::u32x4 w; w.x = pk2(v0[0] * sc, v0[1] * sc); w.y = pk2(v0[2] * sc, v0[3] * sc); w.z = pk2(v1[0] * sc, v1[1] * sc); w.w = pk2(v1[2] * sc, v1[3] * sc);
                    *(pg8::u32x4*)(rowp + bj * 128) = w;
                }
            }
    }
};
struct EpiPool {
    static constexpr bool PERM = true, AFTER_DRAIN = false;
    bf16* HC; const float* pscale;
    __device__ __forceinline__ void operator()(const pg8::f32x4 (&acc)[2][2][4][2], const pg8::Unit& u, int wr, int wc, int fr, int fq) const {
        const int row0 = u.pm * 256 + wr * 64 + fr, col0 = u.pn * 256 + wc * 32 + 8 * fq;
        f32x4 ps[2][2];
#pragma unroll
        for (int bj = 0; bj < 2; ++bj) { ps[bj][0] = *(const f32x4*)(pscale + col0 + bj * 128); ps[bj][1] = *(const f32x4*)(pscale + col0 + bj * 128 + 4); }
#pragma unroll
        for (int ai = 0; ai < 2; ++ai)
#pragma unroll
            for (int m = 0; m < 4; ++m) {
                bf16* rowp = HC + (size_t)(row0 + ai * 128 + m * 16) * 2048 + 1024 + col0;
#pragma unroll
                for (int bj = 0; bj < 2; ++bj) {
                    const f32x4 v0 = acc[ai][bj][m][0] * ps[bj][0], v1 = acc[ai][bj][m][1] * ps[bj][1];
                    pg8::u32x4 w; w.x = pk2(v0[0], v0[1]); w.y = pk2(v0[2], v0[3]); w.z = pk2(v1[0], v1[1]); w.w = pk2(v1[2], v1[3]);
                    *(pg8::u32x4*)(rowp + bj * 128) = w;
                }
            }
    }
};
struct EpiBf {
    static constexpr bool PERM = true, AFTER_DRAIN = false;
    bf16* O; int ldc;
    __device__ __forceinline__ void operator()(const pg8::f32x4 (&acc)[2][2][4][2], const pg8::Unit& u, int wr, int wc, int fr, int fq) const {
        const int row0 = u.pm * 256 + wr * 64 + fr, col0 = u.pn * 256 + wc * 32 + 8 * fq;
#pragma unroll
        for (int ai = 0; ai < 2; ++ai)
#pragma unroll
            for (int m = 0; m < 4; ++m) {
                bf16* rowp = O + (size_t)(row0 + ai * 128 + m * 16) * ldc + col0;
#pragma unroll
                for (int bj = 0; bj < 2; ++bj) {
                    const f32x4 v0 = acc[ai][bj][m][0], v1 = acc[ai][bj][m][1];
                    pg8::u32x4 w; w.x = pk2(v0[0], v0[1]); w.y = pk2(v0[2], v0[3]); w.z = pk2(v1[0], v1[1]); w.w = pk2(v1[2], v1[3]);
                    *(pg8::u32x4*)(rowp + bj * 128) = w;
                }
            }
    }
};
struct EpiQ {
    static constexpr bool PERM = true, AFTER_DRAIN = false;
    bf16* O; const LAS float* rstdT; const LAS float* biasT; int pm0, pn0;
    __device__ __forceinline__ void operator()(const pg8::f32x4 (&acc)[2][2][4][2], const pg8::Unit& u, int wr, int wc, int fr, int fq) const {
        const int slot = (u.pm == pm0 && u.pn == pn0) ? 0 : 1;
        const int row0 = u.pm * 256 + wr * 64 + fr, col0 = u.pn * 256 + wc * 32 + 8 * fq;
        f32x4 bv[2][2];
#pragma unroll
        for (int bj = 0; bj < 2; ++bj) { bv[bj][0] = *(const LAS f32x4*)(biasT + slot * 256 + bj * 128 + wc * 32 + 8 * fq); bv[bj][1] = *(const LAS f32x4*)(biasT + slot * 256 + bj * 128 + wc * 32 + 8 * fq + 4); }
#pragma unroll
        for (int ai = 0; ai < 2; ++ai)
#pragma unroll
            for (int m = 0; m < 4; ++m) {
                const float rs = rstdT[slot * 256 + ai * 128 + wr * 64 + m * 16 + fr];
                bf16* rowp = O + (size_t)(row0 + ai * 128 + m * 16) * D + col0;
#pragma unroll
                for (int bj = 0; bj < 2; ++bj) {
                    const f32x4 v0 = acc[ai][bj][m][0] * rs + bv[bj][0], v1 = acc[ai][bj][m][1] * rs + bv[bj][1];
                    pg8::u32x4 w; w.x = pk2(v0[0], v0[1]); w.y = pk2(v0[2], v0[3]); w.z = pk2(v1[0], v1[1]); w.w = pk2(v1[2], v1[3]);
                    *(pg8::u32x4*)(rowp + bj * 128) = w;
                }
            }
    }
};
struct EpiF {
    static constexpr bool PERM = false, AFTER_DRAIN = false;
    float* C; int ldc;
    __device__ __forceinline__ void operator()(const pg8::f32x4 (&acc)[2][2][4][2], const pg8::Unit& u, int wr, int wc, int fr, int fq) const {
        const int row0 = u.pm * 256 + wr * 64 + fr, col0 = u.pn * 256 + wc * 32 + 4 * fq;
#pragma unroll
        for (int ai = 0; ai < 2; ++ai)
#pragma unroll
            for (int m = 0; m < 4; ++m) { float* rowp = C + (size_t)(row0 + ai * 128 + m * 16) * ldc + col0;
#pragma unroll
                for (int bj = 0; bj < 2; ++bj)
#pragma unroll
                    for (int n = 0; n < 2; ++n) *(f32x4*)(rowp + bj * 128 + n * 16) = acc[ai][bj][m][n]; }
    }
};
struct EpiOut {
    static constexpr bool PERM = true, AFTER_DRAIN = false;
    const float* X; bf16* X1; const float* MODF; float* RSQP; const float* SA; const float* SB;
    __device__ __forceinline__ void operator()(const pg8::f32x4 (&acc)[2][2][4][2], const pg8::Unit& u, int wr, int wc, int fr, int fq) const {
        const int row0 = u.pm * 256 + wr * 64 + fr, col0 = u.pn * 256 + wc * 32 + 8 * fq;
        const float* gp = MODF + (size_t)(u.pm >= 32 ? 1 : 0) * NMOD + 2 * D + col0;
        f32x4 gv[2][2];
#pragma unroll
        for (int bj = 0; bj < 2; ++bj)
#pragma unroll
            for (int n = 0; n < 2; ++n) gv[bj][n] = *(const f32x4*)(gp + bj * 128 + 4 * n);
        f32x4 sb[2][2];
        if (P5_I8) {
#pragma unroll
            for (int bj = 0; bj < 2; ++bj) { sb[bj][0] = *(const f32x4*)(SB + col0 + bj * 128); sb[bj][1] = *(const f32x4*)(SB + col0 + bj * 128 + 4); } }
#pragma unroll
        for (int ai = 0; ai < 2; ++ai)
#pragma unroll
            for (int m = 0; m < 4; ++m) { const size_t off = (size_t)(row0 + ai * 128 + m * 16) * D + col0; float ssr = 0.f;
                const float sr = P5_I8 ? SA[row0 + ai * 128 + m * 16] : 1.0f;
#pragma unroll
                for (int bj = 0; bj < 2; ++bj) {
                    f32x4 a0 = acc[ai][bj][m][0], a1 = acc[ai][bj][m][1];
                    if (P5_I8) { typedef int i32x4_ __attribute__((ext_vector_type(4))); const i32x4_ i0 = __builtin_bit_cast(i32x4_, a0), i1 = __builtin_bit_cast(i32x4_, a1);
#pragma unroll
                        for (int e = 0; e < 4; ++e) { a0[e] = (float)i0[e] * (sr * sb[bj][0][e]); a1[e] = (float)i1[e] * (sr * sb[bj][1][e]); } }
                    const f32x4 v0 = __builtin_nontemporal_load((const f32x4*)(X + off + bj * 128)) + gv[bj][0] * a0, v1 = __builtin_nontemporal_load((const f32x4*)(X + off + bj * 128 + 4)) + gv[bj][1] * a1;
                    pg8::u32x4 w; w.x = pk2(v0[0], v0[1]); w.y = pk2(v0[2], v0[3]); w.z = pk2(v1[0], v1[1]); w.w = pk2(v1[2], v1[3]);
                    *(pg8::u32x4*)(X1 + off + bj * 128) = w;
                    ssr += (v0[0] * v0[0] + v0[1] * v0[1]) + (v0[2] * v0[2] + v0[3] * v0[3]) + (v1[0] * v1[0] + v1[1] * v1[1]) + (v1[2] * v1[2] + v1[3] * v1[3]); }
                ssr += SXOR(ssr, 16, 16 * fq + fr); ssr += SXOR(ssr, 32, 16 * fq + fr);
                if (fq == 0) RSQP[(size_t)(row0 + ai * 128 + m * 16) * 32 + u.pn * 4 + wc] = ssr; }
    }
};

__device__ __forceinline__ void p0_transpose_item(const float* W, int K, int N, bf16* WT, int row_off, LAS float* scr, int item, int lane) {
    const int nblk = N / 32, kb = item / nblk, nb = item % nblk, k0 = 64 * kb, n0 = 32 * nb;
#pragma unroll 8
    for (int i = 0; i < 32; ++i) { const int kk = 2 * i + (lane >> 5); scr[kk * 33 + (lane & 31)] = W[(size_t)(k0 + kk) * N + n0 + (lane & 31)]; }
    LDS_WAIT(); asm volatile("" ::: "memory");
    const int c = lane & 7;
#pragma unroll
    for (int j = 0; j < 4; ++j) { const int n = (lane >> 3) + 8 * j; const LAS float* s = scr + (8 * c) * 33 + n;
        v4u o; o.x = pk2(s[0 * 33], s[1 * 33]); o.y = pk2(s[2 * 33], s[3 * 33]); o.z = pk2(s[4 * 33], s[5 * 33]); o.w = pk2(s[6 * 33], s[7 * 33]);
        *(v4u*)(WT + (size_t)(row_off + n0 + n) * K + k0 + 8 * c) = o; }
    LDS_WAIT(); asm volatile("" ::: "memory");
}
__device__ __forceinline__ float silu_f(float x) { return x / (1.0f + __expf(-x)); }
constexpr int MOD_ITEMS = 48 * 8;
__device__ __forceinline__ void p0_mod_item(const float* cvec, const float* w_mod, float* MODP, int item, int lane) {
    const int cb = item % 48, kc = item / 48, col = 256 * cb + 4 * lane, k0 = 256 * kc;
    f32x4 a0 = {0.f, 0.f, 0.f, 0.f}, a1 = a0;
    const float* wp = w_mod + (size_t)k0 * NMOD + col;
#pragma unroll 32
    for (int k = 0; k < 256; ++k) {
        const f32x4 w = __builtin_nontemporal_load((const f32x4*)(wp + (size_t)k * NMOD));
        const float s0 = silu_f(cvec[k0 + k]), s1 = silu_f(cvec[D + k0 + k]);
        a0 += w * s0; a1 += w * s1;
    }
    *(f32x4*)(MODP + ((size_t)kc * 2 + 0) * NMOD + col) = a0;
    *(f32x4*)(MODP + ((size_t)kc * 2 + 1) * NMOD + col) = a1;
}
template <int OFFS>
__device__ __forceinline__ void p0_quant_row(const float* src, unsigned char* dst, float* scale_out, int lane) {
    f32x4 v[8]; float am = 0.f;
#pragma unroll
    for (int j = 0; j < 8; ++j) { v[j] = *(const f32x4*)(src + 256 * j + 4 * lane); am = fmaxf(fmaxf(am, fmaxf(fabsf(v[j][0]), fabsf(v[j][1]))), fmaxf(fabsf(v[j][2]), fabsf(v[j][3]))); }
    am = wave_max(am);
    const float inv = (am > 0.f) ? 127.0f / am : 0.f;
    if (lane == 0) *scale_out = am * (1.0f / 127.0f);
#pragma unroll
    for (int j = 0; j < 8; ++j) {
        unsigned w = 0u;
#pragma unroll
        for (int e = 0; e < 4; ++e) { int q = __float2int_rn(v[j][e] * inv); q = q > 127 ? 127 : (q < -127 ? -127 : q); w |= ((unsigned)(q + OFFS) & 0xffu) << (8 * e); }
        *(unsigned*)(dst + 256 * j + 4 * lane) = w;
    }
}
__device__ __forceinline__ void p0_quant_load4(const float* src, int lane, f32x4 (&v)[8]) {
#pragma unroll
    for (int j = 0; j < 8; ++j) v[j] = __builtin_nontemporal_load((const f32x4*)(src + 256 * j + 4 * lane));
}
template <unsigned XR>
__device__ __forceinline__ void p0_quant_finish4(const f32x4 (&v)[8], unsigned char* dst, float* scale_out, int lane) {
    float am = 0.f, sq = 0.f;
#pragma unroll
    for (int j = 0; j < 8; ++j)
#pragma unroll
        for (int e = 0; e < 4; ++e) { am = fmaxf(am, fabsf(v[j][e])); sq += v[j][e] * v[j][e]; }
    am = wave_max(am); sq = wave_sum(sq);
    const float step = fmaxf(0.335f * sqrtf(sq * (1.0f / D)), am * (1.0f / 24.0f));
    const float inv = (step > 0.f) ? 1.0f / step : 0.f;
    if (lane == 0) *scale_out = step;
    v4u o;
#pragma unroll
    for (int d = 0; d < 4; ++d) {
        unsigned w = 0u;
#pragma unroll
        for (int e = 0; e < 4; ++e) {
            int lo = (int)floorf(v[2 * d][e] * inv) + 8, hi = (int)floorf(v[2 * d + 1][e] * inv) + 8;
            lo = lo < 0 ? 0 : (lo > 15 ? 15 : lo); hi = hi < 0 ? 0 : (hi > 15 ? 15 : hi);
            w |= ((unsigned)lo | ((unsigned)hi << 4)) << (8 * e);
        }
        w ^= XR * 0x01010101u;
        if (d == 0) o.x = w; else if (d == 1) o.y = w; else if (d == 2) o.z = w; else o.w = w;
    }
    *(v4u*)(dst + 16 * lane) = o;
}
__device__ __forceinline__ unsigned fp4_code(float x) {
    const float a = fabsf(x);
    const unsigned m = (unsigned)(a > 0.25f) + (unsigned)(a > 0.75f) + (unsigned)(a > 1.25f) + (unsigned)(a > 1.75f) + (unsigned)(a > 2.5f) + (unsigned)(a > 3.5f) + (unsigned)(a > 5.0f);
    return m | (x < 0.f ? 8u : 0u);
}
__device__ __forceinline__ void p0_quant_finish_fp4(const f32x4 (&v)[8], unsigned char* dst, float* scale_out, int lane) {
    float am = 0.f, sq = 0.f;
#pragma unroll
    for (int j = 0; j < 8; ++j)
#pragma unroll
        for (int e = 0; e < 4; ++e) { am = fmaxf(am, fabsf(v[j][e])); sq += v[j][e] * v[j][e]; }
    am = wave_max(am); sq = wave_sum(sq);
    const float step = fmaxf(0.48f * sqrtf(sq * (1.0f / D)), am * (1.0f / 18.0f));
    const float inv = (step > 0.f) ? 1.0f / step : 0.f;
    if (lane == 0) *scale_out = step;
    v4u o;
#pragma unroll
    for (int d = 0; d < 4; ++d) {
        unsigned w = 0u;
#pragma unroll
        for (int e = 0; e < 4; ++e) w |= (fp4_code(v[2 * d][e] * inv) | (fp4_code(v[2 * d + 1][e] * inv) << 4)) << (8 * e);
        if (d == 0) o.x = w; else if (d == 1) o.y = w; else if (d == 2) o.z = w; else o.w = w;
    }
    *(v4u*)(dst + 16 * lane) = o;
}
__device__ __forceinline__ void phase0(const Ctx& c, const float* const* in, unsigned char* ws) {
    const float* cvec = in[1]; const float* w_mod = in[3]; const float* w_in = in[6]; const float* w_pool = in[7]; const float* w_out = in[9];
    const float* w_query = in[11]; const float* sub_keys = in[12]; const float* peer_u = in[13]; const float* peer_v = in[14];
    LAS float* scr = (LAS float*)(c.lds + c.wave * 16384);
    if (c.gw < MOD_ITEMS) p0_mod_item(cvec, w_mod, (float*)(ws + WS_MODP), c.gw, c.lane);
    constexpr int I_IN = 32 * 128, I_OUT = 32 * 64, I_POOL = 4 * 32;
    for (int it = c.gw; it < I_IN + I_OUT + I_POOL; it += c.ngw) {
        int r = it;
        if (r < I_IN) { p0_transpose_item(w_in, D, INW, (bf16*)(ws + WS_WTIN), 0, scr, r, c.lane); continue; } r -= I_IN;
        if (r < I_OUT) { p0_transpose_item(w_out, D, D, (bf16*)(ws + WS_WTOUT), 0, scr, r, c.lane); continue; } r -= I_OUT;
        { const int g = r >> 5; p0_transpose_item(w_pool + (size_t)g * 65536, 256, 256, (bf16*)(ws + WS_WTPOOL), g * 256, scr, r & 31, c.lane); }
    }
#if TOPK_SIMPLE
    for (int r = c.gw; r < 2048; r += c.ngw) {
        const int p = (r >> 7) & 1, k = 4 * c.lane; v2u o = {0u, 0u};
        if ((k >> 7) == p) { const f32x4 s = *(const f32x4*)(sub_keys + (size_t)r * 128 + (k & 127)); o.x = pk2(s[0], s[1]); o.y = pk2(s[2], s[3]); }
        *(v2u*)((bf16*)(ws + WS_SKP) + (size_t)r * 256 + k) = o;
    }
#else
    for (int r = c.gw; r < 2048; r += c.ngw) {
        const float a = sub_keys[(size_t)r * 128 + 2 * c.lane], b = sub_keys[(size_t)r * 128 + 2 * c.lane + 1];
        *(unsigned*)((bf16*)(ws + WS_SKP) + (size_t)r * 128 + 2 * c.lane) = pk2(a, b);
    }
#endif
    if (c.gw >= MOD_ITEMS) {
        const int stride = c.ngw - MOD_ITEMS;
        int r = c.gw - MOD_ITEMS;
        f32x4 va[8], vb[8];
#define P0_SRC(R) (((R) < PE_EXP) ? peer_u + (size_t)(R) * D : peer_v + (size_t)((R) - PE_EXP) * D)
#define P0_FIN(V, R) do { if ((R) < PE_EXP) { if (U_MFMA) p0_quant_finish_fp4(V, ws + WS_PU + (size_t)(R) * 1024, (float*)(ws + WS_SU) + (R), c.lane); else p0_quant_finish4<0x88u>(V, ws + WS_PU + (size_t)(R) * 1024, (float*)(ws + WS_SU) + (R), c.lane); } \
                          else { if (V_MFMA) p0_quant_finish_fp4(V, ws + WS_PV + (size_t)((R) - PE_EXP) * 1024, (float*)(ws + WS_SV) + ((R) - PE_EXP), c.lane); else p0_quant_finish4<0x80u>(V, ws + WS_PV + (size_t)((R) - PE_EXP) * 1024, (float*)(ws + WS_SV) + ((R) - PE_EXP), c.lane); } } while (0)
        if (r < 2 * PE_EXP) p0_quant_load4(P0_SRC(r), c.lane, va);
        while (r < 2 * PE_EXP) {
            const int r1 = r + stride, r2 = r + 2 * stride;
            if (r1 < 2 * PE_EXP) p0_quant_load4(P0_SRC(r1), c.lane, vb);
            P0_FIN(va, r);
            if (r1 >= 2 * PE_EXP) break;
            if (r2 < 2 * PE_EXP) p0_quant_load4(P0_SRC(r2), c.lane, va);
            P0_FIN(vb, r1);
            r = r2;
        }
#undef P0_SRC
#undef P0_FIN
    }
}

__device__ __forceinline__ void p1_fold_q_item(const float* W, bf16* WQ2, float* BIASP, const LAS float* A2s, const LAS float* B2s, LAS float* scr, int item, int lane) {
    const int kb = item >> 6, nb = item & 63, k0 = 64 * kb, n0 = 32 * nb;
#pragma unroll 8
    for (int i = 0; i < 32; ++i) { const int kk = 2 * i + (lane >> 5); scr[kk * 33 + (lane & 31)] = W[(size_t)(k0 + kk) * D + n0 + (lane & 31)]; }
    LDS_WAIT(); asm volatile("" ::: "memory");
    {
        const int bb = lane >> 5, n = lane & 31; float sacc = 0.f;
#pragma unroll 8
        for (int kk = 0; kk < 64; ++kk) sacc += B2s[bb * D + k0 + kk] * scr[kk * 33 + n];
        BIASP[((size_t)kb * 2 + bb) * D + n0 + n] = sacc;
    }
    const int c8 = lane & 7;
#pragma unroll
    for (int bb = 0; bb < 2; ++bb) {
        const f32x4 a0 = *(const LAS f32x4*)(A2s + bb * D + k0 + 8 * c8), a1 = *(const LAS f32x4*)(A2s + bb * D + k0 + 8 * c8 + 4);
#pragma unroll
        for (int j = 0; j < 4; ++j) { const int n = (lane >> 3) + 8 * j; const LAS float* t = scr + (8 * c8) * 33 + n;
            v4u o; o.x = pk2(t[0 * 33] * a0[0], t[1 * 33] * a0[1]); o.y = pk2(t[2 * 33] * a0[2], t[3 * 33] * a0[3]); o.z = pk2(t[4 * 33] * a1[0], t[5 * 33] * a1[1]); o.w = pk2(t[6 * 33] * a1[2], t[7 * 33] * a1[3]);
            *(v4u*)(WQ2 + ((size_t)bb * D + n0 + n) * D + k0 + 8 * c8) = o; }
    }
    LDS_WAIT(); asm volatile("" ::: "memory");
}
template <bool FIRST>
__device__ __forceinline__ void phase_rows(const Ctx& c, const float* X, const bf16* XB, const float* gvec, const float* b_mod, const int* positions, unsigned char* ws, int shift_chunk, int scale_chunk, const float* gvec2 = nullptr, const float* w_query = nullptr) {
    LAS float* A1 = (LAS float*)c.lds; LAS float* B1 = A1 + D;
    const int b = c.vcu >> 7;
    const float* MODP = (const float*)(ws + WS_MODP); float* MODF = (float*)(ws + WS_MODF);
    {
        const int j = 4 * c.tid;
        f32x4 sh, sc;
        if (FIRST) {
            sh = *(const f32x4*)(b_mod + shift_chunk * D + j); sc = *(const f32x4*)(b_mod + scale_chunk * D + j);
#pragma unroll
            for (int s = 0; s < 8; ++s) { sh += *(const f32x4*)(MODP + ((size_t)s * 2 + b) * NMOD + shift_chunk * D + j); sc += *(const f32x4*)(MODP + ((size_t)s * 2 + b) * NMOD + scale_chunk * D + j); }
        } else { sh = *(const f32x4*)(MODF + (size_t)b * NMOD + shift_chunk * D + j); sc = *(const f32x4*)(MODF + (size_t)b * NMOD + scale_chunk * D + j); }
        const f32x4 g = *(const f32x4*)(gvec + j);
        *(LAS f32x4*)(A1 + j) = g * (sc + 1.0f); *(LAS f32x4*)(B1 + j) = sh;
    }
    LAS float* A2s = (LAS float*)(c.lds + 16384); LAS float* B2s = A2s + 2 * D;
    if (FIRST) {
        const int j = 4 * c.tid; const f32x4 g2v = *(const f32x4*)(gvec2 + j);
#pragma unroll
        for (int bb = 0; bb < 2; ++bb) {
            f32x4 sh = *(const f32x4*)(b_mod + 3 * D + j), sc = *(const f32x4*)(b_mod + 4 * D + j);
#pragma unroll
            for (int sx = 0; sx < 8; ++sx) { sh += *(const f32x4*)(MODP + ((size_t)sx * 2 + bb) * NMOD + 3 * D + j); sc += *(const f32x4*)(MODP + ((size_t)sx * 2 + bb) * NMOD + 4 * D + j); }
            *(LAS f32x4*)(A2s + bb * D + j) = g2v * (sc + 1.0f); *(LAS f32x4*)(B2s + bb * D + j) = sh;
        }
    }
    if (FIRST && c.vcu < 48 && c.tid < 256) {
        const int col = 256 * c.vcu + c.tid;
#pragma unroll
        for (int bb = 0; bb < 2; ++bb) { float v = b_mod[col];
#pragma unroll
            for (int s = 0; s < 8; ++s) v += MODP[((size_t)s * 2 + bb) * NMOD + col];
            MODF[(size_t)bb * NMOD + col] = v; }
    }
    __syncthreads();
    if (FIRST) {
        LAS float* scr = (LAS float*)(c.lds + 49152 + c.wave * 8448);
        p1_fold_q_item(w_query, (bf16*)(ws + WS_WQ2), (float*)(ws + WS_BIASP), A2s, B2s, scr, c.gw, c.lane);
    }
    bf16* HB = (bf16*)(ws + WS_HB);
    for (int i = 0; i < 8; ++i) {
        const int t = 64 * c.vcu + 8 * c.wave + i;
        f32x4 v[8]; float ss = 0.f;
#pragma unroll
        for (int q = 0; q < 8; ++q) {
            if (FIRST) v[q] = __builtin_nontemporal_load((const f32x4*)(X + (size_t)t * D + 4 * c.lane + 256 * q));
            else { const v2u w = *(const v2u*)(XB + (size_t)t * D + 4 * c.lane + 256 * q); v[q] = (f32x4){bflo(w.x), bfhi(w.x), bflo(w.y), bfhi(w.y)}; }
            ss += (v[q][0] * v[q][0] + v[q][1] * v[q][1]) + (v[q][2] * v[q][2] + v[q][3] * v[q][3]); }
        const float rstd = 1.0f / sqrtf(wave_sum(ss) * (1.0f / D) + NORM_EPS);
        bf16* hr = HB + (size_t)t * D + 4 * c.lane;
        if (FIRST && P2_I8) {
            float am = 0.f;
#pragma unroll
            for (int q = 0; q < 8; ++q) {
                const f32x4 a = *(const LAS f32x4*)(A1 + 256 * q + 4 * c.lane), bb = *(const LAS f32x4*)(B1 + 256 * q + 4 * c.lane);
                v[q] = v[q] * rstd * a + bb;
                am = fmaxf(fmaxf(am, fmaxf(fabsf(v[q][0]), fabsf(v[q][1]))), fmaxf(fabsf(v[q][2]), fabsf(v[q][3]))); }
            am = wave_max(am);
            const float inv = (am > 0.f) ? 127.0f / am : 0.f;
            unsigned w8[8];
#pragma unroll
            for (int q = 0; q < 8; ++q) { unsigned w = 0u;
                w = __builtin_amdgcn_cvt_pk_u8_f32(__builtin_rintf(fmaf(v[q][0], inv, 128.0f)), 0, w); w = __builtin_amdgcn_cvt_pk_u8_f32(__builtin_rintf(fmaf(v[q][1], inv, 128.0f)), 1, w);
                w = __builtin_amdgcn_cvt_pk_u8_f32(__builtin_rintf(fmaf(v[q][2], inv, 128.0f)), 2, w); w = __builtin_amdgcn_cvt_pk_u8_f32(__builtin_rintf(fmaf(v[q][3], inv, 128.0f)), 3, w);
                w8[q] = w ^ 0x80808080u; }
            unsigned char* h8 = ws + WS_H8 + (size_t)t * D + 32 * c.lane;
            *(v4u*)h8 = (v4u){w8[0], w8[1], w8[2], w8[3]}; *(v4u*)(h8 + 16) = (v4u){w8[4], w8[5], w8[6], w8[7]};
            if (c.lane == 0) ((float*)(ws + WS_SA))[t] = am * (1.0f / 127.0f);
        } else {
#pragma unroll
        for (int q = 0; q < 8; ++q) {
            const f32x4 a = *(const LAS f32x4*)(A1 + 256 * q + 4 * c.lane), bb = *(const LAS f32x4*)(B1 + 256 * q + 4 * c.lane);
            const f32x4 y = v[q] * rstd * a + bb;
            v2u o; o.x = pk2(y[0], y[1]); o.y = pk2(y[2], y[3]);
            *(v2u*)(hr + 256 * q) = o;
        }
        }
        if (FIRST && c.lane < 32) {
            const int fi = c.lane & 15;
            const float inv = (float)pow(500000.0, -(double)fi / 16.0);
            const float ang = (float)positions[t] * inv;
            ((float*)(ws + WS_CS))[(size_t)t * 32 + c.lane] = (c.lane < 16) ? cosf(ang) : sinf(ang);
        }
    }
    if (FIRST && P2_I8) {
#pragma unroll 1
        for (int n = c.gw; n < INW; n += c.ngw) {
            const bf16* wr = (const bf16*)(ws + WS_WTIN) + (size_t)n * D + 4 * c.lane;
            v2u w[8]; float f[32]; float am = 0.f;
#pragma unroll
            for (int q = 0; q < 8; ++q) w[q] = *(const v2u*)(wr + 256 * q);
#pragma unroll
            for (int q = 0; q < 8; ++q) { f[4 * q] = bflo(w[q].x); f[4 * q + 1] = bfhi(w[q].x); f[4 * q + 2] = bflo(w[q].y); f[4 * q + 3] = bfhi(w[q].y); }
#pragma unroll
            for (int k = 0; k < 32; ++k) am = fmaxf(am, fabsf(f[k]));
            am = wave_max(am);
            const float inv = (am > 0.f) ? 127.0f / am : 0.f;
            unsigned w8[8];
#pragma unroll
            for (int q = 0; q < 8; ++q) { unsigned ww = 0u;
                ww = __builtin_amdgcn_cvt_pk_u8_f32(__builtin_rintf(fmaf(f[4 * q], inv, 128.0f)), 0, ww); ww = __builtin_amdgcn_cvt_pk_u8_f32(__builtin_rintf(fmaf(f[4 * q + 1], inv, 128.0f)), 1, ww);
                ww = __builtin_amdgcn_cvt_pk_u8_f32(__builtin_rintf(fmaf(f[4 * q + 2], inv, 128.0f)), 2, ww); ww = __builtin_amdgcn_cvt_pk_u8_f32(__builtin_rintf(fmaf(f[4 * q + 3], inv, 128.0f)), 3, ww);
                w8[q] = ww ^ 0x80808080u; }
            unsigned char* o8 = ws + WS_W8 + (size_t)n * D + 32 * c.lane;
            *(v4u*)o8 = (v4u){w8[0], w8[1], w8[2], w8[3]}; *(v4u*)(o8 + 16) = (v4u){w8[4], w8[5], w8[6], w8[7]};
            if (c.lane == 0) ((float*)(ws + WS_SB))[n] = am * (1.0f / 127.0f);
        }
    }
    if (FIRST && P5_I8) {
#pragma unroll 1
        for (int n = c.gw; n < D; n += c.ngw) {
            const bf16* wr = (const bf16*)(ws + WS_WTOUT) + (size_t)n * D + 16 * c.lane;
            const v4u wa0 = *(const v4u*)wr, wa1 = *(const v4u*)(wr + 8), wp0 = *(const v4u*)(wr + 1024), wp1 = *(const v4u*)(wr + 1032);
            const unsigned ww[16] = {wa0.x, wa0.y, wa0.z, wa0.w, wa1.x, wa1.y, wa1.z, wa1.w, wp0.x, wp0.y, wp0.z, wp0.w, wp1.x, wp1.y, wp1.z, wp1.w};
            float f[32]; float am = 0.f;
#pragma unroll
            for (int k = 0; k < 16; ++k) { f[2 * k] = bflo(ww[k]); f[2 * k + 1] = bfhi(ww[k]); }
#pragma unroll
            for (int k = 0; k < 32; ++k) am = fmaxf(am, fabsf(f[k]));
            am = wave_max(am);
            const float inv = (am > 0.f) ? 127.0f / am : 0.f;
            unsigned w8[8];
#pragma unroll
            for (int q = 0; q < 8; ++q) { unsigned x8 = 0u;
                x8 = __builtin_amdgcn_cvt_pk_u8_f32(__builtin_rintf(fmaf(f[4 * q], inv, 128.0f)), 0, x8); x8 = __builtin_amdgcn_cvt_pk_u8_f32(__builtin_rintf(fmaf(f[4 * q + 1], inv, 128.0f)), 1, x8);
                x8 = __builtin_amdgcn_cvt_pk_u8_f32(__builtin_rintf(fmaf(f[4 * q + 2], inv, 128.0f)), 2, x8); x8 = __builtin_amdgcn_cvt_pk_u8_f32(__builtin_rintf(fmaf(f[4 * q + 3], inv, 128.0f)), 3, x8);
                w8[q] = x8 ^ 0x80808080u; }
            unsigned char* o8 = ws + WS_WOUT8 + (size_t)n * D + 32 * c.lane;
            *(v4u*)o8 = (v4u){w8[0], w8[1], w8[2], w8[3]}; *(v4u*)(o8 + 16) = (v4u){w8[4], w8[5], w8[6], w8[7]};
            if (c.lane == 0) ((float*)(ws + WS_SB5))[n] = am * (1.0f / 127.0f);
        }
    }
    __syncthreads();
}

template <int P>
__device__ __forceinline__ void poolr_item(const bf16* U, bf16* RB, int t, int c0) {
    const int tb = t & (SEQ - 1);
    float s[8] = {0.f, 0.f, 0.f, 0.f, 0.f, 0.f, 0.f, 0.f}, u0[8];
    v4u w[P];
#pragma unroll
    for (int j = 0; j < P; ++j) w[j] = *(const v4u*)(U + (size_t)(t - (j <= tb ? j : tb)) * 1024 + c0);
#pragma unroll
    for (int j = 0; j < P; ++j) {
        const float m = (j <= tb) ? 1.0f : 0.0f;
        const float f[8] = {bflo(w[j].x), bfhi(w[j].x), bflo(w[j].y), bfhi(w[j].y), bflo(w[j].z), bfhi(w[j].z), bflo(w[j].w), bfhi(w[j].w)};
#pragma unroll
        for (int e = 0; e < 8; ++e) { s[e] += m * f[e]; if (j == 0) u0[e] = f[e]; }
    }
    const int cnt = (tb + 1 < P) ? tb + 1 : P;
    const float ic = 1.0f / (float)cnt;
    v4u o; o.x = pk2(s[0] * ic - u0[0], s[1] * ic - u0[1]); o.y = pk2(s[2] * ic - u0[2], s[3] * ic - u0[3]);
    o.z = pk2(s[4] * ic - u0[4], s[5] * ic - u0[5]); o.w = pk2(s[6] * ic - u0[6], s[7] * ic - u0[7]);
    *(v4u*)(RB + (size_t)t * 1024 + c0) = o;
}
__device__ __forceinline__ void phase_poolr(const Ctx& c, unsigned char* ws, int it0, int itstep, int nit) {
    const bf16* U = (const bf16*)(ws + WS_U); bf16* RB = (bf16*)(ws + WS_RB);
    LAS unsigned char* tile = c.lds;
    const int ch = c.tid & 31, rg = c.tid >> 5;
    for (int itk = 0; itk < nit; ++itk) {
        const int it = it0 + itk * itstep;
        const int g = it & 3, t0 = 64 * (it >> 2), P = 2 << g, tb0 = t0 & (SEQ - 1), nrows = 63 + P;
        __syncthreads();
        for (int id = c.tid; id < nrows * 32; id += NTHREADS) {
            const int lr = id >> 5, cc = id & 31, dt = lr - (P - 1);
            v4u w = {0u, 0u, 0u, 0u};
            if (tb0 + dt >= 0) w = *(const v4u*)(U + (size_t)(t0 + dt) * 1024 + 256 * g + 8 * cc);
            *(LAS v4u*)(tile + lr * 512 + cc * 16) = w;
        }
        __syncthreads();
        float sacc[8];
#pragma unroll
        for (int e = 0; e < 8; ++e) sacc[e] = 0.f;
        const int r0 = 4 * rg;
        for (int j = 0; j < P; ++j) {
            const v4u w = *(const LAS v4u*)(tile + (r0 + P - 1 - j) * 512 + ch * 16);
            sacc[0] += bflo(w.x); sacc[1] += bfhi(w.x); sacc[2] += bflo(w.y); sacc[3] += bfhi(w.y); sacc[4] += bflo(w.z); sacc[5] += bfhi(w.z); sacc[6] += bflo(w.w); sacc[7] += bfhi(w.w);
        }
#pragma unroll
        for (int i = 0; i < 4; ++i) {
            const int r = r0 + i, tb = tb0 + r;
            const v4u wu = *(const LAS v4u*)(tile + (r + P - 1) * 512 + ch * 16);
            const float u0[8] = {bflo(wu.x), bfhi(wu.x), bflo(wu.y), bfhi(wu.y), bflo(wu.z), bfhi(wu.z), bflo(wu.w), bfhi(wu.w)};
            if (i > 0) {
                const v4u wo = *(const LAS v4u*)(tile + (r - 1) * 512 + ch * 16);
                const float uo[8] = {bflo(wo.x), bfhi(wo.x), bflo(wo.y), bfhi(wo.y), bflo(wo.z), bfhi(wo.z), bflo(wo.w), bfhi(wo.w)};
#pragma unroll
                for (int e = 0; e < 8; ++e) sacc[e] += u0[e] - uo[e];
            }
            const int cnt = (tb + 1 < P) ? tb + 1 : P;
            const float ic = 1.0f / (float)cnt;
            v4u o; o.x = pk2(sacc[0] * ic - u0[0], sacc[1] * ic - u0[1]); o.y = pk2(sacc[2] * ic - u0[2], sacc[3] * ic - u0[3]);
            o.z = pk2(sacc[4] * ic - u0[4], sacc[5] * ic - u0[5]); o.w = pk2(sacc[6] * ic - u0[6], sacc[7] * ic - u0[7]);
            *(v4u*)(RB + (size_t)(t0 + r) * 1024 + 256 * g + 8 * ch) = o;
        }
    }
    asm volatile("s_waitcnt vmcnt(0)" ::: "memory");
    __syncthreads();
}

__device__ __forceinline__ void phase_attn_simple(const Ctx& c, unsigned char* ws) {
    const bf16* QB = (const bf16*)(ws + WS_Q); const bf16* KB = (const bf16*)(ws + WS_K); const bf16* VB = (const bf16*)(ws + WS_V); bf16* HC = (bf16*)(ws + WS_HC);
    LAS float* pb = (LAS float*)(c.lds + c.wave * 2048);
    const float NEG = -3.0e38f;
    for (int item = c.gw; item < T * NH; item += c.ngw) {
        const int t = item >> 3, h = item & 7, tb = t & (SEQ - 1);
        const v4u* qp = (const v4u*)(QB + (size_t)t * 1024 + h * 128);
        v4u q[16];
#pragma unroll
        for (int i = 0; i < 16; ++i) q[i] = qp[i];
        float sv[7]; float mx = NEG;
#pragma unroll
        for (int r = 0; r < 7; ++r) {
            const int e = c.lane + 64 * r, pat = e / 129, j = e - pat * 129, off = j << (2 * pat);
            const bool valid = (e < 387) && (off <= tb);
            float s = NEG;
            if (valid) {
                const v4u* kp = (const v4u*)(KB + (size_t)(t - off) * 1024 + h * 128);
                float a0 = 0.f, a1 = 0.f;
#pragma unroll
                for (int i = 0; i < 16; ++i) { const v4u kk = kp[i]; a0 = dot2(q[i].x, kk.x, a0); a1 = dot2(q[i].y, kk.y, a1); a0 = dot2(q[i].z, kk.z, a0); a1 = dot2(q[i].w, kk.w, a1); }
                s = a0 + a1;
            }
            sv[r] = s; mx = fmaxf(mx, s);
        }
        mx = wave_max(mx);
        float l = 0.f;
#pragma unroll
        for (int r = 0; r < 7; ++r) { const float p = (sv[r] > -1.0e38f) ? exp2f(sv[r] - mx) : 0.f; l += p; pb[c.lane + 64 * r] = p; }
        l = wave_sum(l);
        LDS_WAIT();
        float o0 = 0.f, o1 = 0.f;
        for (int e = 0; e < 387; ++e) {
            const int pat = e / 129, j = e - pat * 129, off = j << (2 * pat);
            if (off > tb) continue;
            const float pe = pb[e];
            const unsigned w = *(const unsigned*)(VB + (size_t)(t - off) * 1024 + h * 128 + 2 * c.lane);
            o0 += pe * bflo(w); o1 += pe * bfhi(w);
        }
        const float il = 1.0f / l;
        *(unsigned*)(HC + (size_t)t * 2048 + h * 128 + 2 * c.lane) = pk2(o0 * il, o1 * il);
        LDS_WAIT();
    }
}

__device__ __forceinline__ unsigned off_k(unsigned row, unsigned ch) { return 256u * row + 16u * (ch ^ ((row & 3u) | (((row >> 3) & 3u) << 2))); }
__device__ __forceinline__ unsigned off_b(unsigned row, unsigned ch) { return 256u * row + 16u * (ch ^ (((row & 3u) << 2) | ((row >> 2) & 3u))); }
typedef short s4v __attribute__((ext_vector_type(4)));
__device__ __forceinline__ void phase_attn_mfma(const Ctx& c, unsigned char* ws) {
    const bf16* QB = (const bf16*)(ws + WS_Q); const bf16* KB = (const bf16*)(ws + WS_K); const bf16* VB = (const bf16*)(ws + WS_V);
    float* LSE = (float*)(ws + WS_LSE);
    const int g = c.lane >> 4, lq = c.lane & 15;
    const float NEG = -3.0e38f;
    const int i0 = 16 * c.wave, jb = 32 * (c.wave >> 1), iq = i0 + lq;
    unsigned kaddr[2][4], vbase[2], vxor[2];
    {
        const unsigned rowa = (unsigned)(jb + 8 * (lq >> 2) + (lq & 3));
        const unsigned q4 = (unsigned)(lq >> 2), p4 = (unsigned)(c.lane & 3);
#pragma unroll
        for (int s4 = 0; s4 < 4; ++s4) { kaddr[0][s4] = off_k(rowa, (unsigned)(4 * s4 + g)); kaddr[1][s4] = off_k(rowa + 4u, (unsigned)(4 * s4 + g)); }
#pragma unroll
        for (int t = 0; t < 2; ++t) {
            const unsigned row = (unsigned)(jb + 8 * g + 4 * t) + q4, f = ((row & 3u) << 2) | ((row >> 2) & 3u);
            vxor[t] = 16u * (f & 14u);
            vbase[t] = 65536u + 256u * row + 16u * ((p4 >> 1) ^ (f & 1u)) + 8u * (p4 & 1u);
        }
    }
    v4u kreg[8], vreg[8]; pg8::bf16x8 qnext[4];
#define ATTN_DECODE(U) const int p_ = (U) >> 10, rem_ = (U) & 1023, bh_ = rem_ >> 6, rn_ = rem_ & 63, b_ = bh_ >> 3, h_ = bh_ & 7; \
        const int dsh_ = 2 * p_, nbl_ = 64 >> dsh_, r_ = rn_ / nbl_, n_ = rn_ - r_ * nbl_; \
        const int tok0q_ = b_ * SEQ + r_ + ((n_ * 128) << dsh_), tok0k_ = tok0q_ - (128 << dsh_);
#define ATTN_ISSUE(U) do { ATTN_DECODE(U) \
        const unsigned rstr_ = 2048u << dsh_;                         \
        const unsigned off0_ = (unsigned)(tok0k_ + ((c.tid >> 4) << dsh_)) * 2048u + (unsigned)(h_ * 256 + (c.tid & 15) * 16); \
        _Pragma("unroll") for (int i_ = 0; i_ < 8; ++i_) {           \
            v4u kv_ = {0u, 0u, 0u, 0u}, vv_ = kv_; \
            if (i_ >= 4 || n_ > 0) { const unsigned o_ = off0_ + (unsigned)(32 * i_) * rstr_; kv_ = *(const v4u*)((const unsigned char*)KB + o_); vv_ = *(const v4u*)((const unsigned char*)VB + o_); } \
            kreg[i_] = kv_; vreg[i_] = vv_; } \
        const int tokq_ = tok0q_ + (iq << dsh_); \
        _Pragma("unroll") for (int s_ = 0; s_ < 4; ++s_) qnext[s_] = *(const pg8::bf16x8*)(QB + (size_t)tokq_ * 1024 + h_ * 128 + 32 * s_ + 8 * g); } while (0)
    ATTN_ISSUE(c.vcu);
    for (int unit = c.vcu; unit < 3072; unit += c.G) {
        ATTN_DECODE(unit)
        const int p = p_, h = h_, n = n_, dsh = dsh_, tok0q = tok0q_;
        bf16* OP = (bf16*)(ws + (p == 0 ? WS_OP0 : (p == 1 ? WS_OP1 : WS_OP2)));
        __syncthreads();
#pragma unroll
        for (int i = 0; i < 8; ++i) {
            const int id = c.tid + 512 * i, row = id >> 4, ch = id & 15;
            *(LAS v4u*)(c.lds + off_k((unsigned)row, (unsigned)ch)) = kreg[i]; *(LAS v4u*)(c.lds + 65536u + off_b((unsigned)row, (unsigned)ch)) = vreg[i];
        }
        const int tokq = tok0q + (iq << dsh);
        pg8::bf16x8 qf[4];
#pragma unroll
        for (int s4 = 0; s4 < 4; ++s4) qf[s4] = qnext[s4];
        __syncthreads();
        if (unit + c.G < 3072) ATTN_ISSUE(unit + c.G);
        f32x4 sa[5], sb[5];
#pragma unroll
        for (int kt = 0; kt < 5; ++kt) {
            f32x4 aa = {0.f, 0.f, 0.f, 0.f}, ab = aa;
#pragma unroll
            for (int s4 = 0; s4 < 4; ++s4) {
                const pg8::bf16x8 ka = *(const LAS pg8::bf16x8*)(c.lds + kaddr[0][s4] + 8192u * kt);
                const pg8::bf16x8 kb = *(const LAS pg8::bf16x8*)(c.lds + kaddr[1][s4] + 8192u * kt);
                aa = __builtin_amdgcn_mfma_f32_16x16x32_bf16(ka, qf[s4], aa, 0, 0, 0);
                ab = __builtin_amdgcn_mfma_f32_16x16x32_bf16(kb, qf[s4], ab, 0, 0, 0);
            }
            sa[kt] = aa; sb[kt] = ab;
        }
        const int jlo = (n > 0) ? iq : (iq > 128 ? iq : 128);
#pragma unroll
        for (int i = 0; i < 4; ++i) {
            const int ja = jb + 8 * g + i;
            sa[0][i] = (ja >= jlo) ? sa[0][i] : NEG; sb[0][i] = (ja + 4 >= jlo) ? sb[0][i] : NEG;
            sa[4][i] = (ja + 128 <= iq + 128) ? sa[4][i] : NEG; sb[4][i] = (ja + 132 <= iq + 128) ? sb[4][i] : NEG;
        }
        if (n == 0) {
#pragma unroll
            for (int kt = 1; kt < 5; ++kt)
#pragma unroll
                for (int i = 0; i < 4; ++i) { const int ja = jb + 32 * kt + 8 * g + i; sa[kt][i] = (ja >= jlo) ? sa[kt][i] : NEG; sb[kt][i] = (ja + 4 >= jlo) ? sb[kt][i] : NEG; }
        }
        float mx = NEG;
#pragma unroll
        for (int kt = 0; kt < 5; ++kt)
#pragma unroll
            for (int i = 0; i < 4; ++i) mx = fmaxf(mx, fmaxf(sa[kt][i], sb[kt][i]));
        mx = fmaxf(mx, SXOR(mx, 16, c.lane)); mx = fmaxf(mx, SXOR(mx, 32, c.lane));
        float l = 0.f;
#pragma unroll
        for (int kt = 0; kt < 5; ++kt)
#pragma unroll
            for (int i = 0; i < 4; ++i) { sa[kt][i] = __builtin_amdgcn_exp2f(sa[kt][i] - mx); sb[kt][i] = __builtin_amdgcn_exp2f(sb[kt][i] - mx); l += sa[kt][i] + sb[kt][i]; }
        l += SXOR(l, 16, c.lane); l += SXOR(l, 32, c.lane);
        f32x4 o[8];
#pragma unroll
        for (int c8 = 0; c8 < 8; ++c8) o[c8] = (f32x4){0.f, 0.f, 0.f, 0.f};
#pragma unroll
        for (int kt = 0; kt < 5; ++kt) {
            pg8::u32x4 pw; pw.x = pk2(sa[kt][0], sa[kt][1]); pw.y = pk2(sa[kt][2], sa[kt][3]); pw.z = pk2(sb[kt][0], sb[kt][1]); pw.w = pk2(sb[kt][2], sb[kt][3]);
            const pg8::bf16x8 pf = __builtin_bit_cast(pg8::bf16x8, pw);
#pragma unroll
            for (int c8 = 0; c8 < 8; ++c8) {
                const s4v t0 = __builtin_amdgcn_ds_read_tr16_b64_v4i16((LAS s4v*)(c.lds + (vbase[0] + ((32u * c8) ^ vxor[0])) + 8192u * kt));
                const s4v t1 = __builtin_amdgcn_ds_read_tr16_b64_v4i16((LAS s4v*)(c.lds + (vbase[1] + ((32u * c8) ^ vxor[1])) + 8192u * kt));
                const pg8::bf16x8 vf = __builtin_shufflevector(t0, t1, 0, 1, 2, 3, 4, 5, 6, 7);
                o[c8] = __builtin_amdgcn_mfma_f32_16x16x32_bf16(vf, pf, o[c8], 0, 0, 0);
            }
        }
        const float il = 1.0f / l;
        bf16* orow = OP + (size_t)tokq * 1024 + h * 128 + 4 * g;
#pragma unroll
        for (int c8 = 0; c8 < 8; ++c8) { v2u w; w.x = pk2(o[c8][0] * il, o[c8][1] * il); w.y = pk2(o[c8][2] * il, o[c8][3] * il); *(v2u*)(orow + 16 * c8) = w; }
        if (g == 0) LSE[((size_t)p * T + tokq) * 8 + h] = mx + __builtin_amdgcn_logf(l);
    }
    __syncthreads();
}
__device__ __forceinline__ void phase_combine_q(const Ctx& c, unsigned char* ws) {
    const float* LSE = (const float*)(ws + WS_LSE); const bf16* HC = (const bf16*)(ws + WS_HC);
    const bf16* OP0 = (const bf16*)(ws + WS_OP0); const bf16* OP1 = (const bf16*)(ws + WS_OP1); const bf16* OP2 = (const bf16*)(ws + WS_OP2);
    for (int t = c.gw; t < T; t += c.ngw) {
        const int h = c.lane >> 3;
        const float l0 = LSE[((size_t)0 * T + t) * 8 + h], l1 = LSE[((size_t)1 * T + t) * 8 + h], l2 = LSE[((size_t)2 * T + t) * 8 + h];
        const float m = fmaxf(l0, fmaxf(l1, l2));
        float w0 = exp2f(l0 - m), w1 = exp2f(l1 - m), w2 = exp2f(l2 - m);
        const float inv = 1.0f / (w0 + w1 + w2); w0 *= inv; w1 *= inv; w2 *= inv;
        const size_t off = (size_t)t * 1024 + 16 * c.lane;
        float f[32]; float am = 0.f;
#pragma unroll
        for (int hh = 0; hh < 2; ++hh) {
            const v4u a = *(const v4u*)(OP0 + off + 8 * hh), bq = *(const v4u*)(OP1 + off + 8 * hh), cq = *(const v4u*)(OP2 + off + 8 * hh);
            const v4u p = *(const v4u*)(HC + (size_t)t * 2048 + 1024 + 16 * c.lane + 8 * hh);
            f[8 * hh + 0] = w0 * bflo(a.x) + w1 * bflo(bq.x) + w2 * bflo(cq.x); f[8 * hh + 1] = w0 * bfhi(a.x) + w1 * bfhi(bq.x) + w2 * bfhi(cq.x);
            f[8 * hh + 2] = w0 * bflo(a.y) + w1 * bflo(bq.y) + w2 * bflo(cq.y); f[8 * hh + 3] = w0 * bfhi(a.y) + w1 * bfhi(bq.y) + w2 * bfhi(cq.y);
            f[8 * hh + 4] = w0 * bflo(a.z) + w1 * bflo(bq.z) + w2 * bflo(cq.z); f[8 * hh + 5] = w0 * bfhi(a.z) + w1 * bfhi(bq.z) + w2 * bfhi(cq.z);
            f[8 * hh + 6] = w0 * bflo(a.w) + w1 * bflo(bq.w) + w2 * bflo(cq.w); f[8 * hh + 7] = w0 * bfhi(a.w) + w1 * bfhi(bq.w) + w2 * bfhi(cq.w);
            f[16 + 8 * hh + 0] = bflo(p.x); f[16 + 8 * hh + 1] = bfhi(p.x); f[16 + 8 * hh + 2] = bflo(p.y); f[16 + 8 * hh + 3] = bfhi(p.y);
            f[16 + 8 * hh + 4] = bflo(p.z); f[16 + 8 * hh + 5] = bfhi(p.z); f[16 + 8 * hh + 6] = bflo(p.w); f[16 + 8 * hh + 7] = bfhi(p.w);
        }
#pragma unroll
        for (int k = 0; k < 32; ++k) am = fmaxf(am, fabsf(f[k]));
        am = wave_max(am);
        const float qi = (am > 0.f) ? 127.0f / am : 0.f;
        unsigned w8[8];
#pragma unroll
        for (int q = 0; q < 8; ++q) { unsigned ww = 0u;
            ww = __builtin_amdgcn_cvt_pk_u8_f32(__builtin_rintf(fmaf(f[4 * q], qi, 128.0f)), 0, ww); ww = __builtin_amdgcn_cvt_pk_u8_f32(__builtin_rintf(fmaf(f[4 * q + 1], qi, 128.0f)), 1, ww);
            ww = __builtin_amdgcn_cvt_pk_u8_f32(__builtin_rintf(fmaf(f[4 * q + 2], qi, 128.0f)), 2, ww); ww = __builtin_amdgcn_cvt_pk_u8_f32(__builtin_rintf(fmaf(f[4 * q + 3], qi, 128.0f)), 3, ww);
            w8[q] = ww ^ 0x80808080u; }
        unsigned char* o8 = ws + WS_HC8 + (size_t)t * D + 32 * c.lane;
        *(v4u*)o8 = (v4u){w8[0], w8[1], w8[2], w8[3]}; *(v4u*)(o8 + 16) = (v4u){w8[4], w8[5], w8[6], w8[7]};
        if (c.lane == 0) ((float*)(ws + WS_SA5))[t] = am * (1.0f / 127.0f);
    }
}
__device__ __forceinline__ void phase_combine(const Ctx& c, unsigned char* ws) {
    const float* LSE = (const float*)(ws + WS_LSE); bf16* HC = (bf16*)(ws + WS_HC);
    const bf16* OP0 = (const bf16*)(ws + WS_OP0); const bf16* OP1 = (const bf16*)(ws + WS_OP1); const bf16* OP2 = (const bf16*)(ws + WS_OP2);
    for (int t = c.gw; t < T; t += c.ngw) {
        const int h = c.lane >> 3;
        const float l0 = LSE[((size_t)0 * T + t) * 8 + h], l1 = LSE[((size_t)1 * T + t) * 8 + h], l2 = LSE[((size_t)2 * T + t) * 8 + h];
        const float m = fmaxf(l0, fmaxf(l1, l2));
        float w0 = exp2f(l0 - m), w1 = exp2f(l1 - m), w2 = exp2f(l2 - m);
        const float inv = 1.0f / (w0 + w1 + w2); w0 *= inv; w1 *= inv; w2 *= inv;
        const size_t off = (size_t)t * 1024 + 16 * c.lane;
#pragma unroll
        for (int hh = 0; hh < 2; ++hh) {
            const v4u a = *(const v4u*)(OP0 + off + 8 * hh), bq = *(const v4u*)(OP1 + off + 8 * hh), cq = *(const v4u*)(OP2 + off + 8 * hh);
            v4u o;
            o.x = pk2(w0 * bflo(a.x) + w1 * bflo(bq.x) + w2 * bflo(cq.x), w0 * bfhi(a.x) + w1 * bfhi(bq.x) + w2 * bfhi(cq.x));
            o.y = pk2(w0 * bflo(a.y) + w1 * bflo(bq.y) + w2 * bflo(cq.y), w0 * bfhi(a.y) + w1 * bfhi(bq.y) + w2 * bfhi(cq.y));
            o.z = pk2(w0 * bflo(a.z) + w1 * bflo(bq.z) + w2 * bflo(cq.z), w0 * bfhi(a.z) + w1 * bfhi(bq.z) + w2 * bfhi(cq.z));
            o.w = pk2(w0 * bflo(a.w) + w1 * bflo(bq.w) + w2 * bflo(cq.w), w0 * bfhi(a.w) + w1 * bfhi(bq.w) + w2 * bfhi(cq.w));
            *(v4u*)(HC + (size_t)t * 2048 + 16 * c.lane + 8 * hh) = o;
        }
    }
}

__device__ __forceinline__ int f2sort(float f) { const int b = __float_as_int(f); return b ^ ((b >> 31) & 0x7fffffff); }
__device__ __forceinline__ float sort2f(int k) { return __int_as_float(k ^ ((k >> 31) & 0x7fffffff)); }
#define CE_DESC(a, b) do { const int hi_ = max((a), (b)), lo_ = min((a), (b)); (a) = hi_; (b) = lo_; } while (0)
__device__ __forceinline__ void bitonic_merge16(int (&v)[16]) {
#pragma unroll
    for (int j = 8; j > 0; j >>= 1)
#pragma unroll
        for (int i = 0; i < 16; ++i) { const int l = i ^ j; if (l > i) CE_DESC(v[i], v[l]); }
}
__device__ __forceinline__ void sort16(int (&v)[16]) {
#pragma unroll
    for (int k = 2; k <= 16; k <<= 1)
#pragma unroll
        for (int j = k >> 1; j > 0; j >>= 1)
#pragma unroll
            for (int i = 0; i < 16; ++i) { const int l = i ^ j; if (l > i) { if ((i & k) == 0) CE_DESC(v[i], v[l]); else CE_DESC(v[l], v[i]); } }
}
__device__ __forceinline__ void merge_top16(int (&a)[16], const int (&b)[16]) {
#pragma unroll
    for (int k = 0; k < 16; ++k) a[k] = max(a[k], b[15 - k]);
    bitonic_merge16(a);
}
__device__ __forceinline__ void xlane_merge(int (&a)[16], int xr, int lane) {
    int b[16];
#pragma unroll
    for (int k = 0; k < 16; ++k) b[k] = SXOR(a[k], xr, lane);
    merge_top16(a, b);
}
__device__ __forceinline__ void phase_scores_topk(const Ctx& c, unsigned char* ws) {
    const bf16* QP = (const bf16*)(ws + WS_QP); const bf16* SKB = (const bf16*)(ws + WS_SKP);
    int* IDX = (int*)(ws + WS_IDX); float* GATE = (float*)(ws + WS_GATE);
    const int g = c.lane >> 4, lq = c.lane & 15;
    const int h = c.vcu & 7, tb = c.vcu >> 3;
    LAS unsigned char* lut = c.lds + 65536 + c.wave * 2560 + c.lane * 36;
#pragma unroll
    for (int i = 0; i < 8; ++i) {
        const int id = c.tid + 512 * i, row = id >> 4, ch = id & 15;
        *(LAS v4u*)(c.lds + off_b((unsigned)row, (unsigned)ch)) = *(const v4u*)(SKB + ((size_t)h * 256 + row) * 128 + ch * 8);
    }
    unsigned ka[4];
#pragma unroll
    for (int s4 = 0; s4 < 4; ++s4) ka[s4] = off_b((unsigned)lq, (unsigned)(4 * s4 + g));
    __syncthreads();
    for (int it = 0; it < 4; ++it) {
        const int t = 512 * tb + 128 * it + 16 * c.wave + lq;
        int top[2][16];
#pragma unroll
        for (int p = 0; p < 2; ++p) {
            pg8::bf16x8 qf[4];
#pragma unroll
            for (int s4 = 0; s4 < 4; ++s4) qf[s4] = *(const pg8::bf16x8*)(QP + (size_t)t * 2048 + h * 256 + p * 128 + 32 * s4 + 8 * g);
            int lo[16], hi[16];
#pragma unroll
            for (int c8 = 0; c8 < 8; ++c8) {
                f32x4 acc = {0.f, 0.f, 0.f, 0.f};
#pragma unroll
                for (int s4 = 0; s4 < 4; ++s4) {
                    const pg8::bf16x8 kf = *(const LAS pg8::bf16x8*)(c.lds + ka[s4] + (unsigned)(32768 * p + 4096 * c8));
                    acc = __builtin_amdgcn_mfma_f32_16x16x32_bf16(kf, qf[s4], acc, 0, 0, 0);
                }
#pragma unroll
                for (int i = 0; i < 4; ++i) { const int key = (f2sort(acc[i]) & ~127) | (16 * c8 + 4 * g + i); if (c8 < 4) lo[4 * c8 + i] = key; else hi[4 * (c8 - 4) + i] = key; }
            }
            sort16(lo); sort16(hi); merge_top16(lo, hi);
            xlane_merge(lo, 16, c.lane); xlane_merge(lo, 32, c.lane);
#pragma unroll
            for (int k = 0; k < 16; ++k) top[p][k] = lo[k];
        }
#pragma unroll
        for (int p = 0; p < 2; ++p)
#pragma unroll
            for (int q = 0; q < 4; ++q)
                *(LAS unsigned*)(lut + 16 * p + 4 * q) = (unsigned)(top[p][4 * q] & 127) | ((unsigned)(top[p][4 * q + 1] & 127) << 8) | ((unsigned)(top[p][4 * q + 2] & 127) << 16) | ((unsigned)(top[p][4 * q + 3] & 127) << 24);
        float f0[16], f1[16];
#pragma unroll
        for (int k = 0; k < 16; ++k) { f0[k] = sort2f(top[0][k] & ~127); f1[k] = sort2f(top[1][k] & ~127); }
#define CAND(a, b) ((f2sort(f0[a] + f1[b]) & ~255) | ((a) << 4) | (b))
        int X[16], Y[16], Z[16];
#pragma unroll
        for (int b2 = 0; b2 < 16; ++b2) X[b2] = CAND(0, b2);
#pragma unroll
        for (int b2 = 0; b2 < 8; ++b2) Y[b2] = CAND(1, b2);
#pragma unroll
        for (int a2 = 8; a2 < 16; ++a2) Y[23 - a2] = CAND(a2, 0);
        Z[0] = CAND(2, 0); Z[1] = CAND(2, 1); Z[2] = CAND(2, 2); Z[3] = CAND(2, 3); Z[4] = CAND(2, 4);
        Z[5] = CAND(3, 0); Z[6] = CAND(3, 1); Z[7] = CAND(3, 2); Z[8] = CAND(3, 3);
        Z[9] = CAND(4, 0); Z[10] = CAND(4, 1); Z[11] = CAND(4, 2);
        Z[12] = CAND(5, 0); Z[13] = CAND(5, 1); Z[14] = CAND(6, 0); Z[15] = CAND(6, 1);
        const int w0 = CAND(7, 0), w1 = CAND(7, 1);
#undef CAND
        bitonic_merge16(Y); sort16(Z);
        merge_top16(X, Y); merge_top16(X, Z);
        X[14] = max(X[14], w1); X[15] = max(X[15], w0); bitonic_merge16(X);
        LDS_WAIT();
        float e[16], sum = 0.f; const float fmx = sort2f(X[0] & ~255);
#pragma unroll
        for (int k = 0; k < 16; ++k) { e[k] = __expf(sort2f(X[k] & ~255) - fmx); sum += e[k]; }
        const float inv = 1.0f / sum;
        int ex[16];
#pragma unroll
        for (int k = 0; k < 16; ++k) { const int a2 = (X[k] >> 4) & 15, b2 = X[k] & 15; ex[k] = (int)(*(const LAS unsigned char*)(lut + a2)) * PE_NK + (int)(*(const LAS unsigned char*)(lut + 16 + b2)); }
        if (g == 0) {
            int* ip = IDX + (size_t)t * 128 + h * 16; float* gp = GATE + (size_t)t * 128 + h * 16;
#pragma unroll
            for (int q = 0; q < 4; ++q) {
                *(int4*)(ip + 4 * q) = make_int4(ex[4 * q], ex[4 * q + 1], ex[4 * q + 2], ex[4 * q + 3]);
                *(f32x4*)(gp + 4 * q) = (f32x4){e[4 * q] * inv, e[4 * q + 1] * inv, e[4 * q + 2] * inv, e[4 * q + 3] * inv};
            }
        }
        LDS_WAIT();
    }
    __syncthreads();
}

__device__ __forceinline__ void phase_topk_simple(const Ctx& c, unsigned char* ws) {
    const float* SC = (const float*)(ws + WS_SC); int* IDX = (int*)(ws + WS_IDX); float* GATE = (float*)(ws + WS_GATE);
    const float NEG = -3.0e38f;
    for (int item = c.gw; item < T * PE_HEADS; item += c.ngw) {
        const int t = item >> 3, h = item & 7;
        const float* sc = SC + (size_t)t * 2048 + h * 256;
        float sh[2] = {0.f, 0.f}; int ih[2] = {0, 0};
#pragma unroll
        for (int p = 0; p < 2; ++p) {
            float va = sc[128 * p + c.lane], vb = sc[128 * p + 64 + c.lane];
            for (int r = 0; r < PE_K; ++r) {
                const float M = wave_max(fmaxf(va, vb));
                const unsigned long long ba = __ballot(va == M), bb = __ballot(vb == M);
                const int n = ba ? (int)__builtin_ctzll(ba) : 64 + (int)__builtin_ctzll(bb);
                if (c.lane == r) { sh[p] = M; ih[p] = n; }
                if (n < 64) { if (c.lane == n) va = NEG; } else { if (c.lane == n - 64) vb = NEG; }
            }
        }
        float cv[4];
#pragma unroll
        for (int q = 0; q < 4; ++q) { const int cc = c.lane + 64 * q; cv[q] = sh_idx(sh[0], cc >> 4) + sh_idx(sh[1], cc & 15); }
        float ts = NEG; int tc = 0;
        for (int r = 0; r < PE_K; ++r) {
            const float M = wave_max(fmaxf(fmaxf(cv[0], cv[1]), fmaxf(cv[2], cv[3])));
            int cc = -1;
#pragma unroll
            for (int q = 3; q >= 0; --q) { const unsigned long long bq = __ballot(cv[q] == M); if (bq) cc = 64 * q + (int)__builtin_ctzll(bq); }
            if (c.lane == r) { ts = M; tc = cc; }
#pragma unroll
            for (int q = 0; q < 4; ++q) if (cc == c.lane + 64 * q) cv[q] = NEG;
        }
        const int i0 = sh_idx(ih[0], tc >> 4), i1 = sh_idx(ih[1], tc & 15);
        const float tmax = sh_idx(ts, 0);
        const float ex = (c.lane < PE_K) ? __expf(ts - tmax) : 0.f;
        const float sum = wave_sum(ex);
        if (c.lane < PE_K) { IDX[(size_t)t * 128 + h * 16 + c.lane] = i0 * PE_NK + i1; GATE[(size_t)t * 128 + h * 16 + c.lane] = ex / sum; }
    }
}

__device__ __forceinline__ void ld_row8(const unsigned char* tab, int e, int lane, v4u (&r)[2]) {
    const v4u* p = (const v4u*)(tab + (size_t)e * D) + lane;
    r[0] = p[0]; r[1] = p[64];
}
__device__ __forceinline__ int idot_row(const int (&h)[8], const v4u (&r)[2]) {
    int a = 0, b = 0;
    a = __builtin_amdgcn_sdot4(h[0], (int)r[0].x, a, false); b = __builtin_amdgcn_sdot4(h[1], (int)r[0].y, b, false);
    a = __builtin_amdgcn_sdot4(h[2], (int)r[0].z, a, false); b = __builtin_amdgcn_sdot4(h[3], (int)r[0].w, b, false);
    a = __builtin_amdgcn_sdot4(h[4], (int)r[1].x, a, false); b = __builtin_amdgcn_sdot4(h[5], (int)r[1].y, b, false);
    a = __builtin_amdgcn_sdot4(h[6], (int)r[1].z, a, false); b = __builtin_amdgcn_sdot4(h[7], (int)r[1].w, b, false);
    return a + b;
}
__device__ __forceinline__ int reduce8(const int (&p)[8], int lane) {
    const bool b0 = lane & 1, b1 = lane & 2, b2 = lane & 4;
    int q[4], r2[2];
#pragma unroll
    for (int i = 0; i < 4; ++i) { const int keep = b0 ? p[2 * i + 1] : p[2 * i], send = b0 ? p[2 * i] : p[2 * i + 1]; q[i] = keep + SXOR(send, 1, lane); }
#pragma unroll
    for (int i = 0; i < 2; ++i) { const int keep = b1 ? q[2 * i + 1] : q[2 * i], send = b1 ? q[2 * i] : q[2 * i + 1]; r2[i] = keep + SXOR(send, 2, lane); }
    int v = (b2 ? r2[1] : r2[0]) + SXOR(b2 ? r2[0] : r2[1], 4, lane);
    v += SXOR(v, 8, lane); v += SXOR(v, 16, lane); v += SXOR(v, 32, lane);
    return v;
}
__device__ __forceinline__ void axpy_row8(float (&y)[32], float a, const v4u (&r)[2]) {
#pragma unroll
    for (int q = 0; q < 2; ++q) {
        const unsigned w[4] = {r[q].x, r[q].y, r[q].z, r[q].w};
#pragma unroll
        for (int d = 0; d < 4; ++d) {
            y[16 * q + 4 * d + 0] += a * (float)(w[d] & 0xffu); y[16 * q + 4 * d + 1] += a * (float)((w[d] >> 8) & 0xffu);
            y[16 * q + 4 * d + 2] += a * (float)((w[d] >> 16) & 0xffu); y[16 * q + 4 * d + 3] += a * (float)(w[d] >> 24);
        }
    }
}
__device__ __forceinline__ void phase_peer(const Ctx& c, const float* X1, const float* final_g, float* out, unsigned char* ws) {
    const unsigned char* PU = ws + WS_PU; const unsigned char* PV = ws + WS_PV; const bf16* HB = (const bf16*)(ws + WS_HB);
    const float* SU = (const float*)(ws + WS_SU); const float* SV = (const float*)(ws + WS_SV);
    const int* IDX = (const int*)(ws + WS_IDX); const float* GATE = (const float*)(ws + WS_GATE); const float* MODF = (const float*)(ws + WS_MODF);
    LAS float* G2 = (LAS float*)c.lds; LAS float* FG = G2 + D;
    const int b = c.vcu >> 7;
    { const int j = 4 * c.tid; *(LAS f32x4*)(G2 + j) = *(const f32x4*)(MODF + (size_t)b * NMOD + 5 * D + j); *(LAS f32x4*)(FG + j) = *(const f32x4*)(final_g + j); }
    __syncthreads();
#pragma unroll 1
    for (int i = (DUP & 1024) ? -8 : 0; i < 8; ++i) {
        const int t = 64 * c.vcu + 8 * c.wave + (i & 7);
        const int e0 = IDX[(size_t)t * 128 + c.lane], e1 = IDX[(size_t)t * 128 + 64 + c.lane];
        const float g0 = GATE[(size_t)t * 128 + c.lane], g1 = GATE[(size_t)t * 128 + 64 + c.lane];
        v4u r[8][2];
#pragma unroll
        for (int q = 0; q < 8; ++q) ld_row8(PU, __builtin_amdgcn_readlane(e0, q), c.lane, r[q]);
        const float su0 = SU[e0], su1 = SU[e1], sv0 = SV[e0], sv1 = SV[e1];
        int hq[8]; float sh;
        {
            float hf[32]; float am = 0.f;
#pragma unroll
            for (int q = 0; q < 2; ++q)
#pragma unroll
                for (int rr = 0; rr < 2; ++rr) {
                    const v4u w = *(const v4u*)(HB + (size_t)t * D + 1024 * q + 16 * c.lane + 8 * rr);
                    float* f = hf + 16 * q + 8 * rr;
                    f[0] = bflo(w.x); f[1] = bfhi(w.x); f[2] = bflo(w.y); f[3] = bfhi(w.y); f[4] = bflo(w.z); f[5] = bfhi(w.z); f[6] = bflo(w.w); f[7] = bfhi(w.w);
                }
#pragma unroll
            for (int k = 0; k < 32; ++k) am = fmaxf(am, fabsf(hf[k]));
            am = wave_max(am);
            const float inv = (am > 0.f) ? 127.0f / am : 0.f; sh = am * (1.0f / 127.0f);
#pragma unroll
            for (int d = 0; d < 8; ++d) { unsigned w = 0u;
#pragma unroll
                for (int e = 0; e < 4; ++e) { const int qv = __float2int_rn(hf[4 * d + e] * inv); w |= ((unsigned)qv & 0xffu) << (8 * e); }
                hq[d] = (int)w; }
        }
        int ia0 = 0, ia1 = 0;
#pragma unroll 1
        for (int m = 0; m < 16; ++m) {
            int part[8];
#pragma unroll
            for (int q = 0; q < 8; ++q) {
                part[q] = idot_row(hq, r[q]);
                const int kn = 8 * (m + 1) + q;
                if (m < 15) { const int en = (kn < 64) ? __builtin_amdgcn_readlane(e0, kn & 63) : __builtin_amdgcn_readlane(e1, kn & 63); ld_row8(PU, en, c.lane, r[q]); }
            }
            const int v = reduce8(part, c.lane);
            if (m < 8) { if ((c.lane >> 3) == m) ia0 = v; } else { if ((c.lane >> 3) == m - 8) ia1 = v; }
        }
#pragma unroll
        for (int q = 0; q < 8; ++q) ld_row8(PV, __builtin_amdgcn_readlane(e0, q), c.lane, r[q]);
        const float a0 = (float)ia0 * su0 * sh, a1 = (float)ia1 * su1 * sh;
        const float c0 = 0.5f * a0 * (1.0f + erff(a0 * 0.70710678118654752f)) * g0 * sv0;
        const float c1 = 0.5f * a1 * (1.0f + erff(a1 * 0.70710678118654752f)) * g1 * sv1;
        const float csum = wave_sum(c0 + c1);
        float y[32];
#pragma unroll
        for (int q = 0; q < 32; ++q) y[q] = 0.f;
#pragma unroll 1
        for (int m = 0; m < 16; ++m) {
#pragma unroll
            for (int q = 0; q < 8; ++q) {
                const int k = 8 * m + q;
                const float ck = __uint_as_float((k < 64) ? __builtin_amdgcn_readlane(__float_as_uint(c0), k & 63) : __builtin_amdgcn_readlane(__float_as_uint(c1), k & 63));
                axpy_row8(y, ck, r[q]);
                const int kn = k + 8;
                if (m < 15) { const int en = (kn < 64) ? __builtin_amdgcn_readlane(e0, kn & 63) : __builtin_amdgcn_readlane(e1, kn & 63); ld_row8(PV, en, c.lane, r[q]); }
            }
        }
        const float* xr = X1 + (size_t)t * D + 16 * c.lane; float* orow = ((DUP & 1024) && i < 0 ? (float*)(ws + WS_HC) : out) + (size_t)t * D + 16 * c.lane;
        const float yoff = 128.0f * csum;
        float ss = 0.f;
#pragma unroll
        for (int q = 0; q < 2; ++q)
#pragma unroll
            for (int d = 0; d < 4; ++d) {
                const f32x4 xa = *(const f32x4*)(xr + 1024 * q + 4 * d);
                const f32x4 ga = *(const LAS f32x4*)(G2 + 1024 * q + 16 * c.lane + 4 * d);
#pragma unroll
                for (int e = 0; e < 4; ++e) { const float v = xa[e] + ga[e] * (y[16 * q + 4 * d + e] - yoff); y[16 * q + 4 * d + e] = v; ss += v * v; }
            }
        const float rstd = 1.0f / sqrtf(wave_sum(ss) * (1.0f / D) + NORM_EPS);
#pragma unroll
        for (int q = 0; q < 2; ++q)
#pragma unroll
            for (int d = 0; d < 4; ++d) {
                const f32x4 fa = *(const LAS f32x4*)(FG + 1024 * q + 16 * c.lane + 4 * d);
                f32x4 o;
#pragma unroll
                for (int e = 0; e < 4; ++e) o[e] = y[16 * q + 4 * d + e] * rstd * fa[e];
                *(f32x4*)(orow + 1024 * q + 4 * d) = o;
            }
    }
}

__device__ __forceinline__ v4u ld_row4(const unsigned char* tab, int e, int lane) { return *((const v4u*)(tab + (size_t)e * 1024) + lane); }
__device__ __forceinline__ int idot_row4(const int (&h)[8], const v4u& r) {
    const int w[4] = {(int)r.x, (int)r.y, (int)r.z, (int)r.w}; int ah = 0, al = 0;
#pragma unroll
    for (int d = 0; d < 4; ++d) { ah = __builtin_amdgcn_sdot8(h[d], w[d], ah, false); al = __builtin_amdgcn_sdot8(h[4 + d], w[d], al, false); }
    return 16 * ah + al;
}
__device__ __forceinline__ void vacc4(int (&y)[32], const v4u& ra, const v4u& rb, const v4u& rc, const v4u& rd, int cq4) {
    const unsigned A[4] = {ra.x, ra.y, ra.z, ra.w}, B[4] = {rb.x, rb.y, rb.z, rb.w}, C[4] = {rc.x, rc.y, rc.z, rc.w}, Dd[4] = {rd.x, rd.y, rd.z, rd.w};
#pragma unroll
    for (int d = 0; d < 4; ++d) {
        const unsigned t0 = __builtin_amdgcn_perm(A[d], B[d], 0x01050004u), t1 = __builtin_amdgcn_perm(A[d], B[d], 0x03070206u);
        const unsigned t2 = __builtin_amdgcn_perm(C[d], Dd[d], 0x01050004u), t3 = __builtin_amdgcn_perm(C[d], Dd[d], 0x03070206u);
        const unsigned T[4] = {__builtin_amdgcn_perm(t0, t2, 0x01000504u), __builtin_amdgcn_perm(t0, t2, 0x03020706u),
                               __builtin_amdgcn_perm(t1, t3, 0x01000504u), __builtin_amdgcn_perm(t1, t3, 0x03020706u)};
#pragma unroll
        for (int e = 0; e < 4; ++e) {
            y[8 * d + e] = __builtin_amdgcn_sdot4((int)(T[e] & 0x0f0f0f0fu), cq4, y[8 * d + e], false);
            y[8 * d + 4 + e] = __builtin_amdgcn_sdot4((int)T[e], cq4, y[8 * d + 4 + e], false);
        }
    }
}
#define SCHED_FENCE() __builtin_amdgcn_sched_barrier(0)
template <bool REMAP>
__device__ __forceinline__ void phase_peer4_u(const Ctx& c, const float* g2vec, unsigned char* ws) {
    const unsigned char* PU = ws + WS_PU; const bf16* HB = (const bf16*)(ws + WS_X1B);
    LAS float* A2 = (LAS float*)(c.lds + 16384); LAS float* B2 = A2 + D;
    { const float* MODF_ = (const float*)(ws + WS_MODF) + (size_t)(c.vcu >> 7) * NMOD; const int j = 4 * c.tid;
      *(LAS f32x4*)(A2 + j) = *(const f32x4*)(g2vec + j) * (*(const f32x4*)(MODF_ + 4 * D + j) + 1.0f); *(LAS f32x4*)(B2 + j) = *(const f32x4*)(MODF_ + 3 * D + j); }
    __syncthreads();
    const float* SU = (const float*)(ws + WS_SU); const float* SV = (const float*)(ws + WS_SV);
    const int* IDX = (const int*)(ws + WS_IDX); const float* GATE = (const float*)(ws + WS_GATE);
    int* TQ = (int*)(ws + (REMAP ? WS_HC : WS_TQ)); float* CSC = (float*)(ws + (REMAP ? WS_HC + 16 * MiB : WS_CSC));
    const int rm_or = (int)(blockIdx.x & 7) << 11;
#define RM(e) (REMAP ? (((e) & 2047) | rm_or) : (e))
    const int tbase = 64 * c.vcu + 8 * c.wave;
    int e0n = RM(IDX[(size_t)tbase * 128 + c.lane]), e1n = RM(IDX[(size_t)tbase * 128 + 64 + c.lane]);
    float g0n = GATE[(size_t)tbase * 128 + c.lane], g1n = GATE[(size_t)tbase * 128 + 64 + c.lane];
    v2u hraw[8];
#pragma unroll
    for (int j = 0; j < 8; ++j) hraw[j] = __builtin_nontemporal_load((const v2u*)(HB + (size_t)tbase * D + 256 * j + 4 * c.lane));
    v4u r[16];
#pragma unroll
    for (int q = 0; q < 16; ++q) r[q] = ld_row4(PU, __builtin_amdgcn_readlane(e0n, q), c.lane);
#pragma unroll 1
    for (int i = (DUP & 1024) ? -8 : 0; i < 8; ++i) {
        const int t = tbase + (i & 7), tn = tbase + ((i + 1) & 7);
        const int e0 = e0n, e1 = e1n; const float g0 = g0n, g1 = g1n;
        const float su0 = SU[e0], su1 = SU[e1], sv0 = SV[e0], sv1 = SV[e1];
        int hq[8]; float sh; int hsum;
        {
            float hf[32]; float am = 0.f, ssx = 0.f;
#pragma unroll
            for (int j = 0; j < 8; ++j) { hf[4 * j] = bflo(hraw[j].x); hf[4 * j + 1] = bfhi(hraw[j].x); hf[4 * j + 2] = bflo(hraw[j].y); hf[4 * j + 3] = bfhi(hraw[j].y); }
#pragma unroll
            for (int k = 0; k < 32; ++k) ssx += hf[k] * hf[k];
            const float rstd2 = 1.0f / sqrtf(wave_sum(ssx) * (1.0f / D) + NORM_EPS);
#pragma unroll
            for (int j = 0; j < 8; ++j) { const f32x4 av = *(const LAS f32x4*)(A2 + 256 * j + 4 * c.lane), bv = *(const LAS f32x4*)(B2 + 256 * j + 4 * c.lane);
#pragma unroll
                for (int e = 0; e < 4; ++e) hf[4 * j + e] = hf[4 * j + e] * rstd2 * av[e] + bv[e]; }
#pragma unroll
            for (int k = 0; k < 32; ++k) am = fmaxf(am, fabsf(hf[k]));
            am = wave_max(am);
            const float inv = (am > 0.f) ? 119.0f / am : 0.f; sh = am * (1.0f / 119.0f);
            int hs = 0;
#pragma unroll
            for (int d = 0; d < 4; ++d) { unsigned wh = 0u, wl = 0u;
#pragma unroll
                for (int e = 0; e < 4; ++e)
#pragma unroll
                    for (int odd = 0; odd < 2; ++odd) {
                        const int qv = __float2int_rn(hf[4 * (2 * d + odd) + e] * inv), hh = (qv + 8) >> 4, hl = qv - 16 * hh;
                        hs += qv; wh |= ((unsigned)hh & 15u) << (8 * e + 4 * odd); wl |= ((unsigned)hl & 15u) << (8 * e + 4 * odd);
                    }
                hq[d] = (int)wh; hq[4 + d] = (int)wl; }
            hsum = wave_sum_i(hs);
        }
        e0n = RM(IDX[(size_t)tn * 128 + c.lane]); e1n = RM(IDX[(size_t)tn * 128 + 64 + c.lane]);
        g0n = GATE[(size_t)tn * 128 + c.lane]; g1n = GATE[(size_t)tn * 128 + 64 + c.lane];
#pragma unroll
        for (int j = 0; j < 8; ++j) hraw[j] = __builtin_nontemporal_load((const v2u*)(HB + (size_t)tn * D + 256 * j + 4 * c.lane));
        int ia0 = 0, ia1 = 0;
#pragma unroll 1
        for (int m = 0; m < 8; ++m) {
            const int esrc = (m + 1 < 4) ? e0 : ((m + 1 < 8) ? e1 : e0n);
            int part[16];
#pragma unroll
            for (int q = 0; q < 16; ++q) {
                part[q] = idot_row4(hq, r[q]);
                SCHED_FENCE();
                r[q] = ld_row4(PU, __builtin_amdgcn_readlane(esrc, (16 * (m + 1) + q) & 63), c.lane);
                SCHED_FENCE();
            }
            int pa[8], pb[8];
#pragma unroll
            for (int q = 0; q < 8; ++q) { pa[q] = part[q]; pb[q] = part[8 + q]; }
            const int va = reduce8(pa, c.lane), vb = reduce8(pb, c.lane);
            const int grp = c.lane >> 3;
            if (m < 4) { if (grp == 2 * m) ia0 = va; if (grp == 2 * m + 1) ia0 = vb; } else { if (grp == 2 * (m - 4)) ia1 = va; if (grp == 2 * (m - 4) + 1) ia1 = vb; }
        }
        const float hoff = 0.5f * (float)hsum;
        const float a0 = ((float)ia0 + hoff) * su0 * sh, a1 = ((float)ia1 + hoff) * su1 * sh;
        const float c0 = 0.5f * a0 * (1.0f + erff(a0 * 0.70710678118654752f)) * g0 * sv0;
        const float c1 = 0.5f * a1 * (1.0f + erff(a1 * 0.70710678118654752f)) * g1 * sv1;
        const float cmx = wave_max(fmaxf(fabsf(c0), fabsf(c1)));
        const float cinv = (cmx > 0.f) ? 127.0f / cmx : 0.f, csc = cmx * (1.0f / 127.0f);
        const int q0 = __float2int_rn(c0 * cinv), q1 = __float2int_rn(c1 * cinv);
        const int cqs = wave_sum_i(q0 + q1);
        const unsigned b0 = (unsigned)q0 & 0xffu, b1 = (unsigned)q1 & 0xffu;
        const int t0 = (int)(b0 | (sh_idx(b0, c.lane + 1) << 8) | (sh_idx(b0, c.lane + 2) << 16) | (sh_idx(b0, c.lane + 3) << 24));
        const int t1 = (int)(b1 | (sh_idx(b1, c.lane + 1) << 8) | (sh_idx(b1, c.lane + 2) << 16) | (sh_idx(b1, c.lane + 3) << 24));
        TQ[(size_t)t * 128 + c.lane] = t0; TQ[(size_t)t * 128 + 64 + c.lane] = t1;
        if (c.lane == 0) { CSC[(size_t)t * 2] = csc; CSC[(size_t)t * 2 + 1] = (float)cqs; }
    }
#undef RM
}
__device__ __forceinline__ void phase_peer4_u_sorted(const Ctx& c, const float* g2vec, unsigned char* ws) {
    const unsigned char* PU = ws + WS_PU; const bf16* X1 = (const bf16*)(ws + WS_X1B);
    LAS float* A2 = (LAS float*)(c.lds + 16384); LAS float* B2 = A2 + D;
    { const float* MODF_ = (const float*)(ws + WS_MODF) + (size_t)(c.vcu >> 7) * NMOD; const int j = 4 * c.tid;
      *(LAS f32x4*)(A2 + j) = *(const f32x4*)(g2vec + j) * (*(const f32x4*)(MODF_ + 4 * D + j) + 1.0f); *(LAS f32x4*)(B2 + j) = *(const f32x4*)(MODF_ + 3 * D + j); }
    __syncthreads();
    const float* SU = (const float*)(ws + WS_SU); const float* SV = (const float*)(ws + WS_SV);
    const int* IDX = (const int*)(ws + WS_IDX); const float* GATE = (const float*)(ws + WS_GATE);
    int* TQ = (int*)(ws + WS_TQ); float* CSC = (float*)(ws + WS_CSC);
    LAS unsigned char* wb = c.lds + 32768 + c.wave * 12288;
    LAS v4u* hqv = (LAS v4u*)wb; LAS unsigned* lst = (LAS unsigned*)(wb + 8192); LAS int* acc = (LAS int*)(wb + 10240);
    v2u hraw[4][8];
#pragma unroll
    for (int jj = 0; jj < 4; ++jj) { const int t = 64 * c.vcu + 8 * c.wave + jj;
#pragma unroll
        for (int j = 0; j < 8; ++j) hraw[jj][j] = __builtin_nontemporal_load((const v2u*)(X1 + (size_t)t * D + 256 * j + 4 * c.lane)); }
#pragma unroll 1
    for (int hf = 0; hf < 2; ++hf) {
        const int tb4 = 64 * c.vcu + 8 * c.wave + 4 * hf;
        int e0[4], e1[4]; float shs[4], hoffs[4];
#pragma unroll
        for (int jj = 0; jj < 4; ++jj) { e0[jj] = IDX[(size_t)(tb4 + jj) * 128 + c.lane]; e1[jj] = IDX[(size_t)(tb4 + jj) * 128 + 64 + c.lane]; }
        {
#pragma unroll
            for (int jj = 0; jj < 4; ++jj) {
                float hf32[32]; float am = 0.f, ssx = 0.f;
#pragma unroll
                for (int j = 0; j < 8; ++j) { hf32[4 * j] = bflo(hraw[jj][j].x); hf32[4 * j + 1] = bfhi(hraw[jj][j].x); hf32[4 * j + 2] = bflo(hraw[jj][j].y); hf32[4 * j + 3] = bfhi(hraw[jj][j].y); }
#pragma unroll
                for (int k = 0; k < 32; ++k) ssx += hf32[k] * hf32[k];
                const float rstd2 = 1.0f / sqrtf(wave_sum(ssx) * (1.0f / D) + NORM_EPS);
#pragma unroll
                for (int j = 0; j < 8; ++j) { const f32x4 av = *(const LAS f32x4*)(A2 + 256 * j + 4 * c.lane), bv = *(const LAS f32x4*)(B2 + 256 * j + 4 * c.lane);
#pragma unroll
                    for (int e = 0; e < 4; ++e) hf32[4 * j + e] = hf32[4 * j + e] * rstd2 * av[e] + bv[e]; }
#pragma unroll
                for (int k = 0; k < 32; ++k) am = fmaxf(am, fabsf(hf32[k]));
                am = wave_max(am);
                const float inv = (am > 0.f) ? 119.0f / am : 0.f;
                unsigned W[8]; unsigned hsu = 0u;
#pragma unroll
                for (int j = 0; j < 8; ++j) { W[j] = 0u;
#pragma unroll
                    for (int e = 0; e < 4; ++e) W[j] = __builtin_amdgcn_cvt_pk_u8_f32(__builtin_rintf(fmaf(hf32[4 * j + e], inv, 136.0f)), e, W[j]);
                    hsu = __builtin_amdgcn_sad_u8(W[j], 0u, hsu); }
                const int hs = (int)hsu - 136 * 32;
                unsigned wh[4], wl[4];
#pragma unroll
                for (int d = 0; d < 4; ++d) {
                    wh[d] = (((W[2 * d] >> 4) & 0x0f0f0f0fu) | (W[2 * d + 1] & 0xf0f0f0f0u)) ^ 0x88888888u;
                    wl[d] = ((W[2 * d] & 0x0f0f0f0fu) | ((W[2 * d + 1] << 4) & 0xf0f0f0f0u)) ^ 0x88888888u; }
                hqv[(jj * 2 + 0) * 64 + c.lane] = (v4u){wh[0], wh[1], wh[2], wh[3]}; hqv[(jj * 2 + 1) * 64 + c.lane] = (v4u){wl[0], wl[1], wl[2], wl[3]};
                shs[jj] = am * (1.0f / 119.0f); hoffs[jj] = 0.5f * (float)wave_sum_i(hs);
            }
        }
        acc[c.lane] = 0;
        LDS_WAIT();
        int pos[8];
#pragma unroll
        for (int jj = 0; jj < 4; ++jj) { pos[2 * jj] = __hip_atomic_fetch_add(acc + (e0[jj] >> 8), 1, __ATOMIC_RELAXED, __HIP_MEMORY_SCOPE_WORKGROUP);
                                         pos[2 * jj + 1] = __hip_atomic_fetch_add(acc + (e1[jj] >> 8), 1, __ATOMIC_RELAXED, __HIP_MEMORY_SCOPE_WORKGROUP); }
        LDS_WAIT();
        { int cnt = acc[c.lane], inc = cnt;
#pragma unroll
          for (int o = 1; o < 64; o <<= 1) { const int up = sh_idx(inc, c.lane - o); inc += (c.lane >= o) ? up : 0; }
          LDS_WAIT(); acc[64 + c.lane] = inc - cnt; }
        LDS_WAIT();
#pragma unroll
        for (int jj = 0; jj < 4; ++jj) {
            lst[acc[64 + (e0[jj] >> 8)] + pos[2 * jj]] = ((unsigned)e0[jj] << 10) | ((unsigned)jj << 7) | (unsigned)c.lane;
            lst[acc[64 + (e1[jj] >> 8)] + pos[2 * jj + 1]] = ((unsigned)e1[jj] << 10) | ((unsigned)jj << 7) | (unsigned)(64 + c.lane);
        }
        LDS_WAIT();
        { const int tbn = 64 * c.vcu + 8 * c.wave + 4;
#pragma unroll
          for (int jj = 0; jj < 4; ++jj) { const int t = tbn + jj;
#pragma unroll
              for (int j = 0; j < 8; ++j) hraw[jj][j] = __builtin_nontemporal_load((const v2u*)(X1 + (size_t)t * D + 256 * j + 4 * c.lane)); } }
        SCHED_FENCE();
        unsigned ent = lst[c.lane & 15];
        v4u r[16];
#pragma unroll
        for (int q = 0; q < 16; ++q) r[q] = ld_row4(PU, (int)(__builtin_amdgcn_readlane(ent, q) >> 10), c.lane);
        v4u hh, hl;
        { const int jj = (int)((__builtin_amdgcn_readlane(ent, 0) >> 7) & 3u); hh = hqv[(jj * 2 + 0) * 64 + c.lane]; hl = hqv[(jj * 2 + 1) * 64 + c.lane]; }
#pragma unroll 1
        for (int m = 0; m < 32; ++m) {
            const unsigned entn = lst[((16 * (m + 1)) & 511) + (c.lane & 15)];
#pragma unroll
            for (int hb = 0; hb < 2; ++hb) {
                int pa[8];
#pragma unroll
                for (int q = 0; q < 8; ++q) {
                    const int s16 = 8 * hb + q;
                    const int jn = (int)(((s16 < 15 ? __builtin_amdgcn_readlane(ent, (s16 + 1) & 15) : __builtin_amdgcn_readlane(entn, 0)) >> 7) & 3u);
                    const v4u hhn = hqv[(jn * 2 + 0) * 64 + c.lane], hln = hqv[(jn * 2 + 1) * 64 + c.lane];
                    const int h8[8] = {(int)hh.x, (int)hh.y, (int)hh.z, (int)hh.w, (int)hl.x, (int)hl.y, (int)hl.z, (int)hl.w};
                    pa[q] = idot_row4(h8, r[s16]);
                    SCHED_FENCE();
                    r[s16] = ld_row4(PU, (int)(__builtin_amdgcn_readlane(entn, s16) >> 10), c.lane);
                    SCHED_FENCE();
                    hh = hhn; hl = hln;
                }
                const int v = reduce8(pa, c.lane);
                if ((c.lane >> 3) == hb) acc[((ent >> 7) & 3u) * 128 + (ent & 127u)] = v;
            }
            ent = entn;
        }
        LDS_WAIT();
        float gg0[4], gg1[4], su0[4], su1[4], sv0[4], sv1[4];
#pragma unroll
        for (int jj = 0; jj < 4; ++jj) { const int t = tb4 + jj;
            gg0[jj] = GATE[(size_t)t * 128 + c.lane]; gg1[jj] = GATE[(size_t)t * 128 + 64 + c.lane];
            su0[jj] = SU[e0[jj]]; su1[jj] = SU[e1[jj]]; sv0[jj] = SV[e0[jj]]; sv1[jj] = SV[e1[jj]]; }
#pragma unroll
        for (int jj = 0; jj < 4; ++jj) { const int t = tb4 + jj;
            const int ia0 = acc[jj * 128 + c.lane], ia1 = acc[jj * 128 + 64 + c.lane];
            const float a0 = ((float)ia0 + hoffs[jj]) * su0[jj] * shs[jj], a1 = ((float)ia1 + hoffs[jj]) * su1[jj] * shs[jj];
            const float c0 = 0.5f * a0 * (1.0f + erff(a0 * 0.70710678118654752f)) * gg0[jj] * sv0[jj];
            const float c1 = 0.5f * a1 * (1.0f + erff(a1 * 0.70710678118654752f)) * gg1[jj] * sv1[jj];
            const float cmx = wave_max(fmaxf(fabsf(c0), fabsf(c1)));
            const float cinv = (cmx > 0.f) ? 127.0f / cmx : 0.f, csc = cmx * (1.0f / 127.0f);
            const int q0 = __float2int_rn(c0 * cinv), q1 = __float2int_rn(c1 * cinv);
            const int cqs = wave_sum_i(q0 + q1);
            const unsigned b0 = (unsigned)q0 & 0xffu, b1 = (unsigned)q1 & 0xffu;
            const int t0 = (int)(b0 | (sh_idx(b0, c.lane + 1) << 8) | (sh_idx(b0, c.lane + 2) << 16) | (sh_idx(b0, c.lane + 3) << 24));
            const int t1 = (int)(b1 | (sh_idx(b1, c.lane + 1) << 8) | (sh_idx(b1, c.lane + 2) << 16) | (sh_idx(b1, c.lane + 3) << 24));
            TQ[(size_t)t * 128 + c.lane] = t0; TQ[(size_t)t * 128 + 64 + c.lane] = t1;
            if (c.lane == 0) { CSC[(size_t)t * 2] = csc; CSC[(size_t)t * 2 + 1] = (float)cqs; }
        }
        LDS_WAIT();
    }
}
typedef int v8i __attribute__((ext_vector_type(8)));
typedef float f32x2 __attribute__((ext_vector_type(2)));
__device__ __forceinline__ void phase_peer4_u_mfma(const Ctx& c, const float* g2vec, unsigned char* ws) {
    const unsigned char* PU = ws + WS_PU; const bf16* X1 = (const bf16*)(ws + WS_X1B);
    LAS float* A2 = (LAS float*)(c.lds + 16384); LAS float* B2 = A2 + D;
    { const float* MODF_ = (const float*)(ws + WS_MODF) + (size_t)(c.vcu >> 7) * NMOD; const int j = 4 * c.tid;
      *(LAS f32x4*)(A2 + j) = *(const f32x4*)(g2vec + j) * (*(const f32x4*)(MODF_ + 4 * D + j) + 1.0f); *(LAS f32x4*)(B2 + j) = *(const f32x4*)(MODF_ + 3 * D + j); }
    __syncthreads();
    const float* SU = (const float*)(ws + WS_SU); const float* SV = (const float*)(ws + WS_SV);
    const int* IDX = (const int*)(ws + WS_IDX); const float* GATE = (const float*)(ws + WS_GATE);
    int* TQ = (int*)(ws + WS_TQ); float* CSC = (float*)(ws + WS_CSC);
    LAS unsigned char* wb = c.lds + 32768 + c.wave * 12288;
    LAS unsigned char* hq = wb; LAS unsigned* lst = (LAS unsigned*)(wb + 8192); LAS int* acc = (LAS int*)(wb + 10240); LAS float* accf = (LAS float*)(wb + 10240);
    const int kg = c.lane >> 4, ncol = c.lane & 15, rho = ncol >> 2, kap = ncol & 3;
#pragma unroll 1
    for (int hf = 0; hf < 2; ++hf) {
        const int tb4 = 64 * c.vcu + 8 * c.wave + 4 * hf;
        int e0[4], e1[4]; float shs[4];
#pragma unroll
        for (int jj = 0; jj < 4; ++jj) { e0[jj] = IDX[(size_t)(tb4 + jj) * 128 + c.lane]; e1[jj] = IDX[(size_t)(tb4 + jj) * 128 + 64 + c.lane]; }
        {
            v2u hraw[4][8];
#pragma unroll
            for (int jj = 0; jj < 4; ++jj) {
#pragma unroll
                for (int j = 0; j < 8; ++j) hraw[jj][j] = __builtin_nontemporal_load((const v2u*)(X1 + (size_t)(tb4 + jj) * D + 256 * j + 4 * c.lane)); }
#pragma unroll
            for (int jj = 0; jj < 4; ++jj) {
                float hf32[32]; float am = 0.f, ssx = 0.f;
#pragma unroll
                for (int j = 0; j < 8; ++j) { hf32[4 * j] = bflo(hraw[jj][j].x); hf32[4 * j + 1] = bfhi(hraw[jj][j].x); hf32[4 * j + 2] = bflo(hraw[jj][j].y); hf32[4 * j + 3] = bfhi(hraw[jj][j].y); }
#pragma unroll
                for (int k = 0; k < 32; ++k) ssx += hf32[k] * hf32[k];
                const float rstd2 = 1.0f / sqrtf(wave_sum(ssx) * (1.0f / D) + NORM_EPS);
#pragma unroll
                for (int j = 0; j < 8; ++j) { const f32x4 av = *(const LAS f32x4*)(A2 + 256 * j + 4 * c.lane), bv = *(const LAS f32x4*)(B2 + 256 * j + 4 * c.lane);
#pragma unroll
                    for (int e = 0; e < 4; ++e) hf32[4 * j + e] = hf32[4 * j + e] * rstd2 * av[e] + bv[e]; }
#pragma unroll
                for (int k = 0; k < 32; ++k) am = fmaxf(am, fabsf(hf32[k]));
                am = wave_max(am);
                const float inv = (am > 0.f) ? 224.0f / am : 0.f;
                unsigned W[8];
#pragma unroll
                for (int w = 0; w < 8; ++w) { const int j0 = 2 * (w >> 1), e0_ = 2 * (w & 1);
                    int pk = __builtin_amdgcn_cvt_pk_fp8_f32(hf32[4 * j0 + e0_] * inv, hf32[4 * (j0 + 1) + e0_] * inv, 0, false);
                    pk = __builtin_amdgcn_cvt_pk_fp8_f32(hf32[4 * j0 + e0_ + 1] * inv, hf32[4 * (j0 + 1) + e0_ + 1] * inv, pk, true);
                    W[w] = (unsigned)pk; }
                { LAS unsigned char* hp = hq + jj * 2048 + c.lane * 32;
                  *(LAS v4u*)hp = (v4u){W[0], W[1], W[2], W[3]}; *(LAS v4u*)(hp + 16) = (v4u){W[4], W[5], W[6], W[7]}; }
                shs[jj] = am * (1.0f / 224.0f);
            }
        }
        acc[c.lane] = 0;
        LDS_WAIT();
        int pos[8];
#pragma unroll
        for (int jj = 0; jj < 4; ++jj) { pos[2 * jj] = __hip_atomic_fetch_add(acc + (e0[jj] >> 8), 1, __ATOMIC_RELAXED, __HIP_MEMORY_SCOPE_WORKGROUP);
                                         pos[2 * jj + 1] = __hip_atomic_fetch_add(acc + (e1[jj] >> 8), 1, __ATOMIC_RELAXED, __HIP_MEMORY_SCOPE_WORKGROUP); }
        LDS_WAIT();
        { int cnt = acc[c.lane], inc = cnt;
#pragma unroll
          for (int o = 1; o < 64; o <<= 1) { const int up = sh_idx(inc, c.lane - o); inc += (c.lane >= o) ? up : 0; }
          LDS_WAIT(); acc[64 + c.lane] = inc - cnt; }
        LDS_WAIT();
#pragma unroll
        for (int jj = 0; jj < 4; ++jj) {
            lst[acc[64 + (e0[jj] >> 8)] + pos[2 * jj]] = ((unsigned)e0[jj] << 10) | ((unsigned)jj << 7) | (unsigned)c.lane;
            lst[acc[64 + (e1[jj] >> 8)] + pos[2 * jj + 1]] = ((unsigned)e1[jj] << 10) | ((unsigned)jj << 7) | (unsigned)(64 + c.lane);
        }
        LDS_WAIT();
        v8i Bp[4];
#pragma unroll
        for (int s4 = 0; s4 < 4; ++s4) { const LAS unsigned char* bp = hq + rho * 2048 + (16 * s4 + 4 * (kg >> 1) + kap) * 32 + (kg & 1) * 16;
            const v4u lo = *(const LAS v4u*)bp, hi = *(const LAS v4u*)(bp + 8 * 32);
            Bp[s4] = (v8i){(int)lo.x, (int)lo.y, (int)lo.z, (int)lo.w, (int)hi.x, (int)hi.y, (int)hi.z, (int)hi.w}; }
        const unsigned lane_off = 64u * (unsigned)kg + 16u * (unsigned)kap;
        v4u r[16];
#pragma unroll
        for (int G = 0; G < 4; ++G) { const unsigned vo = (lst[4 * G + rho] & ~1023u) + lane_off;
#pragma unroll
            for (int s4 = 0; s4 < 4; ++s4) r[4 * G + s4] = *(const v4u*)(PU + vo + 256 * s4); }
#pragma unroll 1
        for (int m = 0; m < 32; ++m) {
#pragma unroll
            for (int G = 0; G < 4; ++G) {
                const unsigned von = (lst[((16 * (m + 1)) & 511) + 4 * G + rho] & ~1023u) + lane_off;
                const unsigned erow = lst[16 * m + 4 * G + kg];
                f32x4 cacc = {0.f, 0.f, 0.f, 0.f};
#pragma unroll
                for (int s4 = 0; s4 < 4; ++s4) {
                    v8i av; av[0] = (int)r[4 * G + s4].x; av[1] = (int)r[4 * G + s4].y; av[2] = (int)r[4 * G + s4].z; av[3] = (int)r[4 * G + s4].w; av[4] = 0; av[5] = 0; av[6] = 0; av[7] = 0;
                    cacc = __builtin_amdgcn_mfma_scale_f32_16x16x128_f8f6f4(av, Bp[s4], cacc, 4, 0, 0, 0x7f7f7f7f, 0, 0x7f7f7f7f);
                }
                SCHED_FENCE();
#pragma unroll
                for (int s4 = 0; s4 < 4; ++s4) r[4 * G + s4] = *(const v4u*)(PU + von + 256 * s4);
                SCHED_FENCE();
                float v = (kap == 0) ? cacc[0] : (kap == 1) ? cacc[1] : (kap == 2) ? cacc[2] : cacc[3];
                v += SXOR(v, 1, c.lane); v += SXOR(v, 2, c.lane);
                const unsigned tk = (erow >> 7) & 3u;
                if (kap == 0 && (unsigned)rho == tk) accf[tk * 128 + (erow & 127u)] = v;
            }
        }
        LDS_WAIT();
        float gg0[4], gg1[4], su0[4], su1[4], sv0[4], sv1[4];
#pragma unroll
        for (int jj = 0; jj < 4; ++jj) { const int t = tb4 + jj;
            gg0[jj] = GATE[(size_t)t * 128 + c.lane]; gg1[jj] = GATE[(size_t)t * 128 + 64 + c.lane];
            su0[jj] = SU[e0[jj]]; su1[jj] = SU[e1[jj]]; sv0[jj] = SV[e0[jj]]; sv1[jj] = SV[e1[jj]]; }
#pragma unroll
        for (int jj = 0; jj < 4; ++jj) { const int t = tb4 + jj;
            const float a0 = accf[jj * 128 + c.lane] * su0[jj] * shs[jj], a1 = accf[jj * 128 + 64 + c.lane] * su1[jj] * shs[jj];
            const float c0 = 0.5f * a0 * (1.0f + erff(a0 * 0.70710678118654752f)) * gg0[jj] * sv0[jj];
            const float c1 = 0.5f * a1 * (1.0f + erff(a1 * 0.70710678118654752f)) * gg1[jj] * sv1[jj];
            const float cmx = wave_max(fmaxf(fabsf(c0), fabsf(c1)));
#if V_MFMA
            const float cinv = (cmx > 0.f) ? 224.0f / cmx : 0.f;
            ((float*)TQ)[(size_t)t * 128 + c.lane] = c0 * cinv; ((float*)TQ)[(size_t)t * 128 + 64 + c.lane] = c1 * cinv;
            if (c.lane == 0) { CSC[(size_t)t * 2] = cmx * (1.0f / 224.0f); CSC[(size_t)t * 2 + 1] = 0.f; }
#else
            const float cinv = (cmx > 0.f) ? 127.0f / cmx : 0.f, csc = cmx * (1.0f / 127.0f);
            const int q0 = __float2int_rn(c0 * cinv), q1 = __float2int_rn(c1 * cinv);
            const int cqs = wave_sum_i(q0 + q1);
            const unsigned b0_ = (unsigned)q0 & 0xffu, b1_ = (unsigned)q1 & 0xffu;
            const int t0 = (int)(b0_ | (sh_idx(b0_, c.lane + 1) << 8) | (sh_idx(b0_, c.lane + 2) << 16) | (sh_idx(b0_, c.lane + 3) << 24));
            const int t1 = (int)(b1_ | (sh_idx(b1_, c.lane + 1) << 8) | (sh_idx(b1_, c.lane + 2) << 16) | (sh_idx(b1_, c.lane + 3) << 24));
            TQ[(size_t)t * 128 + c.lane] = t0; TQ[(size_t)t * 128 + 64 + c.lane] = t1;
            if (c.lane == 0) { CSC[(size_t)t * 2] = csc; CSC[(size_t)t * 2 + 1] = (float)cqs; }
#endif
        }
        LDS_WAIT();
    }
}
__device__ __forceinline__ void phase_peer4_v_mfma(const Ctx& c, const float* final_g, float* out, unsigned char* ws) {
    const bf16* X1 = (const bf16*)(ws + WS_X1B);
    const unsigned char* PV = ws + WS_PV;
    const int* IDX = (const int*)(ws + WS_IDX); const float* CF = (const float*)(ws + WS_TQ); const float* CSC = (const float*)(ws + WS_CSC); const float* MODF = (const float*)(ws + WS_MODF);
    LAS float* G2 = (LAS float*)c.lds; LAS float* FG = G2 + D;
    const int b = c.vcu >> 7;
    { const int j = 4 * c.tid; *(LAS f32x4*)(G2 + j) = *(const f32x4*)(MODF + (size_t)b * NMOD + 5 * D + j); *(LAS f32x4*)(FG + j) = *(const f32x4*)(final_g + j); }
    __syncthreads();
    const int n = c.lane & 15, g = c.lane >> 4;
    const int tbase = 64 * c.vcu + 8 * c.wave;
    const unsigned nb8 = 8u * (unsigned)n;
    const int F0 = 256 * (4 * (n & 1) + 2 * (g >> 1)) + 4 * (n >> 1) + 2 * (g & 1);
    int e0n = IDX[(size_t)tbase * 128 + c.lane], e1n = IDX[(size_t)tbase * 128 + 64 + c.lane];
    float cf0n = CF[(size_t)tbase * 128 + c.lane], cf1n = CF[(size_t)tbase * 128 + 64 + c.lane];
    v2u br[2][8][2];
#pragma unroll
    for (int bf = 0; bf < 2; ++bf) {
        const unsigned o0 = ((unsigned)sh_idx(e0n, 8 * bf + 2 * g) << 10) + nb8, o1 = ((unsigned)sh_idx(e0n, 8 * bf + 2 * g + 1) << 10) + nb8;
#pragma unroll
        for (int s8 = 0; s8 < 8; ++s8) { br[bf][s8][0] = *(const v2u*)(PV + o0 + 128 * s8); br[bf][s8][1] = *(const v2u*)(PV + o1 + 128 * s8); }
    }
#pragma unroll 1
    for (int i = 0; i < 8; ++i) {
        const int t = tbase + i, tn = tbase + ((i + 1) & 7);
        const int e0 = e0n, e1 = e1n; const float cf0 = cf0n, cf1 = cf1n;
        const float csc = CSC[(size_t)t * 2];
        e0n = IDX[(size_t)tn * 128 + c.lane]; e1n = IDX[(size_t)tn * 128 + 64 + c.lane];
        cf0n = CF[(size_t)tn * 128 + c.lane]; cf1n = CF[(size_t)tn * 128 + 64 + c.lane];
        f32x4 C[8];
#pragma unroll
        for (int s8 = 0; s8 < 8; ++s8) C[s8] = (f32x4){0.f, 0.f, 0.f, 0.f};
#pragma unroll 1
        for (int gp = 0; gp < 8; ++gp) {
#pragma unroll
            for (int bf = 0; bf < 2; ++bf) {
                const int grp = 2 * gp + bf;
                const float cfs = (gp < 4) ? cf0 : cf1;
                const float ca = sh_idx(cfs, (8 * grp + g) & 63), cb = sh_idx(cfs, (8 * grp + 4 + g) & 63);
                const unsigned pk = (unsigned)__builtin_amdgcn_cvt_pk_fp8_f32(ca, cb, 0, false);
                const unsigned wlo = (pk & 0xffu) << (8 * (n & 3)), whi = ((pk >> 8) & 0xffu) << (8 * (n & 3));
                const int q = n >> 2;
                const v8i av = {(int)(q == 0 ? wlo : 0u), (int)(q == 1 ? wlo : 0u), (int)(q == 2 ? wlo : 0u), (int)(q == 3 ? wlo : 0u),
                                (int)(q == 0 ? whi : 0u), (int)(q == 1 ? whi : 0u), (int)(q == 2 ? whi : 0u), (int)(q == 3 ? whi : 0u)};
#pragma unroll
                for (int s8 = 0; s8 < 8; ++s8) {
                    v8i bv; bv[0] = (int)br[bf][s8][0].x; bv[1] = (int)br[bf][s8][0].y; bv[2] = (int)br[bf][s8][1].x; bv[3] = (int)br[bf][s8][1].y; bv[4] = 0; bv[5] = 0; bv[6] = 0; bv[7] = 0;
                    C[s8] = __builtin_amdgcn_mfma_scale_f32_16x16x128_f8f6f4(av, bv, C[s8], 0, 4, 0, 0x7f7f7f7f, 0, 0x7f7f7f7f);
                }
                SCHED_FENCE();
                {
                    const int gn = grp + 2;
                    const int es = (gn < 8) ? e0 : ((gn < 16) ? e1 : e0n);
                    const unsigned o0 = ((unsigned)sh_idx(es, (8 * gn + 2 * g) & 63) << 10) + nb8, o1 = ((unsigned)sh_idx(es, (8 * gn + 2 * g + 1) & 63) << 10) + nb8;
#pragma unroll
                    for (int s8 = 0; s8 < 8; ++s8) { br[bf][s8][0] = *(const v2u*)(PV + o0 + 128 * s8); br[bf][s8][1] = *(const v2u*)(PV + o1 + 128 * s8); }
                }
                SCHED_FENCE();
            }
        }
        const bf16* xr = X1 + (size_t)t * D + F0; float* orow = out + (size_t)t * D + F0;
        float ss = 0.f;
#pragma unroll
        for (int s8 = 0; s8 < 8; ++s8) {
            const unsigned xa = __builtin_nontemporal_load((const unsigned*)(xr + 32 * s8)), xb = __builtin_nontemporal_load((const unsigned*)(xr + 256 + 32 * s8));
            const f32x2 ga = *(const LAS f32x2*)(G2 + F0 + 32 * s8), gb = *(const LAS f32x2*)(G2 + F0 + 256 + 32 * s8);
            const float v0 = bflo(xa) + ga[0] * (csc * C[s8][0]), v2 = bfhi(xa) + ga[1] * (csc * C[s8][2]);
            const float v1 = bflo(xb) + gb[0] * (csc * C[s8][1]), v3 = bfhi(xb) + gb[1] * (csc * C[s8][3]);
            C[s8] = (f32x4){v0, v1, v2, v3}; ss += (v0 * v0 + v1 * v1) + (v2 * v2 + v3 * v3);
        }
        const float rstd = 1.0f / sqrtf(wave_sum(ss) * (1.0f / D) + NORM_EPS);
#pragma unroll
        for (int s8 = 0; s8 < 8; ++s8) {
            const f32x2 fa = *(const LAS f32x2*)(FG + F0 + 32 * s8), fb = *(const LAS f32x2*)(FG + F0 + 256 + 32 * s8);
            const f32x2 oa = {C[s8][0] * rstd * fa[0], C[s8][2] * rstd * fa[1]}, ob = {C[s8][1] * rstd * fb[0], C[s8][3] * rstd * fb[1]};
            __builtin_nontemporal_store(oa, (f32x2*)(orow + 32 * s8)); __builtin_nontemporal_store(ob, (f32x2*)(orow + 256 + 32 * s8));
        }
    }
}
__device__ __forceinline__ void phase_peer4_v_sorted(const Ctx& c, const float* final_g, float* out, unsigned char* ws) {
    const bf16* X1 = (const bf16*)(ws + WS_X1B);
    const unsigned char* PV = ws + WS_PV;
    const int* IDX = (const int*)(ws + WS_IDX); const float* CF = (const float*)(ws + WS_TQ); const float* CSC = (const float*)(ws + WS_CSC); const float* MODF = (const float*)(ws + WS_MODF);
    LAS float* G2 = (LAS float*)c.lds; LAS float* FG = G2 + D;
    const int b = c.vcu >> 7;
    { const int j = 4 * c.tid; *(LAS f32x4*)(G2 + j) = *(const f32x4*)(MODF + (size_t)b * NMOD + 5 * D + j); *(LAS f32x4*)(FG + j) = *(const f32x4*)(final_g + j); }
    __syncthreads();
    LAS unsigned char* wb = c.lds + 32768 + c.wave * 12288;
    LAS v2u* lst2 = (LAS v2u*)wb; LAS int* hist = (LAS int*)(wb + 4096);
    const int n = c.lane & 15, g = c.lane >> 4;
    const unsigned nb16 = 16u * (unsigned)n;
    const int F0 = 512 * (g >> 1) + 4 * n + 2 * (g & 1);
    const int q4 = n >> 2, sh8 = 8 * (n & 3);
#pragma unroll 1
    for (int hf = 0; hf < 2; ++hf) {
        const int tb4 = 64 * c.vcu + 8 * c.wave + 4 * hf;
        {
            int e0[4], e1[4]; float w0[4], w1[4];
#pragma unroll
            for (int jj = 0; jj < 4; ++jj) { const size_t o = (size_t)(tb4 + jj) * 128 + c.lane; e0[jj] = IDX[o]; e1[jj] = IDX[o + 64]; w0[jj] = CF[o]; w1[jj] = CF[o + 64]; }
            hist[c.lane] = 0;
            LDS_WAIT();
            int pos[8];
#pragma unroll
            for (int jj = 0; jj < 4; ++jj) { pos[2 * jj] = __hip_atomic_fetch_add(hist + ((e0[jj] >> V_BSH) * 4 + jj), 1, __ATOMIC_RELAXED, __HIP_MEMORY_SCOPE_WORKGROUP);
                                             pos[2 * jj + 1] = __hip_atomic_fetch_add(hist + ((e1[jj] >> V_BSH) * 4 + jj), 1, __ATOMIC_RELAXED, __HIP_MEMORY_SCOPE_WORKGROUP); }
            LDS_WAIT();
            { int cnt = hist[c.lane], inc = cnt;
#pragma unroll
              for (int o = 1; o < 64; o <<= 1) { const int up = sh_idx(inc, c.lane - o); inc += (c.lane >= o) ? up : 0; }
              LDS_WAIT(); hist[64 + c.lane] = inc - cnt; }
            LDS_WAIT();
#pragma unroll
            for (int jj = 0; jj < 4; ++jj) {
                lst2[hist[64 + (e0[jj] >> V_BSH) * 4 + jj] + pos[2 * jj]] = (v2u){((unsigned)e0[jj] << 2) | (unsigned)jj, __float_as_uint(w0[jj])};
                lst2[hist[64 + (e1[jj] >> V_BSH) * 4 + jj] + pos[2 * jj + 1]] = (v2u){((unsigned)e1[jj] << 2) | (unsigned)jj, __float_as_uint(w1[jj])};
            }
            LDS_WAIT();
        }
        f32x4 C[4][8];
#pragma unroll
        for (int jj = 0; jj < 4; ++jj)
#pragma unroll
            for (int s8 = 0; s8 < 8; ++s8) C[jj][s8] = (f32x4){0.f, 0.f, 0.f, 0.f};
        v4u br[2][4][2];
#pragma unroll
        for (int bf = 0; bf < 2; ++bf) {
            const v4u qe = *(const LAS v4u*)(lst2 + 8 * bf + 2 * g);
            const unsigned o0 = ((qe.x >> 2) << 10) + nb16, o1 = ((qe.z >> 2) << 10) + nb16;
#pragma unroll
            for (int s4 = 0; s4 < 4; ++s4) { br[bf][s4][0] = *(const v4u*)(PV + o0 + 256 * s4); br[bf][s4][1] = *(const v4u*)(PV + o1 + 256 * s4); }
        }
#pragma unroll 1
        for (int gp = 0; gp < 32; ++gp) {
#pragma unroll
            for (int bf = 0; bf < 2; ++bf) {
                const int G = 2 * gp + bf;
                const v2u ea = lst2[8 * G + g], eb = lst2[8 * G + 4 + g];
                const unsigned tokA = ea.x & 3u, tokB = eb.x & 3u; const float cA = __uint_as_float(ea.y), cB = __uint_as_float(eb.y);
                const v4u qn = *(const LAS v4u*)(lst2 + ((8 * (G + 2)) & 511) + 2 * g);
#pragma unroll
                for (int jj = 0; jj < 4; ++jj) {
                    const bool hasA = (tokA == (unsigned)jj), hasB = (tokB == (unsigned)jj);
                    if (__builtin_amdgcn_ballot_w64(hasA || hasB) != 0ull) {
                        const unsigned pk = (unsigned)__builtin_amdgcn_cvt_pk_fp8_f32(hasA ? cA : 0.f, hasB ? cB : 0.f, 0, false);
                        const unsigned wlo = (pk & 0xffu) << sh8, whi = ((pk >> 8) & 0xffu) << sh8;
                        const v8i av = {(int)(q4 == 0 ? wlo : 0u), (int)(q4 == 1 ? wlo : 0u), (int)(q4 == 2 ? wlo : 0u), (int)(q4 == 3 ? wlo : 0u),
                                        (int)(q4 == 0 ? whi : 0u), (int)(q4 == 1 ? whi : 0u), (int)(q4 == 2 ? whi : 0u), (int)(q4 == 3 ? whi : 0u)};
#pragma unroll
                        for (int s8 = 0; s8 < 8; ++s8) {
                            const v4u r0 = br[bf][s8 >> 1][0], r1 = br[bf][s8 >> 1][1];
                            v8i bv; bv[0] = (int)((s8 & 1) ? r0.z : r0.x); bv[1] = (int)((s8 & 1) ? r0.w : r0.y); bv[2] = (int)((s8 & 1) ? r1.z : r1.x); bv[3] = (int)((s8 & 1) ? r1.w : r1.y); bv[4] = 0; bv[5] = 0; bv[6] = 0; bv[7] = 0;
                            C[jj][s8] = __builtin_amdgcn_mfma_scale_f32_16x16x128_f8f6f4(av, bv, C[jj][s8], 0, 4, 0, 0x7f7f7f7f, 0, 0x7f7f7f7f);
                        }
                    }
                }
                SCHED_FENCE();
                { const unsigned o0 = ((qn.x >> 2) << 10) + nb16, o1 = ((qn.z >> 2) << 10) + nb16;
#pragma unroll
                  for (int s4 = 0; s4 < 4; ++s4) { br[bf][s4][0] = *(const v4u*)(PV + o0 + 256 * s4); br[bf][s4][1] = *(const v4u*)(PV + o1 + 256 * s4); } }
                SCHED_FENCE();
            }
        }
#pragma unroll
        for (int jj = 0; jj < 4; ++jj) {
            const int t = tb4 + jj;
            const float csc = CSC[(size_t)t * 2];
            const bf16* xr = X1 + (size_t)t * D + F0; float* orow = out + (size_t)t * D + F0;
            float ss = 0.f;
#pragma unroll
            for (int s8 = 0; s8 < 8; ++s8) {
                const unsigned xa = __builtin_nontemporal_load((const unsigned*)(xr + (1024 * (s8 & 1) + 64 * (s8 >> 1)))), xb = __builtin_nontemporal_load((const unsigned*)(xr + 256 + (1024 * (s8 & 1) + 64 * (s8 >> 1))));
                const f32x2 ga = *(const LAS f32x2*)(G2 + F0 + (1024 * (s8 & 1) + 64 * (s8 >> 1))), gb = *(const LAS f32x2*)(G2 + F0 + 256 + (1024 * (s8 & 1) + 64 * (s8 >> 1)));
                const float v0 = bflo(xa) + ga[0] * (csc * C[jj][s8][0]), v2 = bfhi(xa) + ga[1] * (csc * C[jj][s8][2]);
                const float v1 = bflo(xb) + gb[0] * (csc * C[jj][s8][1]), v3 = bfhi(xb) + gb[1] * (csc * C[jj][s8][3]);
                C[jj][s8] = (f32x4){v0, v1, v2, v3}; ss += (v0 * v0 + v1 * v1) + (v2 * v2 + v3 * v3);
            }
            const float rstd = 1.0f / sqrtf(wave_sum(ss) * (1.0f / D) + NORM_EPS);
#pragma unroll
            for (int s8 = 0; s8 < 8; ++s8) {
                const f32x2 fa = *(const LAS f32x2*)(FG + F0 + (1024 * (s8 & 1) + 64 * (s8 >> 1))), fb = *(const LAS f32x2*)(FG + F0 + 256 + (1024 * (s8 & 1) + 64 * (s8 >> 1)));
                const f32x2 oa = {C[jj][s8][0] * rstd * fa[0], C[jj][s8][2] * rstd * fa[1]}, ob = {C[jj][s8][1] * rstd * fb[0], C[jj][s8][3] * rstd * fb[1]};
                __builtin_nontemporal_store(oa, (f32x2*)(orow + (1024 * (s8 & 1) + 64 * (s8 >> 1)))); __builtin_nontemporal_store(ob, (f32x2*)(orow + 256 + (1024 * (s8 & 1) + 64 * (s8 >> 1))));
            }
        }
        LDS_WAIT();
    }
}
__device__ __forceinline__ void phase_peer4_v(const Ctx& c, const float* final_g, float* out, unsigned char* ws) {
    const bf16* X1 = (const bf16*)(ws + WS_X1B);
    const unsigned char* PV = ws + WS_PV;
    const int* IDX = (const int*)(ws + WS_IDX); const int* TQ = (const int*)(ws + WS_TQ); const float* CSC = (const float*)(ws + WS_CSC); const float* MODF = (const float*)(ws + WS_MODF);
    LAS float* G2 = (LAS float*)c.lds; LAS float* FG = G2 + D;
    const int b = c.vcu >> 7;
    { const int j = 4 * c.tid; *(LAS f32x4*)(G2 + j) = *(const f32x4*)(MODF + (size_t)b * NMOD + 5 * D + j); *(LAS f32x4*)(FG + j) = *(const f32x4*)(final_g + j); }
    __syncthreads();
    const int tbase = 64 * c.vcu + 8 * c.wave;
    int e0n = IDX[(size_t)tbase * 128 + c.lane], e1n = IDX[(size_t)tbase * 128 + 64 + c.lane];
    int t0n = TQ[(size_t)tbase * 128 + c.lane], t1n = TQ[(size_t)tbase * 128 + 64 + c.lane];
    v4u r[16];
#pragma unroll
    for (int q = 0; q < 16; ++q) r[q] = ld_row4(PV, __builtin_amdgcn_readlane(e0n, q), c.lane);
#pragma unroll 1
    for (int i = (DUP & 2048) ? -8 : 0; i < 8; ++i) {
        const int t = tbase + (i & 7), tn = tbase + ((i + 1) & 7);
        const int e0 = e0n, e1 = e1n, t0 = t0n, t1 = t1n;
        const float csc = CSC[(size_t)t * 2], cqsf = CSC[(size_t)t * 2 + 1];
        e0n = IDX[(size_t)tn * 128 + c.lane]; e1n = IDX[(size_t)tn * 128 + 64 + c.lane];
        t0n = TQ[(size_t)tn * 128 + c.lane]; t1n = TQ[(size_t)tn * 128 + 64 + c.lane];
        int y[32];
#pragma unroll
        for (int q = 0; q < 32; ++q) y[q] = 0;
#pragma unroll 1
        for (int m = 0; m < 8; ++m) {
            const int esrc = (m + 1 < 4) ? e0 : ((m + 1 < 8) ? e1 : e0n);
            const int tsrc = (m < 4) ? t0 : t1;
#pragma unroll
            for (int gq = 0; gq < 4; ++gq) {
                const int cq4 = __builtin_amdgcn_readlane(tsrc, (16 * m + 4 * gq) & 63);
                vacc4(y, r[4 * gq], r[4 * gq + 1], r[4 * gq + 2], r[4 * gq + 3], cq4);
                SCHED_FENCE();
#pragma unroll
                for (int q = 0; q < 4; ++q) r[4 * gq + q] = ld_row4(PV, __builtin_amdgcn_readlane(esrc, (16 * (m + 1) + 4 * gq + q) & 63), c.lane);
                SCHED_FENCE();
            }
        }
        const bf16* xr = X1 + (size_t)t * D + 4 * c.lane; float* orow = ((DUP & 2048) && i < 0 ? (float*)(ws + WS_HC) : out) + (size_t)t * D + 4 * c.lane;
        float yf[32]; float ss = 0.f;
#pragma unroll
        for (int j = 0; j < 8; ++j) {
            const v2u xw = __builtin_nontemporal_load((const v2u*)(xr + 256 * j)); const f32x4 xa = {bflo(xw.x), bfhi(xw.x), bflo(xw.y), bfhi(xw.y)};
            const f32x4 ga = *(const LAS f32x4*)(G2 + 256 * j + 4 * c.lane);
#pragma unroll
            for (int e = 0; e < 4; ++e) {
                const int d = j >> 1;
                const float yv = (j & 1) ? (float)((y[8 * d + 4 + e] - y[8 * d + e]) >> 4) + 0.5f * cqsf : (float)y[8 * d + e] - 7.5f * cqsf;
                const float v = xa[e] + ga[e] * (csc * yv); yf[4 * j + e] = v; ss += v * v; }
        }
        const float rstd = 1.0f / sqrtf(wave_sum(ss) * (1.0f / D) + NORM_EPS);
#pragma unroll
        for (int j = 0; j < 8; ++j) {
            const f32x4 fa = *(const LAS f32x4*)(FG + 256 * j + 4 * c.lane);
            f32x4 o;
#pragma unroll
            for (int e = 0; e < 4; ++e) o[e] = yf[4 * j + e] * rstd * fa[e];
            __builtin_nontemporal_store(o, (f32x4*)(orow + 256 * j));
        }
    }
}

struct Args { const float* in[16]; float* out; unsigned char* ws; };
__device__ __forceinline__ int lane_id() { unsigned ones = ~0u; asm volatile("" : "+s"(ones)); return (int)__builtin_amdgcn_mbcnt_hi(ones, __builtin_amdgcn_mbcnt_lo(ones, 0u)); }
__global__ void __launch_bounds__(NTHREADS, 2) fwd_kernel(Args args_unused) {
    extern __shared__ __attribute__((aligned(16))) unsigned char lds_raw[];
    const int wave_s = __builtin_amdgcn_readfirstlane((int)(threadIdx.x >> 6));
#define CAS __attribute__((address_space(4)))
#define KARGS() const CAS unsigned char* ka_ = (const CAS unsigned char*)__builtin_amdgcn_kernarg_segment_ptr(); asm volatile("" : "+s"(ka_));
#define ARG_IN(i) (*(const float* const CAS*)(ka_ + 8 * (i)))
#define ARG_OUT() (*(float* const CAS*)(ka_ + 128))
#define ARG_WS() (*(unsigned char* const CAS*)(ka_ + 136))
#define MKCTX() KARGS(); unsigned char* ws = ARG_WS(); Ctx c; { c.lds = (LAS unsigned char*)lds_raw; int l_ = lane_id(); asm volatile("" : "+v"(l_)); c.lane = l_; c.wave = wave_s; c.tid = wave_s * 64 + l_; \
    c.G = 256; { const int bx = blockIdx.x; c.vcu = (bx % 8) * 32 + bx / 8; } c.gw = c.vcu * NWAVES + c.wave; c.ngw = 256 * NWAVES; }
#define IS_T0() (wave_s == 0 && lane_id() == 0)
#define GRID_BAR() xcd_barrier(bar, IS_T0())
    LAS unsigned char* const ldsb = (LAS unsigned char*)lds_raw;
    volatile LAS unsigned* misc = (volatile LAS unsigned*)(ldsb + MISC_OFF);
    if (threadIdx.x < 4) misc[threadIdx.x] = 0u;
    __syncthreads();
    XcdBarrier bar;
    { KARGS(); bar = xcd_barrier_post((unsigned*)(ARG_WS() + WS_CTL), misc, IS_T0()); }
    if (gridDim.x != 256) return;

    { MKCTX(); const float* inp[16];
#pragma unroll
      for (int i = 0; i < 16; ++i) inp[i] = ARG_IN(i);
      phase0(c, inp, ws); if (DUP & 1) phase0(c, inp, ws); }
    GRID_BAR();
    { MKCTX(); phase_rows<true>(c, ARG_IN(0), nullptr, ARG_IN(5), ARG_IN(4), (const int*)ARG_IN(2), ws, 0, 1, ARG_IN(10), ARG_IN(11)); if (DUP & 2) phase_rows<true>(c, ARG_IN(0), nullptr, ARG_IN(5), ARG_IN(4), (const int*)ARG_IN(2), ws, 0, 1, ARG_IN(10), ARG_IN(11)); }
    GRID_BAR();
    { KARGS(); unsigned char* ws = ARG_WS();
#if P2_I8
      pg8::Gemm g{(const bf16*)(ws + WS_H8), (const bf16*)(ws + WS_W8), T, INW, D / 2, D / 2, D / 2, 0}; pg8::StaticOrder S; S.init(T, INW, 256, (int)blockIdx.x);
#else
      pg8::Gemm g{(const bf16*)(ws + WS_HB), (const bf16*)(ws + WS_WTIN), T, INW, D, D, D, 0}; pg8::StaticOrder S; S.init(T, INW, 256, (int)blockIdx.x);
#endif
      Epi1 E{(bf16*)(ws + WS_Q), (const float*)(ws + WS_CS), (const float*)(ws + WS_SA), (const float*)(ws + WS_SB)};
      int nrep_ = (DUP & 4) ? 2 : 1; asm volatile("" : "+s"(nrep_));
#pragma unroll 1
      for (int rep_ = 0; rep_ < nrep_; ++rep_) { pg8::gemm_phase<Epi1, pg8::StaticOrder, false, P2_I8 ? 2 : 0>(ldsb, g, S, E, nullptr, wave_s); } }
    GRID_BAR();
#if P5_I8
    { KARGS(); unsigned char* ws = ARG_WS();
      pg8::StaticOrder S; S.init(T, PW, 256, (int)blockIdx.x); pg8::Unit u0; S.next(0, u0);
      { MKCTX(); phase_poolr(c, ws, 16 * u0.pm + u0.pn, 4, 4); }
      pg8::Gemm g{(const bf16*)(ws + WS_RB), (const bf16*)(ws + WS_WTPOOL), T, PW, 256, PW, 256, 512};
      EpiPool E{(bf16*)(ws + WS_HC), ARG_IN(8)};
      pg8::gemm_phase<EpiPool, pg8::StaticOrder, false>(ldsb, g, S, E, nullptr, wave_s); }
#else
    { MKCTX(); phase_poolr(c, ws, c.vcu, c.G, (1024 - c.vcu + c.G - 1) / c.G); if (DUP & 256) phase_poolr(c, ws, c.vcu, c.G, (1024 - c.vcu + c.G - 1) / c.G); }
#endif
#if ATTN_SIMPLE
    { MKCTX(); phase_attn_simple(c, ws); }
#else
    { MKCTX(); phase_attn_mfma(c, ws); if (DUP & 8) phase_attn_mfma(c, ws); }
#endif
    GRID_BAR();
#if !ATTN_SIMPLE
#if P5_I8
    { MKCTX(); phase_combine_q(c, ws); if (DUP & 16384) phase_combine_q(c, ws); }
#else
    { MKCTX(); phase_combine(c, ws); if (DUP & 16384) phase_combine(c, ws); }
#endif
#endif
#if !P5_I8
    { KARGS(); unsigned char* ws = ARG_WS();
      pg8::Gemm g{(const bf16*)(ws + WS_RB), (const bf16*)(ws + WS_WTPOOL), T, PW, 256, PW, 256, 512}; pg8::StaticOrder S; S.init(T, PW, 256, (int)blockIdx.x);
      EpiPool E{(bf16*)(ws + WS_HC), ARG_IN(8)};
      int nrep_ = (DUP & 16) ? 2 : 1; asm volatile("" : "+s"(nrep_));
#pragma unroll 1
      for (int rep_ = 0; rep_ < nrep_; ++rep_) { pg8::gemm_phase<EpiPool, pg8::StaticOrder, false>(ldsb, g, S, E, nullptr, wave_s); } }
#endif
    GRID_BAR();
    { KARGS(); unsigned char* ws = ARG_WS();
#if P5_I8
      pg8::Gemm g{(const bf16*)(ws + WS_HC8), (const bf16*)(ws + WS_WOUT8), T, D, D / 2, D / 2, D / 2, 0}; pg8::StaticOrder S; S.init(T, D, 256, (int)blockIdx.x);
#else
      pg8::Gemm g{(const bf16*)(ws + WS_HC), (const bf16*)(ws + WS_WTOUT), T, D, D, D, D, 0}; pg8::StaticOrder S; S.init(T, D, 256, (int)blockIdx.x);
#endif
      EpiOut E{ARG_IN(0), (bf16*)(ws + WS_X1B), (const float*)(ws + WS_MODF), (float*)(ws + WS_RSQP), (const float*)(ws + WS_SA5), (const float*)(ws + WS_SB5)};
      int nrep_ = (DUP & 32) ? 2 : 1; asm volatile("" : "+s"(nrep_));
#pragma unroll 1
      for (int rep_ = 0; rep_ < nrep_; ++rep_) { pg8::gemm_phase<EpiOut, pg8::StaticOrder, false, P5_I8 ? 2 : 0>(ldsb, g, S, E, nullptr, wave_s); } }
    GRID_BAR();
    { KARGS(); unsigned char* ws = ARG_WS();
      pg8::StaticOrder S; S.init(T, D, 256, (int)blockIdx.x);
      pg8::Unit u0, u1; S.next(0, u0); S.next(1, u1);
      LAS float* rstdT = (LAS float*)(ldsb + 131072 + 256); LAS float* biasT = rstdT + 512;
      { const int l_ = lane_id(), tid_ = wave_s * 64 + l_, slot = tid_ >> 8, i_ = tid_ & 255; const pg8::Unit uu = slot ? u1 : u0;
        const float* rp = (const float*)(ws + WS_RSQP) + (size_t)(uu.pm * 256 + i_) * 32; float ssum = 0.f;
#pragma unroll
        for (int q = 0; q < 8; ++q) { const f32x4 v = *(const f32x4*)(rp + 4 * q); ssum += (v[0] + v[1]) + (v[2] + v[3]); }
        rstdT[slot * 256 + i_] = 1.0f / sqrtf(ssum * (1.0f / D) + NORM_EPS);
        const float* bp = (const float*)(ws + WS_BIASP) + (size_t)(uu.pm >= 32 ? 1 : 0) * D + uu.pn * 256 + i_; float bsum = 0.f;
#pragma unroll 8
        for (int kb = 0; kb < 32; ++kb) bsum += bp[(size_t)kb * 2 * D];
        biasT[slot * 256 + i_] = bsum; }
      __syncthreads();
      pg8::Gemm g{(const bf16*)(ws + WS_X1B), (const bf16*)(ws + WS_WQ2), T, D, D, D, D, 0, D * D * 2};
      EpiQ E{(bf16*)(ws + WS_QP), rstdT, biasT, u0.pm, u0.pn};
      int nrep_ = (DUP & 128) ? 2 : 1; asm volatile("" : "+s"(nrep_));
#pragma unroll 1
      for (int rep_ = 0; rep_ < nrep_; ++rep_) { pg8::gemm_phase<EpiQ, pg8::StaticOrder, false>(ldsb, g, S, E, nullptr, wave_s); } }
    GRID_BAR();
#if TOPK_SIMPLE
    { KARGS(); unsigned char* ws = ARG_WS();
      pg8::Gemm g{(const bf16*)(ws + WS_QP), (const bf16*)(ws + WS_SKP), T, D, 256, D, 256, 512}; pg8::StaticOrder S; S.init(T, D, 256, (int)blockIdx.x);
      EpiF E{(float*)(ws + WS_SC), D};
      pg8::gemm_phase<EpiF, pg8::StaticOrder, false>(ldsb, g, S, E, nullptr, wave_s); }
    GRID_BAR();
    { MKCTX(); phase_topk_simple(c, ws); if (DUP & 512) phase_topk_simple(c, ws); }
    GRID_BAR();
#else
    { MKCTX(); phase_scores_topk(c, ws); if (DUP & 512) phase_scores_topk(c, ws); }
    GRID_BAR();
#endif
#if PEER_BITS == 8
    { MKCTX(); phase_peer(c, ARG_OUT(), ARG_IN(15), ARG_OUT(), ws); }
#else
#if U_MFMA
    { MKCTX(); int nrep_ = (DUP & 8192) ? 2 : 1; asm volatile("" : "+s"(nrep_));
#pragma unroll 1
      for (int rep_ = 0; rep_ < nrep_; ++rep_) phase_peer4_u_mfma(c, ARG_IN(10), ws); }
#elif U_SORTED
    { MKCTX(); int nrep_ = (DUP & 8192) ? 2 : 1; asm volatile("" : "+s"(nrep_));
#pragma unroll 1
      for (int rep_ = 0; rep_ < nrep_; ++rep_) phase_peer4_u_sorted(c, ARG_IN(10), ws); }
#else
    { MKCTX(); phase_peer4_u<false>(c, ARG_IN(10), ws); }
#endif
    if (DUP & 4096) { MKCTX(); phase_peer4_u<true>(c, ARG_IN(10), ws); }
    asm volatile("s_waitcnt vmcnt(0)" ::: "memory");
#if V_MFMA && V_SORTED
    { MKCTX(); phase_peer4_v_sorted(c, ARG_IN(15), ARG_OUT(), ws); }
#elif V_MFMA
    { MKCTX(); phase_peer4_v_mfma(c, ARG_IN(15), ARG_OUT(), ws); }
#else
    { MKCTX(); phase_peer4_v(c, ARG_IN(15), ARG_OUT(), ws); }
#endif
#endif
}

extern "C" void kernel_launch(void* const* d_in, const int* in_sizes, int n_in, void* d_out, int out_size, void* d_ws, size_t ws_size, hipStream_t stream) {
    static int grid = 0;
    if (grid == 0) {
        if (n_in != 16 || in_sizes[0] != T * D || out_size != T * D || ws_size < WS_END) { fprintf(stderr, "kernel_launch: unexpected shapes (n_in %d, in0 %d, out %d, ws %zu)\n", n_in, n_in > 0 ? in_sizes[0] : -1, out_size, ws_size); grid = -1; return; }
        int dev = 0, cus = 0, per_cu = 0;
        if (hipGetDevice(&dev) != hipSuccess || hipDeviceGetAttribute(&cus, hipDeviceAttributeMultiprocessorCount, dev) != hipSuccess) { grid = -1; return; }
        if (hipFuncSetAttribute((const void*)fwd_kernel, hipFuncAttributeMaxDynamicSharedMemorySize, LDS_BYTES) != hipSuccess) { fprintf(stderr, "kernel_launch: hipFuncSetAttribute failed\n"); grid = -1; return; }
        if (hipOccupancyMaxActiveBlocksPerMultiprocessor(&per_cu, (const void*)fwd_kernel, NTHREADS, LDS_BYTES) != hipSuccess || per_cu < 1) { fprintf(stderr, "kernel_launch: occupancy query reports %d workgroups per CU\n", per_cu); }
        (void)hipGetLastError();
        grid = (cus < 256) ? cus : 256;
    }
    if (grid < 0) return;
    if (hipMemsetAsync((char*)d_ws + WS_CTL, 0, CTL_ZERO_BYTES, stream) != hipSuccess) return;
    Args a{};
    for (int i = 0; i < 16; ++i) a.in[i] = (const float*)d_in[i];
    a.out = (float*)d_out; a.ws = (unsigned char*)d_ws;
    hipLaunchKernelGGL(fwd_kernel, dim3(grid), dim3(NTHREADS), LDS_BYTES, stream, a);
}
```

```cpp
#include <hip/hip_runtime.h>
#include <cstdio>
#include <cstdint>
#ifndef ATTN_SIMPLE
#define ATTN_SIMPLE 0
#endif
#ifndef TOPK_SIMPLE
#define TOPK_SIMPLE 0
#endif
#ifndef PEER_BITS
#define PEER_BITS 4
#endif
#ifndef V_BSH
#define V_BSH 11
#endif
#ifndef V_SORTED
#define V_SORTED 1
#endif
#ifndef V_MFMA
#define V_MFMA 1
#endif
#ifndef OP_FP8
#define OP_FP8 1
#endif
#ifndef P5_I8
#define P5_I8 1
#endif
#ifndef P2_I8
#define P2_I8 1
#endif
#ifndef U_MFMA
#define U_MFMA 1
#endif
#ifndef U_SORTED
#define U_SORTED 1
#endif
#ifndef DUP
#define DUP 0
#endif
namespace pg8 {
#define PG8_LAS __attribute__((address_space(3)))
typedef unsigned short bf16_t;
typedef short bf16x8 __attribute__((ext_vector_type(8)));
typedef float f32x4 __attribute__((ext_vector_type(4)));
typedef unsigned u32x4 __attribute__((ext_vector_type(4)));
constexpr int BM = 256, BK = 64, HALF = 128, HTB = HALF * BK * 2  , STAGE_BYTES = 8 * HTB, NXCD = 8, WGM = 8;

__host__ __device__ __forceinline__ int lds_byte(int r, int c) { const int st = (r >> 4) * 2 + (c >> 5), rr = r & 15, cc = c & 31, ob = rr * 64 + cc * 2; return st * 1024 + (ob ^ (((ob >> 9) & 1) << 5)); }
__host__ __device__ __forceinline__ void stage_rc(int b, int& R, int& C) { const int st = b / 1024, sb = b % 1024, swz = sb ^ (((sb >> 9) & 1) << 5); R = (st >> 1) * 16 + swz / 64; C = (st & 1) * 32 + (swz % 64) / 2; }
__host__ __device__ __forceinline__ int perm32(int rho) { const int n = rho >> 4, i = rho & 15; return 8 * (i >> 2) + 4 * n + (i & 3); }

struct Unit { int pm, pn; };
struct Gemm { const bf16_t* A; const bf16_t* Bt; int M, N, K, lda, ldb, apn, bhalf; };

struct StaticOrder {
    int nM, nN, nwg, G, c;
    __host__ __device__ __forceinline__ void init(int M, int N, int G_, int c_) { nM = M / BM; nN = N / BM; nwg = nM * nN; G = G_; c = c_; }
    __host__ __device__ __forceinline__ bool next(int i, Unit& u) const {
        const long L = (long)i * G + c; if (L >= nwg) return false;
        int wgid = (int)L; { const int q = nwg / NXCD, r = nwg % NXCD, xcd = wgid % NXCD, off = wgid / NXCD; wgid = (xcd < r ? xcd * (q + 1) : r * (q + 1) + (xcd - r) * q) + off; }
        const int nig = WGM * nN, gid = wgid / nig, fm = gid * WGM, gsz = (nM - fm) < WGM ? (nM - fm) : WGM;
        u.pm = fm + ((wgid % nig) % gsz); u.pn = (wgid % nig) / gsz; return true;
    }
    __device__ __forceinline__ void a_ready(const Unit&) const {}
    __device__ __forceinline__ void done(const Unit&) const {}
};
struct QOrder {
    int v;
    __host__ __device__ __forceinline__ bool next(int i, Unit& u) const { if (i >= 2) return false; u.pm = 2 * (v >> 3) + i; u.pn = v & 7; return true; }
    __device__ __forceinline__ void a_ready(const Unit&) const {}
    __device__ __forceinline__ void done(const Unit&) const {}
};
__device__ __forceinline__ unsigned cvt_pk_bf16(float lo, float hi) { typedef __bf16 bf2_ __attribute__((ext_vector_type(2))); bf2_ v; v[0] = (__bf16)lo; v[1] = (__bf16)hi; return __builtin_bit_cast(unsigned, v); }
template <int MODE> __device__ __forceinline__ f32x4 mma1(bf16x8 a, bf16x8 b, f32x4 c) {
    typedef int i32x4_ __attribute__((ext_vector_type(4)));
    if constexpr (MODE == 2) return __builtin_bit_cast(f32x4, __builtin_amdgcn_mfma_i32_16x16x64_i8(__builtin_bit_cast(i32x4_, a), __builtin_bit_cast(i32x4_, b), __builtin_bit_cast(i32x4_, c), 0, 0, 0));
    else return __builtin_amdgcn_mfma_f32_16x16x32_bf16(a, b, c, 0, 0, 0);
}
template <class Epi, class Sched, bool STAMP = false, int MODE = 0>
__device__ __forceinline__ void gemm_phase(PG8_LAS unsigned char* lds, const Gemm g, const Sched& S, const Epi& E, unsigned long long* stamps, int wid_in) {
    unsigned ones_ = ~0u; asm volatile("" : "+s"(ones_)); int lane_ = (int)__builtin_amdgcn_mbcnt_hi(ones_, __builtin_amdgcn_mbcnt_lo(ones_, 0u)); asm volatile("" : "+v"(lane_));
    const int wid = __builtin_amdgcn_readfirstlane(wid_in), lane = lane_, tid = wid * 64 + lane, wr = wid >> 2, wc = wid & 3, fr = lane & 15, fq = lane >> 4;
    int K_ = g.K; asm volatile("" : "+s"(K_));
    const int K = K_, nt = K / BK;
    int ts_lo = 0, ts_hi = 0, nts = 0; const unsigned long long rt_entry = STAMP ? (unsigned long long)wall_clock64() : 0ull;
#define PG8_STAMP() do { if (STAMP && wid == 0 && nts < 64) { const unsigned long long _c = (unsigned long long)clock64(); \
        ts_lo = (lane == nts) ? (int)(unsigned)_c : ts_lo; ts_hi = (lane == nts) ? (int)(unsigned)(_c >> 32) : ts_hi; ++nts; } } while (0)
    PG8_STAMP();
    unsigned voffA[2], voffB[2];
#pragma unroll
    for (int i = 0; i < 2; ++i) { int R, C; stage_rc(tid * 16 + i * 8192, R, C); const int Rb = Epi::PERM ? ((R & ~31) + perm32(R & 31)) : R;
        voffA[i] = (unsigned)(R * g.lda + C) * 2u; voffB[i] = (unsigned)(Rb * g.ldb + C) * 2u; }
    const size_t kstep = (size_t)(BK * 2);
    const size_t hstepA = (size_t)HALF * g.lda * 2, hstepB = (size_t)HALF * g.ldb * 2;
    const size_t tstepA = 2 * hstepA, tstepB = 2 * hstepB;
    const unsigned ldsw = (unsigned)wid * 1024u;
    const int aoff = lds_byte(wr * 64 + fr, fq * 8), boff = lds_byte(wc * 32 + fr, fq * 8);
#define PG8_SA(b, h) (((b) * 2 + (h)) * HTB)
#define PG8_SB(b, h) ((4 + (b) * 2 + (h)) * HTB)
#define PG8_STAGE(bufoff, gbase, voff) do { _Pragma("unroll") for (int _i = 0; _i < 2; ++_i) \
        __builtin_amdgcn_global_load_lds((const unsigned*)((const char*)(gbase) + (voff)[_i]), (PG8_LAS unsigned*)(lds + (bufoff) + ldsw + _i * 8192), 16, 0, 0); } while (0)
#define PG8_LDA(dst, b, h) do { _Pragma("unroll") for (int m = 0; m < 4; ++m) _Pragma("unroll") for (int k = 0; k < 2; ++k) dst[m][k] = *(const PG8_LAS bf16x8*)(lds + PG8_SA(b, h) + aoff + m * 2048 + k * 1024); } while (0)
#define PG8_LDB(dst, b, h) do { _Pragma("unroll") for (int n = 0; n < 2; ++n) _Pragma("unroll") for (int k = 0; k < 2; ++k) dst[n][k] = *(const PG8_LAS bf16x8*)(lds + PG8_SB(b, h) + boff + n * 2048 + k * 1024); } while (0)
#define PG8_MMA(ai, bj, At, Bt) do { __builtin_amdgcn_s_setprio(1); _Pragma("unroll") for (int m = 0; m < 4; ++m) _Pragma("unroll") for (int n = 0; n < 2; ++n) _Pragma("unroll") for (int k = 0; k < 2; ++k) \
        acc[ai][bj][m][n] = mma1<MODE>(Bt[n][k], At[m][k], acc[ai][bj][m][n]); __builtin_amdgcn_s_setprio(0); } while (0)
#define PG8_WAIT_V(n) asm volatile("s_waitcnt vmcnt(" #n ")" ::: "memory")
#define PG8_WAIT_L(n) asm volatile("s_waitcnt lgkmcnt(" #n ")" ::: "memory")
#define PG8_BAR __builtin_amdgcn_s_barrier()
#define PG8_SCHED __builtin_amdgcn_sched_barrier(0)
    Unit cur, nxt; int ui = 0;
    if (!S.next(0, cur)) return;
    f32x4 acc[2][2][4][2];
#pragma unroll
    for (int a = 0; a < 2; ++a)
#pragma unroll
        for (int b = 0; b < 2; ++b)
#pragma unroll
            for (int m = 0; m < 4; ++m)
#pragma unroll
                for (int n = 0; n < 2; ++n) acc[a][b][m][n] = (f32x4){0.f, 0.f, 0.f, 0.f};
    bf16x8 At[4][2], B0[2][2], B1[2][2];
    const char* cA = (const char*)g.A + (size_t)cur.pm * tstepA + (size_t)cur.pn * g.apn; const char* cB = (const char*)g.Bt + (size_t)cur.pn * tstepB + ((2 * cur.pm * BM >= g.M) ? (size_t)g.bhalf : (size_t)0);
    S.a_ready(cur);
    PG8_STAGE(PG8_SB(0, 0), cB, voffB); PG8_STAGE(PG8_SA(0, 0), cA, voffA); PG8_STAGE(PG8_SB(0, 1), cB + hstepB, voffB); PG8_STAGE(PG8_SA(0, 1), cA + hstepA, voffA);
    if (wr == 1) PG8_BAR;
    PG8_WAIT_V(4); PG8_BAR;
    PG8_STAGE(PG8_SB(1, 0), cB + kstep, voffB); PG8_STAGE(PG8_SA(1, 0), cA + kstep, voffA); PG8_STAGE(PG8_SB(1, 1), cB + hstepB + kstep, voffB);
    PG8_WAIT_V(6); PG8_BAR;
    PG8_STAMP();
    for (;;) {
        const bool has_next = S.next(ui + 1, nxt);
        const char* nA = has_next ? (const char*)g.A + (size_t)nxt.pm * tstepA + (size_t)nxt.pn * g.apn : cA; const char* nB = has_next ? (const char*)g.Bt + (size_t)nxt.pn * tstepB + ((2 * nxt.pm * BM >= g.M) ? (size_t)g.bhalf : (size_t)0) : cB;
        for (int t = 0; t < nt; t += 2) {
            const bool last = (t == nt - 2);
            const char* a1 = cA + (size_t)(t + 1) * kstep;
            const char* a2 = last ? nA : cA + (size_t)(t + 2) * kstep; const char* b2 = last ? nB : cB + (size_t)(t + 2) * kstep;
            const char* a3 = a2 + kstep; const char* b3 = b2 + kstep;
            if (last && has_next) S.a_ready(nxt);
            PG8_LDB(B0, 0, 0); PG8_SCHED; PG8_LDA(At, 0, 0); PG8_STAGE(PG8_SA(1, 1), a1 + hstepA, voffA);
            PG8_WAIT_L(8); PG8_BAR; PG8_WAIT_L(0); PG8_MMA(0, 0, At, B0); PG8_BAR; PG8_SCHED;
            PG8_LDB(B1, 0, 1); PG8_STAGE(PG8_SB(0, 0), b2, voffB);
            PG8_BAR; PG8_WAIT_L(0); PG8_MMA(0, 1, At, B1); PG8_BAR;
            PG8_LDA(At, 0, 1); PG8_STAGE(PG8_SA(0, 0), a2, voffA);
            PG8_BAR; PG8_WAIT_L(0); PG8_MMA(1, 0, At, B0); PG8_BAR; PG8_SCHED;
            PG8_STAGE(PG8_SB(0, 1), b2 + hstepB, voffB);
            PG8_WAIT_V(6); PG8_BAR; PG8_MMA(1, 1, At, B1); PG8_BAR;
            PG8_LDB(B0, 1, 0); PG8_SCHED; PG8_LDA(At, 1, 0); PG8_STAGE(PG8_SA(0, 1), a2 + hstepA, voffA);
            PG8_WAIT_L(8); PG8_BAR; PG8_WAIT_L(0); PG8_MMA(0, 0, At, B0); PG8_BAR; PG8_SCHED;
            PG8_LDB(B1, 1, 1); PG8_STAGE(PG8_SB(1, 0), b3, voffB);
            PG8_BAR; PG8_WAIT_L(0); PG8_MMA(0, 1, At, B1); PG8_BAR;
            PG8_LDA(At, 1, 1); PG8_STAGE(PG8_SA(1, 0), a3, voffA);
            PG8_BAR; PG8_WAIT_L(0); PG8_MMA(1, 0, At, B0); PG8_BAR; PG8_SCHED;
            PG8_STAGE(PG8_SB(1, 1), b3 + hstepB, voffB);
            PG8_WAIT_V(6); PG8_BAR; PG8_MMA(1, 1, At, B1); PG8_BAR;
        }
        PG8_STAMP();
        if constexpr (!Epi::AFTER_DRAIN) { E(acc, cur, wr, wc, fr, fq); S.done(cur); }
        PG8_STAMP();
        if (!has_next) break;
#pragma unroll
        for (int a = 0; a < 2; ++a)
#pragma unroll
            for (int b = 0; b < 2; ++b)
#pragma unroll
                for (int m = 0; m < 4; ++m)
#pragma unroll
                    for (int n = 0; n < 2; ++n) acc[a][b][m][n] = (f32x4){0.f, 0.f, 0.f, 0.f};
        cur = nxt; cA = nA; cB = nB; ++ui;
    }
    PG8_WAIT_V(0);
    if (wr == 0) PG8_BAR;
    PG8_BAR;
    if constexpr (Epi::AFTER_DRAIN) { E.fused(acc, cur, wr, wc, fr, fq, lds, wid, lane); S.done(cur); }
    PG8_STAMP();
    if (STAMP && wid == 0) { stamps[lane] = lane < nts ? (((unsigned long long)(unsigned)ts_hi << 32) | (unsigned)ts_lo) : 0ull;
        if (lane == 62) stamps[62] = rt_entry; if (lane == 63) stamps[63] = (unsigned long long)wall_clock64(); }
#undef PG8_STAMP
#undef PG8_SA
#undef PG8_SB
#undef PG8_STAGE
#undef PG8_LDA
#undef PG8_LDB
#undef PG8_MMA
#undef PG8_WAIT_V
#undef PG8_WAIT_L
#undef PG8_BAR
#undef PG8_SCHED
}
}


constexpr int NWAVES = 8, NTHREADS = 512;
constexpr int BATCH = 2, SEQ = 8192, T = BATCH * SEQ, D = 2048;
constexpr int AW = 1024, NH = 8, HD = 128, PW = 1024, INW = 4096;
constexpr int NMOD = 6 * D;
constexpr int PE_HEADS = 8, PE_NK = 128, PE_EXP = 16384, PE_K = 16;
constexpr float NORM_EPS = 1e-6f;
constexpr float QSCALE = 0.08838834764831845f * 1.4426950408889634f;

constexpr size_t MiB = 1u << 20;
constexpr size_t WS_CTL = 0, CTL_ZERO_BYTES = 64 * 1024;
constexpr size_t WS_MODP = 1 * MiB;
constexpr size_t WS_MODF = 1 * MiB + 832 * 1024;
constexpr size_t WS_SA = 1 * MiB + 928 * 1024, WS_SB = 1 * MiB + 992 * 1024;
constexpr size_t WS_CS = 2 * MiB;
constexpr size_t WS_WTIN = 4 * MiB;
constexpr size_t WS_WTOUT = 20 * MiB;
constexpr size_t WS_WTQ = 28 * MiB, WS_W8 = WS_WTQ;
constexpr size_t WS_WTPOOL = 36 * MiB;
constexpr size_t WS_SKP = 37 * MiB;
constexpr size_t WS_SU = 38 * MiB, WS_SV = 38 * MiB + 64 * 1024;
constexpr size_t WS_PU = 40 * MiB, WS_PV = 104 * MiB;
constexpr size_t WS_HB = 168 * MiB, WS_H8 = WS_HB;
constexpr size_t WS_Q = 232 * MiB, WS_K = 264 * MiB, WS_V = 296 * MiB, WS_U = 328 * MiB;
constexpr size_t WS_HC = 360 * MiB;
constexpr size_t WS_RB = 424 * MiB;
constexpr size_t WS_QP = WS_Q;
constexpr size_t WS_SC = WS_V;
constexpr size_t WS_IDX = WS_RB, WS_GATE = WS_RB + 8 * MiB;
constexpr size_t WS_TQ = WS_RB + 16 * MiB, WS_CSC = WS_RB + 24 * MiB;
constexpr size_t WS_OP0 = WS_HB, WS_OP1 = WS_HB + 32 * MiB, WS_OP2 = 456 * MiB;
constexpr size_t WS_X1B = WS_V;
constexpr size_t WS_LSE = 488 * MiB;
constexpr size_t WS_WQ2 = 490 * MiB;
constexpr size_t WS_BIASF = 506 * MiB + 512 * 1024;
constexpr size_t WS_BIASP = 506 * MiB;
constexpr size_t WS_RSQP = 507 * MiB;
constexpr size_t WS_WOUT8 = 509 * MiB;
constexpr size_t WS_HC8 = 64 * MiB;
constexpr size_t WS_SA5 = 489 * MiB + 512 * 1024, WS_SB5 = 1 * MiB + 1008 * 1024;
constexpr size_t WS_END = 513 * MiB;

constexpr int RING_BYTES = 131072, MISC_OFF = RING_BYTES, LDS_BYTES = 147456;

#define GAS __attribute__((address_space(1)))
typedef unsigned short bf16;
typedef unsigned v4u __attribute__((ext_vector_type(4)));
typedef unsigned v2u __attribute__((ext_vector_type(2)));
typedef float f32x4 __attribute__((ext_vector_type(4)));
typedef __bf16 bf2 __attribute__((ext_vector_type(2)));
#define LDS_WAIT() asm volatile("s_waitcnt lgkmcnt(0)" ::: "memory")
#define VM_WAIT() asm volatile("s_waitcnt vmcnt(0)" ::: "memory")
__device__ __forceinline__ unsigned pk2(float lo, float hi) { return pg8::cvt_pk_bf16(lo, hi); }
__device__ __forceinline__ float bflo(unsigned w) { return __uint_as_float(w << 16); }
__device__ __forceinline__ float bfhi(unsigned w) { return __uint_as_float(w & 0xffff0000u); }
__device__ __forceinline__ float dot2(unsigned a, unsigned b, float c) { return __builtin_amdgcn_fdot2_f32_bf16(__builtin_bit_cast(bf2, a), __builtin_bit_cast(bf2, b), c, false); }
__device__ __forceinline__ int my_lane() { unsigned ones = ~0u; asm volatile("" : "+s"(ones)); return (int)__builtin_amdgcn_mbcnt_hi(ones, __builtin_amdgcn_mbcnt_lo(ones, 0u)); }
__device__ __forceinline__ int sh_idx(int v, int idx) { return __builtin_amdgcn_ds_bpermute(idx << 2, v); }
__device__ __forceinline__ unsigned sh_idx(unsigned v, int idx) { return (unsigned)__builtin_amdgcn_ds_bpermute(idx << 2, (int)v); }
__device__ __forceinline__ float sh_idx(float v, int idx) { return __int_as_float(__builtin_amdgcn_ds_bpermute(idx << 2, __float_as_int(v))); }
#define SXOR(v, m, lane) sh_idx((v), (lane) ^ (m))
template <int CTRL> __device__ __forceinline__ float dppf(float v) { return __int_as_float(__builtin_amdgcn_update_dpp(0, __float_as_int(v), CTRL, 0xF, 0xF, true)); }
template <int CTRL> __device__ __forceinline__ int dppi(int v) { return __builtin_amdgcn_update_dpp(0, v, CTRL, 0xF, 0xF, true); }
__device__ __forceinline__ float wave_sum(float v) {
    v += dppf<0xB1>(v); v += dppf<0x4E>(v); v += dppf<0x141>(v); v += dppf<0x140>(v);
    const int b = __float_as_int(v);
    return (__int_as_float(__builtin_amdgcn_readlane(b, 0)) + __int_as_float(__builtin_amdgcn_readlane(b, 16))) + (__int_as_float(__builtin_amdgcn_readlane(b, 32)) + __int_as_float(__builtin_amdgcn_readlane(b, 48)));
}
__device__ __forceinline__ int wave_sum_i(int v) {
    v += dppi<0xB1>(v); v += dppi<0x4E>(v); v += dppi<0x141>(v); v += dppi<0x140>(v);
    return (__builtin_amdgcn_readlane(v, 0) + __builtin_amdgcn_readlane(v, 16)) + (__builtin_amdgcn_readlane(v, 32) + __builtin_amdgcn_readlane(v, 48));
}
__device__ __forceinline__ float wave_max(float v) {
    v = fmaxf(v, dppf<0xB1>(v)); v = fmaxf(v, dppf<0x4E>(v)); v = fmaxf(v, dppf<0x141>(v)); v = fmaxf(v, dppf<0x140>(v));
    const int b = __float_as_int(v);
    return fmaxf(fmaxf(__int_as_float(__builtin_amdgcn_readlane(b, 0)), __int_as_float(__builtin_amdgcn_readlane(b, 16))), fmaxf(__int_as_float(__builtin_amdgcn_readlane(b, 32)), __int_as_float(__builtin_amdgcn_readlane(b, 48))));
}

__device__ __forceinline__ float xsum4(float v) {
    const v2u a = __builtin_amdgcn_permlane16_swap(__float_as_uint(v), __float_as_uint(v), false, false); v = __uint_as_float(a.x) + __uint_as_float(a.y);
    const v2u b = __builtin_amdgcn_permlane32_swap(__float_as_uint(v), __float_as_uint(v), false, false); return __uint_as_float(b.x) + __uint_as_float(b.y);
}
__device__ __forceinline__ float xmax4(float v) {
    const v2u a = __builtin_amdgcn_permlane16_swap(__float_as_uint(v), __float_as_uint(v), false, false); v = fmaxf(__uint_as_float(a.x), __uint_as_float(a.y));
    const v2u b = __builtin_amdgcn_permlane32_swap(__float_as_uint(v), __float_as_uint(v), false, false); return fmaxf(__uint_as_float(b.x), __uint_as_float(b.y));
}

__device__ __forceinline__ int wave_scan_i(int v, int lane) {
    v += __builtin_amdgcn_update_dpp(0, v, 0x111, 0xF, 0xF, true); v += __builtin_amdgcn_update_dpp(0, v, 0x112, 0xF, 0xF, true);
    v += __builtin_amdgcn_update_dpp(0, v, 0x114, 0xF, 0xF, true); v += __builtin_amdgcn_update_dpp(0, v, 0x118, 0xF, 0xF, true);
    const int t0 = __builtin_amdgcn_readlane(v, 15), t1 = __builtin_amdgcn_readlane(v, 31), t2 = __builtin_amdgcn_readlane(v, 47);
    const int row = lane >> 4;
    return v + (row == 0 ? 0 : (row == 1 ? t0 : (row == 2 ? t0 + t1 : t0 + t1 + t2)));
}

#define XB_TMO      128
#define XB_XCNT(j)  (256  + 64 * (j))
#define XB_XSUB(j)  (1280 + 64 * (j))
#define XB_XGEN(j)  (2304 + 64 * (j))
#define XB_TOP      3328
#define XB_TOPGEN   3392
#define XCD_BAR_WORDS 3456
#define XB_XCCOF    4096
#define XB_GCNT(j)  (8192 + 64 * (j))
#define XB_SPIN_CAP (1u << 18)
#define LAS __attribute__((address_space(3)))

__device__ __forceinline__ unsigned xb_ld(unsigned* p)              { return __hip_atomic_load(p, __ATOMIC_RELAXED, __HIP_MEMORY_SCOPE_AGENT); }
__device__ __forceinline__ unsigned xb_add(unsigned* p, unsigned v) { return __hip_atomic_fetch_add(p, v, __ATOMIC_RELAXED, __HIP_MEMORY_SCOPE_AGENT); }
__device__ __forceinline__ unsigned xb_xcc_id() { return (unsigned)__builtin_amdgcn_s_getreg((3 << 11) | 20) & 0xFu; }
#define XB_SPIN(cond, bar) do { unsigned _sp = 0; while (cond) { __builtin_amdgcn_s_sleep(1); \
    if ((++_sp & 255u) == 0u) { if (xb_ld(&(bar)[XB_TMO])) break; if (_sp > XB_SPIN_CAP) { atomicAdd(&(bar)[XB_TMO], 1u); break; } } } } while (0)

struct XcdBarrier {
    unsigned* bar; unsigned x;
    volatile LAS unsigned* st;
};

__device__ __forceinline__ XcdBarrier xcd_barrier_post(unsigned* bar, volatile LAS unsigned* st, bool is_t0) {
    XcdBarrier b; b.bar = bar; b.x = xb_xcc_id(); b.st = st;
    if (is_t0) { (void)xb_add(&bar[XB_XCNT(b.x)], 1u); (void)xb_add(&bar[XB_XCCOF + blockIdx.x], b.x + 1u); }
    return b;
}
__device__ __forceinline__ void xcd_barrier_complete(unsigned* bar, unsigned x, unsigned& nloc, unsigned& nx) {
    const unsigned G = gridDim.x * gridDim.y * gridDim.z;
    unsigned sum, cnt, mine, sp = 0u;
    for (;;) {
        sum = 0u; cnt = 0u; mine = 0u;
#pragma unroll
        for (unsigned j = 0; j < 16; ++j) { const unsigned c = xb_ld(&bar[XB_XCNT(j)]); sum += c; cnt += (c > 0u) ? 1u : 0u; mine = (j == x) ? c : mine; }
        if (sum == G) break;
        __builtin_amdgcn_s_sleep(1);
        if ((++sp & 255u) == 0u) { if (xb_ld(&bar[XB_TMO])) break; if (sp > XB_SPIN_CAP) { atomicAdd(&bar[XB_TMO], 1u); break; } }
    }
    nloc = mine > 0u ? mine : 1u; nx = cnt > 0u ? cnt : 1u;
}

__device__ __forceinline__ void xcd_barrier(const XcdBarrier& b, bool is_t0) {
    asm volatile("s_waitcnt vmcnt(0)" ::: "memory");
    __syncthreads();
    if (is_t0) {
        unsigned* bar = b.bar;
        __builtin_amdgcn_s_waitcnt(0);
        unsigned nloc = b.st[0], nx = b.st[1];
        if (nloc == 0u) { xcd_barrier_complete(bar, b.x, nloc, nx); b.st[0] = nloc; b.st[1] = nx; }
        const unsigned old = xb_add(&bar[XB_XSUB(b.x)], 1u);
        const unsigned gen = old / nloc;
        if (old + 1u == (gen + 1u) * nloc) {
            __builtin_amdgcn_fence(__ATOMIC_RELEASE, "agent");
            asm volatile("s_waitcnt vmcnt(0)" ::: "memory");
            const unsigned og = xb_add(&bar[XB_TOP], 1u);
            const unsigned tg = og / nx;
            if (og + 1u == (tg + 1u) * nx) xb_add(&bar[XB_TOPGEN], 1u);
            else XB_SPIN(xb_ld(&bar[XB_TOPGEN]) == tg, bar);
            __builtin_amdgcn_fence(__ATOMIC_ACQUIRE, "agent");
            xb_add(&bar[XB_XGEN(b.x)], 1u);
            asm volatile("s_waitcnt vmcnt(0)" ::: "memory");
        } else {
            XB_SPIN(xb_ld(&bar[XB_XGEN(b.x)]) == gen, bar);
            __builtin_amdgcn_fence(__ATOMIC_ACQUIRE, "agent");
            asm volatile("s_waitcnt vmcnt(0)" ::: "memory");
        }
    }
    __syncthreads();
}

__device__ __forceinline__ void grp_barrier(const XcdBarrier& b, bool is_t0) {
    asm volatile("s_waitcnt vmcnt(0)" ::: "memory");
    __syncthreads();
    if (is_t0) {
        unsigned* cnt = &b.bar[XB_GCNT(blockIdx.x & 7u)];
        __builtin_amdgcn_s_waitcnt(0);
        const unsigned old = xb_add(cnt, 1u);
        const unsigned target = (old / 32u + 1u) * 32u;
        XB_SPIN((int)(xb_ld(cnt) - target) < 0, b.bar);
        __builtin_amdgcn_fence(__ATOMIC_ACQUIRE, "agent");
        asm volatile("s_waitcnt vmcnt(0)" ::: "memory");
    }
    __syncthreads();
}

struct Ctx { LAS unsigned char* lds; int tid, lane, wave, vcu, G, gw, ngw; };

struct Epi1 {
    static constexpr bool PERM = true, AFTER_DRAIN = false;
    bf16* QKVU; const float* CS; const float* SA; const float* SB;
    __device__ __forceinline__ void operator()(const pg8::f32x4 (&acc)[2][2][4][2], const pg8::Unit& u, int wr, int wc, int fr, int fq) const {
        const int row0 = u.pm * 256 + wr * 64 + fr; const int tt = u.pn >> 2; const int colt = (u.pn & 3) * 256;
        bf16* base = QKVU + (size_t)tt * ((size_t)T * 1024);
        const int col0 = colt + wc * 32 + 8 * fq;
        const bool rot = (tt < 2) && (wc == 0);
        const float sc = (tt == 0) ? QSCALE : 1.0f;
        const float sgn = (fq < 2) ? -1.0f : 1.0f;
        f32x4 sb[2][2];
        if (P2_I8) { const int gcol0 = u.pn * 256 + wc * 32 + 8 * fq;
#pragma unroll
            for (int bj = 0; bj < 2; ++bj) { sb[bj][0] = *(const f32x4*)(SB + gcol0 + bj * 128); sb[bj][1] = *(const f32x4*)(SB + gcol0 + bj * 128 + 4); } }
#define EPI1_ROWF(it) (((it) >> 2) * 128 + ((it) & 3) * 16)
        float srv[8];
#pragma unroll
        for (int it = 0; it < 8; ++it) srv[it] = P2_I8 ? *(const float*)((const char*)SA + ((unsigned)row0 * 4u + (unsigned)(EPI1_ROWF(it) * 4))) : 1.0f;
        f32x4 csr[3][4];
#pragma unroll
        for (int s3 = 0; s3 < 3; ++s3) { csr[s3][0] = (f32x4){1.f, 1.f, 1.f, 1.f}; csr[s3][1] = csr[s3][0]; csr[s3][2] = (f32x4){0.f, 0.f, 0.f, 0.f}; csr[s3][3] = csr[s3][2]; }
        const unsigned cso = (unsigned)(row0 * 32 + 8 * (fq & 1)) * 4u;
#define EPI1_ROW(IT) (((IT) >> 2) * 128 + ((IT) & 3) * 16)
#define EPI1_LDCS(IT) do { if (rot) { const char* cs_ = (const char*)CS + (cso + (unsigned)(EPI1_ROW(IT) * 128)); \
            csr[(IT) % 3][0] = *(const f32x4*)(cs_); csr[(IT) % 3][1] = *(const f32x4*)(cs_ + 16); csr[(IT) % 3][2] = *(const f32x4*)(cs_ + 64); csr[(IT) % 3][3] = *(const f32x4*)(cs_ + 80); } } while (0)
        EPI1_LDCS(0); EPI1_LDCS(1);
#pragma unroll
        for (int it = 0; it < 8; ++it) {
            const int ai = it >> 2, m = it & 3;
            if (it + 2 < 8) EPI1_LDCS(it + 2);
            const unsigned rb = (unsigned)((row0 + ai * 128 + m * 16) * 1024 + col0) * 2u;
            const float sr = srv[it];
            const f32x4 c0 = csr[it % 3][0], c1 = csr[it % 3][1], s0 = csr[it % 3][2], s1 = csr[it % 3][3];
#pragma unroll
            for (int bj = 0; bj < 2; ++bj) {
                f32x4 v0 = acc[ai][bj][m][0], v1 = acc[ai][bj][m][1];
                if (P2_I8) { typedef int i32x4_ __attribute__((ext_vector_type(4))); const i32x4_ i0 = __builtin_bit_cast(i32x4_, v0), i1 = __builtin_bit_cast(i32x4_, v1);
#pragma unroll
                    for (int e = 0; e < 4; ++e) { v0[e] = (float)i0[e] * (sr * sb[bj][0][e]); v1[e] = (float)i1[e] * (sr * sb[bj][1][e]); } }
                if (rot) {
#pragma unroll
                    for (int e = 0; e < 4; ++e) {
                        const float p0 = SXOR(v0[e], 32, 16 * fq + fr), p1 = SXOR(v1[e], 32, 16 * fq + fr);
                        v0[e] = v0[e] * c0[e] + sgn * p0 * s0[e];
                        v1[e] = v1[e] * c1[e] + sgn * p1 * s1[e];
                    }
                }
                pg8::u32x4 w; w.x = pk2(v0[0] * sc, v0[1] * sc); w.y = pk2(v0[2] * sc, v0[3] * sc); w.z = pk2(v1[0] * sc, v1[1] * sc); w.w = pk2(v1[2] * sc, v1[3] * sc);
                *(pg8::u32x4*)((char*)base + (rb + (unsigned)(bj * 256))) = w;
            }
        }
#undef EPI1_LDCS
#undef EPI1_ROW
#undef EPI1_ROWF
    }
};
struct EpiPool {
    static constexpr bool PERM = true, AFTER_DRAIN = false;
    bf16* HC; const float* pscale;
    __device__ __forceinline__ void operator()(const pg8::f32x4 (&acc)[2][2][4][2], const pg8::Unit& u, int wr, int wc, int fr, int fq) const {
        const int row0 = u.pm * 256 + wr * 64 + fr, col0 = u.pn * 256 + wc * 32 + 8 * fq;
        f32x4 ps[2][2];
#pragma unroll
        for (int bj = 0; bj < 2; ++bj) { ps[bj][0] = *(const f32x4*)(pscale + col0 + bj * 128); ps[bj][1] = *(const f32x4*)(pscale + col0 + bj * 128 + 4); }
#pragma unroll
        for (int ai = 0; ai < 2; ++ai)
#pragma unroll
            for (int m = 0; m < 4; ++m) {
                bf16* rowp = HC + (size_t)(row0 + ai * 128 + m * 16) * 2048 + 1024 + col0;
#pragma unroll
                for (int bj = 0; bj < 2; ++bj) {
                    const f32x4 v0 = acc[ai][bj][m][0] * ps[bj][0], v1 = acc[ai][bj][m][1] * ps[bj][1];
                    pg8::u32x4 w; w.x = pk2(v0[0], v0[1]); w.y = pk2(v0[2], v0[3]); w.z = pk2(v1[0], v1[1]); w.w = pk2(v1[2], v1[3]);
                    *(pg8::u32x4*)(rowp + bj * 128) = w;
                }
            }
    }
};
struct EpiBf {
    static constexpr bool PERM = true, AFTER_DRAIN = false;
    bf16* O; int ldc;
    __device__ __forceinline__ void operator()(const pg8::f32x4 (&acc)[2][2][4][2], const pg8::Unit& u, int wr, int wc, int fr, int fq) const {
        const int row0 = u.pm * 256 + wr * 64 + fr, col0 = u.pn * 256 + wc * 32 + 8 * fq;
#pragma unroll
        for (int ai = 0; ai < 2; ++ai)
#pragma unroll
            for (int m = 0; m < 4; ++m) {
                bf16* rowp = O + (size_t)(row0 + ai * 128 + m * 16) * ldc + col0;
#pragma unroll
                for (int bj = 0; bj < 2; ++bj) {
                    const f32x4 v0 = acc[ai][bj][m][0], v1 = acc[ai][bj][m][1];
                    pg8::u32x4 w; w.x = pk2(v0[0], v0[1]); w.y = pk2(v0[2], v0[3]); w.z = pk2(v1[0], v1[1]); w.w = pk2(v1[2], v1[3]);
                    *(pg8::u32x4*)(rowp + bj * 128) = w;
                }
            }
    }
};
struct EpiQ {
    static constexpr bool PERM = true, AFTER_DRAIN = false;
    bf16* O; const LAS float* rstdT; const LAS float* biasT; int pm0, pn0;
    __device__ __forceinline__ void operator()(const pg8::f32x4 (&acc)[2][2][4][2], const pg8::Unit& u, int wr, int wc, int fr, int fq) const {
        const int slot = (u.pm == pm0 && u.pn == pn0) ? 0 : 1;
        const int row0 = u.pm * 256 + wr * 64 + fr, col0 = u.pn * 256 + wc * 32 + 8 * fq;
        f32x4 bv[2][2];
#pragma unroll
        for (int bj = 0; bj < 2; ++bj) { bv[bj][0] = *(const LAS f32x4*)(biasT + slot * 256 + bj * 128 + wc * 32 + 8 * fq); bv[bj][1] = *(const LAS f32x4*)(biasT + slot * 256 + bj * 128 + wc * 32 + 8 * fq + 4); }
#pragma unroll
        for (int ai = 0; ai < 2; ++ai)
#pragma unroll
            for (int m = 0; m < 4; ++m) {
                const float rs = rstdT[slot * 256 + ai * 128 + wr * 64 + m * 16 + fr];
                bf16* rowp = O + (size_t)(row0 + ai * 128 + m * 16) * D + col0;
#pragma unroll
                for (int bj = 0; bj < 2; ++bj) {
                    const f32x4 v0 = acc[ai][bj][m][0] * rs + bv[bj][0], v1 = acc[ai][bj][m][1] * rs + bv[bj][1];
                    pg8::u32x4 w; w.x = pk2(v0[0], v0[1]); w.y = pk2(v0[2], v0[3]); w.z = pk2(v1[0], v1[1]); w.w = pk2(v1[2], v1[3]);
                    *(pg8::u32x4*)(rowp + bj * 128) = w;
                }
            }
    }
};
struct EpiF {
    static constexpr bool PERM = false, AFTER_DRAIN = false;
    float* C; int ldc;
    __device__ __forceinline__ void operator()(const pg8::f32x4 (&acc)[2][2][4][2], const pg8::Unit& u, int wr, int wc, int fr, int fq) const {
        const int row0 = u.pm * 256 + wr * 64 + fr, col0 = u.pn * 256 + wc * 32 + 4 * fq;
#pragma unroll
        for (int ai = 0; ai < 2; ++ai)
#pragma unroll
            for (int m = 0; m < 4; ++m) { float* rowp = C + (size_t)(row0 + ai * 128 + m * 16) * ldc + col0;
#pragma unroll
                for (int bj = 0; bj < 2; ++bj)
#pragma unroll
                    for (int n = 0; n < 2; ++n) *(f32x4*)(rowp + bj * 128 + n * 16) = acc[ai][bj][m][n]; }
    }
};
struct EpiOut {
    static constexpr bool PERM = true, AFTER_DRAIN = false;
    const float* X; bf16* X1; const float* MODF; float* RSQP; const float* SA; const float* SB;
    __device__ __forceinline__ void operator()(const pg8::f32x4 (&acc)[2][2][4][2], const pg8::Unit& u, int wr, int wc, int fr, int fq) const {
        const int row0 = u.pm * 256 + wr * 64 + fr, col0 = u.pn * 256 + wc * 32 + 8 * fq;
        const float* gp = MODF + (size_t)(u.pm >= 32 ? 1 : 0) * NMOD + 2 * D + col0;
        f32x4 gv[2][2];
#pragma unroll
        for (int bj = 0; bj < 2; ++bj)
#pragma unroll
            for (int n = 0; n < 2; ++n) gv[bj][n] = *(const f32x4*)(gp + bj * 128 + 4 * n);
        if (P5_I8) {
#pragma unroll
            for (int bj = 0; bj < 2; ++bj) { gv[bj][0] *= *(const f32x4*)(SB + col0 + bj * 128); gv[bj][1] *= *(const f32x4*)(SB + col0 + bj * 128 + 4); } }
        float srv[8];
#pragma unroll
        for (int it = 0; it < 8; ++it) srv[it] = P5_I8 ? *(const float*)((const char*)SA + ((unsigned)row0 * 4u + (unsigned)(((it >> 2) * 128 + (it & 3) * 16) * 4))) : 1.0f;
        f32x4 xr[3][4];
        const unsigned xo = (unsigned)(row0 * D + col0) * 4u;
#define EPIO_RB(IT) ((unsigned)((((IT) >> 2) * 128 + ((IT) & 3) * 16) * D) * 4u)
#define EPIO_LDX(IT) do { const char* xp_ = (const char*)X + (xo + EPIO_RB(IT)); \
            xr[(IT) % 3][0] = __builtin_nontemporal_load((const f32x4*)(xp_)); xr[(IT) % 3][1] = __builtin_nontemporal_load((const f32x4*)(xp_ + 16)); \
            xr[(IT) % 3][2] = __builtin_nontemporal_load((const f32x4*)(xp_ + 512)); xr[(IT) % 3][3] = __builtin_nontemporal_load((const f32x4*)(xp_ + 528)); } while (0)
        EPIO_LDX(0); EPIO_LDX(1);
#pragma unroll
        for (int it = 0; it < 8; ++it) {
            const int ai = it >> 2, m = it & 3;
            if (it + 2 < 8) EPIO_LDX(it + 2);
            const unsigned ob = (xo + EPIO_RB(it)) >> 1; float ssr = 0.f;
            const float sr = srv[it];
#pragma unroll
            for (int bj = 0; bj < 2; ++bj) {
                f32x4 a0 = acc[ai][bj][m][0], a1 = acc[ai][bj][m][1];
                if (P5_I8) { typedef int i32x4_ __attribute__((ext_vector_type(4))); const i32x4_ i0 = __builtin_bit_cast(i32x4_, a0), i1 = __builtin_bit_cast(i32x4_, a1);
#pragma unroll
                    for (int e = 0; e < 4; ++e) { a0[e] = (float)i0[e] * sr; a1[e] = (float)i1[e] * sr; } }
                const f32x4 v0 = xr[it % 3][2 * bj] + gv[bj][0] * a0, v1 = xr[it % 3][2 * bj + 1] + gv[bj][1] * a1;
                pg8::u32x4 w; w.x = pk2(v0[0], v0[1]); w.y = pk2(v0[2], v0[3]); w.z = pk2(v1[0], v1[1]); w.w = pk2(v1[2], v1[3]);
                *(pg8::u32x4*)((char*)X1 + (ob + (unsigned)(bj * 256))) = w;
                ssr += (v0[0] * v0[0] + v0[1] * v0[1]) + (v0[2] * v0[2] + v0[3] * v0[3]) + (v1[0] * v1[0] + v1[1] * v1[1]) + (v1[2] * v1[2] + v1[3] * v1[3]); }
            ssr = xsum4(ssr);
            if (fq == 0) *(float*)((char*)RSQP + ((unsigned)((row0 + ai * 128 + m * 16) * 32 + u.pn * 4 + wc) * 4u)) = ssr; }
#undef EPIO_LDX
#undef EPIO_RB
    }
};

__device__ __forceinline__ void p0_transpose_item(const float* W, int K, int N, bf16* WT, int row_off, LAS float* scr, int item, int lane) {
    const int nblk = N / 32, kb = item / nblk, nb = item % nblk, k0 = 64 * kb, n0 = 32 * nb;
#pragma unroll 8
    for (int i = 0; i < 32; ++i) { const int kk = 2 * i + (lane >> 5); scr[kk * 33 + (lane & 31)] = W[(size_t)(k0 + kk) * N + n0 + (lane & 31)]; }
    LDS_WAIT(); asm volatile("" ::: "memory");
    const int c = lane & 7;
#pragma unroll
    for (int j = 0; j < 4; ++j) { const int n = (lane >> 3) + 8 * j; const LAS float* s = scr + (8 * c) * 33 + n;
        v4u o; o.x = pk2(s[0 * 33], s[1 * 33]); o.y = pk2(s[2 * 33], s[3 * 33]); o.z = pk2(s[4 * 33], s[5 * 33]); o.w = pk2(s[6 * 33], s[7 * 33]);
        *(v4u*)(WT + (size_t)(row_off + n0 + n) * K + k0 + 8 * c) = o; }
    LDS_WAIT(); asm volatile("" ::: "memory");
}
__device__ __forceinline__ float silu_f(float x) { return x / (1.0f + __expf(-x)); }
constexpr int MOD_ITEMS = 48 * 8;
__device__ __forceinline__ void p0_mod_item(const float* cvec, const float* w_mod, float* MODP, int item, int lane) {
    const int cb = item % 48, kc = item / 48, col = 256 * cb + 4 * lane, k0 = 256 * kc;
    f32x4 a0 = {0.f, 0.f, 0.f, 0.f}, a1 = a0;
    const float* wp = w_mod + (size_t)k0 * NMOD + col;
#pragma unroll 32
    for (int k = 0; k < 256; ++k) {
        const f32x4 w = __builtin_nontemporal_load((const f32x4*)(wp + (size_t)k * NMOD));
        const float s0 = silu_f(cvec[k0 + k]), s1 = silu_f(cvec[D + k0 + k]);
        a0 += w * s0; a1 += w * s1;
    }
    *(f32x4*)(MODP + ((size_t)kc * 2 + 0) * NMOD + col) = a0;
    *(f32x4*)(MODP + ((size_t)kc * 2 + 1) * NMOD + col) = a1;
}
template <int OFFS>
__device__ __forceinline__ void p0_quant_row(const float* src, unsigned char* dst, float* scale_out, int lane) {
    f32x4 v[8]; float am = 0.f;
#pragma unroll
    for (int j = 0; j < 8; ++j) { v[j] = *(const f32x4*)(src + 256 * j + 4 * lane); am = fmaxf(fmaxf(am, fmaxf(fabsf(v[j][0]), fabsf(v[j][1]))), fmaxf(fabsf(v[j][2]), fabsf(v[j][3]))); }
    am = wave_max(am);
    const float inv = (am > 0.f) ? 127.0f / am : 0.f;
    if (lane == 0) *scale_out = am * (1.0f / 127.0f);
#pragma unroll
    for (int j = 0; j < 8; ++j) {
        unsigned w = 0u;
#pragma unroll
        for (int e = 0; e < 4; ++e) { int q = __float2int_rn(v[j][e] * inv); q = q > 127 ? 127 : (q < -127 ? -127 : q); w |= ((unsigned)(q + OFFS) & 0xffu) << (8 * e); }
        *(unsigned*)(dst + 256 * j + 4 * lane) = w;
    }
}
__device__ __forceinline__ void p0_quant_load4(const float* src, int lane, f32x4 (&v)[8]) {
#pragma unroll
    for (int j = 0; j < 8; ++j) v[j] = __builtin_nontemporal_load((const f32x4*)(src + 256 * j + 4 * lane));
}
template <unsigned XR>
__device__ __forceinline__ void p0_quant_finish4(const f32x4 (&v)[8], unsigned char* dst, float* scale_out, int lane) {
    float am = 0.f, sq = 0.f;
#pragma unroll
    for (int j = 0; j < 8; ++j)
#pragma unroll
        for (int e = 0; e < 4; ++e) { am = fmaxf(am, fabsf(v[j][e])); sq += v[j][e] * v[j][e]; }
    am = wave_max(am); sq = wave_sum(sq);
    const float step = fmaxf(0.335f * sqrtf(sq * (1.0f / D)), am * (1.0f / 24.0f));
    const float inv = (step > 0.f) ? 1.0f / step : 0.f;
    if (lane == 0) *scale_out = step;
    v4u o;
#pragma unroll
    for (int d = 0; d < 4; ++d) {
        unsigned w = 0u;
#pragma unroll
        for (int e = 0; e < 4; ++e) {
            int lo = (int)floorf(v[2 * d][e] * inv) + 8, hi = (int)floorf(v[2 * d + 1][e] * inv) + 8;
            lo = lo < 0 ? 0 : (lo > 15 ? 15 : lo); hi = hi < 0 ? 0 : (hi > 15 ? 15 : hi);
            w |= ((unsigned)lo | ((unsigned)hi << 4)) << (8 * e);
        }
        w ^= XR * 0x01010101u;
        if (d == 0) o.x = w; else if (d == 1) o.y = w; else if (d == 2) o.z = w; else o.w = w;
    }
    *(v4u*)(dst + 16 * lane) = o;
}
__device__ __forceinline__ unsigned fp4_code(float x) {
    const float a = fabsf(x);
    const unsigned m = (unsigned)(a > 0.25f) + (unsigned)(a > 0.75f) + (unsigned)(a > 1.25f) + (unsigned)(a > 1.75f) + (unsigned)(a > 2.5f) + (unsigned)(a > 3.5f) + (unsigned)(a > 5.0f);
    return m | (x < 0.f ? 8u : 0u);
}
__device__ __forceinline__ void p0_quant_finish_fp4(const f32x4 (&v)[8], unsigned char* dst, float* scale_out, int lane) {
    float am = 0.f, sq = 0.f;
#pragma unroll
    for (int j = 0; j < 8; ++j)
#pragma unroll
        for (int e = 0; e < 4; ++e) { am = fmaxf(am, fabsf(v[j][e])); sq += v[j][e] * v[j][e]; }
    am = wave_max(am); sq = wave_sum(sq);
    const float step = fmaxf(0.48f * sqrtf(sq * (1.0f / D)), am * (1.0f / 18.0f));
    const float inv = (step > 0.f) ? 1.0f / step : 0.f;
    if (lane == 0) *scale_out = step;
    v4u o;
#pragma unroll
    for (int d = 0; d < 4; ++d) {
        unsigned w = 0u;
#pragma unroll
        for (int e = 0; e < 4; ++e) w |= (fp4_code(v[2 * d][e] * inv) | (fp4_code(v[2 * d + 1][e] * inv) << 4)) << (8 * e);
        if (d == 0) o.x = w; else if (d == 1) o.y = w; else if (d == 2) o.z = w; else o.w = w;
    }
    *(v4u*)(dst + 16 * lane) = o;
}
__device__ __forceinline__ void phase0(const Ctx& c, const float* const* in, unsigned char* ws) {
    const float* cvec = in[1]; const float* w_mod = in[3]; const float* w_in = in[6]; const float* w_pool = in[7]; const float* w_out = in[9];
    const float* w_query = in[11]; const float* sub_keys = in[12]; const float* peer_u = in[13]; const float* peer_v = in[14];
    LAS float* scr = (LAS float*)(c.lds + c.wave * 16384);
    const bool modw = (c.wave == 0) || (c.wave == 1 && c.vcu < 128);
    if (modw) p0_mod_item(cvec, w_mod, (float*)(ws + WS_MODP), c.wave * 256 + c.vcu, c.lane);
    const int tix = (c.vcu < 128) ? c.vcu * 6 + (c.wave - 2) : 768 + (c.vcu - 128) * 7 + (c.wave - 1);
    constexpr int I_IN = 32 * 128, I_OUT = 32 * 64, I_POOL = 4 * 32;
    for (int it = c.gw; it < I_IN + I_OUT + I_POOL; it += c.ngw) {
        int r = it;
        if (r < I_IN) { p0_transpose_item(w_in, D, INW, (bf16*)(ws + WS_WTIN), 0, scr, r, c.lane); continue; } r -= I_IN;
        if (r < I_OUT) { p0_transpose_item(w_out, D, D, (bf16*)(ws + WS_WTOUT), 0, scr, r, c.lane); continue; } r -= I_OUT;
        { const int g = r >> 5; p0_transpose_item(w_pool + (size_t)g * 65536, 256, 256, (bf16*)(ws + WS_WTPOOL), g * 256, scr, r & 31, c.lane); }
    }
#if TOPK_SIMPLE
    for (int r = c.gw; r < 2048; r += c.ngw) {
        const int p = (r >> 7) & 1, k = 4 * c.lane; v2u o = {0u, 0u};
        if ((k >> 7) == p) { const f32x4 s = *(const f32x4*)(sub_keys + (size_t)r * 128 + (k & 127)); o.x = pk2(s[0], s[1]); o.y = pk2(s[2], s[3]); }
        *(v2u*)((bf16*)(ws + WS_SKP) + (size_t)r * 256 + k) = o;
    }
#else
    for (int r = c.gw; r < 2048; r += c.ngw) {
        const float a = sub_keys[(size_t)r * 128 + 2 * c.lane], b = sub_keys[(size_t)r * 128 + 2 * c.lane + 1];
        *(unsigned*)((bf16*)(ws + WS_SKP) + (size_t)r * 128 + 2 * c.lane) = pk2(a, b);
    }
#endif
    if (!modw) {
        const int stride = c.ngw - MOD_ITEMS;
        int r = tix;
        f32x4 va[8], vb[8];
#define P0_SRC(R) (((R) < PE_EXP) ? peer_u + (size_t)(R) * D : peer_v + (size_t)((R) - PE_EXP) * D)
#define P0_FIN(V, R) do { if ((R) < PE_EXP) { if (U_MFMA) p0_quant_finish_fp4(V, ws + WS_PU + (size_t)(R) * 1024, (float*)(ws + WS_SU) + (R), c.lane); else p0_quant_finish4<0x88u>(V, ws + WS_PU + (size_t)(R) * 1024, (float*)(ws + WS_SU) + (R), c.lane); } \
                          else { if (V_MFMA) p0_quant_finish_fp4(V, ws + WS_PV + (size_t)((R) - PE_EXP) * 1024, (float*)(ws + WS_SV) + ((R) - PE_EXP), c.lane); else p0_quant_finish4<0x80u>(V, ws + WS_PV + (size_t)((R) - PE_EXP) * 1024, (float*)(ws + WS_SV) + ((R) - PE_EXP), c.lane); } } while (0)
        if (r < 2 * PE_EXP) p0_quant_load4(P0_SRC(r), c.lane, va);
        while (r < 2 * PE_EXP) {
            const int r1 = r + stride, r2 = r + 2 * stride;
            if (r1 < 2 * PE_EXP) p0_quant_load4(P0_SRC(r1), c.lane, vb);
            P0_FIN(va, r);
            if (r1 >= 2 * PE_EXP) break;
            if (r2 < 2 * PE_EXP) p0_quant_load4(P0_SRC(r2), c.lane, va);
            P0_FIN(vb, r1);
            r = r2;
        }
#undef P0_SRC
#undef P0_FIN
    }
}

__device__ __forceinline__ void p1_fold_q_item(const float* W, bf16* WQ2, float* BIASP, const LAS float* A2s, const LAS float* B2s, LAS float* scr, int item, int lane) {
    const int kb = item >> 6, nb = item & 63, k0 = 64 * kb, n0 = 32 * nb;
#pragma unroll 8
    for (int i = 0; i < 32; ++i) { const int kk = 2 * i + (lane >> 5); scr[kk * 33 + (lane & 31)] = W[(size_t)(k0 + kk) * D + n0 + (lane & 31)]; }
    LDS_WAIT(); asm volatile("" ::: "memory");
    {
        const int bb = lane >> 5, n = lane & 31; float sacc = 0.f;
#pragma unroll 8
        for (int kk = 0; kk < 64; ++kk) sacc += B2s[bb * D + k0 + kk] * scr[kk * 33 + n];
        BIASP[((size_t)kb * 2 + bb) * D + n0 + n] = sacc;
    }
    const int c8 = lane & 7;
#pragma unroll
    for (int bb = 0; bb < 2; ++bb) {
        const f32x4 a0 = *(const LAS f32x4*)(A2s + bb * D + k0 + 8 * c8), a1 = *(const LAS f32x4*)(A2s + bb * D + k0 + 8 * c8 + 4);
#pragma unroll
        for (int j = 0; j < 4; ++j) { const int n = (lane >> 3) + 8 * j; const LAS float* t = scr + (8 * c8) * 33 + n;
            v4u o; o.x = pk2(t[0 * 33] * a0[0], t[1 * 33] * a0[1]); o.y = pk2(t[2 * 33] * a0[2], t[3 * 33] * a0[3]); o.z = pk2(t[4 * 33] * a1[0], t[5 * 33] * a1[1]); o.w = pk2(t[6 * 33] * a1[2], t[7 * 33] * a1[3]);
            *(v4u*)(WQ2 + ((size_t)bb * D + n0 + n) * D + k0 + 8 * c8) = o; }
    }
    LDS_WAIT(); asm volatile("" ::: "memory");
}
template <bool FIRST>
__device__ __forceinline__ void phase_rows(const Ctx& c, const float* X, const bf16* XB, const float* gvec, const float* b_mod, const int* positions, unsigned char* ws, int shift_chunk, int scale_chunk, const float* gvec2 = nullptr, const float* w_query = nullptr) {
    LAS float* A1 = (LAS float*)c.lds; LAS float* B1 = A1 + D;
    const int b = c.vcu >> 7;
    const float* MODP = (const float*)(ws + WS_MODP); float* MODF = (float*)(ws + WS_MODF);
    {
        const int j = 4 * c.tid;
        f32x4 sh, sc;
        if (FIRST) {
            sh = *(const f32x4*)(b_mod + shift_chunk * D + j); sc = *(const f32x4*)(b_mod + scale_chunk * D + j);
#pragma unroll
            for (int s = 0; s < 8; ++s) { sh += *(const f32x4*)(MODP + ((size_t)s * 2 + b) * NMOD + shift_chunk * D + j); sc += *(const f32x4*)(MODP + ((size_t)s * 2 + b) * NMOD + scale_chunk * D + j); }
        } else { sh = *(const f32x4*)(MODF + (size_t)b * NMOD + shift_chunk * D + j); sc = *(const f32x4*)(MODF + (size_t)b * NMOD + scale_chunk * D + j); }
        const f32x4 g = *(const f32x4*)(gvec + j);
        *(LAS f32x4*)(A1 + j) = g * (sc + 1.0f); *(LAS f32x4*)(B1 + j) = sh;
    }
    LAS float* A2s = (LAS float*)(c.lds + 16384); LAS float* B2s = A2s + 2 * D;
    if (FIRST) {
        const int j = 4 * c.tid; const f32x4 g2v = *(const f32x4*)(gvec2 + j);
#pragma unroll
        for (int bb = 0; bb < 2; ++bb) {
            f32x4 sh = *(const f32x4*)(b_mod + 3 * D + j), sc = *(const f32x4*)(b_mod + 4 * D + j);
#pragma unroll
            for (int sx = 0; sx < 8; ++sx) { sh += *(const f32x4*)(MODP + ((size_t)sx * 2 + bb) * NMOD + 3 * D + j); sc += *(const f32x4*)(MODP + ((size_t)sx * 2 + bb) * NMOD + 4 * D + j); }
            *(LAS f32x4*)(A2s + bb * D + j) = g2v * (sc + 1.0f); *(LAS f32x4*)(B2s + bb * D + j) = sh;
        }
    }
    if (FIRST && c.vcu < 48 && c.tid < 256) {
        const int col = 256 * c.vcu + c.tid;
#pragma unroll
        for (int bb = 0; bb < 2; ++bb) { float v = b_mod[col];
#pragma unroll
            for (int s = 0; s < 8; ++s) v += MODP[((size_t)s * 2 + bb) * NMOD + col];
            MODF[(size_t)bb * NMOD + col] = v; }
    }
    __syncthreads();
    if (FIRST) {
        LAS float* scr = (LAS float*)(c.lds + 49152 + c.wave * 8448);
        p1_fold_q_item(w_query, (bf16*)(ws + WS_WQ2), (float*)(ws + WS_BIASP), A2s, B2s, scr, c.gw, c.lane);
    }
    bf16* HB = (bf16*)(ws + WS_HB);
    f32x4 vnx[8];
    if (FIRST) {
#pragma unroll
        for (int q = 0; q < 8; ++q) vnx[q] = __builtin_nontemporal_load((const f32x4*)(X + (size_t)(64 * c.vcu + 8 * c.wave) * D + 4 * c.lane + 256 * q)); }
#pragma unroll 1
    for (int i = 0; i < 8; ++i) {
        const int t = 64 * c.vcu + 8 * c.wave + i;
        f32x4 v[8]; float ss = 0.f;
#pragma unroll
        for (int q = 0; q < 8; ++q) {
            if (FIRST) v[q] = vnx[q];
            else { const v2u w = *(const v2u*)(XB + (size_t)t * D + 4 * c.lane + 256 * q); v[q] = (f32x4){bflo(w.x), bfhi(w.x), bflo(w.y), bfhi(w.y)}; }
            ss += (v[q][0] * v[q][0] + v[q][1] * v[q][1]) + (v[q][2] * v[q][2] + v[q][3] * v[q][3]); }
        if (FIRST) { const int tn = 64 * c.vcu + 8 * c.wave + ((i + 1) & 7);
#pragma unroll
            for (int q = 0; q < 8; ++q) vnx[q] = __builtin_nontemporal_load((const f32x4*)(X + (size_t)tn * D + 4 * c.lane + 256 * q)); }
        const float rstd = 1.0f / sqrtf(wave_sum(ss) * (1.0f / D) + NORM_EPS);
        bf16* hr = HB + (size_t)t * D + 4 * c.lane;
        if (FIRST && P2_I8) {
            float am = 0.f;
#pragma unroll
            for (int q = 0; q < 8; ++q) {
                const f32x4 a = *(const LAS f32x4*)(A1 + 256 * q + 4 * c.lane), bb = *(const LAS f32x4*)(B1 + 256 * q + 4 * c.lane);
                v[q] = v[q] * rstd * a + bb;
                am = fmaxf(fmaxf(am, fmaxf(fabsf(v[q][0]), fabsf(v[q][1]))), fmaxf(fabsf(v[q][2]), fabsf(v[q][3]))); }
            am = wave_max(am);
            const float inv = (am > 0.f) ? 127.0f / am : 0.f;
            unsigned w8[8];
#pragma unroll
            for (int q = 0; q < 8; ++q) { unsigned w = 0u;
                w = __builtin_amdgcn_cvt_pk_u8_f32(__builtin_rintf(fmaf(v[q][0], inv, 128.0f)), 0, w); w = __builtin_amdgcn_cvt_pk_u8_f32(__builtin_rintf(fmaf(v[q][1], inv, 128.0f)), 1, w);
                w = __builtin_amdgcn_cvt_pk_u8_f32(__builtin_rintf(fmaf(v[q][2], inv, 128.0f)), 2, w); w = __builtin_amdgcn_cvt_pk_u8_f32(__builtin_rintf(fmaf(v[q][3], inv, 128.0f)), 3, w);
                w8[q] = w ^ 0x80808080u; }
            unsigned char* h8 = ws + WS_H8 + (size_t)t * D + 32 * c.lane;
            *(v4u*)h8 = (v4u){w8[0], w8[1], w8[2], w8[3]}; *(v4u*)(h8 + 16) = (v4u){w8[4], w8[5], w8[6], w8[7]};
            if (c.lane == 0) ((float*)(ws + WS_SA))[t] = am * (1.0f / 127.0f);
        } else {
#pragma unroll
        for (int q = 0; q < 8; ++q) {
            const f32x4 a = *(const LAS f32x4*)(A1 + 256 * q + 4 * c.lane), bb = *(const LAS f32x4*)(B1 + 256 * q + 4 * c.lane);
            const f32x4 y = v[q] * rstd * a + bb;
            v2u o; o.x = pk2(y[0], y[1]); o.y = pk2(y[2], y[3]);
            *(v2u*)(hr + 256 * q) = o;
        }
        }
        if (FIRST && c.lane < 32) {
            const int fi = c.lane & 15;
            const float inv = (float)pow(500000.0, -(double)fi / 16.0);
            const float ang = (float)positions[t] * inv;
            ((float*)(ws + WS_CS))[(size_t)t * 32 + c.lane] = (c.lane < 16) ? cosf(ang) : sinf(ang);
        }
    }
    if (FIRST && P2_I8) {
#pragma unroll 1
        for (int n = c.gw; n < INW; n += c.ngw) {
            const bf16* wr = (const bf16*)(ws + WS_WTIN) + (size_t)n * D + 4 * c.lane;
            v2u w[8]; float f[32]; float am = 0.f;
#pragma unroll
            for (int q = 0; q < 8; ++q) w[q] = *(const v2u*)(wr + 256 * q);
#pragma unroll
            for (int q = 0; q < 8; ++q) { f[4 * q] = bflo(w[q].x); f[4 * q + 1] = bfhi(w[q].x); f[4 * q + 2] = bflo(w[q].y); f[4 * q + 3] = bfhi(w[q].y); }
#pragma unroll
            for (int k = 0; k < 32; ++k) am = fmaxf(am, fabsf(f[k]));
            am = wave_max(am);
            const float inv = (am > 0.f) ? 127.0f / am : 0.f;
            unsigned w8[8];
#pragma unroll
            for (int q = 0; q < 8; ++q) { unsigned ww = 0u;
                ww = __builtin_amdgcn_cvt_pk_u8_f32(__builtin_rintf(fmaf(f[4 * q], inv, 128.0f)), 0, ww); ww = __builtin_amdgcn_cvt_pk_u8_f32(__builtin_rintf(fmaf(f[4 * q + 1], inv, 128.0f)), 1, ww);
                ww = __builtin_amdgcn_cvt_pk_u8_f32(__builtin_rintf(fmaf(f[4 * q + 2], inv, 128.0f)), 2, ww); ww = __builtin_amdgcn_cvt_pk_u8_f32(__builtin_rintf(fmaf(f[4 * q + 3], inv, 128.0f)), 3, ww);
                w8[q] = ww ^ 0x80808080u; }
            unsigned char* o8 = ws + WS_W8 + (size_t)n * D + 32 * c.lane;
            *(v4u*)o8 = (v4u){w8[0], w8[1], w8[2], w8[3]}; *(v4u*)(o8 + 16) = (v4u){w8[4], w8[5], w8[6], w8[7]};
            if (c.lane == 0) ((float*)(ws + WS_SB))[n] = am * (1.0f / 127.0f);
        }
    }
    if (FIRST && P5_I8) {
#pragma unroll 1
        for (int n = c.gw; n < D; n += c.ngw) {
            const bf16* wr = (const bf16*)(ws + WS_WTOUT) + (size_t)n * D + 16 * c.lane;
            const v4u wa0 = *(const v4u*)wr, wa1 = *(const v4u*)(wr + 8), wp0 = *(const v4u*)(wr + 1024), wp1 = *(const v4u*)(wr + 1032);
            const unsigned ww[16] = {wa0.x, wa0.y, wa0.z, wa0.w, wa1.x, wa1.y, wa1.z, wa1.w, wp0.x, wp0.y, wp0.z, wp0.w, wp1.x, wp1.y, wp1.z, wp1.w};
            float f[32]; float am = 0.f;
#pragma unroll
            for (int k = 0; k < 16; ++k) { f[2 * k] = bflo(ww[k]); f[2 * k + 1] = bfhi(ww[k]); }
#pragma unroll
            for (int k = 0; k < 32; ++k) am = fmaxf(am, fabsf(f[k]));
            am = wave_max(am);
            const float inv = (am > 0.f) ? 127.0f / am : 0.f;
            unsigned w8[8];
#pragma unroll
            for (int q = 0; q < 8; ++q) { unsigned x8 = 0u;
                x8 = __builtin_amdgcn_cvt_pk_u8_f32(__builtin_rintf(fmaf(f[4 * q], inv, 128.0f)), 0, x8); x8 = __builtin_amdgcn_cvt_pk_u8_f32(__builtin_rintf(fmaf(f[4 * q + 1], inv, 128.0f)), 1, x8);
                x8 = __builtin_amdgcn_cvt_pk_u8_f32(__builtin_rintf(fmaf(f[4 * q + 2], inv, 128.0f)), 2, x8); x8 = __builtin_amdgcn_cvt_pk_u8_f32(__builtin_rintf(fmaf(f[4 * q + 3], inv, 128.0f)), 3, x8);
                w8[q] = x8 ^ 0x80808080u; }
            unsigned char* o8 = ws + WS_WOUT8 + (size_t)n * D + 32 * c.lane;
            *(v4u*)o8 = (v4u){w8[0], w8[1], w8[2], w8[3]}; *(v4u*)(o8 + 16) = (v4u){w8[4], w8[5], w8[6], w8[7]};
            if (c.lane == 0) ((float*)(ws + WS_SB5))[n] = am * (1.0f / 127.0f);
        }
    }
    __syncthreads();
}

template <int P>
__device__ __forceinline__ void poolr_item(const bf16* U, bf16* RB, int t, int c0) {
    const int tb = t & (SEQ - 1);
    float s[8] = {0.f, 0.f, 0.f, 0.f, 0.f, 0.f, 0.f, 0.f}, u0[8];
    v4u w[P];
#pragma unroll
    for (int j = 0; j < P; ++j) w[j] = *(const v4u*)(U + (size_t)(t - (j <= tb ? j : tb)) * 1024 + c0);
#pragma unroll
    for (int j = 0; j < P; ++j) {
        const float m = (j <= tb) ? 1.0f : 0.0f;
        const float f[8] = {bflo(w[j].x), bfhi(w[j].x), bflo(w[j].y), bfhi(w[j].y), bflo(w[j].z), bfhi(w[j].z), bflo(w[j].w), bfhi(w[j].w)};
#pragma unroll
        for (int e = 0; e < 8; ++e) { s[e] += m * f[e]; if (j == 0) u0[e] = f[e]; }
    }
    const int cnt = (tb + 1 < P) ? tb + 1 : P;
    const float ic = 1.0f / (float)cnt;
    v4u o; o.x = pk2(s[0] * ic - u0[0], s[1] * ic - u0[1]); o.y = pk2(s[2] * ic - u0[2], s[3] * ic - u0[3]);
    o.z = pk2(s[4] * ic - u0[4], s[5] * ic - u0[5]); o.w = pk2(s[6] * ic - u0[6], s[7] * ic - u0[7]);
    *(v4u*)(RB + (size_t)t * 1024 + c0) = o;
}
__device__ __forceinline__ void phase_poolr(const Ctx& c, unsigned char* ws, int it0, int itstep, int nit) {
    const bf16* U = (const bf16*)(ws + WS_U); bf16* RB = (bf16*)(ws + WS_RB);
    LAS unsigned char* tile = c.lds;
    const int ch = c.tid & 31, rg = c.tid >> 5;
    for (int itk = 0; itk < nit; ++itk) {
        const int it = it0 + itk * itstep;
        const int g = it & 3, t0 = 64 * (it >> 2), P = 2 << g, tb0 = t0 & (SEQ - 1), nrows = 63 + P;
        __syncthreads();
        for (int id = c.tid; id < nrows * 32; id += NTHREADS) {
            const int lr = id >> 5, cc = id & 31, dt = lr - (P - 1);
            v4u w = {0u, 0u, 0u, 0u};
            if (tb0 + dt >= 0) w = *(const v4u*)(U + (size_t)(t0 + dt) * 1024 + 256 * g + 8 * cc);
            *(LAS v4u*)(tile + lr * 512 + cc * 16) = w;
        }
        __syncthreads();
        float sacc[8];
#pragma unroll
        for (int e = 0; e < 8; ++e) sacc[e] = 0.f;
        const int r0 = 4 * rg;
        for (int j = 0; j < P; ++j) {
            const v4u w = *(const LAS v4u*)(tile + (r0 + P - 1 - j) * 512 + ch * 16);
            sacc[0] += bflo(w.x); sacc[1] += bfhi(w.x); sacc[2] += bflo(w.y); sacc[3] += bfhi(w.y); sacc[4] += bflo(w.z); sacc[5] += bfhi(w.z); sacc[6] += bflo(w.w); sacc[7] += bfhi(w.w);
        }
#pragma unroll
        for (int i = 0; i < 4; ++i) {
            const int r = r0 + i, tb = tb0 + r;
            const v4u wu = *(const LAS v4u*)(tile + (r + P - 1) * 512 + ch * 16);
            const float u0[8] = {bflo(wu.x), bfhi(wu.x), bflo(wu.y), bfhi(wu.y), bflo(wu.z), bfhi(wu.z), bflo(wu.w), bfhi(wu.w)};
            if (i > 0) {
                const v4u wo = *(const LAS v4u*)(tile + (r - 1) * 512 + ch * 16);
                const float uo[8] = {bflo(wo.x), bfhi(wo.x), bflo(wo.y), bfhi(wo.y), bflo(wo.z), bfhi(wo.z), bflo(wo.w), bfhi(wo.w)};
#pragma unroll
                for (int e = 0; e < 8; ++e) sacc[e] += u0[e] - uo[e];
            }
            const int cnt = (tb + 1 < P) ? tb + 1 : P;
            const float ic = 1.0f / (float)cnt;
            v4u o; o.x = pk2(sacc[0] * ic - u0[0], sacc[1] * ic - u0[1]); o.y = pk2(sacc[2] * ic - u0[2], sacc[3] * ic - u0[3]);
            o.z = pk2(sacc[4] * ic - u0[4], sacc[5] * ic - u0[5]); o.w = pk2(sacc[6] * ic - u0[6], sacc[7] * ic - u0[7]);
            *(v4u*)(RB + (size_t)(t0 + r) * 1024 + 256 * g + 8 * ch) = o;
        }
    }
    asm volatile("s_waitcnt vmcnt(0)" ::: "memory");
    __syncthreads();
}

__device__ __forceinline__ void phase_attn_simple(const Ctx& c, unsigned char* ws) {
    const bf16* QB = (const bf16*)(ws + WS_Q); const bf16* KB = (const bf16*)(ws + WS_K); const bf16* VB = (const bf16*)(ws + WS_V); bf16* HC = (bf16*)(ws + WS_HC);
    LAS float* pb = (LAS float*)(c.lds + c.wave * 2048);
    const float NEG = -3.0e38f;
    for (int item = c.gw; item < T * NH; item += c.ngw) {
        const int t = item >> 3, h = item & 7, tb = t & (SEQ - 1);
        const v4u* qp = (const v4u*)(QB + (size_t)t * 1024 + h * 128);
        v4u q[16];
#pragma unroll
        for (int i = 0; i < 16; ++i) q[i] = qp[i];
        float sv[7]; float mx = NEG;
#pragma unroll
        for (int r = 0; r < 7; ++r) {
            const int e = c.lane + 64 * r, pat = e / 129, j = e - pat * 129, off = j << (2 * pat);
            const bool valid = (e < 387) && (off <= tb);
            float s = NEG;
            if (valid) {
                const v4u* kp = (const v4u*)(KB + (size_t)(t - off) * 1024 + h * 128);
                float a0 = 0.f, a1 = 0.f;
#pragma unroll
                for (int i = 0; i < 16; ++i) { const v4u kk = kp[i]; a0 = dot2(q[i].x, kk.x, a0); a1 = dot2(q[i].y, kk.y, a1); a0 = dot2(q[i].z, kk.z, a0); a1 = dot2(q[i].w, kk.w, a1); }
                s = a0 + a1;
            }
            sv[r] = s; mx = fmaxf(mx, s);
        }
        mx = wave_max(mx);
        float l = 0.f;
#pragma unroll
        for (int r = 0; r < 7; ++r) { const float p = (sv[r] > -1.0e38f) ? exp2f(sv[r] - mx) : 0.f; l += p; pb[c.lane + 64 * r] = p; }
        l = wave_sum(l);
        LDS_WAIT();
        float o0 = 0.f, o1 = 0.f;
        for (int e = 0; e < 387; ++e) {
            const int pat = e / 129, j = e - pat * 129, off = j << (2 * pat);
            if (off > tb) continue;
            const float pe = pb[e];
            const unsigned w = *(const unsigned*)(VB + (size_t)(t - off) * 1024 + h * 128 + 2 * c.lane);
            o0 += pe * bflo(w); o1 += pe * bfhi(w);
        }
        const float il = 1.0f / l;
        *(unsigned*)(HC + (size_t)t * 2048 + h * 128 + 2 * c.lane) = pk2(o0 * il, o1 * il);
        LDS_WAIT();
    }
}

__device__ __forceinline__ unsigned off_k(unsigned row, unsigned ch) { return 256u * row + 16u * (ch ^ ((row & 3u) | (((row >> 3) & 3u) << 2))); }
__device__ __forceinline__ unsigned off_b(unsigned row, unsigned ch) { return 256u * row + 16u * (ch ^ (((row & 3u) << 2) | ((row >> 2) & 3u))); }
typedef short s4v __attribute__((ext_vector_type(4)));
__device__ __forceinline__ void phase_attn_mfma(const Ctx& c, unsigned char* ws) {
    const bf16* QB = (const bf16*)(ws + WS_Q); const bf16* KB = (const bf16*)(ws + WS_K); const bf16* VB = (const bf16*)(ws + WS_V);
    float* LSE = (float*)(ws + WS_LSE);
    const int g = c.lane >> 4, lq = c.lane & 15;
    const float NEG = -3.0e38f;
    const int i0 = 16 * c.wave, jb = 32 * (c.wave >> 1), iq = i0 + lq;
    unsigned kaddr[2][4], vbase[2], vxor[2];
    {
        const unsigned rowa = (unsigned)(jb + 8 * (lq >> 2) + (lq & 3));
        const unsigned q4 = (unsigned)(lq >> 2), p4 = (unsigned)(c.lane & 3);
#pragma unroll
        for (int s4 = 0; s4 < 4; ++s4) { kaddr[0][s4] = off_k(rowa, (unsigned)(4 * s4 + g)); kaddr[1][s4] = off_k(rowa + 4u, (unsigned)(4 * s4 + g)); }
#pragma unroll
        for (int t = 0; t < 2; ++t) {
            const unsigned row = (unsigned)(jb + 8 * g + 4 * t) + q4, f = ((row & 3u) << 2) | ((row >> 2) & 3u);
            vxor[t] = 16u * (f & 14u);
            vbase[t] = 65536u + 256u * row + 16u * ((p4 >> 1) ^ (f & 1u)) + 8u * (p4 & 1u);
        }
    }
    v4u kreg[8], vreg[8]; pg8::bf16x8 qnext[4];
#define ATTN_DECODE(U) const int v_ = (U) & 255, x_ = v_ >> 5, j_ = (v_ & 31) + 32 * ((U) >> 8), h_ = j_ / 48, w_ = j_ - 48 * h_, p_ = w_ >> 4, q_ = w_ & 15, b_ = x_ >> 2, xs_ = x_ & 3; \
        const int dsh_ = 2 * p_, r_ = q_ >> (4 - dsh_), n_ = (xs_ << (4 - dsh_)) + (q_ & ((16 >> dsh_) - 1)); \
        const int tok0q_ = b_ * SEQ + r_ + ((n_ * 128) << dsh_), tok0k_ = tok0q_ - (128 << dsh_);
#define ATTN_ISSUE(U) do { ATTN_DECODE(U) \
        const unsigned rstr_ = 2048u << dsh_;                         \
        const unsigned off0_ = (unsigned)(tok0k_ + ((c.tid >> 4) << dsh_)) * 2048u + (unsigned)(h_ * 256 + (c.tid & 15) * 16); \
        _Pragma("unroll") for (int i_ = 0; i_ < 8; ++i_) {           \
            v4u kv_ = {0u, 0u, 0u, 0u}, vv_ = kv_; \
            if (i_ >= 4 || n_ > 0) { const unsigned o_ = off0_ + (unsigned)(32 * i_) * rstr_; kv_ = *(const v4u*)((const unsigned char*)KB + o_); vv_ = *(const v4u*)((const unsigned char*)VB + o_); } \
            kreg[i_] = kv_; vreg[i_] = vv_; } \
        const int tokq_ = tok0q_ + (iq << dsh_); \
        _Pragma("unroll") for (int s_ = 0; s_ < 4; ++s_) qnext[s_] = *(const pg8::bf16x8*)(QB + (size_t)tokq_ * 1024 + h_ * 128 + 32 * s_ + 8 * g); } while (0)
    ATTN_ISSUE(c.vcu);
    for (int unit = c.vcu; unit < 3072; unit += c.G) {
        ATTN_DECODE(unit)
        const int p = p_, h = h_, n = n_, dsh = dsh_, tok0q = tok0q_;
        bf16* OP = (bf16*)(ws + (p == 0 ? WS_OP0 : (p == 1 ? WS_OP1 : WS_OP2)));
        __syncthreads();
#pragma unroll
        for (int i = 0; i < 8; ++i) {
            const int id = c.tid + 512 * i, row = id >> 4, ch = id & 15;
            *(LAS v4u*)(c.lds + off_k((unsigned)row, (unsigned)ch)) = kreg[i]; *(LAS v4u*)(c.lds + 65536u + off_b((unsigned)row, (unsigned)ch)) = vreg[i];
        }
        const int tokq = tok0q + (iq << dsh);
        pg8::bf16x8 qf[4];
#pragma unroll
        for (int s4 = 0; s4 < 4; ++s4) qf[s4] = qnext[s4];
        __syncthreads();
        if (unit + c.G < 3072) ATTN_ISSUE(unit + c.G);
        f32x4 sa[5], sb[5];
        pg8::bf16x8 kfa[2][4], kfb[2][4];
#define ATTN_LDK(BUF, KT) do { _Pragma("unroll") for (int s4 = 0; s4 < 4; ++s4) { kfa[BUF][s4] = *(const LAS pg8::bf16x8*)(c.lds + kaddr[0][s4] + 8192u * (KT)); kfb[BUF][s4] = *(const LAS pg8::bf16x8*)(c.lds + kaddr[1][s4] + 8192u * (KT)); } } while (0)
        const int jlo = (n > 0) ? iq : (iq > 128 ? iq : 128);
        float mx = NEG;
#define ATTN_MASKMAX(KT) do { \
            if ((KT) == 0 || n == 0) { _Pragma("unroll") for (int i = 0; i < 4; ++i) { const int ja = jb + 32 * (KT) + 8 * g + i; sa[KT][i] = (ja >= jlo) ? sa[KT][i] : NEG; sb[KT][i] = (ja + 4 >= jlo) ? sb[KT][i] : NEG; } } \
            if ((KT) == 4) { _Pragma("unroll") for (int i = 0; i < 4; ++i) { const int ja = jb + 8 * g + i; sa[4][i] = (ja + 128 <= iq + 128) ? sa[4][i] : NEG; sb[4][i] = (ja + 132 <= iq + 128) ? sb[4][i] : NEG; } } \
            _Pragma("unroll") for (int i = 0; i < 4; ++i) mx = fmaxf(mx, fmaxf(sa[KT][i], sb[KT][i])); } while (0)
        ATTN_LDK(0, 0);
#pragma unroll
        for (int kt = 0; kt < 5; ++kt) {
            if (kt < 4) ATTN_LDK((kt + 1) & 1, kt + 1);
            __builtin_amdgcn_sched_barrier(0);
            f32x4 aa = {0.f, 0.f, 0.f, 0.f}, ab = aa;
#pragma unroll
            for (int s4 = 0; s4 < 4; ++s4) {
                aa = __builtin_amdgcn_mfma_f32_16x16x32_bf16(kfa[kt & 1][s4], qf[s4], aa, 0, 0, 0);
                ab = __builtin_amdgcn_mfma_f32_16x16x32_bf16(kfb[kt & 1][s4], qf[s4], ab, 0, 0, 0);
            }
            sa[kt] = aa; sb[kt] = ab;
            if (kt == 1) ATTN_MASKMAX(0); if (kt == 2) ATTN_MASKMAX(1); if (kt == 3) ATTN_MASKMAX(2); if (kt == 4) ATTN_MASKMAX(3);
            __builtin_amdgcn_sched_barrier(0);
        }
        ATTN_MASKMAX(4);
#undef ATTN_LDK
#undef ATTN_MASKMAX
        mx = xmax4(mx);
        f32x4 o[8];
#pragma unroll
        for (int c8 = 0; c8 < 8; ++c8) o[c8] = (f32x4){0.f, 0.f, 0.f, 0.f};
        s4v vt0[3][4], vt1[3][4];
#define ATTN_LDV(HI) do { _Pragma("unroll") for (int c4 = 0; c4 < 4; ++c4) { const int c8_ = 4 * ((HI) & 1) + c4; \
            vt0[(HI) % 3][c4] = __builtin_amdgcn_ds_read_tr16_b64_v4i16((LAS s4v*)(c.lds + (vbase[0] + ((32u * c8_) ^ vxor[0])) + 8192u * ((HI) >> 1))); \
            vt1[(HI) % 3][c4] = __builtin_amdgcn_ds_read_tr16_b64_v4i16((LAS s4v*)(c.lds + (vbase[1] + ((32u * c8_) ^ vxor[1])) + 8192u * ((HI) >> 1))); } } while (0)
        float l = 0.f;
        pg8::bf16x8 pfv[5];
#define ATTN_EXPPACK(KT) do { _Pragma("unroll") for (int i = 0; i < 4; ++i) { sa[KT][i] = __builtin_amdgcn_exp2f(sa[KT][i] - mx); sb[KT][i] = __builtin_amdgcn_exp2f(sb[KT][i] - mx); l += sa[KT][i] + sb[KT][i]; } \
            pg8::u32x4 pw_; pw_.x = pk2(sa[KT][0], sa[KT][1]); pw_.y = pk2(sa[KT][2], sa[KT][3]); pw_.z = pk2(sb[KT][0], sb[KT][1]); pw_.w = pk2(sb[KT][2], sb[KT][3]); pfv[KT] = __builtin_bit_cast(pg8::bf16x8, pw_); } while (0)
        ATTN_LDV(0); ATTN_LDV(1);
        ATTN_EXPPACK(0);
#pragma unroll
        for (int hi = 0; hi < 10; ++hi) {
            if (hi + 2 < 10) ATTN_LDV(hi + 2);
            __builtin_amdgcn_sched_barrier(0);
#pragma unroll
            for (int c4 = 0; c4 < 4; ++c4) {
                const pg8::bf16x8 vf = __builtin_shufflevector(vt0[hi % 3][c4], vt1[hi % 3][c4], 0, 1, 2, 3, 4, 5, 6, 7);
                o[4 * (hi & 1) + c4] = __builtin_amdgcn_mfma_f32_16x16x32_bf16(vf, pfv[hi >> 1], o[4 * (hi & 1) + c4], 0, 0, 0);
            }
            if (hi == 0) ATTN_EXPPACK(1); if (hi == 2) ATTN_EXPPACK(2); if (hi == 4) ATTN_EXPPACK(3); if (hi == 6) ATTN_EXPPACK(4);
            __builtin_amdgcn_sched_barrier(0);
        }
#undef ATTN_LDV
#undef ATTN_EXPPACK
        l = xsum4(l);
        const float il = 1.0f / l;
        if (OP_FP8 && P5_I8) {
            unsigned char* orow8 = (unsigned char*)OP + (size_t)tokq * 1024 + h * 128 + 4 * g;
#pragma unroll
            for (int c8 = 0; c8 < 8; ++c8) { int pk = __builtin_amdgcn_cvt_pk_fp8_f32(o[c8][0] * il, o[c8][1] * il, 0, false); pk = __builtin_amdgcn_cvt_pk_fp8_f32(o[c8][2] * il, o[c8][3] * il, pk, true); *(int*)(orow8 + 16 * c8) = pk; }
        } else {
        bf16* orow = OP + (size_t)tokq * 1024 + h * 128 + 4 * g;
#pragma unroll
        for (int c8 = 0; c8 < 8; ++c8) { v2u w; w.x = pk2(o[c8][0] * il, o[c8][1] * il); w.y = pk2(o[c8][2] * il, o[c8][3] * il); *(v2u*)(orow + 16 * c8) = w; }
        }
        if (g == 0) LSE[((size_t)p * T + tokq) * 8 + h] = mx + __builtin_amdgcn_logf(l);
    }
    __syncthreads();
}
typedef int i32x4_t __attribute__((ext_vector_type(4)));
__device__ __forceinline__ void phase_combine_q(const Ctx& c, unsigned char* ws) {
    const int grp = c.vcu >> 5, lw = (c.vcu & 31) * NWAVES + c.wave;
    if (lw < 64) {
        const int idx = lw * 64 + c.lane, bb = idx >> 11, nn = idx & 2047; float bs = 0.f;
        const float* bp = (const float*)(ws + WS_BIASP) + (size_t)bb * D + nn; float pv[32];
#pragma unroll
        for (int kb = 0; kb < 32; ++kb) pv[kb] = bp[(size_t)kb * 2 * D];
#pragma unroll
        for (int kb = 0; kb < 32; ++kb) bs += pv[kb];
        ((float*)(ws + WS_BIASF))[grp * 4096 + idx] = bs;
    }
    const float* LSE = (const float*)(ws + WS_LSE); const bf16* HC = (const bf16*)(ws + WS_HC);
    const bf16* OP0 = (const bf16*)(ws + WS_OP0); const bf16* OP1 = (const bf16*)(ws + WS_OP1); const bf16* OP2 = (const bf16*)(ws + WS_OP2);
    const int h = c.lane >> 3;
    i32x4_t na = {0, 0, 0, 0}, nb = na, nc = na; v4u np0 = {0u, 0u, 0u, 0u}, np1 = np0; float nl0 = 0.f, nl1 = 0.f, nl2 = 0.f;
#define CQ_LOAD(TT) do { const size_t off_ = (size_t)(TT) * 1024 + 16 * c.lane; \
        nl0 = LSE[((size_t)0 * T + (TT)) * 8 + h]; nl1 = LSE[((size_t)1 * T + (TT)) * 8 + h]; nl2 = LSE[((size_t)2 * T + (TT)) * 8 + h]; \
        if (OP_FP8) { na = *(const i32x4_t*)((const unsigned char*)OP0 + off_); nb = *(const i32x4_t*)((const unsigned char*)OP1 + off_); nc = *(const i32x4_t*)((const unsigned char*)OP2 + off_); \
            np0 = *(const v4u*)(HC + (size_t)(TT) * 2048 + 1024 + 16 * c.lane); np1 = *(const v4u*)(HC + (size_t)(TT) * 2048 + 1024 + 16 * c.lane + 8); } } while (0)
    const int tend = 2048 * grp + 2048;
    CQ_LOAD(2048 * grp + lw);
    for (int t = 2048 * grp + lw; t < tend; t += 256) {
        const float l0 = nl0, l1 = nl1, l2 = nl2;
        const i32x4_t a = na, bq = nb, cq = nc; const v4u pp[2] = {np0, np1};
        if (t + 256 < tend) CQ_LOAD(t + 256);
        const float m = fmaxf(l0, fmaxf(l1, l2));
        float w0 = exp2f(l0 - m), w1 = exp2f(l1 - m), w2 = exp2f(l2 - m);
        const float inv = 1.0f / (w0 + w1 + w2); w0 *= inv; w1 *= inv; w2 *= inv;
        const size_t off = (size_t)t * 1024 + 16 * c.lane;
        float f[32]; float am = 0.f;
        if (OP_FP8) {
#pragma unroll
            for (int d = 0; d < 4; ++d) {
                f[4 * d + 0] = w0 * __builtin_amdgcn_cvt_f32_fp8(a[d], 0) + w1 * __builtin_amdgcn_cvt_f32_fp8(bq[d], 0) + w2 * __builtin_amdgcn_cvt_f32_fp8(cq[d], 0);
                f[4 * d + 1] = w0 * __builtin_amdgcn_cvt_f32_fp8(a[d], 1) + w1 * __builtin_amdgcn_cvt_f32_fp8(bq[d], 1) + w2 * __builtin_amdgcn_cvt_f32_fp8(cq[d], 1);
                f[4 * d + 2] = w0 * __builtin_amdgcn_cvt_f32_fp8(a[d], 2) + w1 * __builtin_amdgcn_cvt_f32_fp8(bq[d], 2) + w2 * __builtin_amdgcn_cvt_f32_fp8(cq[d], 2);
                f[4 * d + 3] = w0 * __builtin_amdgcn_cvt_f32_fp8(a[d], 3) + w1 * __builtin_amdgcn_cvt_f32_fp8(bq[d], 3) + w2 * __builtin_amdgcn_cvt_f32_fp8(cq[d], 3);
            }
#pragma unroll
            for (int hh = 0; hh < 2; ++hh) {
                const v4u p = pp[hh];
                f[16 + 8 * hh + 0] = bflo(p.x); f[16 + 8 * hh + 1] = bfhi(p.x); f[16 + 8 * hh + 2] = bflo(p.y); f[16 + 8 * hh + 3] = bfhi(p.y);
                f[16 + 8 * hh + 4] = bflo(p.z); f[16 + 8 * hh + 5] = bfhi(p.z); f[16 + 8 * hh + 6] = bflo(p.w); f[16 + 8 * hh + 7] = bfhi(p.w);
            }
        } else {
#pragma unroll
        for (int hh = 0; hh < 2; ++hh) {
            const v4u a = *(const v4u*)(OP0 + off + 8 * hh), bq = *(const v4u*)(OP1 + off + 8 * hh), cq = *(const v4u*)(OP2 + off + 8 * hh);
            const v4u p = *(const v4u*)(HC + (size_t)t * 2048 + 1024 + 16 * c.lane + 8 * hh);
            f[8 * hh + 0] = w0 * bflo(a.x) + w1 * bflo(bq.x) + w2 * bflo(cq.x); f[8 * hh + 1] = w0 * bfhi(a.x) + w1 * bfhi(bq.x) + w2 * bfhi(cq.x);
            f[8 * hh + 2] = w0 * bflo(a.y) + w1 * bflo(bq.y) + w2 * bflo(cq.y); f[8 * hh + 3] = w0 * bfhi(a.y) + w1 * bfhi(bq.y) + w2 * bfhi(cq.y);
            f[8 * hh + 4] = w0 * bflo(a.z) + w1 * bflo(bq.z) + w2 * bflo(cq.z); f[8 * hh + 5] = w0 * bfhi(a.z) + w1 * bfhi(bq.z) + w2 * bfhi(cq.z);
            f[8 * hh + 6] = w0 * bflo(a.w) + w1 * bflo(bq.w) + w2 * bflo(cq.w); f[8 * hh + 7] = w0 * bfhi(a.w) + w1 * bfhi(bq.w) + w2 * bfhi(cq.w);
            f[16 + 8 * hh + 0] = bflo(p.x); f[16 + 8 * hh + 1] = bfhi(p.x); f[16 + 8 * hh + 2] = bflo(p.y); f[16 + 8 * hh + 3] = bfhi(p.y);
            f[16 + 8 * hh + 4] = bflo(p.z); f[16 + 8 * hh + 5] = bfhi(p.z); f[16 + 8 * hh + 6] = bflo(p.w); f[16 + 8 * hh + 7] = bfhi(p.w);
        }
        }
#pragma unroll
        for (int k = 0; k < 32; ++k) am = fmaxf(am, fabsf(f[k]));
        am = wave_max(am);
        const float qi = (am > 0.f) ? 127.0f / am : 0.f;
        unsigned w8[8];
#pragma unroll
        for (int q = 0; q < 8; ++q) { unsigned ww = 0u;
            ww = __builtin_amdgcn_cvt_pk_u8_f32(__builtin_rintf(fmaf(f[4 * q], qi, 128.0f)), 0, ww); ww = __builtin_amdgcn_cvt_pk_u8_f32(__builtin_rintf(fmaf(f[4 * q + 1], qi, 128.0f)), 1, ww);
            ww = __builtin_amdgcn_cvt_pk_u8_f32(__builtin_rintf(fmaf(f[4 * q + 2], qi, 128.0f)), 2, ww); ww = __builtin_amdgcn_cvt_pk_u8_f32(__builtin_rintf(fmaf(f[4 * q + 3], qi, 128.0f)), 3, ww);
            w8[q] = ww ^ 0x80808080u; }
        unsigned char* o8 = ws + WS_HC8 + (size_t)t * D + 32 * c.lane;
        *(v4u*)o8 = (v4u){w8[0], w8[1], w8[2], w8[3]}; *(v4u*)(o8 + 16) = (v4u){w8[4], w8[5], w8[6], w8[7]};
        if (c.lane == 0) ((float*)(ws + WS_SA5))[t] = am * (1.0f / 127.0f);
    }
#undef CQ_LOAD
}
__device__ __forceinline__ void phase_combine(const Ctx& c, unsigned char* ws) {
    const float* LSE = (const float*)(ws + WS_LSE); bf16* HC = (bf16*)(ws + WS_HC);
    const bf16* OP0 = (const bf16*)(ws + WS_OP0); const bf16* OP1 = (const bf16*)(ws + WS_OP1); const bf16* OP2 = (const bf16*)(ws + WS_OP2);
    for (int t = c.gw; t < T; t += c.ngw) {
        const int h = c.lane >> 3;
        const float l0 = LSE[((size_t)0 * T + t) * 8 + h], l1 = LSE[((size_t)1 * T + t) * 8 + h], l2 = LSE[((size_t)2 * T + t) * 8 + h];
        const float m = fmaxf(l0, fmaxf(l1, l2));
        float w0 = exp2f(l0 - m), w1 = exp2f(l1 - m), w2 = exp2f(l2 - m);
        const float inv = 1.0f / (w0 + w1 + w2); w0 *= inv; w1 *= inv; w2 *= inv;
        const size_t off = (size_t)t * 1024 + 16 * c.lane;
#pragma unroll
        for (int hh = 0; hh < 2; ++hh) {
            const v4u a = *(const v4u*)(OP0 + off + 8 * hh), bq = *(const v4u*)(OP1 + off + 8 * hh), cq = *(const v4u*)(OP2 + off + 8 * hh);
            v4u o;
            o.x = pk2(w0 * bflo(a.x) + w1 * bflo(bq.x) + w2 * bflo(cq.x), w0 * bfhi(a.x) + w1 * bfhi(bq.x) + w2 * bfhi(cq.x));
            o.y = pk2(w0 * bflo(a.y) + w1 * bflo(bq.y) + w2 * bflo(cq.y), w0 * bfhi(a.y) + w1 * bfhi(bq.y) + w2 * bfhi(cq.y));
            o.z = pk2(w0 * bflo(a.z) + w1 * bflo(bq.z) + w2 * bflo(cq.z), w0 * bfhi(a.z) + w1 * bfhi(bq.z) + w2 * bfhi(cq.z));
            o.w = pk2(w0 * bflo(a.w) + w1 * bflo(bq.w) + w2 * bflo(cq.w), w0 * bfhi(a.w) + w1 * bfhi(bq.w) + w2 * bfhi(cq.w));
            *(v4u*)(HC + (size_t)t * 2048 + 16 * c.lane + 8 * hh) = o;
        }
    }
}

__device__ __forceinline__ int f2sort(float f) { return __float_as_int(f); }
__device__ __forceinline__ float sort2f(int k) { return __int_as_float(k); }
__device__ __forceinline__ int kmax(int a, int b) { return __float_as_int(fmaxf(__int_as_float(a), __int_as_float(b))); }
__device__ __forceinline__ int kmin(int a, int b) { return __float_as_int(fminf(__int_as_float(a), __int_as_float(b))); }
#define CE_DESC(a, b) do { const int hi_ = kmax((a), (b)), lo_ = kmin((a), (b)); (a) = hi_; (b) = lo_; } while (0)
__device__ __forceinline__ void bitonic_merge16(int (&v)[16]) {
#pragma unroll
    for (int j = 8; j > 0; j >>= 1)
#pragma unroll
        for (int i = 0; i < 16; ++i) { const int l = i ^ j; if (l > i) CE_DESC(v[i], v[l]); }
}
__device__ __forceinline__ void sort16(int (&v)[16]) {
    CE_DESC(v[0], v[13]); CE_DESC(v[1], v[12]); CE_DESC(v[2], v[15]); CE_DESC(v[3], v[14]); CE_DESC(v[4], v[8]); CE_DESC(v[5], v[6]); CE_DESC(v[7], v[11]); CE_DESC(v[9], v[10]); CE_DESC(v[0], v[5]); CE_DESC(v[1], v[7]); CE_DESC(v[2], v[9]); CE_DESC(v[3], v[4]); CE_DESC(v[6], v[13]); CE_DESC(v[8], v[14]); CE_DESC(v[10], v[15]); CE_DESC(v[11], v[12]); CE_DESC(v[0], v[1]); CE_DESC(v[2], v[3]); CE_DESC(v[4], v[5]); CE_DESC(v[6], v[8]); CE_DESC(v[7], v[9]); CE_DESC(v[10], v[11]); CE_DESC(v[12], v[13]); CE_DESC(v[14], v[15]); CE_DESC(v[0], v[2]); CE_DESC(v[1], v[3]); CE_DESC(v[4], v[10]); CE_DESC(v[5], v[11]); CE_DESC(v[6], v[7]); CE_DESC(v[8], v[9]); CE_DESC(v[12], v[14]); CE_DESC(v[13], v[15]); CE_DESC(v[1], v[2]); CE_DESC(v[3], v[12]); CE_DESC(v[4], v[6]); CE_DESC(v[5], v[7]); CE_DESC(v[8], v[10]); CE_DESC(v[9], v[11]); CE_DESC(v[13], v[14]); CE_DESC(v[1], v[4]); CE_DESC(v[2], v[6]); CE_DESC(v[5], v[8]); CE_DESC(v[7], v[10]); CE_DESC(v[9], v[13]); CE_DESC(v[11], v[14]); CE_DESC(v[2], v[4]); CE_DESC(v[3], v[6]); CE_DESC(v[9], v[12]); CE_DESC(v[11], v[13]); CE_DESC(v[3], v[5]); CE_DESC(v[6], v[8]); CE_DESC(v[7], v[9]); CE_DESC(v[10], v[12]); CE_DESC(v[3], v[4]); CE_DESC(v[5], v[6]); CE_DESC(v[7], v[8]); CE_DESC(v[9], v[10]); CE_DESC(v[11], v[12]); CE_DESC(v[6], v[7]); CE_DESC(v[8], v[9]);
}
__device__ __forceinline__ void merge_top16(int (&a)[16], const int (&b)[16]) {
#pragma unroll
    for (int k = 0; k < 16; ++k) a[k] = kmax(a[k], b[15 - k]);
    bitonic_merge16(a);
}
__device__ __forceinline__ void xlane_merge(int (&a)[16], int xr, int lane) {
    int b[16];
#pragma unroll
    for (int k = 0; k < 16; ++k) b[k] = SXOR(a[k], xr, lane);
    merge_top16(a, b);
}
__device__ __forceinline__ void topk_stage(const Ctx& c, unsigned char* ws) {
    const bf16* SKB = (const bf16*)(ws + WS_SKP);
    const int h = c.vcu & 7;
    __syncthreads();
#pragma unroll
    for (int i = 0; i < 8; ++i) {
        const int id = c.tid + 512 * i, row = id >> 4, ch = id & 15;
        *(LAS v4u*)(c.lds + off_b((unsigned)row, (unsigned)ch)) = *(const v4u*)(SKB + ((size_t)h * 256 + row) * 128 + ch * 8);
    }
}
__device__ __forceinline__ void phase_scores_topk(const Ctx& c, unsigned char* ws) {
    const bf16* QP = (const bf16*)(ws + WS_QP); const bf16* SKB = (const bf16*)(ws + WS_SKP);
    int* IDX = (int*)(ws + WS_IDX); float* GATE = (float*)(ws + WS_GATE);
    const int g = c.lane >> 4, lq = c.lane & 15;
    const int h = c.vcu & 7, tb = c.vcu >> 3;
    LAS int* stash = (LAS int*)(c.lds + (c.wave < 7 ? 65536 + c.wave * 8448 : 131328) + c.lane * 132);
    unsigned ka[4];
#pragma unroll
    for (int s4 = 0; s4 < 4; ++s4) ka[s4] = off_b((unsigned)lq, (unsigned)(4 * s4 + g));
    __syncthreads();
#pragma unroll 1
    for (int it = 0; it < 4; ++it) {
        const int t = 512 * tb + 128 * it + 16 * c.wave + lq;
        int top[2][16];
#pragma unroll
        for (int p = 0; p < 2; ++p) {
            pg8::bf16x8 qf[4];
#pragma unroll
            for (int s4 = 0; s4 < 4; ++s4) qf[s4] = *(const pg8::bf16x8*)(QP + (size_t)t * 2048 + h * 256 + p * 128 + 32 * s4 + 8 * g);
            int lo[16], hi[16];
#pragma unroll
            for (int c8 = 0; c8 < 8; ++c8) {
                f32x4 acc = {0.f, 0.f, 0.f, 0.f};
#pragma unroll
                for (int s4 = 0; s4 < 4; ++s4) {
                    const pg8::bf16x8 kf = *(const LAS pg8::bf16x8*)(c.lds + ka[s4] + (unsigned)(32768 * p + 4096 * c8));
                    acc = __builtin_amdgcn_mfma_f32_16x16x32_bf16(kf, qf[s4], acc, 0, 0, 0);
                }
#pragma unroll
                for (int i = 0; i < 4; ++i) { const int key = (f2sort(acc[i]) & ~127) | (16 * c8 + 4 * g + i); if (c8 < 4) lo[4 * c8 + i] = key; else hi[4 * (c8 - 4) + i] = key; }
            }
            sort16(lo); sort16(hi); merge_top16(lo, hi);
            xlane_merge(lo, 16, c.lane); xlane_merge(lo, 32, c.lane);
#pragma unroll
            for (int k = 0; k < 16; ++k) top[p][k] = lo[k];
        }
        if (g == it) {
#pragma unroll
            for (int p = 0; p < 2; ++p)
#pragma unroll
                for (int k = 0; k < 16; ++k) stash[16 * p + k] = top[p][k];
        }
    }
    LDS_WAIT();
    {
        const int t = 512 * tb + 128 * g + 16 * c.wave + lq;
        int top[2][16];
#pragma unroll
        for (int p = 0; p < 2; ++p)
#pragma unroll
            for (int k = 0; k < 16; ++k) top[p][k] = stash[16 * p + k];
        float f0[16], f1[16];
#pragma unroll
        for (int k = 0; k < 16; ++k) { f0[k] = sort2f(top[0][k] & ~127); f1[k] = sort2f(top[1][k] & ~127); }
#define CAND(a, b) ((f2sort(f0[a] + f1[b]) & ~255) | ((a) << 4) | (b))
        int X[16], Y[16], Z[16];
#pragma unroll
        for (int b2 = 0; b2 < 16; ++b2) X[b2] = CAND(0, b2);
#pragma unroll
        for (int b2 = 0; b2 < 8; ++b2) Y[b2] = CAND(1, b2);
#pragma unroll
        for (int a2 = 8; a2 < 16; ++a2) Y[23 - a2] = CAND(a2, 0);
        Z[0] = CAND(2, 0); Z[1] = CAND(2, 1); Z[2] = CAND(2, 2); Z[3] = CAND(2, 3); Z[4] = CAND(2, 4);
        Z[5] = CAND(3, 0); Z[6] = CAND(3, 1); Z[7] = CAND(3, 2); Z[8] = CAND(3, 3);
        Z[9] = CAND(4, 0); Z[10] = CAND(4, 1); Z[11] = CAND(4, 2);
        Z[12] = CAND(5, 0); Z[13] = CAND(5, 1); Z[14] = CAND(6, 0); Z[15] = CAND(6, 1);
        const int w0 = CAND(7, 0), w1 = CAND(7, 1);
#undef CAND
        bitonic_merge16(Y); sort16(Z);
        merge_top16(X, Y); merge_top16(X, Z);
        X[14] = kmax(X[14], w1); X[15] = kmax(X[15], w0); bitonic_merge16(X);
        LDS_WAIT();
        float e[16], sum = 0.f; const float fmx = sort2f(X[0] & ~255);
#pragma unroll
        for (int k = 0; k < 16; ++k) { e[k] = __expf(sort2f(X[k] & ~255) - fmx); sum += e[k]; }
        const float inv = 1.0f / sum;
        int ex[16];
#pragma unroll
        for (int k = 0; k < 16; ++k) { const int a2 = (X[k] >> 4) & 15, b2 = X[k] & 15; ex[k] = (stash[a2] & 127) * PE_NK + (stash[16 + b2] & 127); }
        {
            int* ip = IDX + (size_t)t * 128 + h * 16; float* gp = GATE + (size_t)t * 128 + h * 16;
#pragma unroll
            for (int q = 0; q < 4; ++q) {
                *(int4*)(ip + 4 * q) = make_int4(ex[4 * q], ex[4 * q + 1], ex[4 * q + 2], ex[4 * q + 3]);
                *(f32x4*)(gp + 4 * q) = (f32x4){e[4 * q] * inv, e[4 * q + 1] * inv, e[4 * q + 2] * inv, e[4 * q + 3] * inv};
            }
        }
        LDS_WAIT();
    }
    __syncthreads();
}

__device__ __forceinline__ void phase_topk_simple(const Ctx& c, unsigned char* ws) {
    const float* SC = (const float*)(ws + WS_SC); int* IDX = (int*)(ws + WS_IDX); float* GATE = (float*)(ws + WS_GATE);
    const float NEG = -3.0e38f;
    for (int item = c.gw; item < T * PE_HEADS; item += c.ngw) {
        const int t = item >> 3, h = item & 7;
        const float* sc = SC + (size_t)t * 2048 + h * 256;
        float sh[2] = {0.f, 0.f}; int ih[2] = {0, 0};
#pragma unroll
        for (int p = 0; p < 2; ++p) {
            float va = sc[128 * p + c.lane], vb = sc[128 * p + 64 + c.lane];
            for (int r = 0; r < PE_K; ++r) {
                const float M = wave_max(fmaxf(va, vb));
                const unsigned long long ba = __ballot(va == M), bb = __ballot(vb == M);
                const int n = ba ? (int)__builtin_ctzll(ba) : 64 + (int)__builtin_ctzll(bb);
                if (c.lane == r) { sh[p] = M; ih[p] = n; }
                if (n < 64) { if (c.lane == n) va = NEG; } else { if (c.lane == n - 64) vb = NEG; }
            }
        }
        float cv[4];
#pragma unroll
        for (int q = 0; q < 4; ++q) { const int cc = c.lane + 64 * q; cv[q] = sh_idx(sh[0], cc >> 4) + sh_idx(sh[1], cc & 15); }
        float ts = NEG; int tc = 0;
        for (int r = 0; r < PE_K; ++r) {
            const float M = wave_max(fmaxf(fmaxf(cv[0], cv[1]), fmaxf(cv[2], cv[3])));
            int cc = -1;
#pragma unroll
            for (int q = 3; q >= 0; --q) { const unsigned long long bq = __ballot(cv[q] == M); if (bq) cc = 64 * q + (int)__builtin_ctzll(bq); }
            if (c.lane == r) { ts = M; tc = cc; }
#pragma unroll
            for (int q = 0; q < 4; ++q) if (cc == c.lane + 64 * q) cv[q] = NEG;
        }
        const int i0 = sh_idx(ih[0], tc >> 4), i1 = sh_idx(ih[1], tc & 15);
        const float tmax = sh_idx(ts, 0);
        const float ex = (c.lane < PE_K) ? __expf(ts - tmax) : 0.f;
        const float sum = wave_sum(ex);
        if (c.lane < PE_K) { IDX[(size_t)t * 128 + h * 16 + c.lane] = i0 * PE_NK + i1; GATE[(size_t)t * 128 + h * 16 + c.lane] = ex / sum; }
    }
}

__device__ __forceinline__ void ld_row8(const unsigned char* tab, int e, int lane, v4u (&r)[2]) {
    const v4u* p = (const v4u*)(tab + (size_t)e * D) + lane;
    r[0] = p[0]; r[1] = p[64];
}
__device__ __forceinline__ int idot_row(const int (&h)[8], const v4u (&r)[2]) {
    int a = 0, b = 0;
    a = __builtin_amdgcn_sdot4(h[0], (int)r[0].x, a, false); b = __builtin_amdgcn_sdot4(h[1], (int)r[0].y, b, false);
    a = __builtin_amdgcn_sdot4(h[2], (int)r[0].z, a, false); b = __builtin_amdgcn_sdot4(h[3], (int)r[0].w, b, false);
    a = __builtin_amdgcn_sdot4(h[4], (int)r[1].x, a, false); b = __builtin_amdgcn_sdot4(h[5], (int)r[1].y, b, false);
    a = __builtin_amdgcn_sdot4(h[6], (int)r[1].z, a, false); b = __builtin_amdgcn_sdot4(h[7], (int)r[1].w, b, false);
    return a + b;
}
__device__ __forceinline__ int reduce8(const int (&p)[8], int lane) {
    const bool b0 = lane & 1, b1 = lane & 2, b2 = lane & 4;
    int q[4], r2[2];
#pragma unroll
    for (int i = 0; i < 4; ++i) { const int keep = b0 ? p[2 * i + 1] : p[2 * i], send = b0 ? p[2 * i] : p[2 * i + 1]; q[i] = keep + SXOR(send, 1, lane); }
#pragma unroll
    for (int i = 0; i < 2; ++i) { const int keep = b1 ? q[2 * i + 1] : q[2 * i], send = b1 ? q[2 * i] : q[2 * i + 1]; r2[i] = keep + SXOR(send, 2, lane); }
    int v = (b2 ? r2[1] : r2[0]) + SXOR(b2 ? r2[0] : r2[1], 4, lane);
    v += SXOR(v, 8, lane); v += SXOR(v, 16, lane); v += SXOR(v, 32, lane);
    return v;
}
__device__ __forceinline__ void axpy_row8(float (&y)[32], float a, const v4u (&r)[2]) {
#pragma unroll
    for (int q = 0; q < 2; ++q) {
        const unsigned w[4] = {r[q].x, r[q].y, r[q].z, r[q].w};
#pragma unroll
        for (int d = 0; d < 4; ++d) {
            y[16 * q + 4 * d + 0] += a * (float)(w[d] & 0xffu); y[16 * q + 4 * d + 1] += a * (float)((w[d] >> 8) & 0xffu);
            y[16 * q + 4 * d + 2] += a * (float)((w[d] >> 16) & 0xffu); y[16 * q + 4 * d + 3] += a * (float)(w[d] >> 24);
        }
    }
}
__device__ __forceinline__ void phase_peer(const Ctx& c, const float* X1, const float* final_g, float* out, unsigned char* ws) {
    const unsigned char* PU = ws + WS_PU; const unsigned char* PV = ws + WS_PV; const bf16* HB = (const bf16*)(ws + WS_HB);
    const float* SU = (const float*)(ws + WS_SU); const float* SV = (const float*)(ws + WS_SV);
    const int* IDX = (const int*)(ws + WS_IDX); const float* GATE = (const float*)(ws + WS_GATE); const float* MODF = (const float*)(ws + WS_MODF);
    LAS float* G2 = (LAS float*)c.lds; LAS float* FG = G2 + D;
    const int b = c.vcu >> 7;
    { const int j = 4 * c.tid; *(LAS f32x4*)(G2 + j) = *(const f32x4*)(MODF + (size_t)b * NMOD + 5 * D + j); *(LAS f32x4*)(FG + j) = *(const f32x4*)(final_g + j); }
    __syncthreads();
#pragma unroll 1
    for (int i = (DUP & 1024) ? -8 : 0; i < 8; ++i) {
        const int t = 64 * c.vcu + 8 * c.wave + (i & 7);
        const int e0 = IDX[(size_t)t * 128 + c.lane], e1 = IDX[(size_t)t * 128 + 64 + c.lane];
        const float g0 = GATE[(size_t)t * 128 + c.lane], g1 = GATE[(size_t)t * 128 + 64 + c.lane];
        v4u r[8][2];
#pragma unroll
        for (int q = 0; q < 8; ++q) ld_row8(PU, __builtin_amdgcn_readlane(e0, q), c.lane, r[q]);
        const float su0 = SU[e0], su1 = SU[e1], sv0 = SV[e0], sv1 = SV[e1];
        int hq[8]; float sh;
        {
            float hf[32]; float am = 0.f;
#pragma unroll
            for (int q = 0; q < 2; ++q)
#pragma unroll
                for (int rr = 0; rr < 2; ++rr) {
                    const v4u w = *(const v4u*)(HB + (size_t)t * D + 1024 * q + 16 * c.lane + 8 * rr);
                    float* f = hf + 16 * q + 8 * rr;
                    f[0] = bflo(w.x); f[1] = bfhi(w.x); f[2] = bflo(w.y); f[3] = bfhi(w.y); f[4] = bflo(w.z); f[5] = bfhi(w.z); f[6] = bflo(w.w); f[7] = bfhi(w.w);
                }
#pragma unroll
            for (int k = 0; k < 32; ++k) am = fmaxf(am, fabsf(hf[k]));
            am = wave_max(am);
            const float inv = (am > 0.f) ? 127.0f / am : 0.f; sh = am * (1.0f / 127.0f);
#pragma unroll
            for (int d = 0; d < 8; ++d) { unsigned w = 0u;
#pragma unroll
                for (int e = 0; e < 4; ++e) { const int qv = __float2int_rn(hf[4 * d + e] * inv); w |= ((unsigned)qv & 0xffu) << (8 * e); }
                hq[d] = (int)w; }
        }
        int ia0 = 0, ia1 = 0;
#pragma unroll 1
        for (int m = 0; m < 16; ++m) {
            int part[8];
#pragma unroll
            for (int q = 0; q < 8; ++q) {
                part[q] = idot_row(hq, r[q]);
                const int kn = 8 * (m + 1) + q;
                if (m < 15) { const int en = (kn < 64) ? __builtin_amdgcn_readlane(e0, kn & 63) : __builtin_amdgcn_readlane(e1, kn & 63); ld_row8(PU, en, c.lane, r[q]); }
            }
            const int v = reduce8(part, c.lane);
            if (m < 8) { if ((c.lane >> 3) == m) ia0 = v; } else { if ((c.lane >> 3) == m - 8) ia1 = v; }
        }
#pragma unroll
        for (int q = 0; q < 8; ++q) ld_row8(PV, __builtin_amdgcn_readlane(e0, q), c.lane, r[q]);
        const float a0 = (float)ia0 * su0 * sh, a1 = (float)ia1 * su1 * sh;
        const float c0 = 0.5f * a0 * (1.0f + erff(a0 * 0.70710678118654752f)) * g0 * sv0;
        const float c1 = 0.5f * a1 * (1.0f + erff(a1 * 0.70710678118654752f)) * g1 * sv1;
        const float csum = wave_sum(c0 + c1);
        float y[32];
#pragma unroll
        for (int q = 0; q < 32; ++q) y[q] = 0.f;
#pragma unroll 1
        for (int m = 0; m < 16; ++m) {
#pragma unroll
            for (int q = 0; q < 8; ++q) {
                const int k = 8 * m + q;
                const float ck = __uint_as_float((k < 64) ? __builtin_amdgcn_readlane(__float_as_uint(c0), k & 63) : __builtin_amdgcn_readlane(__float_as_uint(c1), k & 63));
                axpy_row8(y, ck, r[q]);
                const int kn = k + 8;
                if (m < 15) { const int en = (kn < 64) ? __builtin_amdgcn_readlane(e0, kn & 63) : __builtin_amdgcn_readlane(e1, kn & 63); ld_row8(PV, en, c.lane, r[q]); }
            }
        }
        const float* xr = X1 + (size_t)t * D + 16 * c.lane; float* orow = ((DUP & 1024) && i < 0 ? (float*)(ws + WS_HC) : out) + (size_t)t * D + 16 * c.lane;
        const float yoff = 128.0f * csum;
        float ss = 0.f;
#pragma unroll
        for (int q = 0; q < 2; ++q)
#pragma unroll
            for (int d = 0; d < 4; ++d) {
                const f32x4 xa = *(const f32x4*)(xr + 1024 * q + 4 * d);
                const f32x4 ga = *(const LAS f32x4*)(G2 + 1024 * q + 16 * c.lane + 4 * d);
#pragma unroll
                for (int e = 0; e < 4; ++e) { const float v = xa[e] + ga[e] * (y[16 * q + 4 * d + e] - yoff); y[16 * q + 4 * d + e] = v; ss += v * v; }
            }
        const float rstd = 1.0f / sqrtf(wave_sum(ss) * (1.0f / D) + NORM_EPS);
#pragma unroll
        for (int q = 0; q < 2; ++q)
#pragma unroll
            for (int d = 0; d < 4; ++d) {
                const f32x4 fa = *(const LAS f32x4*)(FG + 1024 * q + 16 * c.lane + 4 * d);
                f32x4 o;
#pragma unroll
                for (int e = 0; e < 4; ++e) o[e] = y[16 * q + 4 * d + e] * rstd * fa[e];
                *(f32x4*)(orow + 1024 * q + 4 * d) = o;
            }
    }
}

__device__ __forceinline__ v4u ld_row4(const unsigned char* tab, int e, int lane) { return *((const v4u*)(tab + (size_t)e * 1024) + lane); }
__device__ __forceinline__ int idot_row4(const int (&h)[8], const v4u& r) {
    const int w[4] = {(int)r.x, (int)r.y, (int)r.z, (int)r.w}; int ah = 0, al = 0;
#pragma unroll
    for (int d = 0; d < 4; ++d) { ah = __builtin_amdgcn_sdot8(h[d], w[d], ah, false); al = __builtin_amdgcn_sdot8(h[4 + d], w[d], al, false); }
    return 16 * ah + al;
}
__device__ __forceinline__ void vacc4(int (&y)[32], const v4u& ra, const v4u& rb, const v4u& rc, const v4u& rd, int cq4) {
    const unsigned A[4] = {ra.x, ra.y, ra.z, ra.w}, B[4] = {rb.x, rb.y, rb.z, rb.w}, C[4] = {rc.x, rc.y, rc.z, rc.w}, Dd[4] = {rd.x, rd.y, rd.z, rd.w};
#pragma unroll
    for (int d = 0; d < 4; ++d) {
        const unsigned t0 = __builtin_amdgcn_perm(A[d], B[d], 0x01050004u), t1 = __builtin_amdgcn_perm(A[d], B[d], 0x03070206u);
        const unsigned t2 = __builtin_amdgcn_perm(C[d], Dd[d], 0x01050004u), t3 = __builtin_amdgcn_perm(C[d], Dd[d], 0x03070206u);
        const unsigned T[4] = {__builtin_amdgcn_perm(t0, t2, 0x01000504u), __builtin_amdgcn_perm(t0, t2, 0x03020706u),
                               __builtin_amdgcn_perm(t1, t3, 0x01000504u), __builtin_amdgcn_perm(t1, t3, 0x03020706u)};
#pragma unroll
        for (int e = 0; e < 4; ++e) {
            y[8 * d + e] = __builtin_amdgcn_sdot4((int)(T[e] & 0x0f0f0f0fu), cq4, y[8 * d + e], false);
            y[8 * d + 4 + e] = __builtin_amdgcn_sdot4((int)T[e], cq4, y[8 * d + 4 + e], false);
        }
    }
}
#define SCHED_FENCE() __builtin_amdgcn_sched_barrier(0)
template <bool REMAP>
__device__ __forceinline__ void phase_peer4_u(const Ctx& c, const float* g2vec, unsigned char* ws) {
    const unsigned char* PU = ws + WS_PU; const bf16* HB = (const bf16*)(ws + WS_X1B);
    LAS float* A2 = (LAS float*)(c.lds + 16384); LAS float* B2 = A2 + D;
    { const float* MODF_ = (const float*)(ws + WS_MODF) + (size_t)(c.vcu >> 7) * NMOD; const int j = 4 * c.tid;
      *(LAS f32x4*)(A2 + j) = *(const f32x4*)(g2vec + j) * (*(const f32x4*)(MODF_ + 4 * D + j) + 1.0f); *(LAS f32x4*)(B2 + j) = *(const f32x4*)(MODF_ + 3 * D + j); }
    __syncthreads();
    const float* SU = (const float*)(ws + WS_SU); const float* SV = (const float*)(ws + WS_SV);
    const int* IDX = (const int*)(ws + WS_IDX); const float* GATE = (const float*)(ws + WS_GATE);
    int* TQ = (int*)(ws + (REMAP ? WS_HC : WS_TQ)); float* CSC = (float*)(ws + (REMAP ? WS_HC + 16 * MiB : WS_CSC));
    const int rm_or = (int)(blockIdx.x & 7) << 11;
#define RM(e) (REMAP ? (((e) & 2047) | rm_or) : (e))
    const int tbase = 64 * c.vcu + 8 * c.wave;
    int e0n = RM(IDX[(size_t)tbase * 128 + c.lane]), e1n = RM(IDX[(size_t)tbase * 128 + 64 + c.lane]);
    float g0n = GATE[(size_t)tbase * 128 + c.lane], g1n = GATE[(size_t)tbase * 128 + 64 + c.lane];
    v2u hraw[8];
#pragma unroll
    for (int j = 0; j < 8; ++j) hraw[j] = __builtin_nontemporal_load((const v2u*)(HB + (size_t)tbase * D + 256 * j + 4 * c.lane));
    v4u r[16];
#pragma unroll
    for (int q = 0; q < 16; ++q) r[q] = ld_row4(PU, __builtin_amdgcn_readlane(e0n, q), c.lane);
#pragma unroll 1
    for (int i = (DUP & 1024) ? -8 : 0; i < 8; ++i) {
        const int t = tbase + (i & 7), tn = tbase + ((i + 1) & 7);
        const int e0 = e0n, e1 = e1n; const float g0 = g0n, g1 = g1n;
        const float su0 = SU[e0], su1 = SU[e1], sv0 = SV[e0], sv1 = SV[e1];
        int hq[8]; float sh; int hsum;
        {
            float hf[32]; float am = 0.f, ssx = 0.f;
#pragma unroll
            for (int j = 0; j < 8; ++j) { hf[4 * j] = bflo(hraw[j].x); hf[4 * j + 1] = bfhi(hraw[j].x); hf[4 * j + 2] = bflo(hraw[j].y); hf[4 * j + 3] = bfhi(hraw[j].y); }
#pragma unroll
            for (int k = 0; k < 32; ++k) ssx += hf[k] * hf[k];
            const float rstd2 = 1.0f / sqrtf(wave_sum(ssx) * (1.0f / D) + NORM_EPS);
#pragma unroll
            for (int j = 0; j < 8; ++j) { const f32x4 av = *(const LAS f32x4*)(A2 + 256 * j + 4 * c.lane), bv = *(const LAS f32x4*)(B2 + 256 * j + 4 * c.lane);
#pragma unroll
                for (int e = 0; e < 4; ++e) hf[4 * j + e] = hf[4 * j + e] * rstd2 * av[e] + bv[e]; }
#pragma unroll
            for (int k = 0; k < 32; ++k) am = fmaxf(am, fabsf(hf[k]));
            am = wave_max(am);
            const float inv = (am > 0.f) ? 119.0f / am : 0.f; sh = am * (1.0f / 119.0f);
            int hs = 0;
#pragma unroll
            for (int d = 0; d < 4; ++d) { unsigned wh = 0u, wl = 0u;
#pragma unroll
                for (int e = 0; e < 4; ++e)
#pragma unroll
                    for (int odd = 0; odd < 2; ++odd) {
                        const int qv = __float2int_rn(hf[4 * (2 * d + odd) + e] * inv), hh = (qv + 8) >> 4, hl = qv - 16 * hh;
                        hs += qv; wh |= ((unsigned)hh & 15u) << (8 * e + 4 * odd); wl |= ((unsigned)hl & 15u) << (8 * e + 4 * odd);
                    }
                hq[d] = (int)wh; hq[4 + d] = (int)wl; }
            hsum = wave_sum_i(hs);
        }
        e0n = RM(IDX[(size_t)tn * 128 + c.lane]); e1n = RM(IDX[(size_t)tn * 128 + 64 + c.lane]);
        g0n = GATE[(size_t)tn * 128 + c.lane]; g1n = GATE[(size_t)tn * 128 + 64 + c.lane];
#pragma unroll
        for (int j = 0; j < 8; ++j) hraw[j] = __builtin_nontemporal_load((const v2u*)(HB + (size_t)tn * D + 256 * j + 4 * c.lane));
        int ia0 = 0, ia1 = 0;
#pragma unroll 1
        for (int m = 0; m < 8; ++m) {
            const int esrc = (m + 1 < 4) ? e0 : ((m + 1 < 8) ? e1 : e0n);
            int part[16];
#pragma unroll
            for (int q = 0; q < 16; ++q) {
                part[q] = idot_row4(hq, r[q]);
                SCHED_FENCE();
                r[q] = ld_row4(PU, __builtin_amdgcn_readlane(esrc, (16 * (m + 1) + q) & 63), c.lane);
                SCHED_FENCE();
            }
            int pa[8], pb[8];
#pragma unroll
            for (int q = 0; q < 8; ++q) { pa[q] = part[q]; pb[q] = part[8 + q]; }
            const int va = reduce8(pa, c.lane), vb = reduce8(pb, c.lane);
            const int grp = c.lane >> 3;
            if (m < 4) { if (grp == 2 * m) ia0 = va; if (grp == 2 * m + 1) ia0 = vb; } else { if (grp == 2 * (m - 4)) ia1 = va; if (grp == 2 * (m - 4) + 1) ia1 = vb; }
        }
        const float hoff = 0.5f * (float)hsum;
        const float a0 = ((float)ia0 + hoff) * su0 * sh, a1 = ((float)ia1 + hoff) * su1 * sh;
        const float c0 = 0.5f * a0 * (1.0f + erff(a0 * 0.70710678118654752f)) * g0 * sv0;
        const float c1 = 0.5f * a1 * (1.0f + erff(a1 * 0.70710678118654752f)) * g1 * sv1;
        const float cmx = wave_max(fmaxf(fabsf(c0), fabsf(c1)));
        const float cinv = (cmx > 0.f) ? 127.0f / cmx : 0.f, csc = cmx * (1.0f / 127.0f);
        const int q0 = __float2int_rn(c0 * cinv), q1 = __float2int_rn(c1 * cinv);
        const int cqs = wave_sum_i(q0 + q1);
        const unsigned b0 = (unsigned)q0 & 0xffu, b1 = (unsigned)q1 & 0xffu;
        const int t0 = (int)(b0 | (sh_idx(b0, c.lane + 1) << 8) | (sh_idx(b0, c.lane + 2) << 16) | (sh_idx(b0, c.lane + 3) << 24));
        const int t1 = (int)(b1 | (sh_idx(b1, c.lane + 1) << 8) | (sh_idx(b1, c.lane + 2) << 16) | (sh_idx(b1, c.lane + 3) << 24));
        TQ[(size_t)t * 128 + c.lane] = t0; TQ[(size_t)t * 128 + 64 + c.lane] = t1;
        if (c.lane == 0) { CSC[(size_t)t * 2] = csc; CSC[(size_t)t * 2 + 1] = (float)cqs; }
    }
#undef RM
}
__device__ __forceinline__ void phase_peer4_u_sorted(const Ctx& c, const float* g2vec, unsigned char* ws) {
    const unsigned char* PU = ws + WS_PU; const bf16* X1 = (const bf16*)(ws + WS_X1B);
    LAS float* A2 = (LAS float*)(c.lds + 16384); LAS float* B2 = A2 + D;
    { const float* MODF_ = (const float*)(ws + WS_MODF) + (size_t)(c.vcu >> 7) * NMOD; const int j = 4 * c.tid;
      *(LAS f32x4*)(A2 + j) = *(const f32x4*)(g2vec + j) * (*(const f32x4*)(MODF_ + 4 * D + j) + 1.0f); *(LAS f32x4*)(B2 + j) = *(const f32x4*)(MODF_ + 3 * D + j); }
    __syncthreads();
    const float* SU = (const float*)(ws + WS_SU); const float* SV = (const float*)(ws + WS_SV);
    const int* IDX = (const int*)(ws + WS_IDX); const float* GATE = (const float*)(ws + WS_GATE);
    int* TQ = (int*)(ws + WS_TQ); float* CSC = (float*)(ws + WS_CSC);
    LAS unsigned char* wb = c.lds + 32768 + c.wave * 12288;
    LAS v4u* hqv = (LAS v4u*)wb; LAS unsigned* lst = (LAS unsigned*)(wb + 8192); LAS int* acc = (LAS int*)(wb + 10240);
    v2u hraw[4][8];
#pragma unroll
    for (int jj = 0; jj < 4; ++jj) { const int t = 64 * c.vcu + 8 * c.wave + jj;
#pragma unroll
        for (int j = 0; j < 8; ++j) hraw[jj][j] = __builtin_nontemporal_load((const v2u*)(X1 + (size_t)t * D + 256 * j + 4 * c.lane)); }
#pragma unroll 1
    for (int hf = 0; hf < 2; ++hf) {
        const int tb4 = 64 * c.vcu + 8 * c.wave + 4 * hf;
        int e0[4], e1[4]; float shs[4], hoffs[4];
#pragma unroll
        for (int jj = 0; jj < 4; ++jj) { e0[jj] = IDX[(size_t)(tb4 + jj) * 128 + c.lane]; e1[jj] = IDX[(size_t)(tb4 + jj) * 128 + 64 + c.lane]; }
        {
#pragma unroll
            for (int jj = 0; jj < 4; ++jj) {
                float hf32[32]; float am = 0.f, ssx = 0.f;
#pragma unroll
                for (int j = 0; j < 8; ++j) { hf32[4 * j] = bflo(hraw[jj][j].x); hf32[4 * j + 1] = bfhi(hraw[jj][j].x); hf32[4 * j + 2] = bflo(hraw[jj][j].y); hf32[4 * j + 3] = bfhi(hraw[jj][j].y); }
#pragma unroll
                for (int k = 0; k < 32; ++k) ssx += hf32[k] * hf32[k];
                const float rstd2 = 1.0f / sqrtf(wave_sum(ssx) * (1.0f / D) + NORM_EPS);
#pragma unroll
                for (int j = 0; j < 8; ++j) { const f32x4 av = *(const LAS f32x4*)(A2 + 256 * j + 4 * c.lane), bv = *(const LAS f32x4*)(B2 + 256 * j + 4 * c.lane);
#pragma unroll
                    for (int e = 0; e < 4; ++e) hf32[4 * j + e] = hf32[4 * j + e] * rstd2 * av[e] + bv[e]; }
#pragma unroll
                for (int k = 0; k < 32; ++k) am = fmaxf(am, fabsf(hf32[k]));
                am = wave_max(am);
                const float inv = (am > 0.f) ? 119.0f / am : 0.f;
                unsigned W[8]; unsigned hsu = 0u;
#pragma unroll
                for (int j = 0; j < 8; ++j) { W[j] = 0u;
#pragma unroll
                    for (int e = 0; e < 4; ++e) W[j] = __builtin_amdgcn_cvt_pk_u8_f32(__builtin_rintf(fmaf(hf32[4 * j + e], inv, 136.0f)), e, W[j]);
                    hsu = __builtin_amdgcn_sad_u8(W[j], 0u, hsu); }
                const int hs = (int)hsu - 136 * 32;
                unsigned wh[4], wl[4];
#pragma unroll
                for (int d = 0; d < 4; ++d) {
                    wh[d] = (((W[2 * d] >> 4) & 0x0f0f0f0fu) | (W[2 * d + 1] & 0xf0f0f0f0u)) ^ 0x88888888u;
                    wl[d] = ((W[2 * d] & 0x0f0f0f0fu) | ((W[2 * d + 1] << 4) & 0xf0f0f0f0u)) ^ 0x88888888u; }
                hqv[(jj * 2 + 0) * 64 + c.lane] = (v4u){wh[0], wh[1], wh[2], wh[3]}; hqv[(jj * 2 + 1) * 64 + c.lane] = (v4u){wl[0], wl[1], wl[2], wl[3]};
                shs[jj] = am * (1.0f / 119.0f); hoffs[jj] = 0.5f * (float)wave_sum_i(hs);
            }
        }
        acc[c.lane] = 0;
        LDS_WAIT();
        int pos[8];
#pragma unroll
        for (int jj = 0; jj < 4; ++jj) { pos[2 * jj] = __hip_atomic_fetch_add(acc + (e0[jj] >> 8), 1, __ATOMIC_RELAXED, __HIP_MEMORY_SCOPE_WORKGROUP);
                                         pos[2 * jj + 1] = __hip_atomic_fetch_add(acc + (e1[jj] >> 8), 1, __ATOMIC_RELAXED, __HIP_MEMORY_SCOPE_WORKGROUP); }
        LDS_WAIT();
        { int cnt = acc[c.lane], inc = cnt;
          inc = wave_scan_i(inc, c.lane);
          LDS_WAIT(); acc[64 + c.lane] = inc - cnt; }
        LDS_WAIT();
#pragma unroll
        for (int jj = 0; jj < 4; ++jj) {
            lst[acc[64 + (e0[jj] >> 8)] + pos[2 * jj]] = ((unsigned)e0[jj] << 10) | ((unsigned)jj << 7) | (unsigned)c.lane;
            lst[acc[64 + (e1[jj] >> 8)] + pos[2 * jj + 1]] = ((unsigned)e1[jj] << 10) | ((unsigned)jj << 7) | (unsigned)(64 + c.lane);
        }
        LDS_WAIT();
        { const int tbn = 64 * c.vcu + 8 * c.wave + 4;
#pragma unroll
          for (int jj = 0; jj < 4; ++jj) { const int t = tbn + jj;
#pragma unroll
              for (int j = 0; j < 8; ++j) hraw[jj][j] = __builtin_nontemporal_load((const v2u*)(X1 + (size_t)t * D + 256 * j + 4 * c.lane)); } }
        SCHED_FENCE();
        unsigned ent = lst[c.lane & 15];
        v4u r[16];
#pragma unroll
        for (int q = 0; q < 16; ++q) r[q] = ld_row4(PU, (int)(__builtin_amdgcn_readlane(ent, q) >> 10), c.lane);
        v4u hh, hl;
        { const int jj = (int)((__builtin_amdgcn_readlane(ent, 0) >> 7) & 3u); hh = hqv[(jj * 2 + 0) * 64 + c.lane]; hl = hqv[(jj * 2 + 1) * 64 + c.lane]; }
#pragma unroll 1
        for (int m = 0; m < 32; ++m) {
            const unsigned entn = lst[((16 * (m + 1)) & 511) + (c.lane & 15)];
#pragma unroll
            for (int hb = 0; hb < 2; ++hb) {
                int pa[8];
#pragma unroll
                for (int q = 0; q < 8; ++q) {
                    const int s16 = 8 * hb + q;
                    const int jn = (int)(((s16 < 15 ? __builtin_amdgcn_readlane(ent, (s16 + 1) & 15) : __builtin_amdgcn_readlane(entn, 0)) >> 7) & 3u);
                    const v4u hhn = hqv[(jn * 2 + 0) * 64 + c.lane], hln = hqv[(jn * 2 + 1) * 64 + c.lane];
                    const int h8[8] = {(int)hh.x, (int)hh.y, (int)hh.z, (int)hh.w, (int)hl.x, (int)hl.y, (int)hl.z, (int)hl.w};
                    pa[q] = idot_row4(h8, r[s16]);
                    SCHED_FENCE();
                    r[s16] = ld_row4(PU, (int)(__builtin_amdgcn_readlane(entn, s16) >> 10), c.lane);
                    SCHED_FENCE();
                    hh = hhn; hl = hln;
                }
                const int v = reduce8(pa, c.lane);
                if ((c.lane >> 3) == hb) acc[((ent >> 7) & 3u) * 128 + (ent & 127u)] = v;
            }
            ent = entn;
        }
        LDS_WAIT();
        float gg0[4], gg1[4], su0[4], su1[4], sv0[4], sv1[4];
#pragma unroll
        for (int jj = 0; jj < 4; ++jj) { const int t = tb4 + jj;
            gg0[jj] = GATE[(size_t)t * 128 + c.lane]; gg1[jj] = GATE[(size_t)t * 128 + 64 + c.lane];
            su0[jj] = SU[e0[jj]]; su1[jj] = SU[e1[jj]]; sv0[jj] = SV[e0[jj]]; sv1[jj] = SV[e1[jj]]; }
#pragma unroll
        for (int jj = 0; jj < 4; ++jj) { const int t = tb4 + jj;
            const int ia0 = acc[jj * 128 + c.lane], ia1 = acc[jj * 128 + 64 + c.lane];
            const float a0 = ((float)ia0 + hoffs[jj]) * su0[jj] * shs[jj], a1 = ((float)ia1 + hoffs[jj]) * su1[jj] * shs[jj];
            const float c0 = 0.5f * a0 * (1.0f + erff(a0 * 0.70710678118654752f)) * gg0[jj] * sv0[jj];
            const float c1 = 0.5f * a1 * (1.0f + erff(a1 * 0.70710678118654752f)) * gg1[jj] * sv1[jj];
            const float cmx = wave_max(fmaxf(fabsf(c0), fabsf(c1)));
            const float cinv = (cmx > 0.f) ? 127.0f / cmx : 0.f, csc = cmx * (1.0f / 127.0f);
            const int q0 = __float2int_rn(c0 * cinv), q1 = __float2int_rn(c1 * cinv);
            const int cqs = wave_sum_i(q0 + q1);
            const unsigned b0 = (unsigned)q0 & 0xffu, b1 = (unsigned)q1 & 0xffu;
            const int t0 = (int)(b0 | (sh_idx(b0, c.lane + 1) << 8) | (sh_idx(b0, c.lane + 2) << 16) | (sh_idx(b0, c.lane + 3) << 24));
            const int t1 = (int)(b1 | (sh_idx(b1, c.lane + 1) << 8) | (sh_idx(b1, c.lane + 2) << 16) | (sh_idx(b1, c.lane + 3) << 24));
            TQ[(size_t)t * 128 + c.lane] = t0; TQ[(size_t)t * 128 + 64 + c.lane] = t1;
            if (c.lane == 0) { CSC[(size_t)t * 2] = csc; CSC[(size_t)t * 2 + 1] = (float)cqs; }
        }
        LDS_WAIT();
    }
}
typedef int v8i __attribute__((ext_vector_type(8)));
typedef float f32x2 __attribute__((ext_vector_type(2)));
__device__ __forceinline__ void phase_peer4_u_mfma(const Ctx& c, const float* g2vec, unsigned char* ws) {
    const unsigned char* PU = ws + WS_PU; const bf16* X1 = (const bf16*)(ws + WS_X1B);
    LAS float* A2 = (LAS float*)(c.lds + 16384); LAS float* B2 = A2 + D;
    { const float* MODF_ = (const float*)(ws + WS_MODF) + (size_t)(c.vcu >> 7) * NMOD; const int j = 4 * c.tid;
      *(LAS f32x4*)(A2 + j) = *(const f32x4*)(g2vec + j) * (*(const f32x4*)(MODF_ + 4 * D + j) + 1.0f); *(LAS f32x4*)(B2 + j) = *(const f32x4*)(MODF_ + 3 * D + j); }
    __syncthreads();
    const float* SU = (const float*)(ws + WS_SU); const float* SV = (const float*)(ws + WS_SV);
    const int* IDX = (const int*)(ws + WS_IDX); const float* GATE = (const float*)(ws + WS_GATE);
    int* TQ = (int*)(ws + WS_TQ); float* CSC = (float*)(ws + WS_CSC);
    LAS unsigned char* wb = c.lds + 32768 + c.wave * 12288;
    LAS unsigned char* hq = wb; LAS unsigned* lst = (LAS unsigned*)(wb + 8192); LAS int* acc = (LAS int*)(wb + 10240); LAS float* accf = (LAS float*)(wb + 10240);
    const int kg = c.lane >> 4, ncol = c.lane & 15, rho = ncol >> 2, kap = ncol & 3;
#pragma unroll 1
    for (int hf = 0; hf < 2; ++hf) {
        const int tb4 = 64 * c.vcu + 8 * c.wave + 4 * hf;
        int e0[4], e1[4]; float shs[4];
#pragma unroll
        for (int jj = 0; jj < 4; ++jj) { e0[jj] = IDX[(size_t)(tb4 + jj) * 128 + c.lane]; e1[jj] = IDX[(size_t)(tb4 + jj) * 128 + 64 + c.lane]; }
        {
            v2u hraw[4][8];
#pragma unroll
            for (int jj = 0; jj < 4; ++jj) {
#pragma unroll
                for (int j = 0; j < 8; ++j) hraw[jj][j] = __builtin_nontemporal_load((const v2u*)(X1 + (size_t)(tb4 + jj) * D + 256 * j + 4 * c.lane)); }
#pragma unroll
            for (int jj = 0; jj < 4; ++jj) {
                float hf32[32]; float am = 0.f, ssx = 0.f;
#pragma unroll
                for (int j = 0; j < 8; ++j) { hf32[4 * j] = bflo(hraw[jj][j].x); hf32[4 * j + 1] = bfhi(hraw[jj][j].x); hf32[4 * j + 2] = bflo(hraw[jj][j].y); hf32[4 * j + 3] = bfhi(hraw[jj][j].y); }
#pragma unroll
                for (int k = 0; k < 32; ++k) ssx += hf32[k] * hf32[k];
                const float rstd2 = 1.0f / sqrtf(wave_sum(ssx) * (1.0f / D) + NORM_EPS);
#pragma unroll
                for (int j = 0; j < 8; ++j) { const f32x4 av = *(const LAS f32x4*)(A2 + 256 * j + 4 * c.lane), bv = *(const LAS f32x4*)(B2 + 256 * j + 4 * c.lane);
#pragma unroll
                    for (int e = 0; e < 4; ++e) hf32[4 * j + e] = hf32[4 * j + e] * rstd2 * av[e] + bv[e]; }
#pragma unroll
                for (int k = 0; k < 32; ++k) am = fmaxf(am, fabsf(hf32[k]));
                am = wave_max(am);
                const float inv = (am > 0.f) ? 224.0f / am : 0.f;
                unsigned W[8];
#pragma unroll
                for (int w = 0; w < 8; ++w) { const int j0 = 2 * (w >> 1), e0_ = 2 * (w & 1);
                    int pk = __builtin_amdgcn_cvt_pk_fp8_f32(hf32[4 * j0 + e0_] * inv, hf32[4 * (j0 + 1) + e0_] * inv, 0, false);
                    pk = __builtin_amdgcn_cvt_pk_fp8_f32(hf32[4 * j0 + e0_ + 1] * inv, hf32[4 * (j0 + 1) + e0_ + 1] * inv, pk, true);
                    W[w] = (unsigned)pk; }
                { LAS unsigned char* hp = hq + jj * 2048 + c.lane * 32;
                  *(LAS v4u*)hp = (v4u){W[0], W[1], W[2], W[3]}; *(LAS v4u*)(hp + 16) = (v4u){W[4], W[5], W[6], W[7]}; }
                shs[jj] = am * (1.0f / 224.0f);
            }
        }
        acc[c.lane] = 0;
        LDS_WAIT();
        int pos[8];
#pragma unroll
        for (int jj = 0; jj < 4; ++jj) { pos[2 * jj] = __hip_atomic_fetch_add(acc + (e0[jj] >> 8), 1, __ATOMIC_RELAXED, __HIP_MEMORY_SCOPE_WORKGROUP);
                                         pos[2 * jj + 1] = __hip_atomic_fetch_add(acc + (e1[jj] >> 8), 1, __ATOMIC_RELAXED, __HIP_MEMORY_SCOPE_WORKGROUP); }
        LDS_WAIT();
        { int cnt = acc[c.lane], inc = cnt;
          inc = wave_scan_i(inc, c.lane);
          LDS_WAIT(); acc[64 + c.lane] = inc - cnt; }
        LDS_WAIT();
#pragma unroll
        for (int jj = 0; jj < 4; ++jj) {
            lst[acc[64 + (e0[jj] >> 8)] + pos[2 * jj]] = ((unsigned)e0[jj] << 10) | ((unsigned)jj << 7) | (unsigned)c.lane;
            lst[acc[64 + (e1[jj] >> 8)] + pos[2 * jj + 1]] = ((unsigned)e1[jj] << 10) | ((unsigned)jj << 7) | (unsigned)(64 + c.lane);
        }
        LDS_WAIT();
        v8i Bp[4];
#pragma unroll
        for (int s4 = 0; s4 < 4; ++s4) { const LAS unsigned char* bp = hq + rho * 2048 + (16 * s4 + 4 * (kg >> 1) + kap) * 32 + (kg & 1) * 16;
            const v4u lo = *(const LAS v4u*)bp, hi = *(const LAS v4u*)(bp + 8 * 32);
            Bp[s4] = (v8i){(int)lo.x, (int)lo.y, (int)lo.z, (int)lo.w, (int)hi.x, (int)hi.y, (int)hi.z, (int)hi.w}; }
        const unsigned lane_off = 64u * (unsigned)kg + 16u * (unsigned)kap;
        v4u r[16];
#pragma unroll
        for (int G = 0; G < 4; ++G) { const unsigned vo = (lst[4 * G + rho] & ~1023u) + lane_off;
#pragma unroll
            for (int s4 = 0; s4 < 4; ++s4) r[4 * G + s4] = *(const v4u*)(PU + vo + 256 * s4); }
        unsigned lvn[4], len[4];
#pragma unroll
        for (int G = 0; G < 4; ++G) { lvn[G] = lst[16 + 4 * G + rho]; len[G] = lst[4 * G + kg]; }
#pragma unroll 1
        for (int m = 0; m < 32; ++m) {
            unsigned lv[4], le[4];
#pragma unroll
            for (int G = 0; G < 4; ++G) { lv[G] = lvn[G]; le[G] = len[G]; }
#pragma unroll
            for (int G = 0; G < 4; ++G) { lvn[G] = lst[((16 * (m + 2)) & 511) + 4 * G + rho]; len[G] = lst[((16 * (m + 1)) & 511) + 4 * G + kg]; }
#pragma unroll
            for (int G = 0; G < 4; ++G) {
                const unsigned von = (lv[G] & ~1023u) + lane_off;
                const unsigned erow = le[G];
                f32x4 cacc = {0.f, 0.f, 0.f, 0.f};
#pragma unroll
                for (int s4 = 0; s4 < 4; ++s4) {
                    v8i av; av[0] = (int)r[4 * G + s4].x; av[1] = (int)r[4 * G + s4].y; av[2] = (int)r[4 * G + s4].z; av[3] = (int)r[4 * G + s4].w; av[4] = 0; av[5] = 0; av[6] = 0; av[7] = 0;
                    cacc = __builtin_amdgcn_mfma_scale_f32_16x16x128_f8f6f4(av, Bp[s4], cacc, 4, 0, 0, 0x7f7f7f7f, 0, 0x7f7f7f7f);
                }
                SCHED_FENCE();
#pragma unroll
                for (int s4 = 0; s4 < 4; ++s4) r[4 * G + s4] = *(const v4u*)(PU + von + 256 * s4);
                SCHED_FENCE();
                float v = (kap == 0) ? cacc[0] : (kap == 1) ? cacc[1] : (kap == 2) ? cacc[2] : cacc[3];
                v += __int_as_float(__builtin_amdgcn_update_dpp(0, __float_as_int(v), 0xB1, 0xF, 0xF, true));
                v += __int_as_float(__builtin_amdgcn_update_dpp(0, __float_as_int(v), 0x4E, 0xF, 0xF, true));
                const unsigned tk = (erow >> 7) & 3u;
                if (kap == 0 && (unsigned)rho == tk) accf[tk * 128 + (erow & 127u)] = v;
            }
        }
        LDS_WAIT();
        float gg0[4], gg1[4], su0[4], su1[4], sv0[4], sv1[4];
#pragma unroll
        for (int jj = 0; jj < 4; ++jj) { const int t = tb4 + jj;
            gg0[jj] = GATE[(size_t)t * 128 + c.lane]; gg1[jj] = GATE[(size_t)t * 128 + 64 + c.lane];
            su0[jj] = SU[e0[jj]]; su1[jj] = SU[e1[jj]]; sv0[jj] = SV[e0[jj]]; sv1[jj] = SV[e1[jj]]; }
#pragma unroll
        for (int jj = 0; jj < 4; ++jj) { const int t = tb4 + jj;
            const float a0 = accf[jj * 128 + c.lane] * su0[jj] * shs[jj], a1 = accf[jj * 128 + 64 + c.lane] * su1[jj] * shs[jj];
            const float c0 = 0.5f * a0 * (1.0f + erff(a0 * 0.70710678118654752f)) * gg0[jj] * sv0[jj];
            const float c1 = 0.5f * a1 * (1.0f + erff(a1 * 0.70710678118654752f)) * gg1[jj] * sv1[jj];
            const float cmx = wave_max(fmaxf(fabsf(c0), fabsf(c1)));
#if V_MFMA
            const float cinv = (cmx > 0.f) ? 224.0f / cmx : 0.f;
            ((float*)TQ)[(size_t)t * 128 + c.lane] = c0 * cinv; ((float*)TQ)[(size_t)t * 128 + 64 + c.lane] = c1 * cinv;
            if (c.lane == 0) { CSC[(size_t)t * 2] = cmx * (1.0f / 224.0f); CSC[(size_t)t * 2 + 1] = 0.f; }
#else
            const float cinv = (cmx > 0.f) ? 127.0f / cmx : 0.f, csc = cmx * (1.0f / 127.0f);
            const int q0 = __float2int_rn(c0 * cinv), q1 = __float2int_rn(c1 * cinv);
            const int cqs = wave_sum_i(q0 + q1);
            const unsigned b0_ = (unsigned)q0 & 0xffu, b1_ = (unsigned)q1 & 0xffu;
            const int t0 = (int)(b0_ | (sh_idx(b0_, c.lane + 1) << 8) | (sh_idx(b0_, c.lane + 2) << 16) | (sh_idx(b0_, c.lane + 3) << 24));
            const int t1 = (int)(b1_ | (sh_idx(b1_, c.lane + 1) << 8) | (sh_idx(b1_, c.lane + 2) << 16) | (sh_idx(b1_, c.lane + 3) << 24));
            TQ[(size_t)t * 128 + c.lane] = t0; TQ[(size_t)t * 128 + 64 + c.lane] = t1;
            if (c.lane == 0) { CSC[(size_t)t * 2] = csc; CSC[(size_t)t * 2 + 1] = (float)cqs; }
#endif
        }
        LDS_WAIT();
    }
}
__device__ __forceinline__ void phase_peer4_v_mfma(const Ctx& c, const float* final_g, float* out, unsigned char* ws) {
    const bf16* X1 = (const bf16*)(ws + WS_X1B);
    const unsigned char* PV = ws + WS_PV;
    const int* IDX = (const int*)(ws + WS_IDX); const float* CF = (const float*)(ws + WS_TQ); const float* CSC = (const float*)(ws + WS_CSC); const float* MODF = (const float*)(ws + WS_MODF);
    LAS float* G2 = (LAS float*)c.lds; LAS float* FG = G2 + D;
    const int b = c.vcu >> 7;
    { const int j = 4 * c.tid; *(LAS f32x4*)(G2 + j) = *(const f32x4*)(MODF + (size_t)b * NMOD + 5 * D + j); *(LAS f32x4*)(FG + j) = *(const f32x4*)(final_g + j); }
    __syncthreads();
    const int n = c.lane & 15, g = c.lane >> 4;
    const int tbase = 64 * c.vcu + 8 * c.wave;
    const unsigned nb8 = 8u * (unsigned)n;
    const int F0 = 256 * (4 * (n & 1) + 2 * (g >> 1)) + 4 * (n >> 1) + 2 * (g & 1);
    int e0n = IDX[(size_t)tbase * 128 + c.lane], e1n = IDX[(size_t)tbase * 128 + 64 + c.lane];
    float cf0n = CF[(size_t)tbase * 128 + c.lane], cf1n = CF[(size_t)tbase * 128 + 64 + c.lane];
    v2u br[2][8][2];
#pragma unroll
    for (int bf = 0; bf < 2; ++bf) {
        const unsigned o0 = ((unsigned)sh_idx(e0n, 8 * bf + 2 * g) << 10) + nb8, o1 = ((unsigned)sh_idx(e0n, 8 * bf + 2 * g + 1) << 10) + nb8;
#pragma unroll
        for (int s8 = 0; s8 < 8; ++s8) { br[bf][s8][0] = *(const v2u*)(PV + o0 + 128 * s8); br[bf][s8][1] = *(const v2u*)(PV + o1 + 128 * s8); }
    }
#pragma unroll 1
    for (int i = 0; i < 8; ++i) {
        const int t = tbase + i, tn = tbase + ((i + 1) & 7);
        const int e0 = e0n, e1 = e1n; const float cf0 = cf0n, cf1 = cf1n;
        const float csc = CSC[(size_t)t * 2];
        e0n = IDX[(size_t)tn * 128 + c.lane]; e1n = IDX[(size_t)tn * 128 + 64 + c.lane];
        cf0n = CF[(size_t)tn * 128 + c.lane]; cf1n = CF[(size_t)tn * 128 + 64 + c.lane];
        f32x4 C[8];
#pragma unroll
        for (int s8 = 0; s8 < 8; ++s8) C[s8] = (f32x4){0.f, 0.f, 0.f, 0.f};
#pragma unroll 1
        for (int gp = 0; gp < 8; ++gp) {
#pragma unroll
            for (int bf = 0; bf < 2; ++bf) {
                const int grp = 2 * gp + bf;
                const float cfs = (gp < 4) ? cf0 : cf1;
                const float ca = sh_idx(cfs, (8 * grp + g) & 63), cb = sh_idx(cfs, (8 * grp + 4 + g) & 63);
                const unsigned pk = (unsigned)__builtin_amdgcn_cvt_pk_fp8_f32(ca, cb, 0, false);
                const unsigned wlo = (pk & 0xffu) << (8 * (n & 3)), whi = ((pk >> 8) & 0xffu) << (8 * (n & 3));
                const int q = n >> 2;
                const v8i av = {(int)(q == 0 ? wlo : 0u), (int)(q == 1 ? wlo : 0u), (int)(q == 2 ? wlo : 0u), (int)(q == 3 ? wlo : 0u),
                                (int)(q == 0 ? whi : 0u), (int)(q == 1 ? whi : 0u), (int)(q == 2 ? whi : 0u), (int)(q == 3 ? whi : 0u)};
#pragma unroll
                for (int s8 = 0; s8 < 8; ++s8) {
                    v8i bv; bv[0] = (int)br[bf][s8][0].x; bv[1] = (int)br[bf][s8][0].y; bv[2] = (int)br[bf][s8][1].x; bv[3] = (int)br[bf][s8][1].y; bv[4] = 0; bv[5] = 0; bv[6] = 0; bv[7] = 0;
                    C[s8] = __builtin_amdgcn_mfma_scale_f32_16x16x128_f8f6f4(av, bv, C[s8], 0, 4, 0, 0x7f7f7f7f, 0, 0x7f7f7f7f);
                }
                SCHED_FENCE();
                {
                    const int gn = grp + 2;
                    const int es = (gn < 8) ? e0 : ((gn < 16) ? e1 : e0n);
                    const unsigned o0 = ((unsigned)sh_idx(es, (8 * gn + 2 * g) & 63) << 10) + nb8, o1 = ((unsigned)sh_idx(es, (8 * gn + 2 * g + 1) & 63) << 10) + nb8;
#pragma unroll
                    for (int s8 = 0; s8 < 8; ++s8) { br[bf][s8][0] = *(const v2u*)(PV + o0 + 128 * s8); br[bf][s8][1] = *(const v2u*)(PV + o1 + 128 * s8); }
                }
                SCHED_FENCE();
            }
        }
        const bf16* xr = X1 + (size_t)t * D + F0; float* orow = out + (size_t)t * D + F0;
        float ss = 0.f;
#pragma unroll
        for (int s8 = 0; s8 < 8; ++s8) {
            const unsigned xa = __builtin_nontemporal_load((const unsigned*)(xr + 32 * s8)), xb = __builtin_nontemporal_load((const unsigned*)(xr + 256 + 32 * s8));
            const f32x2 ga = *(const LAS f32x2*)(G2 + F0 + 32 * s8), gb = *(const LAS f32x2*)(G2 + F0 + 256 + 32 * s8);
            const float v0 = bflo(xa) + ga[0] * (csc * C[s8][0]), v2 = bfhi(xa) + ga[1] * (csc * C[s8][2]);
            const float v1 = bflo(xb) + gb[0] * (csc * C[s8][1]), v3 = bfhi(xb) + gb[1] * (csc * C[s8][3]);
            C[s8] = (f32x4){v0, v1, v2, v3}; ss += (v0 * v0 + v1 * v1) + (v2 * v2 + v3 * v3);
        }
        const float rstd = 1.0f / sqrtf(wave_sum(ss) * (1.0f / D) + NORM_EPS);
#pragma unroll
        for (int s8 = 0; s8 < 8; ++s8) {
            const f32x2 fa = *(const LAS f32x2*)(FG + F0 + 32 * s8), fb = *(const LAS f32x2*)(FG + F0 + 256 + 32 * s8);
            const f32x2 oa = {C[s8][0] * rstd * fa[0], C[s8][2] * rstd * fa[1]}, ob = {C[s8][1] * rstd * fb[0], C[s8][3] * rstd * fb[1]};
            __builtin_nontemporal_store(oa, (f32x2*)(orow + 32 * s8)); __builtin_nontemporal_store(ob, (f32x2*)(orow + 256 + 32 * s8));
        }
    }
}
__device__ __forceinline__ void phase_peer4_v_sorted(const Ctx& c, const float* final_g, float* out, unsigned char* ws) {
    const bf16* X1 = (const bf16*)(ws + WS_X1B);
    const unsigned char* PV = ws + WS_PV;
    const int* IDX = (const int*)(ws + WS_IDX); const float* CF = (const float*)(ws + WS_TQ); const float* CSC = (const float*)(ws + WS_CSC); const float* MODF = (const float*)(ws + WS_MODF);
    LAS float* G2 = (LAS float*)c.lds; LAS float* FG = G2 + D;
    const int b = c.vcu >> 7;
    { const int j = 4 * c.tid; *(LAS f32x4*)(G2 + j) = *(const f32x4*)(MODF + (size_t)b * NMOD + 5 * D + j); *(LAS f32x4*)(FG + j) = *(const f32x4*)(final_g + j); }
    __syncthreads();
    LAS unsigned char* wb = c.lds + 32768 + c.wave * 12288;
    LAS v2u* lst2 = (LAS v2u*)wb; LAS int* hist = (LAS int*)(wb + 4096);
    const int n = c.lane & 15, g = c.lane >> 4;
    const unsigned nb16 = 16u * (unsigned)n;
    const int F0 = 512 * (g >> 1) + 4 * n + 2 * (g & 1);
    const int q4 = n >> 2, sh8 = 8 * (n & 3);
#pragma unroll 1
    for (int hf = 0; hf < 2; ++hf) {
        const int tb4 = 64 * c.vcu + 8 * c.wave + 4 * hf;
        {
            int e0[4], e1[4]; float w0[4], w1[4];
#pragma unroll
            for (int jj = 0; jj < 4; ++jj) { const size_t o = (size_t)(tb4 + jj) * 128 + c.lane; e0[jj] = IDX[o]; e1[jj] = IDX[o + 64]; w0[jj] = CF[o]; w1[jj] = CF[o + 64]; }
            hist[c.lane] = 0;
            LDS_WAIT();
            int pos[8];
#pragma unroll
            for (int jj = 0; jj < 4; ++jj) { pos[2 * jj] = __hip_atomic_fetch_add(hist + ((e0[jj] >> V_BSH) * 4 + jj), 1, __ATOMIC_RELAXED, __HIP_MEMORY_SCOPE_WORKGROUP);
                                             pos[2 * jj + 1] = __hip_atomic_fetch_add(hist + ((e1[jj] >> V_BSH) * 4 + jj), 1, __ATOMIC_RELAXED, __HIP_MEMORY_SCOPE_WORKGROUP); }
            LDS_WAIT();
            { int cnt = hist[c.lane], inc = cnt;
              inc = wave_scan_i(inc, c.lane);
              LDS_WAIT(); hist[64 + c.lane] = inc - cnt; }
            LDS_WAIT();
#pragma unroll
            for (int jj = 0; jj < 4; ++jj) {
                lst2[hist[64 + (e0[jj] >> V_BSH) * 4 + jj] + pos[2 * jj]] = (v2u){((unsigned)e0[jj] << 2) | (unsigned)jj, __float_as_uint(w0[jj])};
                lst2[hist[64 + (e1[jj] >> V_BSH) * 4 + jj] + pos[2 * jj + 1]] = (v2u){((unsigned)e1[jj] << 2) | (unsigned)jj, __float_as_uint(w1[jj])};
            }
            LDS_WAIT();
        }
        f32x4 C[4][8];
#pragma unroll
        for (int jj = 0; jj < 4; ++jj)
#pragma unroll
            for (int s8 = 0; s8 < 8; ++s8) C[jj][s8] = (f32x4){0.f, 0.f, 0.f, 0.f};
        v4u br[2][4][2];
#pragma unroll
        for (int bf = 0; bf < 2; ++bf) {
            const v4u qe = *(const LAS v4u*)(lst2 + 8 * bf + 2 * g);
            const unsigned o0 = ((qe.x >> 2) << 10) + nb16, o1 = ((qe.z >> 2) << 10) + nb16;
#pragma unroll
            for (int s4 = 0; s4 < 4; ++s4) { br[bf][s4][0] = *(const v4u*)(PV + o0 + 256 * s4); br[bf][s4][1] = *(const v4u*)(PV + o1 + 256 * s4); }
        }
        v2u ean = lst2[g], ebn = lst2[4 + g];
#pragma unroll 1
        for (int gp = 0; gp < 32; ++gp) {
#pragma unroll
            for (int bf = 0; bf < 2; ++bf) {
                const int G = 2 * gp + bf;
                const v2u ea = ean, eb = ebn;
                ean = lst2[((8 * (G + 1)) & 511) + g]; ebn = lst2[((8 * (G + 1)) & 511) + 4 + g];
                const unsigned tokA = ea.x & 3u, tokB = eb.x & 3u; const float cA = __uint_as_float(ea.y), cB = __uint_as_float(eb.y);
                const v4u qn = *(const LAS v4u*)(lst2 + ((8 * (G + 2)) & 511) + 2 * g);
#pragma unroll
                for (int jj = 0; jj < 4; ++jj) {
                    const bool hasA = (tokA == (unsigned)jj), hasB = (tokB == (unsigned)jj);
                    if (__builtin_amdgcn_ballot_w64(hasA || hasB) != 0ull) {
                        const unsigned pk = (unsigned)__builtin_amdgcn_cvt_pk_fp8_f32(hasA ? cA : 0.f, hasB ? cB : 0.f, 0, false);
                        const unsigned wlo = (pk & 0xffu) << sh8, whi = ((pk >> 8) & 0xffu) << sh8;
                        const v8i av = {(int)(q4 == 0 ? wlo : 0u), (int)(q4 == 1 ? wlo : 0u), (int)(q4 == 2 ? wlo : 0u), (int)(q4 == 3 ? wlo : 0u),
                                        (int)(q4 == 0 ? whi : 0u), (int)(q4 == 1 ? whi : 0u), (int)(q4 == 2 ? whi : 0u), (int)(q4 == 3 ? whi : 0u)};
#pragma unroll
                        for (int s8 = 0; s8 < 8; ++s8) {
                            const v4u r0 = br[bf][s8 >> 1][0], r1 = br[bf][s8 >> 1][1];
                            v8i bv; bv[0] = (int)((s8 & 1) ? r0.z : r0.x); bv[1] = (int)((s8 & 1) ? r0.w : r0.y); bv[2] = (int)((s8 & 1) ? r1.z : r1.x); bv[3] = (int)((s8 & 1) ? r1.w : r1.y); bv[4] = 0; bv[5] = 0; bv[6] = 0; bv[7] = 0;
                            C[jj][s8] = __builtin_amdgcn_mfma_scale_f32_16x16x128_f8f6f4(av, bv, C[jj][s8], 0, 4, 0, 0x7f7f7f7f, 0, 0x7f7f7f7f);
                        }
                    }
                }
                SCHED_FENCE();
                { const unsigned o0 = ((qn.x >> 2) << 10) + nb16, o1 = ((qn.z >> 2) << 10) + nb16;
#pragma unroll
                  for (int s4 = 0; s4 < 4; ++s4) { br[bf][s4][0] = *(const v4u*)(PV + o0 + 256 * s4); br[bf][s4][1] = *(const v4u*)(PV + o1 + 256 * s4); } }
                SCHED_FENCE();
            }
        }
#pragma unroll
        for (int jj = 0; jj < 4; ++jj) {
            const int t = tb4 + jj;
            const float csc = CSC[(size_t)t * 2];
            const bf16* xr = X1 + (size_t)t * D + F0; float* orow = out + (size_t)t * D + F0;
            float ss = 0.f;
#pragma unroll
            for (int s8 = 0; s8 < 8; ++s8) {
                const unsigned xa = __builtin_nontemporal_load((const unsigned*)(xr + (1024 * (s8 & 1) + 64 * (s8 >> 1)))), xb = __builtin_nontemporal_load((const unsigned*)(xr + 256 + (1024 * (s8 & 1) + 64 * (s8 >> 1))));
                const f32x2 ga = *(const LAS f32x2*)(G2 + F0 + (1024 * (s8 & 1) + 64 * (s8 >> 1))), gb = *(const LAS f32x2*)(G2 + F0 + 256 + (1024 * (s8 & 1) + 64 * (s8 >> 1)));
                const float v0 = bflo(xa) + ga[0] * (csc * C[jj][s8][0]), v2 = bfhi(xa) + ga[1] * (csc * C[jj][s8][2]);
                const float v1 = bflo(xb) + gb[0] * (csc * C[jj][s8][1]), v3 = bfhi(xb) + gb[1] * (csc * C[jj][s8][3]);
                C[jj][s8] = (f32x4){v0, v1, v2, v3}; ss += (v0 * v0 + v1 * v1) + (v2 * v2 + v3 * v3);
            }
            const float rstd = 1.0f / sqrtf(wave_sum(ss) * (1.0f / D) + NORM_EPS);
#pragma unroll
            for (int s8 = 0; s8 < 8; ++s8) {
                const f32x2 fa = *(const LAS f32x2*)(FG + F0 + (1024 * (s8 & 1) + 64 * (s8 >> 1))), fb = *(const LAS f32x2*)(FG + F0 + 256 + (1024 * (s8 & 1) + 64 * (s8 >> 1)));
                const f32x2 oa = {C[jj][s8][0] * rstd * fa[0], C[jj][s8][2] * rstd * fa[1]}, ob = {C[jj][s8][1] * rstd * fb[0], C[jj][s8][3] * rstd * fb[1]};
                __builtin_nontemporal_store(oa, (f32x2*)(orow + (1024 * (s8 & 1) + 64 * (s8 >> 1)))); __builtin_nontemporal_store(ob, (f32x2*)(orow + 256 + (1024 * (s8 & 1) + 64 * (s8 >> 1))));
            }
        }
        LDS_WAIT();
    }
}
__device__ __forceinline__ void phase_peer4_v(const Ctx& c, const float* final_g, float* out, unsigned char* ws) {
    const bf16* X1 = (const bf16*)(ws + WS_X1B);
    const unsigned char* PV = ws + WS_PV;
    const int* IDX = (const int*)(ws + WS_IDX); const int* TQ = (const int*)(ws + WS_TQ); const float* CSC = (const float*)(ws + WS_CSC); const float* MODF = (const float*)(ws + WS_MODF);
    LAS float* G2 = (LAS float*)c.lds; LAS float* FG = G2 + D;
    const int b = c.vcu >> 7;
    { const int j = 4 * c.tid; *(LAS f32x4*)(G2 + j) = *(const f32x4*)(MODF + (size_t)b * NMOD + 5 * D + j); *(LAS f32x4*)(FG + j) = *(const f32x4*)(final_g + j); }
    __syncthreads();
    const int tbase = 64 * c.vcu + 8 * c.wave;
    int e0n = IDX[(size_t)tbase * 128 + c.lane], e1n = IDX[(size_t)tbase * 128 + 64 + c.lane];
    int t0n = TQ[(size_t)tbase * 128 + c.lane], t1n = TQ[(size_t)tbase * 128 + 64 + c.lane];
    v4u r[16];
#pragma unroll
    for (int q = 0; q < 16; ++q) r[q] = ld_row4(PV, __builtin_amdgcn_readlane(e0n, q), c.lane);
#pragma unroll 1
    for (int i = (DUP & 2048) ? -8 : 0; i < 8; ++i) {
        const int t = tbase + (i & 7), tn = tbase + ((i + 1) & 7);
        const int e0 = e0n, e1 = e1n, t0 = t0n, t1 = t1n;
        const float csc = CSC[(size_t)t * 2], cqsf = CSC[(size_t)t * 2 + 1];
        e0n = IDX[(size_t)tn * 128 + c.lane]; e1n = IDX[(size_t)tn * 128 + 64 + c.lane];
        t0n = TQ[(size_t)tn * 128 + c.lane]; t1n = TQ[(size_t)tn * 128 + 64 + c.lane];
        int y[32];
#pragma unroll
        for (int q = 0; q < 32; ++q) y[q] = 0;
#pragma unroll 1
        for (int m = 0; m < 8; ++m) {
            const int esrc = (m + 1 < 4) ? e0 : ((m + 1 < 8) ? e1 : e0n);
            const int tsrc = (m < 4) ? t0 : t1;
#pragma unroll
            for (int gq = 0; gq < 4; ++gq) {
                const int cq4 = __builtin_amdgcn_readlane(tsrc, (16 * m + 4 * gq) & 63);
                vacc4(y, r[4 * gq], r[4 * gq + 1], r[4 * gq + 2], r[4 * gq + 3], cq4);
                SCHED_FENCE();
#pragma unroll
                for (int q = 0; q < 4; ++q) r[4 * gq + q] = ld_row4(PV, __builtin_amdgcn_readlane(esrc, (16 * (m + 1) + 4 * gq + q) & 63), c.lane);
                SCHED_FENCE();
            }
        }
        const bf16* xr = X1 + (size_t)t * D + 4 * c.lane; float* orow = ((DUP & 2048) && i < 0 ? (float*)(ws + WS_HC) : out) + (size_t)t * D + 4 * c.lane;
        float yf[32]; float ss = 0.f;
#pragma unroll
        for (int j = 0; j < 8; ++j) {
            const v2u xw = __builtin_nontemporal_load((const v2u*)(xr + 256 * j)); const f32x4 xa = {bflo(xw.x), bfhi(xw.x), bflo(xw.y), bfhi(xw.y)};
            const f32x4 ga = *(const LAS f32x4*)(G2 + 256 * j + 4 * c.lane);
#pragma unroll
            for (int e = 0; e < 4; ++e) {
                const int d = j >> 1;
                const float yv = (j & 1) ? (float)((y[8 * d + 4 + e] - y[8 * d + e]) >> 4) + 0.5f * cqsf : (float)y[8 * d + e] - 7.5f * cqsf;
                const float v = xa[e] + ga[e] * (csc * yv); yf[4 * j + e] = v; ss += v * v; }
        }
        const float rstd = 1.0f / sqrtf(wave_sum(ss) * (1.0f / D) + NORM_EPS);
#pragma unroll
        for (int j = 0; j < 8; ++j) {
            const f32x4 fa = *(const LAS f32x4*)(FG + 256 * j + 4 * c.lane);
            f32x4 o;
#pragma unroll
            for (int e = 0; e < 4; ++e) o[e] = yf[4 * j + e] * rstd * fa[e];
            __builtin_nontemporal_store(o, (f32x4*)(orow + 256 * j));
        }
    }
}

struct Args { const float* in[16]; float* out; unsigned char* ws; };
__device__ __forceinline__ int lane_id() { unsigned ones = ~0u; asm volatile("" : "+s"(ones)); return (int)__builtin_amdgcn_mbcnt_hi(ones, __builtin_amdgcn_mbcnt_lo(ones, 0u)); }
__global__ void __launch_bounds__(NTHREADS, 2) fwd_kernel(Args args_unused) {
    extern __shared__ __attribute__((aligned(16))) unsigned char lds_raw[];
    const int wave_s = __builtin_amdgcn_readfirstlane((int)(threadIdx.x >> 6));
#define CAS __attribute__((address_space(4)))
#define KARGS() const CAS unsigned char* ka_ = (const CAS unsigned char*)__builtin_amdgcn_kernarg_segment_ptr(); asm volatile("" : "+s"(ka_));
#define ARG_IN(i) (*(const float* const CAS*)(ka_ + 8 * (i)))
#define ARG_OUT() (*(float* const CAS*)(ka_ + 128))
#define ARG_WS() (*(unsigned char* const CAS*)(ka_ + 136))
#define MKCTX() KARGS(); unsigned char* ws = ARG_WS(); Ctx c; { c.lds = (LAS unsigned char*)lds_raw; int l_ = lane_id(); asm volatile("" : "+v"(l_)); c.lane = l_; c.wave = wave_s; c.tid = wave_s * 64 + l_; \
    c.G = 256; { const int bx = blockIdx.x; c.vcu = (bx % 8) * 32 + bx / 8; } c.gw = c.vcu * NWAVES + c.wave; c.ngw = 256 * NWAVES; }
#define IS_T0() (wave_s == 0 && lane_id() == 0)
#define GRID_BAR() xcd_barrier(bar, IS_T0())
#define GRP_BAR() do { if (misc[2] == 1u) grp_barrier(bar, IS_T0()); else xcd_barrier(bar, IS_T0()); } while (0)
    LAS unsigned char* const ldsb = (LAS unsigned char*)lds_raw;
    volatile LAS unsigned* misc = (volatile LAS unsigned*)(ldsb + MISC_OFF);
    if (threadIdx.x < 4) misc[threadIdx.x] = 0u;
    __syncthreads();
    XcdBarrier bar;
    { KARGS(); bar = xcd_barrier_post((unsigned*)(ARG_WS() + WS_CTL), misc, IS_T0()); }
    if (gridDim.x != 256) return;

    { MKCTX(); const float* inp[16];
#pragma unroll
      for (int i = 0; i < 16; ++i) inp[i] = ARG_IN(i);
      phase0(c, inp, ws); if (DUP & 1) phase0(c, inp, ws); }
    GRID_BAR();
    if (wave_s == 0) {
        KARGS(); unsigned* bw = (unsigned*)(ARG_WS() + WS_CTL); const int l_ = lane_id();
        const unsigned v0 = xb_ld(&bw[XB_XCCOF + l_]), v1 = xb_ld(&bw[XB_XCCOF + 64 + l_]), v2 = xb_ld(&bw[XB_XCCOF + 128 + l_]), v3 = xb_ld(&bw[XB_XCCOF + 192 + l_]);
        const unsigned ref = (unsigned)sh_idx((int)v0, l_ & 7);
        const bool bad = (v0 == 0u) || (v0 != v1) || (v0 != v2) || (v0 != v3) || (v0 != ref);
        const unsigned long long anybad = __builtin_amdgcn_ballot_w64(bad);
        if (l_ == 0) misc[2] = anybad ? 2u : 1u;
    }
    { MKCTX(); phase_rows<true>(c, ARG_IN(0), nullptr, ARG_IN(5), ARG_IN(4), (const int*)ARG_IN(2), ws, 0, 1, ARG_IN(10), ARG_IN(11)); if (DUP & 2) phase_rows<true>(c, ARG_IN(0), nullptr, ARG_IN(5), ARG_IN(4), (const int*)ARG_IN(2), ws, 0, 1, ARG_IN(10), ARG_IN(11)); }
    GRID_BAR();
    { KARGS(); unsigned char* ws = ARG_WS();
#if P2_I8
      pg8::Gemm g{(const bf16*)(ws + WS_H8), (const bf16*)(ws + WS_W8), T, INW, D / 2, D / 2, D / 2, 0}; pg8::StaticOrder S; S.init(T, INW, 256, (int)blockIdx.x);
#else
      pg8::Gemm g{(const bf16*)(ws + WS_HB), (const bf16*)(ws + WS_WTIN), T, INW, D, D, D, 0}; pg8::StaticOrder S; S.init(T, INW, 256, (int)blockIdx.x);
#endif
      Epi1 E{(bf16*)(ws + WS_Q), (const float*)(ws + WS_CS), (const float*)(ws + WS_SA), (const float*)(ws + WS_SB)};
      int nrep_ = (DUP & 4) ? 2 : 1; asm volatile("" : "+s"(nrep_));
#pragma unroll 1
      for (int rep_ = 0; rep_ < nrep_; ++rep_) { pg8::gemm_phase<Epi1, pg8::StaticOrder, false, P2_I8 ? 2 : 0>(ldsb, g, S, E, nullptr, wave_s); } }
    GRID_BAR();
#if P5_I8
    { KARGS(); unsigned char* ws = ARG_WS();
      pg8::StaticOrder S; S.init(T, PW, 256, (int)blockIdx.x); pg8::Unit u0; S.next(0, u0);
      { MKCTX(); phase_poolr(c, ws, 16 * u0.pm + u0.pn, 4, 4); }
      pg8::Gemm g{(const bf16*)(ws + WS_RB), (const bf16*)(ws + WS_WTPOOL), T, PW, 256, PW, 256, 512};
      EpiPool E{(bf16*)(ws + WS_HC), ARG_IN(8)};
      pg8::gemm_phase<EpiPool, pg8::StaticOrder, false>(ldsb, g, S, E, nullptr, wave_s); }
#else
    { MKCTX(); phase_poolr(c, ws, c.vcu, c.G, (1024 - c.vcu + c.G - 1) / c.G); if (DUP & 256) phase_poolr(c, ws, c.vcu, c.G, (1024 - c.vcu + c.G - 1) / c.G); }
#endif
#if ATTN_SIMPLE
    { MKCTX(); phase_attn_simple(c, ws); }
#else
    { MKCTX(); phase_attn_mfma(c, ws); if (DUP & 8) phase_attn_mfma(c, ws); }
#endif
    GRID_BAR();
#if !ATTN_SIMPLE
#if P5_I8
    { MKCTX(); phase_combine_q(c, ws); if (DUP & 16384) phase_combine_q(c, ws); }
#else
    { MKCTX(); phase_combine(c, ws); if (DUP & 16384) phase_combine(c, ws); }
#endif
#endif
#if !P5_I8
    { KARGS(); unsigned char* ws = ARG_WS();
      pg8::Gemm g{(const bf16*)(ws + WS_RB), (const bf16*)(ws + WS_WTPOOL), T, PW, 256, PW, 256, 512}; pg8::StaticOrder S; S.init(T, PW, 256, (int)blockIdx.x);
      EpiPool E{(bf16*)(ws + WS_HC), ARG_IN(8)};
      int nrep_ = (DUP & 16) ? 2 : 1; asm volatile("" : "+s"(nrep_));
#pragma unroll 1
      for (int rep_ = 0; rep_ < nrep_; ++rep_) { pg8::gemm_phase<EpiPool, pg8::StaticOrder, false>(ldsb, g, S, E, nullptr, wave_s); } }
#endif
    GRP_BAR();
    { KARGS(); unsigned char* ws = ARG_WS();
#if P5_I8
      pg8::Gemm g{(const bf16*)(ws + WS_HC8), (const bf16*)(ws + WS_WOUT8), T, D, D / 2, D / 2, D / 2, 0}; pg8::StaticOrder S; S.init(T, D, 256, (int)blockIdx.x);
#else
      pg8::Gemm g{(const bf16*)(ws + WS_HC), (const bf16*)(ws + WS_WTOUT), T, D, D, D, D, 0}; pg8::StaticOrder S; S.init(T, D, 256, (int)blockIdx.x);
#endif
      EpiOut E{ARG_IN(0), (bf16*)(ws + WS_X1B), (const float*)(ws + WS_MODF), (float*)(ws + WS_RSQP), (const float*)(ws + WS_SA5), (const float*)(ws + WS_SB5)};
      int nrep_ = (DUP & 32) ? 2 : 1; asm volatile("" : "+s"(nrep_));
#pragma unroll 1
      for (int rep_ = 0; rep_ < nrep_; ++rep_) { pg8::gemm_phase<EpiOut, pg8::StaticOrder, false, P5_I8 ? 2 : 0>(ldsb, g, S, E, nullptr, wave_s); } }
    GRP_BAR();
    { KARGS(); unsigned char* ws = ARG_WS();
      pg8::QOrder S; { const int bx = blockIdx.x; S.v = (bx % 8) * 32 + bx / 8; }
      pg8::Unit u0, u1; S.next(0, u0); S.next(1, u1);
      LAS float* rstdT = (LAS float*)(ldsb + 131072 + 256); LAS float* biasT = rstdT + 512;
      { const int l_ = lane_id(), tid_ = wave_s * 64 + l_, slot = tid_ >> 8, i_ = tid_ & 255; const pg8::Unit uu = slot ? u1 : u0;
        const float* rp = (const float*)(ws + WS_RSQP) + (size_t)(uu.pm * 256 + i_) * 32; float ssum = 0.f;
#pragma unroll
        for (int q = 0; q < 8; ++q) { const f32x4 v = *(const f32x4*)(rp + 4 * q); ssum += (v[0] + v[1]) + (v[2] + v[3]); }
        rstdT[slot * 256 + i_] = 1.0f / sqrtf(ssum * (1.0f / D) + NORM_EPS);
#if P5_I8
        biasT[slot * 256 + i_] = ((const float*)(ws + WS_BIASF))[(size_t)(S.v >> 5) * 4096 + (size_t)(uu.pm >= 32 ? 1 : 0) * D + uu.pn * 256 + i_]; }
#else
        const float* bp = (const float*)(ws + WS_BIASP) + (size_t)(uu.pm >= 32 ? 1 : 0) * D + uu.pn * 256 + i_; float bsum = 0.f;
#pragma unroll 8
        for (int kb = 0; kb < 32; ++kb) bsum += bp[(size_t)kb * 2 * D];
        biasT[slot * 256 + i_] = bsum; }
#endif
      __syncthreads();
      pg8::Gemm g{(const bf16*)(ws + WS_X1B), (const bf16*)(ws + WS_WQ2), T, D, D, D, D, 0, D * D * 2};
      EpiQ E{(bf16*)(ws + WS_QP), rstdT, biasT, u0.pm, u0.pn};
      int nrep_ = (DUP & 128) ? 2 : 1; asm volatile("" : "+s"(nrep_));
#pragma unroll 1
      for (int rep_ = 0; rep_ < nrep_; ++rep_) { pg8::gemm_phase<EpiQ, pg8::QOrder, false>(ldsb, g, S, E, nullptr, wave_s); } }
#if !TOPK_SIMPLE
    asm volatile("s_waitcnt vmcnt(0)" ::: "memory");
    { MKCTX(); topk_stage(c, ws); }
    __builtin_amdgcn_fence(__ATOMIC_ACQUIRE, "agent");
    asm volatile("s_waitcnt vmcnt(0)" ::: "memory");
#else
    GRID_BAR();
#endif
#if TOPK_SIMPLE
    { KARGS(); unsigned char* ws = ARG_WS();
      pg8::Gemm g{(const bf16*)(ws + WS_QP), (const bf16*)(ws + WS_SKP), T, D, 256, D, 256, 512}; pg8::StaticOrder S; S.init(T, D, 256, (int)blockIdx.x);
      EpiF E{(float*)(ws + WS_SC), D};
      pg8::gemm_phase<EpiF, pg8::StaticOrder, false>(ldsb, g, S, E, nullptr, wave_s); }
    GRID_BAR();
    { MKCTX(); phase_topk_simple(c, ws); if (DUP & 512) phase_topk_simple(c, ws); }
    GRID_BAR();
#else
    { MKCTX(); phase_scores_topk(c, ws); if (DUP & 512) phase_scores_topk(c, ws); }
    GRP_BAR();
#endif
#if PEER_BITS == 8
    { MKCTX(); phase_peer(c, ARG_OUT(), ARG_IN(15), ARG_OUT(), ws); }
#else
#if U_MFMA
    { MKCTX(); int nrep_ = (DUP & 8192) ? 2 : 1; asm volatile("" : "+s"(nrep_));
#pragma unroll 1
      for (int rep_ = 0; rep_ < nrep_; ++rep_) phase_peer4_u_mfma(c, ARG_IN(10), ws); }
#elif U_SORTED
    { MKCTX(); int nrep_ = (DUP & 8192) ? 2 : 1; asm volatile("" : "+s"(nrep_));
#pragma unroll 1
      for (int rep_ = 0; rep_ < nrep_; ++rep_) phase_peer4_u_sorted(c, ARG_IN(10), ws); }
#else
    { MKCTX(); phase_peer4_u<false>(c, ARG_IN(10), ws); }
#endif
    if (DUP & 4096) { MKCTX(); phase_peer4_u<true>(c, ARG_IN(10), ws); }
    asm volatile("s_waitcnt vmcnt(0)" ::: "memory");
#if V_MFMA && V_SORTED
    { MKCTX(); phase_peer4_v_sorted(c, ARG_IN(15), ARG_OUT(), ws); }
#elif V_MFMA
    { MKCTX(); phase_peer4_v_mfma(c, ARG_IN(15), ARG_OUT(), ws); }
#else
    { MKCTX(); phase_peer4_v(c, ARG_IN(15), ARG_OUT(), ws); }
#endif
#endif
}

extern "C" void kernel_launch(void* const* d_in, const int* in_sizes, int n_in, void* d_out, int out_size, void* d_ws, size_t ws_size, hipStream_t stream) {
    static int grid = 0;
    if (grid == 0) {
        if (n_in != 16 || in_sizes[0] != T * D || out_size != T * D || ws_size < WS_END) { fprintf(stderr, "kernel_launch: unexpected shapes (n_in %d, in0 %d, out %d, ws %zu)\n", n_in, n_in > 0 ? in_sizes[0] : -1, out_size, ws_size); grid = -1; return; }
        int dev = 0, cus = 0, per_cu = 0;
        if (hipGetDevice(&dev) != hipSuccess || hipDeviceGetAttribute(&cus, hipDeviceAttributeMultiprocessorCount, dev) != hipSuccess) { grid = -1; return; }
        if (hipFuncSetAttribute((const void*)fwd_kernel, hipFuncAttributeMaxDynamicSharedMemorySize, LDS_BYTES) != hipSuccess) { fprintf(stderr, "kernel_launch: hipFuncSetAttribute failed\n"); grid = -1; return; }
        if (hipOccupancyMaxActiveBlocksPerMultiprocessor(&per_cu, (const void*)fwd_kernel, NTHREADS, LDS_BYTES) != hipSuccess || per_cu < 1) { fprintf(stderr, "kernel_launch: occupancy query reports %d workgroups per CU\n", per_cu); }
        (void)hipGetLastError();
        grid = (cus < 256) ? cus : 256;
    }
    if (grid < 0) return;
    if (hipMemsetAsync((char*)d_ws + WS_CTL, 0, CTL_ZERO_BYTES, stream) != hipSuccess) return;
    Args a{};
    for (int i = 0; i < 16; ++i) a.in[i] = (const float*)d_in[i];
    a.out = (float*)d_out; a.ws = (unsigned char*)d_ws;
    hipLaunchKernelGGL(fwd_kernel, dim3(grid), dim3(NTHREADS), LDS_BYTES, stream, a);
}
```
